# Optimizing an MI355X kernel written in HIP

```python
import math
import jax, jax.numpy as jnp
from jax import lax
import numpy as np

D_MODEL = 1024
BATCH = 8
SEQ = 4096
DEPTH = 2

CONV_CH = 512
CONV_WIDTH = 31
DSA_HEADS = 8
DSA_HEAD_DIM = 64
IDX_HEADS = 8
IDX_DIM = 64
DSA_TOPK_MAX = 256
Q_BLOCK = 128
DIL_GROUPS = ((128, 1), (512, 4), (2048, 16))
DIL_HEADS = 8
DIL_HEAD_DIM = 128
BAND_BLOCK = 128
NUM_BUCKETS = 32
MAX_DISTANCE = 2048
N_BIAS_HEADS = 8
D_FF_DENSE = 2816
N_EXPERTS = 8
TOP_K = 2
D_FF_EXPERT = 3584
LN_EPS = 1e-5
NEG = -1e30
N_EVEN = (DEPTH + 1) // 2
N_ODD = DEPTH // 2
DEEPNORM_ALPHA = (2 * DEPTH) ** 0.25
DEEPNORM_BETA = (8 * DEPTH) ** -0.25
EVEN_IN_PARTS = (CONV_CH, CONV_CH, DSA_HEADS * DSA_HEAD_DIM, DSA_HEADS * DSA_HEAD_DIM,
                 DSA_HEADS * DSA_HEAD_DIM, IDX_HEADS * IDX_DIM, IDX_DIM, IDX_HEADS)
EVEN_IN_WIDTH = sum(EVEN_IN_PARTS)
EVEN_SPLITS = [int(s) for s in np.cumsum(EVEN_IN_PARTS)[:-1]]
EVEN_OUT_WIDTH = CONV_CH + DSA_HEADS * DSA_HEAD_DIM
ODD_IN_WIDTH = len(DIL_GROUPS) * 3 * DIL_HEADS * DIL_HEAD_DIM
ODD_OUT_WIDTH = DIL_HEADS * DIL_HEAD_DIM

kernel_name = 'hybrid_conv_dsa_dilated_moe_deepnorm'


def layer_norm(x, g, b):
    xf = x.astype(jnp.float32)
    mu = xf.mean(-1, keepdims=True)
    var = jnp.square(xf - mu).mean(-1, keepdims=True)
    y = (xf - mu) * lax.rsqrt(var + LN_EPS) * g.astype(jnp.float32) + b.astype(jnp.float32)
    return y.astype(x.dtype)


def rel_bucket(dist):
    max_exact = NUM_BUCKETS // 2
    n = dist.astype(jnp.int32)
    nf = jnp.maximum(n, 1).astype(jnp.float32)
    large = max_exact + (jnp.log(nf / max_exact) / math.log(MAX_DISTANCE / max_exact)
                         * (NUM_BUCKETS - max_exact)).astype(jnp.int32)
    large = jnp.minimum(large, NUM_BUCKETS - 1)
    return jnp.where(n < max_exact, n, large)


def conformer_conv(a_val, a_gate, conv_w, conv_b, ln_g, ln_b):
    u = a_val * jax.nn.sigmoid(a_gate)
    y = lax.conv_general_dilated(u, conv_w.astype(u.dtype)[:, None, :], (1,), [(CONV_WIDTH - 1, 0)],
                                 dimension_numbers=('NWC', 'WIO', 'NWC'), feature_group_count=CONV_CH)
    y = layer_norm(y + conv_b, ln_g, ln_b)
    return jax.nn.silu(y)


def dsa_attention(q, k, v, q_idx, k_idx, w_idx, rel_bias):
    B, S, H, Dh = q.shape
    topk = min(DSA_TOPK_MAX, S // 4)
    nqb = S // Q_BLOCK
    key_pos = jnp.arange(S, dtype=jnp.int32)
    w_scaled = w_idx.astype(jnp.float32) * (IDX_HEADS ** -0.5 * IDX_DIM ** -0.5)

    def blocks(t):
        return t.reshape((B, nqb, Q_BLOCK) + t.shape[2:]).swapaxes(0, 1)

    starts = jnp.arange(nqb, dtype=jnp.int32) * Q_BLOCK

    def one_block(args):
        qb, qib, wb, start = args
        q_pos = start + jnp.arange(Q_BLOCK, dtype=jnp.int32)
        causal = key_pos[None, :] <= q_pos[:, None]
        dots = jnp.einsum('bqhe,bse->bqhs', qib, k_idx).astype(jnp.float32)
        score = jnp.einsum('bqh,bqhs->bqs', wb, jax.nn.relu(dots))
        score = jnp.where(causal[None], score, -jnp.inf)
        _, sel = lax.top_k(score, topk)
        k_sel = jax.vmap(lambda kk, ii: kk[ii])(k, sel)
        v_sel = jax.vmap(lambda vv, ii: vv[ii])(v, sel)
        dist = q_pos[None, :, None] - sel
        bias = rel_bias[rel_bucket(jnp.maximum(dist, 0))].astype(jnp.float32)
        logits = jnp.einsum('bqhd,bqkhd->bqhk', qb, k_sel).astype(jnp.float32) * (Dh ** -0.5)
        logits = logits + bias.swapaxes(-1, -2)
        logits = jnp.where((dist >= 0)[:, :, None, :], logits, NEG)
        p = jax.nn.softmax(logits, axis=-1)
        return jnp.einsum('bqhk,bqkhd->bqhd', p.astype(v.dtype), v_sel)

    out = lax.map(one_block, (blocks(q), blocks(q_idx), blocks(w_scaled), starts))
    return out.swapaxes(0, 1).reshape(B, S, H, Dh)


def dilated_branch(q, k, v, dil, span, rel_bias):
    B, S, H, Dh = q.shape
    L = S // dil
    nb = -(-L // BAND_BLOCK)
    Lp = nb * BAND_BLOCK

    def to_sub(t):
        t = t.reshape(B, L, dil, H, Dh).transpose(0, 2, 3, 1, 4)
        t = jnp.pad(t, ((0, 0), (0, 0), (0, 0), (0, Lp - L), (0, 0)))
        return t.reshape(B, dil, H, nb, BAND_BLOCK, Dh)

    def with_prev(t):
        prev = jnp.pad(t, ((0, 0), (0, 0), (0, 0), (1, 0), (0, 0), (0, 0)))[:, :, :, :nb]
        return jnp.concatenate([prev, t], axis=4)

    qs = to_sub(q)
    kk = with_prev(to_sub(k))
    vv = with_prev(to_sub(v))
    logits = jnp.einsum('bghnqe,bghnke->bghnqk', qs, kk).astype(jnp.float32) * (Dh ** -0.5)
    i = jnp.arange(BAND_BLOCK, dtype=jnp.int32)[:, None]
    j = jnp.arange(2 * BAND_BLOCK, dtype=jnp.int32)[None, :]
    dist = BAND_BLOCK + i - j
    bias = rel_bias[rel_bucket(jnp.maximum(dist, 0) * dil)]
    bias = jnp.moveaxis(bias, -1, 0).astype(jnp.float32)
    blk = jnp.arange(nb, dtype=jnp.int32)[:, None, None]
    valid = (dist >= 0) & (dist <= span) & ((blk > 0) | (j >= BAND_BLOCK))
    logits = jnp.where(valid, logits + bias[:, None], NEG)
    m = logits.max(-1, keepdims=True)
    p = jnp.exp(logits - m)
    s = p.sum(-1, keepdims=True)
    o = jnp.einsum('bghnqk,bghnke->bghnqe', p.astype(vv.dtype), vv).astype(jnp.float32) / s
    lse = (m + jnp.log(s))[..., 0]

    def from_sub(t):
        t = t.reshape((B, dil, H, Lp) + t.shape[5:])[:, :, :, :L]
        t = jnp.moveaxis(t, 3, 1)
        return t.reshape((B, S, H) + t.shape[4:])

    return from_sub(o), from_sub(lse)


def swiglu(x, wg, wu, wd):
    return (jax.nn.silu(x @ wg) * (x @ wu)) @ wd


def moe_swiglu(x, router, wg, wu, wd):
    B, S, D = x.shape
    xt = x.reshape(-1, D)
    logits = (xt @ router).astype(jnp.float32)
    top_val, top_idx = lax.top_k(logits, TOP_K)
    gate_w = jax.nn.softmax(top_val, axis=-1)
    gates = jnp.sum(jax.nn.one_hot(top_idx, N_EXPERTS, dtype=jnp.float32) * gate_w[..., None], axis=1)
    y = jnp.zeros(xt.shape, jnp.float32)
    for e in range(N_EXPERTS):
        h = jax.nn.silu(xt @ wg[e]) * (xt @ wu[e])
        y = y + gates[:, e:e + 1] * (h @ wd[e]).astype(jnp.float32)
    return y.astype(x.dtype).reshape(B, S, D)


def even_layer(x, rel_bias, w_in, conv_w, conv_b, conv_ln_g, conv_ln_b, w_out, ln1_g, ln1_b,
               ffn_wg, ffn_wu, ffn_wd, ln2_g, ln2_b):
    B, S, _ = x.shape
    h = x @ w_in
    a_val, a_gate, q, k, v, q_idx, k_idx, w_idx = jnp.split(h, EVEN_SPLITS, axis=-1)
    a_out = conformer_conv(a_val, a_gate, conv_w, conv_b, conv_ln_g, conv_ln_b)
    hd = (B, S, DSA_HEADS, DSA_HEAD_DIM)
    att = dsa_attention(q.reshape(hd), k.reshape(hd), v.reshape(hd),
                        q_idx.reshape(B, S, IDX_HEADS, IDX_DIM), k_idx, w_idx, rel_bias)
    mix = jnp.concatenate([a_out, att.reshape(B, S, -1).astype(a_out.dtype)], axis=-1) @ w_out
    x = layer_norm(DEEPNORM_ALPHA * x + mix, ln1_g, ln1_b)
    return layer_norm(DEEPNORM_ALPHA * x + swiglu(x, ffn_wg, ffn_wu, ffn_wd), ln2_g, ln2_b)


def odd_layer(x, rel_bias, w_in, w_out, ln1_g, ln1_b, router, moe_wg, moe_wu, moe_wd, ln2_g, ln2_b):
    B, S, _ = x.shape
    h = (x @ w_in).reshape(B, S, len(DIL_GROUPS), 3, DIL_HEADS, DIL_HEAD_DIM)
    outs, lses = [], []
    for g, (window, dil) in enumerate(DIL_GROUPS):
        o, lse = dilated_branch(h[:, :, g, 0], h[:, :, g, 1], h[:, :, g, 2], dil, window // dil, rel_bias)
        outs.append(o)
        lses.append(lse)
    wts = jax.nn.softmax(jnp.stack(lses), axis=0)
    o = jnp.sum(wts[..., None] * jnp.stack(outs), axis=0)
    mix = o.astype(x.dtype).reshape(B, S, ODD_OUT_WIDTH) @ w_out
    x = layer_norm(DEEPNORM_ALPHA * x + mix, ln1_g, ln1_b)
    return layer_norm(DEEPNORM_ALPHA * x + moe_swiglu(x, router, moe_wg, moe_wu, moe_wd), ln2_g, ln2_b)


def setup_inputs(seed: int = 0) -> dict:
    key = jax.random.key(seed)
    ks = jax.random.split(key, 32)
    nrm = lambda k, shape, scale: jax.random.normal(k, shape, jnp.float32) * scale
    D = D_MODEL
    return {
        'x': nrm(ks[0], (BATCH, SEQ, D), 1.0),
        'rel_bias': nrm(ks[1], (NUM_BUCKETS, N_BIAS_HEADS), 0.2),
        'even_w_in': nrm(ks[2], (N_EVEN, D, EVEN_IN_WIDTH), D ** -0.5),
        'even_conv_w': nrm(ks[3], (N_EVEN, CONV_WIDTH, CONV_CH), CONV_WIDTH ** -0.5),
        'even_conv_b': nrm(ks[4], (N_EVEN, CONV_CH), 0.02),
        'even_conv_ln_g': 1.0 + nrm(ks[5], (N_EVEN, CONV_CH), 0.02),
        'even_conv_ln_b': nrm(ks[6], (N_EVEN, CONV_CH), 0.02),
        'even_w_out': nrm(ks[7], (N_EVEN, EVEN_OUT_WIDTH, D), EVEN_OUT_WIDTH ** -0.5 * DEEPNORM_BETA),
        'even_ln1_g': 1.0 + nrm(ks[8], (N_EVEN, D), 0.02),
        'even_ln1_b': nrm(ks[9], (N_EVEN, D), 0.02),
        'even_ffn_wg': nrm(ks[10], (N_EVEN, D, D_FF_DENSE), D ** -0.5),
        'even_ffn_wu': nrm(ks[11], (N_EVEN, D, D_FF_DENSE), D ** -0.5),
        'even_ffn_wd': nrm(ks[12], (N_EVEN, D_FF_DENSE, D), D_FF_DENSE ** -0.5 * DEEPNORM_BETA),
        'even_ln2_g': 1.0 + nrm(ks[13], (N_EVEN, D), 0.02),
        'even_ln2_b': nrm(ks[14], (N_EVEN, D), 0.02),
        'odd_w_in': nrm(ks[15], (N_ODD, D, ODD_IN_WIDTH), D ** -0.5),
        'odd_w_out': nrm(ks[16], (N_ODD, ODD_OUT_WIDTH, D), ODD_OUT_WIDTH ** -0.5 * DEEPNORM_BETA),
        'odd_ln1_g': 1.0 + nrm(ks[17], (N_ODD, D), 0.02),
        'odd_ln1_b': nrm(ks[18], (N_ODD, D), 0.02),
        'odd_router': nrm(ks[19], (N_ODD, D, N_EXPERTS), D ** -0.5),
        'odd_moe_wg': nrm(ks[20], (N_ODD, N_EXPERTS, D, D_FF_EXPERT), D ** -0.5),
        'odd_moe_wu': nrm(ks[21], (N_ODD, N_EXPERTS, D, D_FF_EXPERT), D ** -0.5),
        'odd_moe_wd': nrm(ks[22], (N_ODD, N_EXPERTS, D_FF_EXPERT, D), D_FF_EXPERT ** -0.5 * DEEPNORM_BETA),
        'odd_ln2_g': 1.0 + nrm(ks[23], (N_ODD, D), 0.02),
        'odd_ln2_b': nrm(ks[24], (N_ODD, D), 0.02),
    }


def reference(x, rel_bias, even_w_in, even_conv_w, even_conv_b, even_conv_ln_g, even_conv_ln_b,
              even_w_out, even_ln1_g, even_ln1_b, even_ffn_wg, even_ffn_wu, even_ffn_wd,
              even_ln2_g, even_ln2_b, odd_w_in, odd_w_out, odd_ln1_g, odd_ln1_b, odd_router,
              odd_moe_wg, odd_moe_wu, odd_moe_wd, odd_ln2_g, odd_ln2_b):
    for layer in range(DEPTH):
        i = layer // 2
        if layer % 2 == 0:
            x = even_layer(x, rel_bias, even_w_in[i], even_conv_w[i], even_conv_b[i], even_conv_ln_g[i],
                           even_conv_ln_b[i], even_w_out[i], even_ln1_g[i], even_ln1_b[i],
                           even_ffn_wg[i], even_ffn_wu[i], even_ffn_wd[i], even_ln2_g[i], even_ln2_b[i])
        else:
            x = odd_layer(x, rel_bias, odd_w_in[i], odd_w_out[i], odd_ln1_g[i], odd_ln1_b[i], odd_router[i],
                          odd_moe_wg[i], odd_moe_wu[i], odd_moe_wd[i], odd_ln2_g[i], odd_ln2_b[i])
    return x
```

```cpp
#include <hip/hip_runtime.h>
#include <cstdio>
#include <cstdint>

#ifndef ONE_LAUNCH
#define ONE_LAUNCH 0
#endif

#define LAS __attribute__((address_space(3)))
typedef unsigned short bf16_t;
typedef short bf16x8 __attribute__((ext_vector_type(8)));
typedef float f32x4 __attribute__((ext_vector_type(4)));
typedef float f32x2 __attribute__((ext_vector_type(2)));
typedef unsigned u32x4 __attribute__((ext_vector_type(4)));
typedef unsigned u32x2 __attribute__((ext_vector_type(2)));
typedef unsigned long long u64;

constexpr int NB = 8, SEQ = 4096, DM = 1024, NTOK = NB * SEQ;
constexpr int IN0_SRC = 3144, IN0_N = 3328;
constexpr int FF0 = 2816, FFE = 3584, NEXP = 8;
constexpr int IN1_N = 9216;
constexpr int CHUNK_B = 4, CHUNK_T = CHUNK_B * SEQ;
constexpr int MOE_CH_TILES = 132;
constexpr int HM_DOUT_TILES = 73;
constexpr float ALPHA = 1.4142135623730951f;
constexpr float LN_EPS = 1e-5f;
constexpr int NWAVES = 8, NTHR = 512;

constexpr size_t MiB = 1u << 20;
constexpr size_t WS_CTL = 0, CTL_ZERO_BYTES = 64 * 1024;
constexpr size_t WS_BIAST = 1 * MiB;
constexpr size_t WS_MOE_TOK = 2 * MiB;
constexpr size_t WS_MOE_GATE = 3 * MiB;
constexpr size_t WS_WIN0 = 4 * MiB;
constexpr size_t WS_WOUT0 = 11 * MiB;
constexpr size_t WS_WGU0 = 13 * MiB;
constexpr size_t WS_WD0 = 24 * MiB;
constexpr size_t WS_WIN1 = 30 * MiB;
constexpr size_t WS_WOUT1 = 48 * MiB;
constexpr size_t WS_XB = 50 * MiB;
constexpr size_t WS_U = 114 * MiB;
constexpr size_t WS_Q0 = 146 * MiB, SEG0 = 32 * MiB;
constexpr size_t WS_KI = 274 * MiB;
constexpr size_t WS_WI = 278 * MiB;
constexpr size_t WS_MASK = 280 * MiB;
constexpr size_t WS_MIXIN = 296 * MiB;
constexpr size_t WS_X1B = 50 * MiB;
constexpr size_t WS_H0 = 114 * MiB;
constexpr size_t WS_X2B = 448 * MiB;
constexpr size_t WS_H1 = 50 * MiB;
constexpr size_t WS_Y3 = 216 * MiB;
constexpr size_t WS_X3B = 152 * MiB;
constexpr size_t WS_YB = 216 * MiB;
constexpr size_t WS_MWGU = 344 * MiB;
constexpr size_t WS_MWD = 456 * MiB;
constexpr size_t WS_HM = 4 * MiB;
constexpr size_t WS_END = 512 * MiB;
constexpr size_t HM_TILE_BYTES = (size_t)256 * FFE * 2;
constexpr int CW_MOECNT = 64;
constexpr int CW_BAR = 1024;

constexpr int LDS_GTAB = 131072;
constexpr int LDS_RT = 147456;
constexpr int LDS_MISC = 155648 + 2048;
constexpr int LDS_BYTES = 159744;

__device__ __forceinline__ unsigned cvt_pk_bf16(float lo, float hi) { unsigned r; asm volatile("v_cvt_pk_bf16_f32 %0, %1, %2" : "=v"(r) : "v"(lo), "v"(hi)); return r; }
__device__ __forceinline__ float bf_lo(unsigned w) { return __uint_as_float(w << 16); }
__device__ __forceinline__ float bf_hi(unsigned w) { return __uint_as_float(w & 0xffff0000u); }
__device__ __forceinline__ float bf2f(bf16_t b) { return __uint_as_float(((unsigned)b) << 16); }
__device__ __forceinline__ float wave_sum(float v) {
#pragma unroll
    for (int o = 1; o < 64; o <<= 1) v += __shfl_xor(v, o);
    return v;
}
__device__ __forceinline__ float wave_max(float v) {
#pragma unroll
    for (int o = 1; o < 64; o <<= 1) v = fmaxf(v, __shfl_xor(v, o));
    return v;
}
__device__ __forceinline__ float sigmoidf_(float x) { return __builtin_amdgcn_rcpf(1.0f + __expf(-x)); }
#define WAVE_LDS_FENCE() do { asm volatile("s_waitcnt lgkmcnt(0)" ::: "memory"); __builtin_amdgcn_wave_barrier(); } while (0)

#define XB_TMO      128
#define XB_XCNT(j)  (256  + 64 * (j))
#define XB_XSUB(j)  (1280 + 64 * (j))
#define XB_XGEN(j)  (2304 + 64 * (j))
#define XB_TOP      3328
#define XB_TOPGEN   3392
#define XCD_BAR_WORDS 3456
#define XB_SPIN_CAP (1u << 18)
__device__ __forceinline__ unsigned xb_ld(unsigned* p)              { return __hip_atomic_load(p, __ATOMIC_RELAXED, __HIP_MEMORY_SCOPE_AGENT); }
__device__ __forceinline__ unsigned xb_add(unsigned* p, unsigned v) { return __hip_atomic_fetch_add(p, v, __ATOMIC_RELAXED, __HIP_MEMORY_SCOPE_AGENT); }
__device__ __forceinline__ unsigned xb_xcc_id() { return (unsigned)__builtin_amdgcn_s_getreg((3 << 11) | 20) & 0xFu; }
#define XB_SPIN(cond, bar) do { unsigned _sp = 0; while (cond) { __builtin_amdgcn_s_sleep(1); \
    if ((++_sp & 255u) == 0u) { if (xb_ld(&(bar)[XB_TMO])) break; if (_sp > XB_SPIN_CAP) { atomicAdd(&(bar)[XB_TMO], 1u); break; } } } } while (0)
struct XcdBarrier { unsigned* bar; unsigned x; volatile LAS unsigned* st; };
__device__ __forceinline__ XcdBarrier xcd_barrier_post(unsigned* bar, volatile LAS unsigned* st, bool leader) {
    XcdBarrier b; b.bar = bar; b.x = xb_xcc_id(); b.st = st;
    if (leader) (void)xb_add(&bar[XB_XCNT(b.x)], 1u);
    return b;
}
__device__ __forceinline__ void xcd_barrier_complete(unsigned* bar, unsigned x, unsigned& nloc, unsigned& nx) {
    const unsigned G = gridDim.x * gridDim.y * gridDim.z;
    unsigned sum, cnt, mine, sp = 0u;
    for (;;) {
        sum = 0u; cnt = 0u; mine = 0u;
#pragma unroll
        for (unsigned j = 0; j < 16; ++j) { const unsigned c = xb_ld(&bar[XB_XCNT(j)]); sum += c; cnt += (c > 0u) ? 1u : 0u; mine = (j == x) ? c : mine; }
        if (sum == G) break;
        __builtin_amdgcn_s_sleep(1);
        if ((++sp & 255u) == 0u) { if (xb_ld(&bar[XB_TMO])) break; if (sp > XB_SPIN_CAP) { atomicAdd(&bar[XB_TMO], 1u); break; } }
    }
    nloc = mine > 0u ? mine : 1u; nx = cnt > 0u ? cnt : 1u;
}
__device__ __forceinline__ void xcd_barrier(const XcdBarrier& b, bool leader) {
    asm volatile("s_waitcnt vmcnt(0)" ::: "memory");
    __syncthreads();
    if (leader) {
        unsigned* bar = b.bar;
        __builtin_amdgcn_s_waitcnt(0);
        unsigned nloc = b.st[0], nx = b.st[1];
        if (nloc == 0u) { xcd_barrier_complete(bar, b.x, nloc, nx); b.st[0] = nloc; b.st[1] = nx; }
        const unsigned old = xb_add(&bar[XB_XSUB(b.x)], 1u);
        const unsigned gen = old / nloc;
        if (old + 1u == (gen + 1u) * nloc) {
            __builtin_amdgcn_fence(__ATOMIC_RELEASE, "agent");
            asm volatile("s_waitcnt vmcnt(0)" ::: "memory");
            const unsigned og = xb_add(&bar[XB_TOP], 1u);
            const unsigned tg = og / nx;
            if (og + 1u == (tg + 1u) * nx) xb_add(&bar[XB_TOPGEN], 1u);
            else XB_SPIN(xb_ld(&bar[XB_TOPGEN]) == tg, bar);
            __builtin_amdgcn_fence(__ATOMIC_ACQUIRE, "agent");
            xb_add(&bar[XB_XGEN(b.x)], 1u);
            asm volatile("s_waitcnt vmcnt(0)" ::: "memory");
        } else {
            XB_SPIN(xb_ld(&bar[XB_XGEN(b.x)]) == gen, bar);
            __builtin_amdgcn_fence(__ATOMIC_ACQUIRE, "agent");
            asm volatile("s_waitcnt vmcnt(0)" ::: "memory");
        }
    }
    __syncthreads();
}

namespace pg8 {
constexpr int BM = 256, BK = 64, HALF = 128, HTB = HALF * BK * 2, STAGE_BYTES = 8 * HTB, NXCD = 8, WGM = 8;
__host__ __device__ __forceinline__ int lds_byte(int r, int c) { const int st = (r >> 4) * 2 + (c >> 5), rr = r & 15, cc = c & 31, ob = rr * 64 + cc * 2; return st * 1024 + (ob ^ (((ob >> 9) & 1) << 5)); }
__host__ __device__ __forceinline__ void stage_rc(int b, int& R, int& C) { const int st = b / 1024, sb = b % 1024, swz = sb ^ (((sb >> 9) & 1) << 5); R = (st >> 1) * 16 + swz / 64; C = (st & 1) * 32 + (swz % 64) / 2; }
__host__ __device__ __forceinline__ int perm32(int rho) { const int n = rho >> 4, i = rho & 15; return 8 * (i >> 2) + 4 * n + (i & 3); }

struct Unit { int pm, pn; };

__device__ __forceinline__ void remap_unit(int wgid, int nM, int nN, int& pm, int& pn) {
    const int nwg = nM * nN;
    { const int q = nwg / NXCD, r = nwg % NXCD, xcd = wgid % NXCD, off = wgid / NXCD; wgid = (xcd < r ? xcd * (q + 1) : r * (q + 1) + (xcd - r) * q) + off; }
    const int nig = WGM * nN, gid = wgid / nig, fm = gid * WGM, gsz = (nM - fm) < WGM ? (nM - fm) : WGM;
    pm = fm + ((wgid % nig) % gsz); pn = (wgid % nig) / gsz;
}
struct StaticOrder {
    int nM, nN, nwg, G, c; const char* A; size_t tstepA;
    __device__ void init(const bf16_t* A_, int M, int N, int K, int G_, int c_) { nM = M / BM; nN = N / BM; nwg = nM * nN; G = G_; c = c_; A = (const char*)A_; tstepA = (size_t)BM * K * 2; }
    __device__ __forceinline__ bool next(int i, Unit& u) const {
        const long L = (long)i * G + c; if (L >= nwg) return false;
        remap_unit((int)L, nM, nN, u.pm, u.pn); return true;
    }
    __device__ __forceinline__ const char* a_ptr(const Unit& u) const { return A + (size_t)u.pm * tstepA; }
    __device__ __forceinline__ int b_tile(const Unit& u) const { return u.pn; }
};

#define PG8_LAS __attribute__((address_space(3)))
template <class Epi, class Sched, bool ALIGN_EPI, bool GATHER>
__device__ __forceinline__ void gemm_phase(const int tid, PG8_LAS unsigned char* lds, const bf16_t* Btp, const int K, const Sched& S, const Epi& E, const PG8_LAS int* gtab) {
    const int wid = __builtin_amdgcn_readfirstlane(tid >> 6), lane = tid & 63, wr = wid >> 2, wc = wid & 3, fr = lane & 15, fq = lane >> 4;
    const int nt = K / BK;
    unsigned voffA[2], voffB[2];
#pragma unroll
    for (int i = 0; i < 2; ++i) { int R, C; stage_rc(tid * 16 + i * 8192, R, C); const int Rb = Epi::PERM ? ((R & ~31) + perm32(R & 31)) : R;
        voffA[i] = (unsigned)(R * K + C) * 2u; voffB[i] = (unsigned)(Rb * K + C) * 2u; }
    const size_t kstep = (size_t)(BK * 2);
    const size_t hstep = (size_t)HALF * K * 2;
    const size_t tstep = 2 * hstep;
    const unsigned ldsw = (unsigned)wid * 1024u;
    const int aoff = lds_byte(wr * 64 + fr, fq * 8), boff = lds_byte(wc * 32 + fr, fq * 8);
#define PG8_SA(b, h) (((b) * 2 + (h)) * HTB)
#define PG8_SB(b, h) ((4 + (b) * 2 + (h)) * HTB)
#define PG8_STAGE(bufoff, gbase, voff) do { _Pragma("unroll") for (int _i = 0; _i < 2; ++_i) \
        __builtin_amdgcn_global_load_lds((const unsigned*)((const char*)(gbase) + (voff)[_i]), (PG8_LAS unsigned*)(lds + (bufoff) + ldsw + _i * 8192), 16, 0, 0); } while (0)
#define PG8_STAGE_AC(bufoff, kt, h) do { if constexpr (GATHER) { PG8_STAGE(bufoff, cA + (size_t)(kt) * kstep, gcur[h]); } else { PG8_STAGE(bufoff, cA + (size_t)(kt) * kstep + (h) * hstep, voffA); } } while (0)
#define PG8_STAGE_AN(bufoff, d, h) do { if constexpr (GATHER) { if (last) { unsigned _g[2]; _Pragma("unroll") for (int _i = 0; _i < 2; ++_i) { int _R, _C; stage_rc(tid * 16 + _i * 8192, _R, _C); _g[_i] = (unsigned)gtab[nslot * 256 + (h) * 128 + _R] * (unsigned)(K * 2) + (unsigned)(_C * 2); } \
            PG8_STAGE(bufoff, nA + (size_t)(d) * kstep, _g); } else { PG8_STAGE(bufoff, cA + (size_t)(t + 2 + (d)) * kstep, gcur[h]); } } \
        else { PG8_STAGE(bufoff, a2 + (size_t)(d) * kstep + (h) * hstep, voffA); } } while (0)
#define PG8_LDA(dst, b, h) do { _Pragma("unroll") for (int m = 0; m < 4; ++m) _Pragma("unroll") for (int k = 0; k < 2; ++k) dst[m][k] = *(const PG8_LAS bf16x8*)(lds + PG8_SA(b, h) + aoff + m * 2048 + k * 1024); } while (0)
#define PG8_LDB(dst, b, h) do { _Pragma("unroll") for (int n = 0; n < 2; ++n) _Pragma("unroll") for (int k = 0; k < 2; ++k) dst[n][k] = *(const PG8_LAS bf16x8*)(lds + PG8_SB(b, h) + boff + n * 2048 + k * 1024); } while (0)
#define PG8_MMA(ai, bj, At, Bt) do { __builtin_amdgcn_s_setprio(1); _Pragma("unroll") for (int m = 0; m < 4; ++m) _Pragma("unroll") for (int n = 0; n < 2; ++n) _Pragma("unroll") for (int k = 0; k < 2; ++k) \
        acc[ai][bj][m][n] = __builtin_amdgcn_mfma_f32_16x16x32_bf16(Bt[n][k], At[m][k], acc[ai][bj][m][n], 0, 0, 0); __builtin_amdgcn_s_setprio(0); } while (0)
#define PG8_WAIT_V(n) asm volatile("s_waitcnt vmcnt(" #n ")" ::: "memory")
#define PG8_WAIT_L(n) asm volatile("s_waitcnt lgkmcnt(" #n ")" ::: "memory")
#define PG8_BAR __builtin_amdgcn_s_barrier()
#define PG8_SCHED __builtin_amdgcn_sched_barrier(0)
#define PG8_LOADG(dst, slot_) do { _Pragma("unroll") for (int _i = 0; _i < 2; ++_i) { int _R, _C; stage_rc(tid * 16 + _i * 8192, _R, _C); _Pragma("unroll") for (int _h = 0; _h < 2; ++_h) \
        dst[_h][_i] = (unsigned)gtab[(slot_) * 256 + _h * 128 + _R] * (unsigned)(K * 2) + (unsigned)(_C * 2); } } while (0)
    Unit cur, nxt; int ui = 0;
    if (!S.next(0, cur)) return;
    f32x4 acc[2][2][4][2];
#pragma unroll
    for (int a = 0; a < 2; ++a)
#pragma unroll
        for (int b = 0; b < 2; ++b)
#pragma unroll
            for (int m = 0; m < 4; ++m)
#pragma unroll
                for (int n = 0; n < 2; ++n) acc[a][b][m][n] = (f32x4){0.f, 0.f, 0.f, 0.f};
    bf16x8 At[4][2], B0[2][2], B1[2][2];
    unsigned gcur[2][2] = {{0u, 0u}, {0u, 0u}};
    const char* cA = S.a_ptr(cur); const char* cB = (const char*)Btp + (size_t)S.b_tile(cur) * tstep;
    if constexpr (GATHER) { PG8_LOADG(gcur, 0); PG8_WAIT_L(0); }
    PG8_STAGE(PG8_SB(0, 0), cB, voffB); PG8_STAGE(PG8_SB(0, 1), cB + hstep, voffB); PG8_STAGE_AC(PG8_SA(0, 0), 0, 0); PG8_STAGE_AC(PG8_SA(0, 1), 0, 1);
    if (wr == 1) PG8_BAR;
    PG8_WAIT_V(2); PG8_BAR;
    PG8_STAGE(PG8_SB(1, 0), cB + kstep, voffB); PG8_STAGE_AC(PG8_SA(1, 0), 1, 0); PG8_STAGE(PG8_SB(1, 1), cB + hstep + kstep, voffB);
    PG8_WAIT_V(6); PG8_BAR;
    for (;;) {
        const bool has_next = S.next(ui + 1, nxt);
        const char* nA = has_next ? S.a_ptr(nxt) : cA; const char* nB = has_next ? (const char*)Btp + (size_t)S.b_tile(nxt) * tstep : cB;
        const int nslot = has_next ? ui + 1 : ui;
        for (int t = 0; t < nt; t += 2) {
            const bool last = (t == nt - 2);
            const char* a2 = last ? nA : cA + (size_t)(t + 2) * kstep; const char* b2 = last ? nB : cB + (size_t)(t + 2) * kstep;
            const char* b3 = b2 + kstep;
            (void)a2;
            PG8_LDB(B0, 0, 0); PG8_LDB(B1, 0, 1); PG8_SCHED; PG8_LDA(At, 0, 0); PG8_STAGE_AC(PG8_SA(1, 1), t + 1, 1);
            PG8_WAIT_V(8); PG8_WAIT_L(0); PG8_BAR; PG8_MMA(0, 0, At, B0); PG8_MMA(0, 1, At, B1); PG8_BAR; PG8_SCHED;
            PG8_LDA(At, 0, 1); PG8_STAGE(PG8_SB(0, 0), b2, voffB); PG8_STAGE(PG8_SB(0, 1), b2 + hstep, voffB); PG8_STAGE_AN(PG8_SA(0, 0), 0, 0);
            PG8_WAIT_V(8); PG8_WAIT_L(0); PG8_BAR; PG8_MMA(1, 0, At, B0); PG8_MMA(1, 1, At, B1); PG8_BAR; PG8_SCHED;
            PG8_LDB(B0, 1, 0); PG8_LDB(B1, 1, 1); PG8_SCHED; PG8_LDA(At, 1, 0); PG8_STAGE_AN(PG8_SA(0, 1), 0, 1);
            PG8_WAIT_V(8); PG8_WAIT_L(0); PG8_BAR; PG8_MMA(0, 0, At, B0); PG8_MMA(0, 1, At, B1); PG8_BAR; PG8_SCHED;
            PG8_LDA(At, 1, 1); PG8_STAGE(PG8_SB(1, 0), b3, voffB); PG8_STAGE(PG8_SB(1, 1), b3 + hstep, voffB); PG8_STAGE_AN(PG8_SA(1, 0), 1, 0);
            PG8_WAIT_V(8); PG8_WAIT_L(0); PG8_BAR; PG8_MMA(1, 0, At, B0); PG8_MMA(1, 1, At, B1); PG8_BAR; PG8_SCHED;
        }
        if constexpr (ALIGN_EPI) { if (wr == 0) PG8_BAR; }
        { int fr_e = fr, fq_e = fq; asm volatile("" : "+v"(fr_e), "+v"(fq_e)); E(acc, cur, wr, wc, fr_e, fq_e); }
        if (!has_next) break;
#pragma unroll
        for (int a = 0; a < 2; ++a)
#pragma unroll
            for (int b = 0; b < 2; ++b)
#pragma unroll
                for (int m = 0; m < 4; ++m)
#pragma unroll
                    for (int n = 0; n < 2; ++n) acc[a][b][m][n] = (f32x4){0.f, 0.f, 0.f, 0.f};
        cur = nxt; cA = nA; cB = nB; ++ui;
        if constexpr (GATHER) { PG8_LOADG(gcur, ui); }
        if constexpr (ALIGN_EPI) { if (wr == 1) PG8_BAR; }
    }
    PG8_WAIT_V(0);
    if constexpr (!ALIGN_EPI) { if (wr == 0) PG8_BAR; }
    PG8_BAR;
#undef PG8_SA
#undef PG8_SB
#undef PG8_STAGE
#undef PG8_STAGE_AC
#undef PG8_STAGE_AN
#undef PG8_LDA
#undef PG8_LDB
#undef PG8_MMA
#undef PG8_WAIT_V
#undef PG8_WAIT_L
#undef PG8_BAR
#undef PG8_SCHED
#undef PG8_LOADG
}

typedef f32x4 AccT[2][2][4][2];
__device__ __forceinline__ u32x4 pack8(const f32x4 v0, const f32x4 v1) { u32x4 w; w.x = cvt_pk_bf16(v0[0], v0[1]); w.y = cvt_pk_bf16(v0[2], v0[3]); w.z = cvt_pk_bf16(v1[0], v1[1]); w.w = cvt_pk_bf16(v1[2], v1[3]); return w; }

struct EpiIn0 {
    static constexpr bool PERM = true;
    bf16_t* U; bf16_t* Q; bf16_t* KI; float* WI;
    __device__ __forceinline__ void operator()(const AccT& acc, const Unit& u, int wr, int wc, int fr, int fq) const {
        const int row0 = u.pm * BM + wr * 64 + fr;
        if (u.pn < 4) {
            const int col0 = u.pn * 128 + wc * 32 + 8 * fq;
#pragma unroll
            for (int ai = 0; ai < 2; ++ai)
#pragma unroll
                for (int m = 0; m < 4; ++m) { f32x4 o0, o1;
#pragma unroll
                    for (int j = 0; j < 4; ++j) { o0[j] = acc[ai][0][m][0][j] * sigmoidf_(acc[ai][1][m][0][j]); o1[j] = acc[ai][0][m][1][j] * sigmoidf_(acc[ai][1][m][1][j]); }
                    *(u32x4*)(U + (size_t)(row0 + ai * HALF + m * 16) * 512 + col0) = pack8(o0, o1); }
        } else if (u.pn < 12) {
            const int t = (u.pn - 4) >> 1; bf16_t* base = Q + (size_t)t * (SEG0 / 2); const float sc = (t == 0) ? 0.125f : 1.0f;
            const int col0 = ((u.pn - 4) & 1) * 256 + wc * 32 + 8 * fq;
#pragma unroll
            for (int ai = 0; ai < 2; ++ai)
#pragma unroll
                for (int m = 0; m < 4; ++m)
#pragma unroll
                    for (int bj = 0; bj < 2; ++bj)
                        *(u32x4*)(base + (size_t)(row0 + ai * HALF + m * 16) * 512 + col0 + bj * HALF) = pack8(acc[ai][bj][m][0] * sc, acc[ai][bj][m][1] * sc);
        } else {
            if (wc < 2) {
#pragma unroll
                for (int ai = 0; ai < 2; ++ai)
#pragma unroll
                    for (int m = 0; m < 4; ++m) *(u32x4*)(KI + (size_t)(row0 + ai * HALF + m * 16) * 64 + wc * 32 + 8 * fq) = pack8(acc[ai][0][m][0], acc[ai][0][m][1]);
            } else if (wc == 2 && fq == 0) {
                const float sc = 0.04419417382415922f;
#pragma unroll
                for (int ai = 0; ai < 2; ++ai)
#pragma unroll
                    for (int m = 0; m < 4; ++m) { float* p = WI + (size_t)(row0 + ai * HALF + m * 16) * 8; *(f32x4*)p = acc[ai][0][m][0] * sc; *(f32x4*)(p + 4) = acc[ai][0][m][1] * sc; }
            }
        }
    }
};
template <bool RB> struct EpiRes {
    static constexpr bool PERM = false;
    float* out; const void* resid;
    __device__ __forceinline__ void operator()(const AccT& acc, const Unit& u, int wr, int wc, int fr, int fq) const {
        const int row0 = u.pm * BM + wr * 64 + fr, col0 = u.pn * BM + wc * 32 + 4 * fq;
#pragma unroll
        for (int ai = 0; ai < 2; ++ai)
#pragma unroll
            for (int m = 0; m < 4; ++m) { const size_t off = (size_t)(row0 + ai * HALF + m * 16) * DM + col0;
#pragma unroll
                for (int bj = 0; bj < 2; ++bj)
#pragma unroll
                    for (int n = 0; n < 2; ++n) { f32x4 r;
                        if (RB) { const u32x2 w = *(const u32x2*)((const bf16_t*)resid + off + bj * HALF + n * 16); r = (f32x4){bf_lo(w.x), bf_hi(w.x), bf_lo(w.y), bf_hi(w.y)}; }
                        else r = *(const f32x4*)((const float*)resid + off + bj * HALF + n * 16);
                        *(f32x4*)(out + off + bj * HALF + n * 16) = r * ALPHA + acc[ai][bj][m][n]; } }
    }
};
__device__ __forceinline__ char* hm_tile(char* dout, char* ws, int p) { return p < HM_DOUT_TILES ? dout + (size_t)p * HM_TILE_BYTES : ws + WS_HM + (size_t)(p - HM_DOUT_TILES) * HM_TILE_BYTES; }
template <bool TILE_LOCAL> struct EpiSwiglu {
    static constexpr bool PERM = true;
    bf16_t* H; int ldh; char* dout; char* ws;
    __device__ __forceinline__ void operator()(const AccT& acc, const Unit& u, int wr, int wc, int fr, int fq) const {
        bf16_t* base; if constexpr (TILE_LOCAL) base = (bf16_t*)hm_tile(dout, ws, u.pm); else base = H + (size_t)u.pm * BM * ldh;
        const int rl0 = wr * 64 + fr, col0 = u.pn * 128 + wc * 32 + 8 * fq;
#pragma unroll
        for (int ai = 0; ai < 2; ++ai)
#pragma unroll
            for (int m = 0; m < 4; ++m) { f32x4 o0, o1;
#pragma unroll
                for (int j = 0; j < 4; ++j) { const float g0 = acc[ai][0][m][0][j], g1 = acc[ai][0][m][1][j];
                    o0[j] = g0 * sigmoidf_(g0) * acc[ai][1][m][0][j]; o1[j] = g1 * sigmoidf_(g1) * acc[ai][1][m][1][j]; }
                *(u32x4*)(base + (size_t)(rl0 + ai * HALF + m * 16) * ldh + col0) = pack8(o0, o1); }
    }
};
struct EpiQkv1 {
    static constexpr bool PERM = true;
    bf16_t* O; int ldc; float qscale;
    __device__ __forceinline__ void operator()(const AccT& acc, const Unit& u, int wr, int wc, int fr, int fq) const {
        const int row0 = u.pm * BM + wr * 64 + fr, col0 = u.pn * BM + wc * 32 + 8 * fq; const float sc = ((u.pn % 12) < 4) ? qscale : 1.0f;
#pragma unroll
        for (int ai = 0; ai < 2; ++ai)
#pragma unroll
            for (int m = 0; m < 4; ++m)
#pragma unroll
                for (int bj = 0; bj < 2; ++bj)
                    *(u32x4*)(O + (size_t)(row0 + ai * HALF + m * 16) * ldc + col0 + bj * HALF) = pack8(acc[ai][bj][m][0] * sc, acc[ai][bj][m][1] * sc);
    }
};
struct EpiMoeDown {
    static constexpr bool PERM = true;
    bf16_t* YB; const int* tokk; const float* gate; const PG8_LAS int* rt;
    __device__ __forceinline__ void operator()(const AccT& acc, const Unit& u, int wr, int wc, int fr, int fq) const {
        const int lbase = rt[u.pm * 4 + 1], nvalid = rt[u.pm * 4 + 2];
        const int rl0 = wr * 64 + fr, col0 = u.pn * BM + wc * 32 + 8 * fq;
#pragma unroll
        for (int ai = 0; ai < 2; ++ai)
#pragma unroll
            for (int m = 0; m < 4; ++m) { const int rl = rl0 + ai * HALF + m * 16;
                if (rl < nvalid) { const int tk = tokk[lbase + rl]; const float g = gate[lbase + rl];
                    bf16_t* rowp = YB + ((size_t)(tk & 1) * NTOK + (size_t)(tk >> 1)) * DM + col0;
#pragma unroll
                    for (int bj = 0; bj < 2; ++bj) *(u32x4*)(rowp + bj * HALF) = pack8(acc[ai][bj][m][0] * g, acc[ai][bj][m][1] * g); } }
    }
};
struct MoeOrder {
    int G, c, nM, nN; const PG8_LAS int* rt; const char* xbase; char* dout; char* ws; bool up;
    __device__ __forceinline__ bool next(int i, Unit& u) const {
        const long L = (long)i * G + c; if (L >= (long)nM * nN) return false;
        remap_unit((int)L, nM, nN, u.pm, u.pn); return true;
    }
    __device__ __forceinline__ const char* a_ptr(const Unit& u) const { return up ? xbase : (const char*)hm_tile(dout, ws, u.pm); }
    __device__ __forceinline__ int b_tile(const Unit& u) const { return __builtin_amdgcn_readfirstlane(rt[u.pm * 4]) * nN + u.pn; }
};
}

struct Args {
    const float* in[25]; float* out; unsigned char* ws; int ph_lo, ph_hi;
};
enum { I_X = 0, I_RELB, I_EWIN, I_CONVW, I_CONVB, I_CLNG, I_CLNB, I_EWOUT, I_ELN1G, I_ELN1B, I_FWG, I_FWU, I_FWD, I_ELN2G, I_ELN2B,
       I_OWIN, I_OWOUT, I_OLN1G, I_OLN1B, I_ROUTER, I_MWG, I_MWU, I_MWD, I_OLN2G, I_OLN2B };

__device__ __forceinline__ void transpose_item(const float* W, int ldw, int src_c0, int nvalid, int k0, bf16_t* WT, int K, int dst_row0, LAS float* scr, int lane) {
#pragma unroll 8
    for (int i = 0; i < 32; ++i) { const int kk = 2 * i + (lane >> 5), j = lane & 31; scr[kk * 33 + j] = (j < nvalid) ? W[(size_t)(k0 + kk) * ldw + src_c0 + j] : 0.f; }
    WAVE_LDS_FENCE();
    const int c = lane & 7;
#pragma unroll
    for (int jj = 0; jj < 4; ++jj) { const int n = (lane >> 3) + 8 * jj; const LAS float* s = scr + (8 * c) * 33 + n;
        u32x4 o; o.x = cvt_pk_bf16(s[0 * 33], s[1 * 33]); o.y = cvt_pk_bf16(s[2 * 33], s[3 * 33]); o.z = cvt_pk_bf16(s[4 * 33], s[5 * 33]); o.w = cvt_pk_bf16(s[6 * 33], s[7 * 33]);
        *(u32x4*)(WT + (size_t)(dst_row0 + n) * K + k0 + 8 * c) = o; }
    WAVE_LDS_FENCE();
}
__device__ __forceinline__ void gu_item(const float* wg, const float* wu, int FF, int K, bf16_t* WT, int item, LAS float* scr, int lane) {
    const int nblk = 2 * FF / 32, kb = item / nblk, nb = item % nblk, tile = nb >> 3, sub = nb & 7;
    transpose_item(sub < 4 ? wg : wu, FF, tile * 128 + (sub & 3) * 32, 32, kb * 64, WT, K, nb * 32, scr, lane);
}
__device__ __forceinline__ void plain_item(const float* W, int K, int N, bf16_t* WT, int item, LAS float* scr, int lane) {
    const int nblk = N / 32, kb = item / nblk, nb = item % nblk;
    transpose_item(W, N, nb * 32, 32, kb * 64, WT, K, nb * 32, scr, lane);
}
__device__ __forceinline__ void in0_item(const float* W, bf16_t* WT, int item, LAS float* scr, int lane) {
    const int nblk = IN0_N / 32, kb = item / nblk, nb = item % nblk, tile = nb >> 3, sub = nb & 7;
    int src_c0, nvalid = 32;
    if (tile < 4) src_c0 = (sub < 4) ? tile * 128 + sub * 32 : 512 + tile * 128 + (sub - 4) * 32;
    else { src_c0 = nb * 32; nvalid = IN0_SRC - src_c0; nvalid = nvalid < 0 ? 0 : (nvalid > 32 ? 32 : nvalid); if (nvalid == 0) src_c0 = 0; }
    transpose_item(W, IN0_SRC, src_c0, nvalid, kb * 64, WT, DM, nb * 32, scr, lane);
}
__device__ __forceinline__ int rel_bucket(int n) {
    if (n < 16) return n;
    const float nf = (float)n;
    int large = 16 + (int)(logf(nf / 16.0f) / logf(128.0f) * 16.0f);
    return large < 31 ? large : 31;
}

__device__ __forceinline__ void ln_core(f32x4 (&v)[4], const float* g, const float* b, int lane) {
    float s = 0.f;
#pragma unroll
    for (int j = 0; j < 4; ++j) s += (v[j][0] + v[j][1]) + (v[j][2] + v[j][3]);
    const float mean = wave_sum(s) * (1.f / DM); float s2 = 0.f;
#pragma unroll
    for (int j = 0; j < 4; ++j) { v[j] = v[j] - mean; s2 += (v[j][0] * v[j][0] + v[j][1] * v[j][1]) + (v[j][2] * v[j][2] + v[j][3] * v[j][3]); }
    const float rstd = 1.f / sqrtf(wave_sum(s2) * (1.f / DM) + LN_EPS);
#pragma unroll
    for (int j = 0; j < 4; ++j) { const f32x4 gg = *(const f32x4*)(g + 4 * lane + 256 * j), bb = *(const f32x4*)(b + 4 * lane + 256 * j); v[j] = v[j] * rstd * gg + bb; }
}
__device__ __forceinline__ void store_row_bf16(bf16_t* orow, const f32x4 (&v)[4], int lane) {
#pragma unroll
    for (int j = 0; j < 4; ++j) { u32x2 w; w.x = cvt_pk_bf16(v[j][0], v[j][1]); w.y = cvt_pk_bf16(v[j][2], v[j][3]); *(u32x2*)(orow + 4 * lane + 256 * j) = w; }
}
__device__ __forceinline__ f32x4 ld_bf4(const bf16_t* p) { const u32x2 w = *(const u32x2*)p; return (f32x4){bf_lo(w.x), bf_hi(w.x), bf_lo(w.y), bf_hi(w.y)}; }

__global__ void __launch_bounds__(NTHR, 2) fwd_kernel(Args args) {
    extern __shared__ __attribute__((aligned(16))) unsigned char lds_raw[];
    LAS unsigned char* lds = (LAS unsigned char*)lds_raw;
    const int G = gridDim.x, bid = blockIdx.x;
    const int NGW = G * NWAVES;
    volatile LAS unsigned* MISC = (volatile LAS unsigned*)(lds + LDS_MISC);
    int wave_id;
    {
        const int l0 = (int)__builtin_amdgcn_mbcnt_hi(~0u, __builtin_amdgcn_mbcnt_lo(~0u, 0u));
        if (l0 < 16) MISC[l0] = 0u;
        __syncthreads();
        unsigned id = 0u; if (l0 == 0) id = atomicAdd((unsigned*)(MISC + 2), 1u);
        wave_id = __builtin_amdgcn_readfirstlane((int)id);
        __syncthreads();
    }
#define MY_LANE() ((int)__builtin_amdgcn_mbcnt_hi(~0u, __builtin_amdgcn_mbcnt_lo(~0u, 0u)))
#if ONE_LAUNCH
    XcdBarrier bar = xcd_barrier_post((unsigned*)(args.ws + WS_CTL) + CW_BAR, MISC, wave_id == 0 && MY_LANE() == 0);
#define GRID_BAR() xcd_barrier(bar, tid == 0)
#else
#define GRID_BAR() do { } while (0)
#endif
    const int lo = args.ph_lo, hi = args.ph_hi;
#ifndef PH_MASK
#define PH_MASK 0xFFFFFFu
#endif
#define IN(k) ((((PH_MASK) >> (k)) & 1u) && lo <= (k) && (k) < hi)
#define BOTH(k) (IN(k) && IN((k) + 1))
#define PHASE_BEGIN int lane = MY_LANE(); asm volatile("" : "+v"(lane)); const int wave = wave_id; const int tid = wave * 64 + lane; const int gw = bid * NWAVES + wave; \
    unsigned char* ws = args.ws; asm volatile("" : "+s"(ws)); float* outp = args.out; asm volatile("" : "+s"(outp)); unsigned* ctl = (unsigned*)(ws + WS_CTL); (void)lane; (void)wave; (void)gw; (void)ctl; (void)outp;
#define x_in (args.in[I_X])
#define WIN0 ((bf16_t*)(ws + WS_WIN0))
#define WOUT0 ((bf16_t*)(ws + WS_WOUT0))
#define WGU0 ((bf16_t*)(ws + WS_WGU0))
#define WD0 ((bf16_t*)(ws + WS_WD0))
#define WIN1 ((bf16_t*)(ws + WS_WIN1))
#define WOUT1 ((bf16_t*)(ws + WS_WOUT1))
#define MWGU ((bf16_t*)(ws + WS_MWGU))
#define MWD ((bf16_t*)(ws + WS_MWD))
#define BIAST ((float*)(ws + WS_BIAST))
#define XB ((bf16_t*)(ws + WS_XB))
#define Ub ((bf16_t*)(ws + WS_U))
#define Q0 ((bf16_t*)(ws + WS_Q0))
#define K0 ((bf16_t*)(ws + WS_Q0 + SEG0))
#define V0 ((bf16_t*)(ws + WS_Q0 + 2 * SEG0))
#define QI ((bf16_t*)(ws + WS_Q0 + 3 * SEG0))
#define KI ((bf16_t*)(ws + WS_KI))
#define WI ((float*)(ws + WS_WI))
#define MASK ((u64*)(ws + WS_MASK))
#define MIXIN ((bf16_t*)(ws + WS_MIXIN))
#define X1B ((bf16_t*)(ws + WS_X1B))
#define H0 ((bf16_t*)(ws + WS_H0))
#define X2B ((bf16_t*)(ws + WS_X2B))
#define H1 ((bf16_t*)(ws + WS_H1))
#define O1 ((bf16_t*)outp)
#define Y3 ((float*)(ws + WS_Y3))
#define X3B ((bf16_t*)(ws + WS_X3B))
#define YB ((bf16_t*)(ws + WS_YB))
#define MTOK ((int*)(ws + WS_MOE_TOK))
#define MGATE ((float*)(ws + WS_MOE_GATE))
#define GTAB ((const LAS int*)(lds + LDS_GTAB))

    if (IN(0)) { asm volatile("; PHASE_MARK 0"); PHASE_BEGIN
        LAS float* scr = (LAS float*)(lds + wave * 16384);
        constexpr int I_IN0 = 16 * (IN0_N / 32), I_OUT = 16 * 32, I_GU0 = 16 * (2 * FF0 / 32), I_D0 = (FF0 / 64) * 32, I_IN1 = 16 * (IN1_N / 32);
        constexpr int NIT = I_IN0 + I_OUT + I_GU0 + I_D0 + I_IN1 + I_OUT;
        for (int it = gw; it < NIT; it += NGW) {
            int r = it;
            if (r < I_IN0) { in0_item(args.in[I_EWIN], WIN0, r, scr, lane); continue; } r -= I_IN0;
            if (r < I_OUT) { plain_item(args.in[I_EWOUT], DM, DM, WOUT0, r, scr, lane); continue; } r -= I_OUT;
            if (r < I_GU0) { gu_item(args.in[I_FWG], args.in[I_FWU], FF0, DM, WGU0, r, scr, lane); continue; } r -= I_GU0;
            if (r < I_D0) { plain_item(args.in[I_FWD], FF0, DM, WD0, r, scr, lane); continue; } r -= I_D0;
            if (r < I_IN1) { plain_item(args.in[I_OWIN], DM, IN1_N, WIN1, r, scr, lane); continue; } r -= I_IN1;
            plain_item(args.in[I_OWOUT], DM, DM, WOUT1, r, scr, lane);
        }
        for (size_t i = (size_t)bid * NTHR + tid; i < (size_t)NTOK * DM / 8; i += (size_t)G * NTHR) {
            const f32x4 a = *(const f32x4*)(x_in + i * 8), b = *(const f32x4*)(x_in + i * 8 + 4);
            *(u32x4*)(XB + i * 8) = pg8::pack8(a, b);
        }
        for (int i = bid * NTHR + tid; i < 8 * 4096; i += G * NTHR) { const int h = i >> 12, d = i & 4095; BIAST[i] = args.in[I_RELB][rel_bucket(d) * 8 + h]; }
        if (BOTH(0)) GRID_BAR();
    }

    if (IN(1)) { asm volatile("; PHASE_MARK 1"); PHASE_BEGIN
        pg8::StaticOrder S; S.init(XB, NTOK, IN0_N, DM, G, bid);
        pg8::EpiIn0 E{Ub, Q0, KI, WI};
        pg8::gemm_phase<pg8::EpiIn0, pg8::StaticOrder, true, false>(tid, lds, WIN0, DM, S, E, GTAB);
        if (BOTH(1)) GRID_BAR();
    }

    if (IN(2)) { asm volatile("; PHASE_MARK 2"); PHASE_BEGIN
        {
            LAS bf16_t* ut = (LAS bf16_t*)lds;
            LAS float* yt = (LAS float*)(lds + 65536);
            const float* cw = args.in[I_CONVW]; const int c = tid;
            float w[31];
#pragma unroll
            for (int j = 0; j < 31; ++j) w[j] = cw[j * 512 + c];
            const float cb = args.in[I_CONVB][c];
            for (int tile = bid; tile < NTOK / 32; tile += G) {
                const int t0 = tile * 32, s0 = t0 & (SEQ - 1);
                for (int i = tid; i < 62 * 64; i += NTHR) { const int r = i >> 6, c8 = i & 63; const int sr = s0 - 30 + r;
                    u32x4 v = (u32x4){0u, 0u, 0u, 0u}; if (sr >= 0) v = *(const u32x4*)(Ub + (size_t)(t0 - 30 + r) * 512 + c8 * 8);
                    *(LAS u32x4*)(ut + r * 512 + c8 * 8) = v; }
                __syncthreads();
                for (int t = 0; t < 32; ++t) { float a = cb;
#pragma unroll
                    for (int j = 0; j < 31; ++j) a += w[j] * bf2f(ut[(t + j) * 512 + c]);
                    yt[t * 512 + c] = a; }
                __syncthreads();
                const float* lg = args.in[I_CLNG]; const float* lb = args.in[I_CLNB];
#pragma unroll
                for (int tt = 0; tt < 4; ++tt) { const int t = wave * 4 + tt;
                    f32x4 a = *(LAS f32x4*)(yt + t * 512 + lane * 8), b = *(LAS f32x4*)(yt + t * 512 + lane * 8 + 4);
                    float s = (a[0] + a[1]) + (a[2] + a[3]) + (b[0] + b[1]) + (b[2] + b[3]); const float mean = wave_sum(s) * (1.f / 512.f);
                    a = a - mean; b = b - mean; float s2 = a[0] * a[0] + a[1] * a[1] + a[2] * a[2] + a[3] * a[3] + b[0] * b[0] + b[1] * b[1] + b[2] * b[2] + b[3] * b[3];
                    const float rstd = 1.f / sqrtf(wave_sum(s2) * (1.f / 512.f) + LN_EPS);
                    const f32x4 g0 = *(const f32x4*)(lg + lane * 8), g1 = *(const f32x4*)(lg + lane * 8 + 4), b0 = *(const f32x4*)(lb + lane * 8), b1 = *(const f32x4*)(lb + lane * 8 + 4);
                    a = a * rstd * g0 + b0; b = b * rstd * g1 + b1;
#pragma unroll
                    for (int j = 0; j < 4; ++j) { a[j] = a[j] * sigmoidf_(a[j]); b[j] = b[j] * sigmoidf_(b[j]); }
                    *(u32x4*)(MIXIN + (size_t)(t0 + t) * DM + lane * 8) = pg8::pack8(a, b); }
                __syncthreads();
            }
        }
        {
            LAS float* sc = (LAS float*)lds;
            LAS float* qf = (LAS float*)(lds + 131072);
            LAS unsigned* hist = (LAS unsigned*)(lds + 147456);
            LAS float* wq = (LAS float*)(lds + 155648);
            for (int item = bid; item < NTOK / 8; item += G) {
                const int tok0 = item * 8, b0 = tok0 & ~(SEQ - 1), q0 = tok0 & (SEQ - 1);
                for (int i = tid; i < 8 * 512; i += NTHR) qf[i] = bf2f(QI[(size_t)tok0 * 512 + i]);
                if (tid < 64) wq[tid] = WI[(size_t)tok0 * 8 + tid];
                __syncthreads();
                const int nk = q0 + 8;
                for (int kc = 0; kc * 512 < nk; ++kc) {
                    const int k = kc * 512 + tid;
                    if (k < nk) {
                        float kf[64];
#pragma unroll
                        for (int d8 = 0; d8 < 8; ++d8) { const u32x4 v = *(const u32x4*)(KI + (size_t)(b0 + k) * 64 + d8 * 8);
                            kf[d8 * 8 + 0] = bf_lo(v.x); kf[d8 * 8 + 1] = bf_hi(v.x); kf[d8 * 8 + 2] = bf_lo(v.y); kf[d8 * 8 + 3] = bf_hi(v.y);
                            kf[d8 * 8 + 4] = bf_lo(v.z); kf[d8 * 8 + 5] = bf_hi(v.z); kf[d8 * 8 + 6] = bf_lo(v.w); kf[d8 * 8 + 7] = bf_hi(v.w); }
                        for (int qq = 0; qq < 8; ++qq) { float s = 0.f;
                            for (int h = 0; h < 8; ++h) { float dot = 0.f;
#pragma unroll
                                for (int d4 = 0; d4 < 16; ++d4) { const f32x4 q4 = *(LAS f32x4*)(qf + qq * 512 + h * 64 + d4 * 4);
                                    dot += q4[0] * kf[d4 * 4] + q4[1] * kf[d4 * 4 + 1] + q4[2] * kf[d4 * 4 + 2] + q4[3] * kf[d4 * 4 + 3]; }
                                s += wq[qq * 8 + h] * fmaxf(dot, 0.f); }
                            sc[qq * 4096 + k] = s; }
                    }
                }
                __syncthreads();
                {
                    const int q = q0 + wave, n = q + 1; LAS float* row = sc + wave * 4096; LAS unsigned* hh = hist + wave * 256;
                    u64* mrow = MASK + (size_t)(tok0 + wave) * 64;
                    unsigned thr = 0u; int need = 0;
                    if (n > 256) {
                        unsigned prefix = 0u; int kk = 256;
                        for (int pass = 0; pass < 4; ++pass) {
                            const int shift = 24 - 8 * pass;
#pragma unroll
                            for (int j = 0; j < 4; ++j) hh[lane * 4 + j] = 0u;
                            WAVE_LDS_FENCE();
                            for (int i = lane; i < n; i += 64) { const unsigned u = __float_as_uint(row[i] + 0.0f); const unsigned key = (u & 0x80000000u) ? ~u : (u | 0x80000000u);
                                const bool match = (pass == 0) || ((key >> (shift + 8)) == (prefix >> (shift + 8)));
                                if (match) atomicAdd((unsigned*)(hh + ((key >> shift) & 255u)), 1u); }
                            WAVE_LDS_FENCE();
                            unsigned c0 = hh[lane * 4 + 0], c1 = hh[lane * 4 + 1], c2 = hh[lane * 4 + 2], c3 = hh[lane * 4 + 3];
                            const unsigned sl = c0 + c1 + c2 + c3; unsigned inc = sl;
#pragma unroll
                            for (int o = 1; o < 64; o <<= 1) { const unsigned t = __shfl_down(inc, o); if (lane + o < 64) inc += t; }
                            const unsigned exc = inc - sl;
                            const bool found = (exc < (unsigned)kk) && (inc >= (unsigned)kk);
                            int bin = 0, kn = 0;
                            { unsigned cum = exc;
                              if (cum + c3 >= (unsigned)kk) { bin = 3; kn = kk - (int)cum; } else { cum += c3;
                              if (cum + c2 >= (unsigned)kk) { bin = 2; kn = kk - (int)cum; } else { cum += c2;
                              if (cum + c1 >= (unsigned)kk) { bin = 1; kn = kk - (int)cum; } else { cum += c1; bin = 0; kn = kk - (int)cum; } } } }
                            const u64 fm = __ballot(found); const int src = fm ? (__ffsll((long long)fm) - 1) : 0;
                            bin = __shfl(lane * 4 + bin, src); kk = __shfl(kn, src);
                            prefix |= ((unsigned)bin) << shift;
                            WAVE_LDS_FENCE();
                        }
                        thr = prefix; need = kk;
                    }
                    int tie_run = 0;
                    for (int j = 0; j < 64; ++j) { const int i = j * 64 + lane; u64 word;
                        if (n <= 256) word = __ballot(i < n);
                        else { bool gt = false, eq = false;
                            if (i < n) { const unsigned u = __float_as_uint(row[i] + 0.0f); const unsigned key = (u & 0x80000000u) ? ~u : (u | 0x80000000u); gt = key > thr; eq = key == thr; }
                            const u64 eqm = __ballot(eq); const int rank = tie_run + __popcll(eqm & ((1ull << lane) - 1ull));
                            word = __ballot(gt || (eq && rank < need)); tie_run += __popcll(eqm); }
                        if (lane == 0) mrow[j] = word; }
                }
                __syncthreads();
            }
        }
        if (BOTH(2)) GRID_BAR();
    }

    if (IN(3)) { asm volatile("; PHASE_MARK 3"); PHASE_BEGIN
        LAS int* list = (LAS int*)lds;
        LAS unsigned* base = (LAS unsigned*)(lds + 1024);
        LAS u64* words = (LAS u64*)(lds + 1536);
        LAS float* pw = (LAS float*)(lds + 2048 + wave * 1024);
        for (int item = bid; item < NTOK; item += G) {
            const int tok = item, b0 = tok & ~(SEQ - 1), t = tok & (SEQ - 1), n = t + 1, cnt = n < 256 ? n : 256;
            if (tid < 64) { const u64 w = MASK[(size_t)tok * 64 + tid]; words[tid] = w; const unsigned c = (unsigned)__popcll(w); unsigned inc = c;
#pragma unroll
                for (int o = 1; o < 64; o <<= 1) { const unsigned tt = __shfl_up(inc, o); if (lane >= o) inc += tt; }
                base[tid] = inc - c; }
            __syncthreads();
            { const int j = tid >> 3, bb0 = (tid & 7) * 8; const u64 w = words[j]; const unsigned bs = base[j];
#pragma unroll
              for (int bb = 0; bb < 8; ++bb) { const int bit = bb0 + bb; if ((w >> bit) & 1ull) { const int pos = (int)bs + __popcll(w & ((1ull << bit) - 1ull)); if (pos < 256) list[pos] = j * 64 + bit; } } }
            __syncthreads();
            {
                const int h = wave; float qv[64];
#pragma unroll
                for (int d8 = 0; d8 < 8; ++d8) { const u32x4 v = *(const u32x4*)(Q0 + (size_t)tok * 512 + h * 64 + d8 * 8);
                    qv[d8 * 8 + 0] = bf_lo(v.x); qv[d8 * 8 + 1] = bf_hi(v.x); qv[d8 * 8 + 2] = bf_lo(v.y); qv[d8 * 8 + 3] = bf_hi(v.y);
                    qv[d8 * 8 + 4] = bf_lo(v.z); qv[d8 * 8 + 5] = bf_hi(v.z); qv[d8 * 8 + 6] = bf_lo(v.w); qv[d8 * 8 + 7] = bf_hi(v.w); }
                float lg[4]; float mx = -INFINITY;
#pragma unroll
                for (int i = 0; i < 4; ++i) { const int idx = lane + 64 * i; lg[i] = -INFINITY;
                    if (idx < cnt) { const int key = list[idx]; const bf16_t* kp = K0 + (size_t)(b0 + key) * 512 + h * 64; float dot = 0.f;
#pragma unroll
                        for (int d8 = 0; d8 < 8; ++d8) { const u32x4 v = *(const u32x4*)(kp + d8 * 8);
                            dot += qv[d8 * 8 + 0] * bf_lo(v.x) + qv[d8 * 8 + 1] * bf_hi(v.x) + qv[d8 * 8 + 2] * bf_lo(v.y) + qv[d8 * 8 + 3] * bf_hi(v.y)
                                 + qv[d8 * 8 + 4] * bf_lo(v.z) + qv[d8 * 8 + 5] * bf_hi(v.z) + qv[d8 * 8 + 6] * bf_lo(v.w) + qv[d8 * 8 + 7] * bf_hi(v.w); }
                        lg[i] = dot + BIAST[h * 4096 + (t - key)]; }
                    mx = fmaxf(mx, lg[i]); }
                mx = wave_max(mx); float sum = 0.f;
#pragma unroll
                for (int i = 0; i < 4; ++i) { const float p = (lg[i] == -INFINITY) ? 0.f : __expf(lg[i] - mx); sum += p; pw[lane + 64 * i] = p; }
                sum = wave_sum(sum);
                WAVE_LDS_FENCE();
                float acc = 0.f;
                for (int i = 0; i < cnt; ++i) { const int key = list[i]; acc += pw[i] * bf2f(V0[(size_t)(b0 + key) * 512 + h * 64 + lane]); }
                MIXIN[(size_t)tok * DM + 512 + h * 64 + lane] = (bf16_t)(cvt_pk_bf16(acc / sum, 0.f) & 0xffffu);
            }
            __syncthreads();
        }
        if (BOTH(3)) GRID_BAR();
    }

    if (IN(4)) { asm volatile("; PHASE_MARK 4"); PHASE_BEGIN
        pg8::StaticOrder S; S.init(MIXIN, NTOK, DM, DM, G, bid);
        pg8::EpiRes<false> E{outp, x_in};
        pg8::gemm_phase<pg8::EpiRes<false>, pg8::StaticOrder, true, false>(tid, lds, WOUT0, DM, S, E, GTAB);
        if (BOTH(4)) GRID_BAR();
    }
    if (IN(5)) { asm volatile("; PHASE_MARK 5"); PHASE_BEGIN
        for (int m = gw; m < NTOK; m += NGW) { f32x4 v[4];
#pragma unroll
            for (int j = 0; j < 4; ++j) v[j] = *(const f32x4*)(outp + (size_t)m * DM + 4 * lane + 256 * j);
            ln_core(v, args.in[I_ELN1G], args.in[I_ELN1B], lane); store_row_bf16(X1B + (size_t)m * DM, v, lane); }
        if (BOTH(5)) GRID_BAR();
    }
    if (IN(6)) { asm volatile("; PHASE_MARK 6"); PHASE_BEGIN
        pg8::StaticOrder S; S.init(X1B, NTOK, 2 * FF0, DM, G, bid);
        pg8::EpiSwiglu<false> E{H0, FF0, (char*)outp, (char*)ws};
        pg8::gemm_phase<pg8::EpiSwiglu<false>, pg8::StaticOrder, true, false>(tid, lds, WGU0, DM, S, E, GTAB);
        if (BOTH(6)) GRID_BAR();
    }
    if (IN(7)) { asm volatile("; PHASE_MARK 7"); PHASE_BEGIN
        pg8::StaticOrder S; S.init(H0, NTOK, DM, FF0, G, bid);
        pg8::EpiRes<true> E{outp, X1B};
        pg8::gemm_phase<pg8::EpiRes<true>, pg8::StaticOrder, true, false>(tid, lds, WD0, FF0, S, E, GTAB);
        if (BOTH(7)) GRID_BAR();
    }
    if (IN(8)) { asm volatile("; PHASE_MARK 8"); PHASE_BEGIN
        for (int m = gw; m < NTOK; m += NGW) { f32x4 v[4];
#pragma unroll
            for (int j = 0; j < 4; ++j) v[j] = *(const f32x4*)(outp + (size_t)m * DM + 4 * lane + 256 * j);
            ln_core(v, args.in[I_ELN2G], args.in[I_ELN2B], lane); store_row_bf16(X2B + (size_t)m * DM, v, lane); }
        if (BOTH(8)) GRID_BAR();
    }
#pragma unroll
    for (int ch = 0; ch < 2; ++ch) {
        if (IN(9 + 2 * ch)) { asm volatile("; PHASE_MARK 9"); PHASE_BEGIN
            pg8::StaticOrder S; S.init(X2B + (size_t)ch * CHUNK_T * DM, CHUNK_T, IN1_N, DM, G, bid);
            pg8::EpiQkv1 E{H1, IN1_N, 0.08838834764831845f};
            pg8::gemm_phase<pg8::EpiQkv1, pg8::StaticOrder, true, false>(tid, lds, WIN1, DM, S, E, GTAB);
            if (BOTH(9 + 2 * ch)) GRID_BAR();
        }
        if (IN(10 + 2 * ch)) { asm volatile("; PHASE_MARK 10"); PHASE_BEGIN
            LAS float* qw = (LAS float*)(lds + wave * 512);
            LAS float* pw = (LAS float*)(lds + 4096 + wave * 2048);
            for (int it = gw; it < CHUNK_T * 8; it += NGW) {
                const int tl = it >> 3, h = it & 7, t = tl & (SEQ - 1);
                const bf16_t* hrow = H1 + (size_t)tl * IN1_N;
                float mx = -INFINITY;
#pragma unroll 1
                for (int g = 0; g < 3; ++g) {
                    const int dsh = 2 * g;
                    { const unsigned w = *(const unsigned*)(hrow + g * 3072 + h * 128 + 2 * lane); qw[2 * lane] = bf_lo(w); qw[2 * lane + 1] = bf_hi(w); }
                    WAVE_LDS_FENCE();
#pragma unroll 1
                    for (int jj = 0; jj < 3; ++jj) { const int j = lane + 64 * jj; float l = -INFINITY;
                        if (j <= 128 && (j << dsh) <= t) { const bf16_t* kp = H1 + (size_t)(tl - (j << dsh)) * IN1_N + g * 3072 + 1024 + h * 128; float dot = 0.f;
#pragma unroll
                            for (int d8 = 0; d8 < 16; ++d8) { const u32x4 v = *(const u32x4*)(kp + d8 * 8); const f32x4 qa = *(LAS f32x4*)(qw + d8 * 8), qb = *(LAS f32x4*)(qw + d8 * 8 + 4);
                                dot += qa[0] * bf_lo(v.x) + qa[1] * bf_hi(v.x) + qa[2] * bf_lo(v.y) + qa[3] * bf_hi(v.y) + qb[0] * bf_lo(v.z) + qb[1] * bf_hi(v.z) + qb[2] * bf_lo(v.w) + qb[3] * bf_hi(v.w); }
                            l = dot + BIAST[h * 4096 + (j << dsh)]; }
                        if (j <= 128) pw[g * 129 + j] = l;
                        mx = fmaxf(mx, l); }
                    WAVE_LDS_FENCE();
                }
                mx = wave_max(mx); float sum = 0.f;
                for (int f = lane; f < 387; f += 64) { const float l = pw[f]; const float p = (l == -INFINITY) ? 0.f : __expf(l - mx); pw[f] = p; sum += p; }
                sum = wave_sum(sum);
                WAVE_LDS_FENCE();
                float a0 = 0.f, a1 = 0.f;
#pragma unroll 1
                for (int g = 0; g < 3; ++g) { const int dsh = 2 * g; int jmax = t >> dsh; jmax = jmax > 128 ? 128 : jmax;
                    for (int j = 0; j <= jmax; ++j) { const float p = pw[g * 129 + j]; const unsigned w = *(const unsigned*)(H1 + (size_t)(tl - (j << dsh)) * IN1_N + g * 3072 + 2048 + h * 128 + 2 * lane);
                        a0 += p * bf_lo(w); a1 += p * bf_hi(w); } }
                const float inv = 1.f / sum;
                *(unsigned*)(O1 + ((size_t)ch * CHUNK_T + tl) * DM + h * 128 + 2 * lane) = cvt_pk_bf16(a0 * inv, a1 * inv);
                WAVE_LDS_FENCE();
            }
            if (BOTH(10 + 2 * ch)) GRID_BAR();
        }
    }
    if (IN(13)) { asm volatile("; PHASE_MARK 13"); PHASE_BEGIN
        pg8::StaticOrder S; S.init(O1, NTOK, DM, DM, G, bid);
        pg8::EpiRes<true> E{Y3, X2B};
        pg8::gemm_phase<pg8::EpiRes<true>, pg8::StaticOrder, true, false>(tid, lds, WOUT1, DM, S, E, GTAB);
        if (BOTH(13)) GRID_BAR();
    }
    if (IN(14)) { asm volatile("; PHASE_MARK 14"); PHASE_BEGIN
        const float* rt = args.in[I_ROUTER];
        for (int m = gw; m < NTOK; m += NGW) { f32x4 v[4];
#pragma unroll
            for (int j = 0; j < 4; ++j) v[j] = *(const f32x4*)(Y3 + (size_t)m * DM + 4 * lane + 256 * j);
            ln_core(v, args.in[I_OLN1G], args.in[I_OLN1B], lane); store_row_bf16(X3B + (size_t)m * DM, v, lane);
            float lgt[8];
#pragma unroll
            for (int e = 0; e < 8; ++e) lgt[e] = 0.f;
#pragma unroll
            for (int j = 0; j < 4; ++j)
#pragma unroll
                for (int i = 0; i < 4; ++i) { const float* rr = rt + (size_t)(4 * lane + 256 * j + i) * 8; const f32x4 r0 = *(const f32x4*)rr, r1 = *(const f32x4*)(rr + 4); const float xv = v[j][i];
                    lgt[0] += xv * r0[0]; lgt[1] += xv * r0[1]; lgt[2] += xv * r0[2]; lgt[3] += xv * r0[3]; lgt[4] += xv * r1[0]; lgt[5] += xv * r1[1]; lgt[6] += xv * r1[2]; lgt[7] += xv * r1[3]; }
#pragma unroll
            for (int e = 0; e < 8; ++e) lgt[e] = wave_sum(lgt[e]);
            int e1 = 0; float v1 = lgt[0];
#pragma unroll
            for (int e = 1; e < 8; ++e) if (lgt[e] > v1) { v1 = lgt[e]; e1 = e; }
            int e2 = -1; float v2 = -INFINITY;
#pragma unroll
            for (int e = 0; e < 8; ++e) if (e != e1 && lgt[e] > v2) { v2 = lgt[e]; e2 = e; }
            const float g2 = 1.f / (1.f + __expf(v1 - v2)), g1 = 1.f - g2;
            if (lane == 0) {
                const unsigned p1 = atomicAdd(ctl + CW_MOECNT + e1, 1u), p2 = atomicAdd(ctl + CW_MOECNT + e2, 1u);
                if (p1 < (unsigned)NTOK) { MTOK[e1 * NTOK + p1] = m * 2; MGATE[e1 * NTOK + p1] = g1; }
                if (p2 < (unsigned)NTOK) { MTOK[e2 * NTOK + p2] = m * 2 + 1; MGATE[e2 * NTOK + p2] = g2; }
            }
        }
        __syncthreads();
        {
            LAS float* scr = (LAS float*)(lds + wave * 16384);
            constexpr int I_GU = 16 * (2 * FFE / 32), I_D = (FFE / 64) * 32;
            for (int it = gw; it < NEXP * (I_GU + I_D); it += NGW) {
                const int e = it / (I_GU + I_D), r = it % (I_GU + I_D);
                if (r < I_GU) gu_item(args.in[I_MWG] + (size_t)e * DM * FFE, args.in[I_MWU] + (size_t)e * DM * FFE, FFE, DM, MWGU + (size_t)e * 2 * FFE * DM, r, scr, lane);
                else plain_item(args.in[I_MWD] + (size_t)e * FFE * DM, FFE, DM, MWD + (size_t)e * DM * FFE, r - I_GU, scr, lane);
            }
        }
        if (BOTH(14)) GRID_BAR();
    }
#pragma unroll
    for (int ch = 0; ch < 2; ++ch) {
        if (IN(15 + 2 * ch) || IN(16 + 2 * ch)) {
            LAS int* rt = (LAS int*)(lds + LDS_RT);
            int nM;
            { PHASE_BEGIN int ts[9]; int cn[8]; ts[0] = 0;
#pragma unroll
              for (int e = 0; e < 8; ++e) { int ce = (int)ctl[CW_MOECNT + e]; ce = ce > NTOK ? NTOK : ce; cn[e] = ce; ts[e + 1] = ts[e] + (ce + 255) / 256; }
              const int t0 = ch * MOE_CH_TILES; int t1 = t0 + MOE_CH_TILES; if (t1 > ts[8]) t1 = ts[8]; nM = t1 > t0 ? t1 - t0 : 0;
              if (tid < nM) { const int g = t0 + tid; int e = 0;
#pragma unroll
                  for (int k = 1; k < 8; ++k) e += (g >= ts[k]) ? 1 : 0;
                  int ce = cn[0], tse = ts[0];
#pragma unroll
                  for (int k = 1; k < 8; ++k) { ce = (e == k) ? cn[k] : ce; tse = (e == k) ? ts[k] : tse; }
                  const int j = g - tse; int nv = ce - j * 256; nv = nv > 256 ? 256 : nv;
                  rt[tid * 4 + 0] = e; rt[tid * 4 + 1] = e * NTOK + j * 256; rt[tid * 4 + 2] = nv; rt[tid * 4 + 3] = 0; } }
            __syncthreads();
            if (IN(15 + 2 * ch)) { asm volatile("; PHASE_MARK 15"); PHASE_BEGIN
                pg8::MoeOrder S{G, bid, nM, 2 * FFE / 256, rt, (const char*)X3B, (char*)outp, (char*)ws, true};
                LAS int* gtab = (LAS int*)(lds + LDS_GTAB);
                { pg8::Unit u; for (int i = 0; i < 16 && S.next(i, u); ++i) { if (tid < 256) { const int lb = rt[u.pm * 4 + 1], nv = rt[u.pm * 4 + 2]; const int r = tid < nv ? tid : 0; gtab[i * 256 + tid] = MTOK[lb + r] >> 1; } } }
                __syncthreads();
                pg8::EpiSwiglu<true> E{H0, FFE, (char*)outp, (char*)ws};
                pg8::gemm_phase<pg8::EpiSwiglu<true>, pg8::MoeOrder, true, true>(tid, lds, MWGU, DM, S, E, gtab);
                if (BOTH(15 + 2 * ch)) GRID_BAR();
            }
            if (IN(16 + 2 * ch)) { asm volatile("; PHASE_MARK 16"); PHASE_BEGIN
                pg8::MoeOrder S{G, bid, nM, DM / 256, rt, (const char*)X3B, (char*)outp, (char*)ws, false};
                pg8::EpiMoeDown E{YB, MTOK, MGATE, rt};
                pg8::gemm_phase<pg8::EpiMoeDown, pg8::MoeOrder, true, false>(tid, lds, MWD, FFE, S, E, GTAB);
                if (BOTH(16 + 2 * ch)) GRID_BAR();
            }
        }
    }
    if (IN(19)) { asm volatile("; PHASE_MARK 19"); PHASE_BEGIN
        for (int m = gw; m < NTOK; m += NGW) { f32x4 v[4];
#pragma unroll
            for (int j = 0; j < 4; ++j) { const size_t o = (size_t)m * DM + 4 * lane + 256 * j; v[j] = ld_bf4(X3B + o) * ALPHA + ld_bf4(YB + o) + ld_bf4(YB + (size_t)NTOK * DM + o); }
            ln_core(v, args.in[I_OLN2G], args.in[I_OLN2B], lane);
#pragma unroll
            for (int j = 0; j < 4; ++j) *(f32x4*)(outp + (size_t)m * DM + 4 * lane + 256 * j) = v[j]; }
    }
#undef IN
#undef BOTH
}

constexpr int NPHASES = 20;
extern "C" void kernel_launch(void* const* d_in, const int* in_sizes, int n_in, void* d_out, int out_size, void* d_ws, size_t ws_size, hipStream_t stream) {
    static int grid = 0;
    if (grid == 0) {
        if (n_in != 25 || out_size != NTOK * DM || ws_size < WS_END) { fprintf(stderr, "kernel_launch: unexpected shapes (n_in %d out %d ws %zu)\n", n_in, out_size, ws_size); grid = -1; return; }
        int dev = 0, cus = 0;
        if (hipGetDevice(&dev) != hipSuccess || hipDeviceGetAttribute(&cus, hipDeviceAttributeMultiprocessorCount, dev) != hipSuccess) { grid = -1; return; }
        if (hipFuncSetAttribute((const void*)fwd_kernel, hipFuncAttributeMaxDynamicSharedMemorySize, LDS_BYTES) != hipSuccess) { fprintf(stderr, "kernel_launch: hipFuncSetAttribute failed\n"); grid = -1; return; }
        int per_cu = 0;
        if (hipOccupancyMaxActiveBlocksPerMultiprocessor(&per_cu, (const void*)fwd_kernel, NTHR, LDS_BYTES) != hipSuccess || per_cu < 1) { fprintf(stderr, "kernel_launch: occupancy query says %d\n", per_cu); }
        (void)hipGetLastError();
        grid = cus;
    }
    if (grid < 0) return;
    (void)hipMemsetAsync((char*)d_ws + WS_CTL, 0, CTL_ZERO_BYTES, stream);
    Args a{};
    for (int i = 0; i < 25; ++i) a.in[i] = (const float*)d_in[i];
    a.out = (float*)d_out; a.ws = (unsigned char*)d_ws;
#if ONE_LAUNCH
    a.ph_lo = 0; a.ph_hi = NPHASES;
    hipLaunchKernelGGL(fwd_kernel, dim3(grid), dim3(NTHR), LDS_BYTES, stream, a);
#else
    for (int ph = 0; ph < NPHASES; ++ph) { a.ph_lo = ph; a.ph_hi = ph + 1; hipLaunchKernelGGL(fwd_kernel, dim3(grid), dim3(NTHR), LDS_BYTES, stream, a); }
#endif
}
```

```cpp
#include <hip/hip_runtime.h>
#include <cstdio>
#include <cstdint>

#ifndef ONE_LAUNCH
#define ONE_LAUNCH 1
#endif

#define LAS __attribute__((address_space(3)))
typedef unsigned short bf16_t;
typedef short bf16x8 __attribute__((ext_vector_type(8)));
typedef float f32x4 __attribute__((ext_vector_type(4)));
typedef float f32x2 __attribute__((ext_vector_type(2)));
typedef unsigned u32x4 __attribute__((ext_vector_type(4)));
typedef unsigned u32x2 __attribute__((ext_vector_type(2)));
typedef unsigned long long u64;

constexpr int NB = 8, SEQ = 4096, DM = 1024, NTOK = NB * SEQ;
constexpr int IN0_SRC = 3144, IN0_N = 3328;
constexpr int FF0 = 2816, FFE = 3584, NEXP = 8;
constexpr int IN1_N = 9216;
constexpr int CHUNK_B = 4, CHUNK_T = CHUNK_B * SEQ;
constexpr int MOE_CH_TILES = 132;
constexpr int HM_DOUT_TILES = 73;
constexpr float ALPHA = 1.4142135623730951f;
constexpr float LN_EPS = 1e-5f;
constexpr int NWAVES = 8, NTHR = 512;

constexpr size_t MiB = 1u << 20;
constexpr size_t WS_CTL = 0, CTL_ZERO_BYTES = 64 * 1024;
constexpr size_t WS_BIAST = 1 * MiB;
constexpr size_t WS_MOE_TOK = 2 * MiB;
constexpr size_t WS_MOE_GATE = 3 * MiB;
constexpr size_t WS_WIN0 = 4 * MiB;
constexpr size_t WS_WOUT0 = 11 * MiB;
constexpr size_t WS_WGU0 = 13 * MiB;
constexpr size_t WS_WD0 = 24 * MiB;
constexpr size_t WS_WIN1 = 30 * MiB;
constexpr size_t WS_WOUT1 = 48 * MiB;
constexpr size_t WS_XB = 50 * MiB;
constexpr size_t WS_U = 114 * MiB;
constexpr size_t WS_Q0 = 146 * MiB, SEG0 = 32 * MiB;
constexpr size_t WS_KI = 274 * MiB;
constexpr size_t WS_WI = 278 * MiB;
constexpr size_t WS_MASK = 280 * MiB;
constexpr size_t WS_MIXIN = 296 * MiB;
constexpr size_t WS_X1B = 50 * MiB;
constexpr size_t WS_H0 = 114 * MiB;
constexpr size_t WS_X2B = 448 * MiB;
constexpr size_t WS_H1 = 50 * MiB;
constexpr size_t WS_Y3 = 216 * MiB;
constexpr size_t WS_X3B = 152 * MiB;
constexpr size_t WS_YB = 216 * MiB;
constexpr size_t WS_MWGU = 344 * MiB;
constexpr size_t WS_MWD = 456 * MiB;
constexpr size_t WS_HM = 4 * MiB;
constexpr size_t WS_END = 512 * MiB;
constexpr size_t HM_TILE_BYTES = (size_t)256 * FFE * 2;
constexpr int CW_MOECNT = 64;
constexpr int CW_BAR = 1024;

constexpr int LDS_GTAB = 131072;
constexpr int LDS_RT = 147456;
constexpr int LDS_MISC = 155648 + 2048;
constexpr int LDS_BYTES = 159744;

__device__ __forceinline__ unsigned cvt_pk_bf16(float lo, float hi) { unsigned r; asm volatile("v_cvt_pk_bf16_f32 %0, %1, %2" : "=v"(r) : "v"(lo), "v"(hi)); return r; }
__device__ __forceinline__ float bf_lo(unsigned w) { return __uint_as_float(w << 16); }
__device__ __forceinline__ float bf_hi(unsigned w) { return __uint_as_float(w & 0xffff0000u); }
__device__ __forceinline__ float bf2f(bf16_t b) { return __uint_as_float(((unsigned)b) << 16); }
__device__ __forceinline__ float wave_sum(float v) {
#pragma unroll
    for (int o = 1; o < 64; o <<= 1) v += __shfl_xor(v, o);
    return v;
}
__device__ __forceinline__ float wave_max(float v) {
#pragma unroll
    for (int o = 1; o < 64; o <<= 1) v = fmaxf(v, __shfl_xor(v, o));
    return v;
}
__device__ __forceinline__ float sigmoidf_(float x) { return __builtin_amdgcn_rcpf(1.0f + __expf(-x)); }
#define WAVE_LDS_FENCE() do { asm volatile("s_waitcnt lgkmcnt(0)" ::: "memory"); __builtin_amdgcn_wave_barrier(); } while (0)

#define XB_TMO      128
#define XB_XCNT(j)  (256  + 64 * (j))
#define XB_XSUB(j)  (1280 + 64 * (j))
#define XB_XGEN(j)  (2304 + 64 * (j))
#define XB_TOP      3328
#define XB_TOPGEN   3392
#define XCD_BAR_WORDS 3456
#define XB_SPIN_CAP (1u << 18)
__device__ __forceinline__ unsigned xb_ld(unsigned* p)              { return __hip_atomic_load(p, __ATOMIC_RELAXED, __HIP_MEMORY_SCOPE_AGENT); }
__device__ __forceinline__ unsigned xb_add(unsigned* p, unsigned v) { return __hip_atomic_fetch_add(p, v, __ATOMIC_RELAXED, __HIP_MEMORY_SCOPE_AGENT); }
__device__ __forceinline__ unsigned xb_xcc_id() { return (unsigned)__builtin_amdgcn_s_getreg((3 << 11) | 20) & 0xFu; }
#define XB_SPIN(cond, bar) do { unsigned _sp = 0; while (cond) { __builtin_amdgcn_s_sleep(1); \
    if ((++_sp & 255u) == 0u) { if (xb_ld(&(bar)[XB_TMO])) break; if (_sp > XB_SPIN_CAP) { atomicAdd(&(bar)[XB_TMO], 1u); break; } } } } while (0)
struct XcdBarrier { unsigned* bar; unsigned x; volatile LAS unsigned* st; };
__device__ __forceinline__ XcdBarrier xcd_barrier_post(unsigned* bar, volatile LAS unsigned* st, bool leader) {
    XcdBarrier b; b.bar = bar; b.x = xb_xcc_id(); b.st = st;
    if (leader) (void)xb_add(&bar[XB_XCNT(b.x)], 1u);
    return b;
}
__device__ __forceinline__ void xcd_barrier_complete(unsigned* bar, unsigned x, unsigned& nloc, unsigned& nx) {
    const unsigned G = gridDim.x * gridDim.y * gridDim.z;
    unsigned sum, cnt, mine, sp = 0u;
    for (;;) {
        sum = 0u; cnt = 0u; mine = 0u;
#pragma unroll
        for (unsigned j = 0; j < 16; ++j) { const unsigned c = xb_ld(&bar[XB_XCNT(j)]); sum += c; cnt += (c > 0u) ? 1u : 0u; mine = (j == x) ? c : mine; }
        if (sum == G) break;
        __builtin_amdgcn_s_sleep(1);
        if ((++sp & 255u) == 0u) { if (xb_ld(&bar[XB_TMO])) break; if (sp > XB_SPIN_CAP) { atomicAdd(&bar[XB_TMO], 1u); break; } }
    }
    nloc = mine > 0u ? mine : 1u; nx = cnt > 0u ? cnt : 1u;
}
__device__ __forceinline__ void xcd_barrier(const XcdBarrier& b, bool leader) {
    asm volatile("s_waitcnt vmcnt(0)" ::: "memory");
    __syncthreads();
    if (leader) {
        unsigned* bar = b.bar;
        __builtin_amdgcn_s_waitcnt(0);
        unsigned nloc = b.st[0], nx = b.st[1];
        if (nloc == 0u) { xcd_barrier_complete(bar, b.x, nloc, nx); b.st[0] = nloc; b.st[1] = nx; }
        const unsigned old = xb_add(&bar[XB_XSUB(b.x)], 1u);
        const unsigned gen = old / nloc;
        if (old + 1u == (gen + 1u) * nloc) {
            __builtin_amdgcn_fence(__ATOMIC_RELEASE, "agent");
            asm volatile("s_waitcnt vmcnt(0)" ::: "memory");
            const unsigned og = xb_add(&bar[XB_TOP], 1u);
            const unsigned tg = og / nx;
            if (og + 1u == (tg + 1u) * nx) xb_add(&bar[XB_TOPGEN], 1u);
            else XB_SPIN(xb_ld(&bar[XB_TOPGEN]) == tg, bar);
            __builtin_amdgcn_fence(__ATOMIC_ACQUIRE, "agent");
            xb_add(&bar[XB_XGEN(b.x)], 1u);
            asm volatile("s_waitcnt vmcnt(0)" ::: "memory");
        } else {
            XB_SPIN(xb_ld(&bar[XB_XGEN(b.x)]) == gen, bar);
            __builtin_amdgcn_fence(__ATOMIC_ACQUIRE, "agent");
            asm volatile("s_waitcnt vmcnt(0)" ::: "memory");
        }
    }
    __syncthreads();
}

namespace pg8 {
constexpr int BM = 256, BK = 64, HALF = 128, HTB = HALF * BK * 2, STAGE_BYTES = 8 * HTB, NXCD = 8, WGM = 8;
__host__ __device__ __forceinline__ int lds_byte(int r, int c) { const int st = (r >> 4) * 2 + (c >> 5), rr = r & 15, cc = c & 31, ob = rr * 64 + cc * 2; return st * 1024 + (ob ^ (((ob >> 9) & 1) << 5)); }
__host__ __device__ __forceinline__ void stage_rc(int b, int& R, int& C) { const int st = b / 1024, sb = b % 1024, swz = sb ^ (((sb >> 9) & 1) << 5); R = (st >> 1) * 16 + swz / 64; C = (st & 1) * 32 + (swz % 64) / 2; }
__host__ __device__ __forceinline__ int perm32(int rho) { const int n = rho >> 4, i = rho & 15; return 8 * (i >> 2) + 4 * n + (i & 3); }

struct Unit { int pm, pn; };

__device__ __forceinline__ void remap_unit(int wgid, int nM, int nN, int& pm, int& pn) {
    const int nwg = nM * nN;
    { const int q = nwg / NXCD, r = nwg % NXCD, xcd = wgid % NXCD, off = wgid / NXCD; wgid = (xcd < r ? xcd * (q + 1) : r * (q + 1) + (xcd - r) * q) + off; }
    const int nig = WGM * nN, gid = wgid / nig, fm = gid * WGM, gsz = (nM - fm) < WGM ? (nM - fm) : WGM;
    pm = fm + ((wgid % nig) % gsz); pn = (wgid % nig) / gsz;
}
struct StaticOrder {
    int nM, nN, nwg, G, c; const char* A; size_t tstepA;
    __device__ void init(const bf16_t* A_, int M, int N, int K, int G_, int c_) { nM = M / BM; nN = N / BM; nwg = nM * nN; G = G_; c = c_; A = (const char*)A_; tstepA = (size_t)BM * K * 2; }
    __device__ __forceinline__ bool next(int i, Unit& u) const {
        const long L = (long)i * G + c; if (L >= nwg) return false;
        remap_unit((int)L, nM, nN, u.pm, u.pn); return true;
    }
    __device__ __forceinline__ const char* a_ptr(const Unit& u) const { return A + (size_t)u.pm * tstepA; }
    __device__ __forceinline__ int b_tile(const Unit& u) const { return u.pn; }
};

#define PG8_LAS __attribute__((address_space(3)))
template <class Epi, class Sched, bool ALIGN_EPI, bool GATHER>
__device__ __forceinline__ void gemm_phase(const int tid, PG8_LAS unsigned char* lds, const bf16_t* Btp, const int K, const Sched& S, const Epi& E, const PG8_LAS int* gtab) {
    const int wid = __builtin_amdgcn_readfirstlane(tid >> 6), lane = tid & 63, wr = wid >> 2, wc = wid & 3, fr = lane & 15, fq = lane >> 4;
    const int nt = K / BK;
    unsigned voffA[2], voffB[2];
#pragma unroll
    for (int i = 0; i < 2; ++i) { int R, C; stage_rc(tid * 16 + i * 8192, R, C); const int Rb = Epi::PERM ? ((R & ~31) + perm32(R & 31)) : R;
        voffA[i] = (unsigned)(R * K + C) * 2u; voffB[i] = (unsigned)(Rb * K + C) * 2u; }
    const size_t kstep = (size_t)(BK * 2);
    const size_t hstep = (size_t)HALF * K * 2;
    const size_t tstep = 2 * hstep;
    const unsigned ldsw = (unsigned)wid * 1024u;
    const int aoff = lds_byte(wr * 64 + fr, fq * 8), boff = lds_byte(wc * 32 + fr, fq * 8);
#define PG8_SA(b, h) (((b) * 2 + (h)) * HTB)
#define PG8_SB(b, h) ((4 + (b) * 2 + (h)) * HTB)
#define PG8_STAGE(bufoff, gbase, voff) do { _Pragma("unroll") for (int _i = 0; _i < 2; ++_i) \
        __builtin_amdgcn_global_load_lds((const unsigned*)((const char*)(gbase) + (voff)[_i]), (PG8_LAS unsigned*)(lds + (bufoff) + ldsw + _i * 8192), 16, 0, 0); } while (0)
#define PG8_STAGE_AC(bufoff, kt, h) do { if constexpr (GATHER) { PG8_STAGE(bufoff, cA + (size_t)(kt) * kstep, gcur[h]); } else { PG8_STAGE(bufoff, cA + (size_t)(kt) * kstep + (h) * hstep, voffA); } } while (0)
#define PG8_STAGE_AN(bufoff, d, h) do { if constexpr (GATHER) { if (last) { unsigned _g[2]; _Pragma("unroll") for (int _i = 0; _i < 2; ++_i) { int _R, _C; stage_rc(tid * 16 + _i * 8192, _R, _C); _g[_i] = (unsigned)gtab[nslot * 256 + (h) * 128 + _R] * (unsigned)(K * 2) + (unsigned)(_C * 2); } \
            PG8_STAGE(bufoff, nA + (size_t)(d) * kstep, _g); } else { PG8_STAGE(bufoff, cA + (size_t)(t + 2 + (d)) * kstep, gcur[h]); } } \
        else { PG8_STAGE(bufoff, a2 + (size_t)(d) * kstep + (h) * hstep, voffA); } } while (0)
#define PG8_LDA(dst, b, h) do { _Pragma("unroll") for (int m = 0; m < 4; ++m) _Pragma("unroll") for (int k = 0; k < 2; ++k) dst[m][k] = *(const PG8_LAS bf16x8*)(lds + PG8_SA(b, h) + aoff + m * 2048 + k * 1024); } while (0)
#define PG8_LDB(dst, b, h) do { _Pragma("unroll") for (int n = 0; n < 2; ++n) _Pragma("unroll") for (int k = 0; k < 2; ++k) dst[n][k] = *(const PG8_LAS bf16x8*)(lds + PG8_SB(b, h) + boff + n * 2048 + k * 1024); } while (0)
#define PG8_MMA(ai, bj, At, Bt) do { __builtin_amdgcn_s_setprio(1); _Pragma("unroll") for (int m = 0; m < 4; ++m) _Pragma("unroll") for (int n = 0; n < 2; ++n) _Pragma("unroll") for (int k = 0; k < 2; ++k) \
        acc[ai][bj][m][n] = __builtin_amdgcn_mfma_f32_16x16x32_bf16(Bt[n][k], At[m][k], acc[ai][bj][m][n], 0, 0, 0); __builtin_amdgcn_s_setprio(0); } while (0)
#define PG8_WAIT_V(n) asm volatile("s_waitcnt vmcnt(" #n ")" ::: "memory")
#define PG8_WAIT_L(n) asm volatile("s_waitcnt lgkmcnt(" #n ")" ::: "memory")
#define PG8_BAR __builtin_amdgcn_s_barrier()
#define PG8_SCHED __builtin_amdgcn_sched_barrier(0)
#define PG8_LOADG(dst, slot_) do { _Pragma("unroll") for (int _i = 0; _i < 2; ++_i) { int _R, _C; stage_rc(tid * 16 + _i * 8192, _R, _C); _Pragma("unroll") for (int _h = 0; _h < 2; ++_h) \
        dst[_h][_i] = (unsigned)gtab[(slot_) * 256 + _h * 128 + _R] * (unsigned)(K * 2) + (unsigned)(_C * 2); } } while (0)
    Unit cur, nxt; int ui = 0;
    if (!S.next(0, cur)) return;
    f32x4 acc[2][2][4][2];
#pragma unroll
    for (int a = 0; a < 2; ++a)
#pragma unroll
        for (int b = 0; b < 2; ++b)
#pragma unroll
            for (int m = 0; m < 4; ++m)
#pragma unroll
                for (int n = 0; n < 2; ++n) acc[a][b][m][n] = (f32x4){0.f, 0.f, 0.f, 0.f};
    bf16x8 At[4][2], B0[2][2], B1[2][2];
    unsigned gcur[2][2] = {{0u, 0u}, {0u, 0u}};
    const char* cA = S.a_ptr(cur); const char* cB = (const char*)Btp + (size_t)S.b_tile(cur) * tstep;
    if constexpr (GATHER) { PG8_LOADG(gcur, 0); PG8_WAIT_L(0); }
    PG8_STAGE(PG8_SB(0, 0), cB, voffB); PG8_STAGE(PG8_SB(0, 1), cB + hstep, voffB); PG8_STAGE_AC(PG8_SA(0, 0), 0, 0); PG8_STAGE_AC(PG8_SA(0, 1), 0, 1);
    if (wr == 1) PG8_BAR;
    PG8_WAIT_V(2); PG8_BAR;
    PG8_STAGE(PG8_SB(1, 0), cB + kstep, voffB); PG8_STAGE_AC(PG8_SA(1, 0), 1, 0); PG8_STAGE(PG8_SB(1, 1), cB + hstep + kstep, voffB);
    PG8_WAIT_V(6); PG8_BAR;
    for (;;) {
        const bool has_next = S.next(ui + 1, nxt);
        const char* nA = has_next ? S.a_ptr(nxt) : cA; const char* nB = has_next ? (const char*)Btp + (size_t)S.b_tile(nxt) * tstep : cB;
        const int nslot = has_next ? ui + 1 : ui;
        for (int t = 0; t < nt; t += 2) {
            const bool last = (t == nt - 2);
            const char* a2 = last ? nA : cA + (size_t)(t + 2) * kstep; const char* b2 = last ? nB : cB + (size_t)(t + 2) * kstep;
            const char* b3 = b2 + kstep;
            (void)a2;
            PG8_LDB(B0, 0, 0); PG8_LDB(B1, 0, 1); PG8_SCHED; PG8_LDA(At, 0, 0); PG8_STAGE_AC(PG8_SA(1, 1), t + 1, 1);
            PG8_WAIT_V(8); PG8_WAIT_L(0); PG8_BAR; PG8_MMA(0, 0, At, B0); PG8_MMA(0, 1, At, B1); PG8_BAR; PG8_SCHED;
            PG8_LDA(At, 0, 1); PG8_STAGE(PG8_SB(0, 0), b2, voffB); PG8_STAGE(PG8_SB(0, 1), b2 + hstep, voffB); PG8_STAGE_AN(PG8_SA(0, 0), 0, 0);
            PG8_WAIT_V(8); PG8_WAIT_L(0); PG8_BAR; PG8_MMA(1, 0, At, B0); PG8_MMA(1, 1, At, B1); PG8_BAR; PG8_SCHED;
            PG8_LDB(B0, 1, 0); PG8_LDB(B1, 1, 1); PG8_SCHED; PG8_LDA(At, 1, 0); PG8_STAGE_AN(PG8_SA(0, 1), 0, 1);
            PG8_WAIT_V(8); PG8_WAIT_L(0); PG8_BAR; PG8_MMA(0, 0, At, B0); PG8_MMA(0, 1, At, B1); PG8_BAR; PG8_SCHED;
            PG8_LDA(At, 1, 1); PG8_STAGE(PG8_SB(1, 0), b3, voffB); PG8_STAGE(PG8_SB(1, 1), b3 + hstep, voffB); PG8_STAGE_AN(PG8_SA(1, 0), 1, 0);
            PG8_WAIT_V(8); PG8_WAIT_L(0); PG8_BAR; PG8_MMA(1, 0, At, B0); PG8_MMA(1, 1, At, B1); PG8_BAR; PG8_SCHED;
        }
        if constexpr (ALIGN_EPI) { if (wr == 0) PG8_BAR; }
        { int fr_e = fr, fq_e = fq; asm volatile("" : "+v"(fr_e), "+v"(fq_e)); E(acc, cur, wr, wc, fr_e, fq_e); }
        if (!has_next) break;
#pragma unroll
        for (int a = 0; a < 2; ++a)
#pragma unroll
            for (int b = 0; b < 2; ++b)
#pragma unroll
                for (int m = 0; m < 4; ++m)
#pragma unroll
                    for (int n = 0; n < 2; ++n) acc[a][b][m][n] = (f32x4){0.f, 0.f, 0.f, 0.f};
        cur = nxt; cA = nA; cB = nB; ++ui;
        if constexpr (GATHER) { PG8_LOADG(gcur, ui); }
        if constexpr (ALIGN_EPI) { if (wr == 1) PG8_BAR; }
    }
    PG8_WAIT_V(0);
    if constexpr (!ALIGN_EPI) { if (wr == 0) PG8_BAR; }
    PG8_BAR;
#undef PG8_SA
#undef PG8_SB
#undef PG8_STAGE
#undef PG8_STAGE_AC
#undef PG8_STAGE_AN
#undef PG8_LDA
#undef PG8_LDB
#undef PG8_MMA
#undef PG8_WAIT_V
#undef PG8_WAIT_L
#undef PG8_BAR
#undef PG8_SCHED
#undef PG8_LOADG
}

typedef f32x4 AccT[2][2][4][2];
__device__ __forceinline__ u32x4 pack8(const f32x4 v0, const f32x4 v1) { u32x4 w; w.x = cvt_pk_bf16(v0[0], v0[1]); w.y = cvt_pk_bf16(v0[2], v0[3]); w.z = cvt_pk_bf16(v1[0], v1[1]); w.w = cvt_pk_bf16(v1[2], v1[3]); return w; }

struct EpiIn0 {
    static constexpr bool PERM = true;
    bf16_t* U; bf16_t* Q; bf16_t* KI; float* WI;
    __device__ __forceinline__ void operator()(const AccT& acc, const Unit& u, int wr, int wc, int fr, int fq) const {
        const int row0 = u.pm * BM + wr * 64 + fr;
        if (u.pn < 4) {
            const int col0 = u.pn * 128 + wc * 32 + 8 * fq;
#pragma unroll
            for (int ai = 0; ai < 2; ++ai)
#pragma unroll
                for (int m = 0; m < 4; ++m) { f32x4 o0, o1;
#pragma unroll
                    for (int j = 0; j < 4; ++j) { o0[j] = acc[ai][0][m][0][j] * sigmoidf_(acc[ai][1][m][0][j]); o1[j] = acc[ai][0][m][1][j] * sigmoidf_(acc[ai][1][m][1][j]); }
                    *(u32x4*)(U + (size_t)(row0 + ai * HALF + m * 16) * 512 + col0) = pack8(o0, o1); }
        } else if (u.pn < 12) {
            const int t = (u.pn - 4) >> 1; bf16_t* base = Q + (size_t)t * (SEG0 / 2); const float sc = (t == 0) ? 0.125f : 1.0f;
            const int col0 = ((u.pn - 4) & 1) * 256 + wc * 32 + 8 * fq;
#pragma unroll
            for (int ai = 0; ai < 2; ++ai)
#pragma unroll
                for (int m = 0; m < 4; ++m)
#pragma unroll
                    for (int bj = 0; bj < 2; ++bj)
                        *(u32x4*)(base + (size_t)(row0 + ai * HALF + m * 16) * 512 + col0 + bj * HALF) = pack8(acc[ai][bj][m][0] * sc, acc[ai][bj][m][1] * sc);
        } else {
            if (wc < 2) {
#pragma unroll
                for (int ai = 0; ai < 2; ++ai)
#pragma unroll
                    for (int m = 0; m < 4; ++m) *(u32x4*)(KI + (size_t)(row0 + ai * HALF + m * 16) * 64 + wc * 32 + 8 * fq) = pack8(acc[ai][0][m][0], acc[ai][0][m][1]);
            } else if (wc == 2 && fq == 0) {
                const float sc = 0.04419417382415922f;
#pragma unroll
                for (int ai = 0; ai < 2; ++ai)
#pragma unroll
                    for (int m = 0; m < 4; ++m) { float* p = WI + (size_t)(row0 + ai * HALF + m * 16) * 8; *(f32x4*)p = acc[ai][0][m][0] * sc; *(f32x4*)(p + 4) = acc[ai][0][m][1] * sc; }
            }
        }
    }
};
template <bool RB> struct EpiRes {
    static constexpr bool PERM = false;
    float* out; const void* resid;
    __device__ __forceinline__ void operator()(const AccT& acc, const Unit& u, int wr, int wc, int fr, int fq) const {
        const int row0 = u.pm * BM + wr * 64 + fr, col0 = u.pn * BM + wc * 32 + 4 * fq;
#pragma unroll
        for (int ai = 0; ai < 2; ++ai)
#pragma unroll
            for (int m = 0; m < 4; ++m) { const size_t off = (size_t)(row0 + ai * HALF + m * 16) * DM + col0;
#pragma unroll
                for (int bj = 0; bj < 2; ++bj)
#pragma unroll
                    for (int n = 0; n < 2; ++n) { f32x4 r;
                        if (RB) { const u32x2 w = *(const u32x2*)((const bf16_t*)resid + off + bj * HALF + n * 16); r = (f32x4){bf_lo(w.x), bf_hi(w.x), bf_lo(w.y), bf_hi(w.y)}; }
                        else r = *(const f32x4*)((const float*)resid + off + bj * HALF + n * 16);
                        *(f32x4*)(out + off + bj * HALF + n * 16) = r * ALPHA + acc[ai][bj][m][n]; } }
    }
};
__device__ __forceinline__ char* hm_tile(char* dout, char* ws, int p) { return p < HM_DOUT_TILES ? dout + (size_t)p * HM_TILE_BYTES : ws + WS_HM + (size_t)(p - HM_DOUT_TILES) * HM_TILE_BYTES; }
template <bool TILE_LOCAL> struct EpiSwiglu {
    static constexpr bool PERM = true;
    bf16_t* H; int ldh; char* dout; char* ws;
    __device__ __forceinline__ void operator()(const AccT& acc, const Unit& u, int wr, int wc, int fr, int fq) const {
        bf16_t* base; if constexpr (TILE_LOCAL) base = (bf16_t*)hm_tile(dout, ws, u.pm); else base = H + (size_t)u.pm * BM * ldh;
        const int rl0 = wr * 64 + fr, col0 = u.pn * 128 + wc * 32 + 8 * fq;
#pragma unroll
        for (int ai = 0; ai < 2; ++ai)
#pragma unroll
            for (int m = 0; m < 4; ++m) { f32x4 o0, o1;
#pragma unroll
                for (int j = 0; j < 4; ++j) { const float g0 = acc[ai][0][m][0][j], g1 = acc[ai][0][m][1][j];
                    o0[j] = g0 * sigmoidf_(g0) * acc[ai][1][m][0][j]; o1[j] = g1 * sigmoidf_(g1) * acc[ai][1][m][1][j]; }
                *(u32x4*)(base + (size_t)(rl0 + ai * HALF + m * 16) * ldh + col0) = pack8(o0, o1); }
    }
};
struct EpiQkv1 {
    static constexpr bool PERM = true;
    bf16_t* O; int ldc; float qscale;
    __device__ __forceinline__ void operator()(const AccT& acc, const Unit& u, int wr, int wc, int fr, int fq) const {
        const int row0 = u.pm * BM + wr * 64 + fr, col0 = u.pn * BM + wc * 32 + 8 * fq; const float sc = ((u.pn % 12) < 4) ? qscale : 1.0f;
#pragma unroll
        for (int ai = 0; ai < 2; ++ai)
#pragma unroll
            for (int m = 0; m < 4; ++m)
#pragma unroll
                for (int bj = 0; bj < 2; ++bj)
                    *(u32x4*)(O + (size_t)(row0 + ai * HALF + m * 16) * ldc + col0 + bj * HALF) = pack8(acc[ai][bj][m][0] * sc, acc[ai][bj][m][1] * sc);
    }
};
struct EpiMoeDown {
    static constexpr bool PERM = true;
    bf16_t* YB; const int* tokk; const float* gate; const PG8_LAS int* rt;
    __device__ __forceinline__ void operator()(const AccT& acc, const Unit& u, int wr, int wc, int fr, int fq) const {
        const int lbase = rt[u.pm * 4 + 1], nvalid = rt[u.pm * 4 + 2];
        const int rl0 = wr * 64 + fr, col0 = u.pn * BM + wc * 32 + 8 * fq;
#pragma unroll
        for (int ai = 0; ai < 2; ++ai)
#pragma unroll
            for (int m = 0; m < 4; ++m) { const int rl = rl0 + ai * HALF + m * 16;
                if (rl < nvalid) { const int tk = tokk[lbase + rl]; const float g = gate[lbase + rl];
                    bf16_t* rowp = YB + ((size_t)(tk & 1) * NTOK + (size_t)(tk >> 1)) * DM + col0;
#pragma unroll
                    for (int bj = 0; bj < 2; ++bj) *(u32x4*)(rowp + bj * HALF) = pack8(acc[ai][bj][m][0] * g, acc[ai][bj][m][1] * g); } }
    }
};
struct MoeOrder {
    int G, c, nM, nN; const PG8_LAS int* rt; const char* xbase; char* dout; char* ws; bool up;
    __device__ __forceinline__ bool next(int i, Unit& u) const {
        const long L = (long)i * G + c; if (L >= (long)nM * nN) return false;
        remap_unit((int)L, nM, nN, u.pm, u.pn); return true;
    }
    __device__ __forceinline__ const char* a_ptr(const Unit& u) const { return up ? xbase : (const char*)hm_tile(dout, ws, u.pm); }
    __device__ __forceinline__ int b_tile(const Unit& u) const { return __builtin_amdgcn_readfirstlane(rt[u.pm * 4]) * nN + u.pn; }
};
}

struct Args {
    const float* in[25]; float* out; unsigned char* ws; int ph_lo, ph_hi;
};
enum { I_X = 0, I_RELB, I_EWIN, I_CONVW, I_CONVB, I_CLNG, I_CLNB, I_EWOUT, I_ELN1G, I_ELN1B, I_FWG, I_FWU, I_FWD, I_ELN2G, I_ELN2B,
       I_OWIN, I_OWOUT, I_OLN1G, I_OLN1B, I_ROUTER, I_MWG, I_MWU, I_MWD, I_OLN2G, I_OLN2B };

__device__ __forceinline__ void transpose_item(const float* W, int ldw, int src_c0, int nvalid, int k0, bf16_t* WT, int K, int dst_row0, LAS float* scr, int lane) {
#pragma unroll 8
    for (int i = 0; i < 32; ++i) { const int kk = 2 * i + (lane >> 5), j = lane & 31; scr[kk * 33 + j] = (j < nvalid) ? W[(size_t)(k0 + kk) * ldw + src_c0 + j] : 0.f; }
    WAVE_LDS_FENCE();
    const int c = lane & 7;
#pragma unroll
    for (int jj = 0; jj < 4; ++jj) { const int n = (lane >> 3) + 8 * jj; const LAS float* s = scr + (8 * c) * 33 + n;
        u32x4 o; o.x = cvt_pk_bf16(s[0 * 33], s[1 * 33]); o.y = cvt_pk_bf16(s[2 * 33], s[3 * 33]); o.z = cvt_pk_bf16(s[4 * 33], s[5 * 33]); o.w = cvt_pk_bf16(s[6 * 33], s[7 * 33]);
        *(u32x4*)(WT + (size_t)(dst_row0 + n) * K + k0 + 8 * c) = o; }
    WAVE_LDS_FENCE();
}
__device__ __forceinline__ void gu_item(const float* wg, const float* wu, int FF, int K, bf16_t* WT, int item, LAS float* scr, int lane) {
    const int nblk = 2 * FF / 32, kb = item / nblk, nb = item % nblk, tile = nb >> 3, sub = nb & 7;
    transpose_item(sub < 4 ? wg : wu, FF, tile * 128 + (sub & 3) * 32, 32, kb * 64, WT, K, nb * 32, scr, lane);
}
__device__ __forceinline__ void plain_item(const float* W, int K, int N, bf16_t* WT, int item, LAS float* scr, int lane) {
    const int nblk = N / 32, kb = item / nblk, nb = item % nblk;
    transpose_item(W, N, nb * 32, 32, kb * 64, WT, K, nb * 32, scr, lane);
}
__device__ __forceinline__ void in0_item(const float* W, bf16_t* WT, int item, LAS float* scr, int lane) {
    const int nblk = IN0_N / 32, kb = item / nblk, nb = item % nblk, tile = nb >> 3, sub = nb & 7;
    int src_c0, nvalid = 32;
    if (tile < 4) src_c0 = (sub < 4) ? tile * 128 + sub * 32 : 512 + tile * 128 + (sub - 4) * 32;
    else { src_c0 = nb * 32; nvalid = IN0_SRC - src_c0; nvalid = nvalid < 0 ? 0 : (nvalid > 32 ? 32 : nvalid); if (nvalid == 0) src_c0 = 0; }
    transpose_item(W, IN0_SRC, src_c0, nvalid, kb * 64, WT, DM, nb * 32, scr, lane);
}
__device__ __forceinline__ int rel_bucket(int n) {
    if (n < 16) return n;
    const float nf = (float)n;
    int large = 16 + (int)(logf(nf / 16.0f) / logf(128.0f) * 16.0f);
    return large < 31 ? large : 31;
}

__device__ __forceinline__ void ln_core(f32x4 (&v)[4], const float* g, const float* b, int lane) {
    float s = 0.f;
#pragma unroll
    for (int j = 0; j < 4; ++j) s += (v[j][0] + v[j][1]) + (v[j][2] + v[j][3]);
    const float mean = wave_sum(s) * (1.f / DM); float s2 = 0.f;
#pragma unroll
    for (int j = 0; j < 4; ++j) { v[j] = v[j] - mean; s2 += (v[j][0] * v[j][0] + v[j][1] * v[j][1]) + (v[j][2] * v[j][2] + v[j][3] * v[j][3]); }
    const float rstd = 1.f / sqrtf(wave_sum(s2) * (1.f / DM) + LN_EPS);
#pragma unroll
    for (int j = 0; j < 4; ++j) { const f32x4 gg = *(const f32x4*)(g + 4 * lane + 256 * j), bb = *(const f32x4*)(b + 4 * lane + 256 * j); v[j] = v[j] * rstd * gg + bb; }
}
__device__ __forceinline__ void store_row_bf16(bf16_t* orow, const f32x4 (&v)[4], int lane) {
#pragma unroll
    for (int j = 0; j < 4; ++j) { u32x2 w; w.x = cvt_pk_bf16(v[j][0], v[j][1]); w.y = cvt_pk_bf16(v[j][2], v[j][3]); *(u32x2*)(orow + 4 * lane + 256 * j) = w; }
}
__device__ __forceinline__ f32x4 ld_bf4(const bf16_t* p) { const u32x2 w = *(const u32x2*)p; return (f32x4){bf_lo(w.x), bf_hi(w.x), bf_lo(w.y), bf_hi(w.y)}; }

__global__ void __launch_bounds__(NTHR, 2) fwd_kernel(Args args) {
    extern __shared__ __attribute__((aligned(16))) unsigned char lds_raw[];
    LAS unsigned char* lds = (LAS unsigned char*)lds_raw;
    const int G = gridDim.x, bid = blockIdx.x;
    const int NGW = G * NWAVES;
    volatile LAS unsigned* MISC = (volatile LAS unsigned*)(lds + LDS_MISC);
    int wave_id;
    {
        const int l0 = (int)__builtin_amdgcn_mbcnt_hi(~0u, __builtin_amdgcn_mbcnt_lo(~0u, 0u));
        if (l0 < 16) MISC[l0] = 0u;
        __syncthreads();
        unsigned id = 0u; if (l0 == 0) id = atomicAdd((unsigned*)(MISC + 2), 1u);
        wave_id = __builtin_amdgcn_readfirstlane((int)id);
        __syncthreads();
    }
#define MY_LANE() ((int)__builtin_amdgcn_mbcnt_hi(~0u, __builtin_amdgcn_mbcnt_lo(~0u, 0u)))
#if ONE_LAUNCH
    (void)xcd_barrier_post((unsigned*)(args.ws + WS_CTL) + CW_BAR, MISC, wave_id == 0 && MY_LANE() == 0);
#define GRID_BAR() do { XcdBarrier _b; _b.bar = (unsigned*)(ws + WS_CTL) + CW_BAR; _b.x = xb_xcc_id(); _b.st = (volatile LAS unsigned*)(lds + LDS_MISC); xcd_barrier(_b, tid == 0); } while (0)
#else
#define GRID_BAR() do { } while (0)
#endif
    const int lo = args.ph_lo, hi = args.ph_hi;
#ifndef PH_MASK
#define PH_MASK 0xFFFFFFu
#endif
#define IN(k) ((((PH_MASK) >> (k)) & 1u) && lo <= (k) && (k) < hi)
#define BOTH(k) (IN(k) && IN((k) + 1))
#define PHASE_BEGIN int lane = MY_LANE(); asm volatile("" : "+v"(lane)); const int wave = wave_id; const int tid = wave * 64 + lane; const int gw = bid * NWAVES + wave; \
    unsigned char* ws = args.ws; asm volatile("" : "+s"(ws)); float* outp = args.out; asm volatile("" : "+s"(outp)); unsigned* ctl = (unsigned*)(ws + WS_CTL); (void)lane; (void)wave; (void)gw; (void)ctl; (void)outp;
#define x_in (args.in[I_X])
#define WIN0 ((bf16_t*)(ws + WS_WIN0))
#define WOUT0 ((bf16_t*)(ws + WS_WOUT0))
#define WGU0 ((bf16_t*)(ws + WS_WGU0))
#define WD0 ((bf16_t*)(ws + WS_WD0))
#define WIN1 ((bf16_t*)(ws + WS_WIN1))
#define WOUT1 ((bf16_t*)(ws + WS_WOUT1))
#define MWGU ((bf16_t*)(ws + WS_MWGU))
#define MWD ((bf16_t*)(ws + WS_MWD))
#define BIAST ((float*)(ws + WS_BIAST))
#define XB ((bf16_t*)(ws + WS_XB))
#define Ub ((bf16_t*)(ws + WS_U))
#define Q0 ((bf16_t*)(ws + WS_Q0))
#define K0 ((bf16_t*)(ws + WS_Q0 + SEG0))
#define V0 ((bf16_t*)(ws + WS_Q0 + 2 * SEG0))
#define QI ((bf16_t*)(ws + WS_Q0 + 3 * SEG0))
#define KI ((bf16_t*)(ws + WS_KI))
#define WI ((float*)(ws + WS_WI))
#define MASK ((u64*)(ws + WS_MASK))
#define MIXIN ((bf16_t*)(ws + WS_MIXIN))
#define X1B ((bf16_t*)(ws + WS_X1B))
#define H0 ((bf16_t*)(ws + WS_H0))
#define X2B ((bf16_t*)(ws + WS_X2B))
#define H1 ((bf16_t*)(ws + WS_H1))
#define O1 ((bf16_t*)outp)
#define Y3 ((float*)(ws + WS_Y3))
#define X3B ((bf16_t*)(ws + WS_X3B))
#define YB ((bf16_t*)(ws + WS_YB))
#define MTOK ((int*)(ws + WS_MOE_TOK))
#define MGATE ((float*)(ws + WS_MOE_GATE))
#define GTAB ((const LAS int*)(lds + LDS_GTAB))

    if (IN(0)) { asm volatile("; PHASE_MARK 0"); PHASE_BEGIN
        LAS float* scr = (LAS float*)(lds + wave * 16384);
        constexpr int I_IN0 = 16 * (IN0_N / 32), I_OUT = 16 * 32, I_GU0 = 16 * (2 * FF0 / 32), I_D0 = (FF0 / 64) * 32, I_IN1 = 16 * (IN1_N / 32);
        constexpr int NIT = I_IN0 + I_OUT + I_GU0 + I_D0 + I_IN1 + I_OUT;
        for (int it = gw; it < NIT; it += NGW) {
            int r = it;
            if (r < I_IN0) { in0_item(args.in[I_EWIN], WIN0, r, scr, lane); continue; } r -= I_IN0;
            if (r < I_OUT) { plain_item(args.in[I_EWOUT], DM, DM, WOUT0, r, scr, lane); continue; } r -= I_OUT;
            if (r < I_GU0) { gu_item(args.in[I_FWG], args.in[I_FWU], FF0, DM, WGU0, r, scr, lane); continue; } r -= I_GU0;
            if (r < I_D0) { plain_item(args.in[I_FWD], FF0, DM, WD0, r, scr, lane); continue; } r -= I_D0;
            if (r < I_IN1) { plain_item(args.in[I_OWIN], DM, IN1_N, WIN1, r, scr, lane); continue; } r -= I_IN1;
            plain_item(args.in[I_OWOUT], DM, DM, WOUT1, r, scr, lane);
        }
        for (size_t i = (size_t)bid * NTHR + tid; i < (size_t)NTOK * DM / 8; i += (size_t)G * NTHR) {
            const f32x4 a = *(const f32x4*)(x_in + i * 8), b = *(const f32x4*)(x_in + i * 8 + 4);
            *(u32x4*)(XB + i * 8) = pg8::pack8(a, b);
        }
        for (int i = bid * NTHR + tid; i < 8 * 4096; i += G * NTHR) { const int h = i >> 12, d = i & 4095; BIAST[i] = args.in[I_RELB][rel_bucket(d) * 8 + h]; }
        if (BOTH(0)) GRID_BAR();
    }

    if (IN(1)) { asm volatile("; PHASE_MARK 1"); PHASE_BEGIN
        pg8::StaticOrder S; S.init(XB, NTOK, IN0_N, DM, G, bid);
        pg8::EpiIn0 E{Ub, Q0, KI, WI};
        pg8::gemm_phase<pg8::EpiIn0, pg8::StaticOrder, true, false>(tid, lds, WIN0, DM, S, E, GTAB);
        if (BOTH(1)) GRID_BAR();
    }

    if (IN(2)) { asm volatile("; PHASE_MARK 2"); PHASE_BEGIN
        {
            LAS bf16_t* ut = (LAS bf16_t*)lds;
            LAS float* yt = (LAS float*)(lds + 65536);
            const float* cw = args.in[I_CONVW]; const int c = tid;
            float w[31];
#pragma unroll
            for (int j = 0; j < 31; ++j) w[j] = cw[j * 512 + c];
            const float cb = args.in[I_CONVB][c];
            for (int tile = bid; tile < NTOK / 32; tile += G) {
                const int t0 = tile * 32, s0 = t0 & (SEQ - 1);
                for (int i = tid; i < 62 * 64; i += NTHR) { const int r = i >> 6, c8 = i & 63; const int sr = s0 - 30 + r;
                    u32x4 v = (u32x4){0u, 0u, 0u, 0u}; if (sr >= 0) v = *(const u32x4*)(Ub + (size_t)(t0 - 30 + r) * 512 + c8 * 8);
                    *(LAS u32x4*)(ut + r * 512 + c8 * 8) = v; }
                __syncthreads();
                for (int t = 0; t < 32; ++t) { float a = cb;
#pragma unroll
                    for (int j = 0; j < 31; ++j) a += w[j] * bf2f(ut[(t + j) * 512 + c]);
                    yt[t * 512 + c] = a; }
                __syncthreads();
                const float* lg = args.in[I_CLNG]; const float* lb = args.in[I_CLNB];
#pragma unroll
                for (int tt = 0; tt < 4; ++tt) { const int t = wave * 4 + tt;
                    f32x4 a = *(LAS f32x4*)(yt + t * 512 + lane * 8), b = *(LAS f32x4*)(yt + t * 512 + lane * 8 + 4);
                    float s = (a[0] + a[1]) + (a[2] + a[3]) + (b[0] + b[1]) + (b[2] + b[3]); const float mean = wave_sum(s) * (1.f / 512.f);
                    a = a - mean; b = b - mean; float s2 = a[0] * a[0] + a[1] * a[1] + a[2] * a[2] + a[3] * a[3] + b[0] * b[0] + b[1] * b[1] + b[2] * b[2] + b[3] * b[3];
                    const float rstd = 1.f / sqrtf(wave_sum(s2) * (1.f / 512.f) + LN_EPS);
                    const f32x4 g0 = *(const f32x4*)(lg + lane * 8), g1 = *(const f32x4*)(lg + lane * 8 + 4), b0 = *(const f32x4*)(lb + lane * 8), b1 = *(const f32x4*)(lb + lane * 8 + 4);
                    a = a * rstd * g0 + b0; b = b * rstd * g1 + b1;
#pragma unroll
                    for (int j = 0; j < 4; ++j) { a[j] = a[j] * sigmoidf_(a[j]); b[j] = b[j] * sigmoidf_(b[j]); }
                    *(u32x4*)(MIXIN + (size_t)(t0 + t) * DM + lane * 8) = pg8::pack8(a, b); }
                __syncthreads();
            }
        }
        {
            LAS float* sc = (LAS float*)lds;
            LAS float* qf = (LAS float*)(lds + 131072);
            LAS unsigned* hist = (LAS unsigned*)(lds + 147456);
            LAS float* wq = (LAS float*)(lds + 155648);
            for (int item = bid; item < NTOK / 8; item += G) {
                const int tok0 = item * 8, b0 = tok0 & ~(SEQ - 1), q0 = tok0 & (SEQ - 1);
                for (int i = tid; i < 8 * 512; i += NTHR) qf[i] = bf2f(QI[(size_t)tok0 * 512 + i]);
                if (tid < 64) wq[tid] = WI[(size_t)tok0 * 8 + tid];
                __syncthreads();
                const int nk = q0 + 8;
                for (int kc = 0; kc * 512 < nk; ++kc) {
                    const int k = kc * 512 + tid;
                    if (k < nk) {
                        float kf[64];
#pragma unroll
                        for (int d8 = 0; d8 < 8; ++d8) { const u32x4 v = *(const u32x4*)(KI + (size_t)(b0 + k) * 64 + d8 * 8);
                            kf[d8 * 8 + 0] = bf_lo(v.x); kf[d8 * 8 + 1] = bf_hi(v.x); kf[d8 * 8 + 2] = bf_lo(v.y); kf[d8 * 8 + 3] = bf_hi(v.y);
                            kf[d8 * 8 + 4] = bf_lo(v.z); kf[d8 * 8 + 5] = bf_hi(v.z); kf[d8 * 8 + 6] = bf_lo(v.w); kf[d8 * 8 + 7] = bf_hi(v.w); }
                        for (int qq = 0; qq < 8; ++qq) { float s = 0.f;
                            for (int h = 0; h < 8; ++h) { float dot = 0.f;
#pragma unroll
                                for (int d4 = 0; d4 < 16; ++d4) { const f32x4 q4 = *(LAS f32x4*)(qf + qq * 512 + h * 64 + d4 * 4);
                                    dot += q4[0] * kf[d4 * 4] + q4[1] * kf[d4 * 4 + 1] + q4[2] * kf[d4 * 4 + 2] + q4[3] * kf[d4 * 4 + 3]; }
                                s += wq[qq * 8 + h] * fmaxf(dot, 0.f); }
                            sc[qq * 4096 + k] = s; }
                    }
                }
                __syncthreads();
                {
                    const int q = q0 + wave, n = q + 1; LAS float* row = sc + wave * 4096; LAS unsigned* hh = hist + wave * 256;
                    u64* mrow = MASK + (size_t)(tok0 + wave) * 64;
                    unsigned thr = 0u; int need = 0;
                    if (n > 256) {
                        unsigned prefix = 0u; int kk = 256;
                        for (int pass = 0; pass < 4; ++pass) {
                            const int shift = 24 - 8 * pass;
#pragma unroll
                            for (int j = 0; j < 4; ++j) hh[lane * 4 + j] = 0u;
                            WAVE_LDS_FENCE();
                            for (int i = lane; i < n; i += 64) { const unsigned u = __float_as_uint(row[i] + 0.0f); const unsigned key = (u & 0x80000000u) ? ~u : (u | 0x80000000u);
                                const bool match = (pass == 0) || ((key >> (shift + 8)) == (prefix >> (shift + 8)));
                                if (match) atomicAdd((unsigned*)(hh + ((key >> shift) & 255u)), 1u); }
                            WAVE_LDS_FENCE();
                            unsigned c0 = hh[lane * 4 + 0], c1 = hh[lane * 4 + 1], c2 = hh[lane * 4 + 2], c3 = hh[lane * 4 + 3];
                            const unsigned sl = c0 + c1 + c2 + c3; unsigned inc = sl;
#pragma unroll
                            for (int o = 1; o < 64; o <<= 1) { const unsigned t = __shfl_down(inc, o); if (lane + o < 64) inc += t; }
                            const unsigned exc = inc - sl;
                            const bool found = (exc < (unsigned)kk) && (inc >= (unsigned)kk);
                            int bin = 0, kn = 0;
                            { unsigned cum = exc;
                              if (cum + c3 >= (unsigned)kk) { bin = 3; kn = kk - (int)cum; } else { cum += c3;
                              if (cum + c2 >= (unsigned)kk) { bin = 2; kn = kk - (int)cum; } else { cum += c2;
                              if (cum + c1 >= (unsigned)kk) { bin = 1; kn = kk - (int)cum; } else { cum += c1; bin = 0; kn = kk - (int)cum; } } } }
                            const u64 fm = __ballot(found); const int src = fm ? (__ffsll((long long)fm) - 1) : 0;
                            bin = __shfl(lane * 4 + bin, src); kk = __shfl(kn, src);
                            prefix |= ((unsigned)bin) << shift;
                            WAVE_LDS_FENCE();
                        }
                        thr = prefix; need = kk;
                    }
                    int tie_run = 0;
                    for (int j = 0; j < 64; ++j) { const int i = j * 64 + lane; u64 word;
                        if (n <= 256) word = __ballot(i < n);
                        else { bool gt = false, eq = false;
                            if (i < n) { const unsigned u = __float_as_uint(row[i] + 0.0f); const unsigned key = (u & 0x80000000u) ? ~u : (u | 0x80000000u); gt = key > thr; eq = key == thr; }
                            const u64 eqm = __ballot(eq); const int rank = tie_run + __popcll(eqm & ((1ull << lane) - 1ull));
                            word = __ballot(gt || (eq && rank < need)); tie_run += __popcll(eqm); }
                        if (lane == 0) mrow[j] = word; }
                }
                __syncthreads();
            }
        }
        if (BOTH(2)) GRID_BAR();
    }

    if (IN(3)) { asm volatile("; PHASE_MARK 3"); PHASE_BEGIN
        LAS int* list = (LAS int*)lds;
        LAS unsigned* base = (LAS unsigned*)(lds + 1024);
        LAS u64* words = (LAS u64*)(lds + 1536);
        LAS float* pw = (LAS float*)(lds + 2048 + wave * 1024);
        for (int item = bid; item < NTOK; item += G) {
            const int tok = item, b0 = tok & ~(SEQ - 1), t = tok & (SEQ - 1), n = t + 1, cnt = n < 256 ? n : 256;
            if (tid < 64) { const u64 w = MASK[(size_t)tok * 64 + tid]; words[tid] = w; const unsigned c = (unsigned)__popcll(w); unsigned inc = c;
#pragma unroll
                for (int o = 1; o < 64; o <<= 1) { const unsigned tt = __shfl_up(inc, o); if (lane >= o) inc += tt; }
                base[tid] = inc - c; }
            __syncthreads();
            { const int j = tid >> 3, bb0 = (tid & 7) * 8; const u64 w = words[j]; const unsigned bs = base[j];
#pragma unroll
              for (int bb = 0; bb < 8; ++bb) { const int bit = bb0 + bb; if ((w >> bit) & 1ull) { const int pos = (int)bs + __popcll(w & ((1ull << bit) - 1ull)); if (pos < 256) list[pos] = j * 64 + bit; } } }
            __syncthreads();
            {
                const int h = wave; float qv[64];
#pragma unroll
                for (int d8 = 0; d8 < 8; ++d8) { const u32x4 v = *(const u32x4*)(Q0 + (size_t)tok * 512 + h * 64 + d8 * 8);
                    qv[d8 * 8 + 0] = bf_lo(v.x); qv[d8 * 8 + 1] = bf_hi(v.x); qv[d8 * 8 + 2] = bf_lo(v.y); qv[d8 * 8 + 3] = bf_hi(v.y);
                    qv[d8 * 8 + 4] = bf_lo(v.z); qv[d8 * 8 + 5] = bf_hi(v.z); qv[d8 * 8 + 6] = bf_lo(v.w); qv[d8 * 8 + 7] = bf_hi(v.w); }
                float lg[4]; float mx = -INFINITY;
#pragma unroll
                for (int i = 0; i < 4; ++i) { const int idx = lane + 64 * i; lg[i] = -INFINITY;
                    if (idx < cnt) { const int key = list[idx]; const bf16_t* kp = K0 + (size_t)(b0 + key) * 512 + h * 64; float dot = 0.f;
#pragma unroll
                        for (int d8 = 0; d8 < 8; ++d8) { const u32x4 v = *(const u32x4*)(kp + d8 * 8);
                            dot += qv[d8 * 8 + 0] * bf_lo(v.x) + qv[d8 * 8 + 1] * bf_hi(v.x) + qv[d8 * 8 + 2] * bf_lo(v.y) + qv[d8 * 8 + 3] * bf_hi(v.y)
                                 + qv[d8 * 8 + 4] * bf_lo(v.z) + qv[d8 * 8 + 5] * bf_hi(v.z) + qv[d8 * 8 + 6] * bf_lo(v.w) + qv[d8 * 8 + 7] * bf_hi(v.w); }
                        lg[i] = dot + BIAST[h * 4096 + (t - key)]; }
                    mx = fmaxf(mx, lg[i]); }
                mx = wave_max(mx); float sum = 0.f;
#pragma unroll
                for (int i = 0; i < 4; ++i) { const float p = (lg[i] == -INFINITY) ? 0.f : __expf(lg[i] - mx); sum += p; pw[lane + 64 * i] = p; }
                sum = wave_sum(sum);
                WAVE_LDS_FENCE();
                float acc = 0.f;
                for (int i = 0; i < cnt; ++i) { const int key = list[i]; acc += pw[i] * bf2f(V0[(size_t)(b0 + key) * 512 + h * 64 + lane]); }
                MIXIN[(size_t)tok * DM + 512 + h * 64 + lane] = (bf16_t)(cvt_pk_bf16(acc / sum, 0.f) & 0xffffu);
            }
            __syncthreads();
        }
        if (BOTH(3)) GRID_BAR();
    }

    if (IN(4)) { asm volatile("; PHASE_MARK 4"); PHASE_BEGIN
        pg8::StaticOrder S; S.init(MIXIN, NTOK, DM, DM, G, bid);
        pg8::EpiRes<false> E{outp, x_in};
        pg8::gemm_phase<pg8::EpiRes<false>, pg8::StaticOrder, true, false>(tid, lds, WOUT0, DM, S, E, GTAB);
        if (BOTH(4)) GRID_BAR();
    }
    if (IN(5)) { asm volatile("; PHASE_MARK 5"); PHASE_BEGIN
        for (int m = gw; m < NTOK; m += NGW) { f32x4 v[4];
#pragma unroll
            for (int j = 0; j < 4; ++j) v[j] = *(const f32x4*)(outp + (size_t)m * DM + 4 * lane + 256 * j);
            ln_core(v, args.in[I_ELN1G], args.in[I_ELN1B], lane); store_row_bf16(X1B + (size_t)m * DM, v, lane); }
        if (BOTH(5)) GRID_BAR();
    }
    if (IN(6)) { asm volatile("; PHASE_MARK 6"); PHASE_BEGIN
        pg8::StaticOrder S; S.init(X1B, NTOK, 2 * FF0, DM, G, bid);
        pg8::EpiSwiglu<false> E{H0, FF0, (char*)outp, (char*)ws};
        pg8::gemm_phase<pg8::EpiSwiglu<false>, pg8::StaticOrder, true, false>(tid, lds, WGU0, DM, S, E, GTAB);
        if (BOTH(6)) GRID_BAR();
    }
    if (IN(7)) { asm volatile("; PHASE_MARK 7"); PHASE_BEGIN
        pg8::StaticOrder S; S.init(H0, NTOK, DM, FF0, G, bid);
        pg8::EpiRes<true> E{outp, X1B};
        pg8::gemm_phase<pg8::EpiRes<true>, pg8::StaticOrder, true, false>(tid, lds, WD0, FF0, S, E, GTAB);
        if (BOTH(7)) GRID_BAR();
    }
    if (IN(8)) { asm volatile("; PHASE_MARK 8"); PHASE_BEGIN
        for (int m = gw; m < NTOK; m += NGW) { f32x4 v[4];
#pragma unroll
            for (int j = 0; j < 4; ++j) v[j] = *(const f32x4*)(outp + (size_t)m * DM + 4 * lane + 256 * j);
            ln_core(v, args.in[I_ELN2G], args.in[I_ELN2B], lane); store_row_bf16(X2B + (size_t)m * DM, v, lane); }
        if (BOTH(8)) GRID_BAR();
    }
#pragma unroll
    for (int ch = 0; ch < 2; ++ch) {
        if (IN(9 + 2 * ch)) { asm volatile("; PHASE_MARK 9"); PHASE_BEGIN
            pg8::StaticOrder S; S.init(X2B + (size_t)ch * CHUNK_T * DM, CHUNK_T, IN1_N, DM, G, bid);
            pg8::EpiQkv1 E{H1, IN1_N, 0.08838834764831845f};
            pg8::gemm_phase<pg8::EpiQkv1, pg8::StaticOrder, true, false>(tid, lds, WIN1, DM, S, E, GTAB);
            if (BOTH(9 + 2 * ch)) GRID_BAR();
        }
        if (IN(10 + 2 * ch)) { asm volatile("; PHASE_MARK 10"); PHASE_BEGIN
            LAS float* qw = (LAS float*)(lds + wave * 512);
            LAS float* pw = (LAS float*)(lds + 4096 + wave * 2048);
            for (int it = gw; it < CHUNK_T * 8; it += NGW) {
                const int tl = it >> 3, h = it & 7, t = tl & (SEQ - 1);
                const bf16_t* hrow = H1 + (size_t)tl * IN1_N;
                float mx = -INFINITY;
#pragma unroll 1
                for (int g = 0; g < 3; ++g) {
                    const int dsh = 2 * g;
                    { const unsigned w = *(const unsigned*)(hrow + g * 3072 + h * 128 + 2 * lane); qw[2 * lane] = bf_lo(w); qw[2 * lane + 1] = bf_hi(w); }
                    WAVE_LDS_FENCE();
#pragma unroll 1
                    for (int jj = 0; jj < 3; ++jj) { const int j = lane + 64 * jj; float l = -INFINITY;
                        if (j <= 128 && (j << dsh) <= t) { const bf16_t* kp = H1 + (size_t)(tl - (j << dsh)) * IN1_N + g * 3072 + 1024 + h * 128; float dot = 0.f;
#pragma unroll
                            for (int d8 = 0; d8 < 16; ++d8) { const u32x4 v = *(const u32x4*)(kp + d8 * 8); const f32x4 qa = *(LAS f32x4*)(qw + d8 * 8), qb = *(LAS f32x4*)(qw + d8 * 8 + 4);
                                dot += qa[0] * bf_lo(v.x) + qa[1] * bf_hi(v.x) + qa[2] * bf_lo(v.y) + qa[3] * bf_hi(v.y) + qb[0] * bf_lo(v.z) + qb[1] * bf_hi(v.z) + qb[2] * bf_lo(v.w) + qb[3] * bf_hi(v.w); }
                            l = dot + BIAST[h * 4096 + (j << dsh)]; }
                        if (j <= 128) pw[g * 129 + j] = l;
                        mx = fmaxf(mx, l); }
                    WAVE_LDS_FENCE();
                }
                mx = wave_max(mx); float sum = 0.f;
                for (int f = lane; f < 387; f += 64) { const float l = pw[f]; const float p = (l == -INFINITY) ? 0.f : __expf(l - mx); pw[f] = p; sum += p; }
                sum = wave_sum(sum);
                WAVE_LDS_FENCE();
                float a0 = 0.f, a1 = 0.f;
#pragma unroll 1
                for (int g = 0; g < 3; ++g) { const int dsh = 2 * g; int jmax = t >> dsh; jmax = jmax > 128 ? 128 : jmax;
                    for (int j = 0; j <= jmax; ++j) { const float p = pw[g * 129 + j]; const unsigned w = *(const unsigned*)(H1 + (size_t)(tl - (j << dsh)) * IN1_N + g * 3072 + 2048 + h * 128 + 2 * lane);
                        a0 += p * bf_lo(w); a1 += p * bf_hi(w); } }
                const float inv = 1.f / sum;
                *(unsigned*)(O1 + ((size_t)ch * CHUNK_T + tl) * DM + h * 128 + 2 * lane) = cvt_pk_bf16(a0 * inv, a1 * inv);
                WAVE_LDS_FENCE();
            }
            if (BOTH(10 + 2 * ch)) GRID_BAR();
        }
    }
    if (IN(13)) { asm volatile("; PHASE_MARK 13"); PHASE_BEGIN
        pg8::StaticOrder S; S.init(O1, NTOK, DM, DM, G, bid);
        pg8::EpiRes<true> E{Y3, X2B};
        pg8::gemm_phase<pg8::EpiRes<true>, pg8::StaticOrder, true, false>(tid, lds, WOUT1, DM, S, E, GTAB);
        if (BOTH(13)) GRID_BAR();
    }
    if (IN(14)) { asm volatile("; PHASE_MARK 14"); PHASE_BEGIN
        const float* rt = args.in[I_ROUTER];
        for (int m = gw; m < NTOK; m += NGW) { f32x4 v[4];
#pragma unroll
            for (int j = 0; j < 4; ++j) v[j] = *(const f32x4*)(Y3 + (size_t)m * DM + 4 * lane + 256 * j);
            ln_core(v, args.in[I_OLN1G], args.in[I_OLN1B], lane); store_row_bf16(X3B + (size_t)m * DM, v, lane);
            float lgt[8];
#pragma unroll
            for (int e = 0; e < 8; ++e) lgt[e] = 0.f;
#pragma unroll
            for (int j = 0; j < 4; ++j)
#pragma unroll
                for (int i = 0; i < 4; ++i) { const float* rr = rt + (size_t)(4 * lane + 256 * j + i) * 8; const f32x4 r0 = *(const f32x4*)rr, r1 = *(const f32x4*)(rr + 4); const float xv = v[j][i];
                    lgt[0] += xv * r0[0]; lgt[1] += xv * r0[1]; lgt[2] += xv * r0[2]; lgt[3] += xv * r0[3]; lgt[4] += xv * r1[0]; lgt[5] += xv * r1[1]; lgt[6] += xv * r1[2]; lgt[7] += xv * r1[3]; }
#pragma unroll
            for (int e = 0; e < 8; ++e) lgt[e] = wave_sum(lgt[e]);
            int e1 = 0; float v1 = lgt[0];
#pragma unroll
            for (int e = 1; e < 8; ++e) if (lgt[e] > v1) { v1 = lgt[e]; e1 = e; }
            int e2 = -1; float v2 = -INFINITY;
#pragma unroll
            for (int e = 0; e < 8; ++e) if (e != e1 && lgt[e] > v2) { v2 = lgt[e]; e2 = e; }
            const float g2 = 1.f / (1.f + __expf(v1 - v2)), g1 = 1.f - g2;
            if (lane == 0) {
                const unsigned p1 = atomicAdd(ctl + CW_MOECNT + e1, 1u), p2 = atomicAdd(ctl + CW_MOECNT + e2, 1u);
                if (p1 < (unsigned)NTOK) { MTOK[e1 * NTOK + p1] = m * 2; MGATE[e1 * NTOK + p1] = g1; }
                if (p2 < (unsigned)NTOK) { MTOK[e2 * NTOK + p2] = m * 2 + 1; MGATE[e2 * NTOK + p2] = g2; }
            }
        }
        __syncthreads();
        {
            LAS float* scr = (LAS float*)(lds + wave * 16384);
            constexpr int I_GU = 16 * (2 * FFE / 32), I_D = (FFE / 64) * 32;
            for (int it = gw; it < NEXP * (I_GU + I_D); it += NGW) {
                const int e = it / (I_GU + I_D), r = it % (I_GU + I_D);
                if (r < I_GU) gu_item(args.in[I_MWG] + (size_t)e * DM * FFE, args.in[I_MWU] + (size_t)e * DM * FFE, FFE, DM, MWGU + (size_t)e * 2 * FFE * DM, r, scr, lane);
                else plain_item(args.in[I_MWD] + (size_t)e * FFE * DM, FFE, DM, MWD + (size_t)e * DM * FFE, r - I_GU, scr, lane);
            }
        }
        if (BOTH(14)) GRID_BAR();
    }
#pragma unroll
    for (int ch = 0; ch < 2; ++ch) {
        if (IN(15 + 2 * ch) || IN(16 + 2 * ch)) {
            LAS int* rt = (LAS int*)(lds + LDS_RT);
            int nM;
            { PHASE_BEGIN int ts[9]; int cn[8]; ts[0] = 0;
#pragma unroll
              for (int e = 0; e < 8; ++e) { int ce = __builtin_amdgcn_readfirstlane((int)ctl[CW_MOECNT + e]); ce = ce > NTOK ? NTOK : ce; cn[e] = ce; ts[e + 1] = ts[e] + (ce + 255) / 256; }
              const int t0 = ch * MOE_CH_TILES; int t1 = t0 + MOE_CH_TILES; if (t1 > ts[8]) t1 = ts[8]; nM = __builtin_amdgcn_readfirstlane(t1 > t0 ? t1 - t0 : 0);
              if (tid < nM) { const int g = t0 + tid; int e = 0;
#pragma unroll
                  for (int k = 1; k < 8; ++k) e += (g >= ts[k]) ? 1 : 0;
                  int ce = cn[0], tse = ts[0];
#pragma unroll
                  for (int k = 1; k < 8; ++k) { ce = (e == k) ? cn[k] : ce; tse = (e == k) ? ts[k] : tse; }
                  const int j = g - tse; int nv = ce - j * 256; nv = nv > 256 ? 256 : nv;
                  rt[tid * 4 + 0] = e; rt[tid * 4 + 1] = e * NTOK + j * 256; rt[tid * 4 + 2] = nv; rt[tid * 4 + 3] = 0; } }
            __syncthreads();
            if (IN(15 + 2 * ch)) { asm volatile("; PHASE_MARK 15"); PHASE_BEGIN
                pg8::MoeOrder S{G, bid, nM, 2 * FFE / 256, rt, (const char*)X3B, (char*)outp, (char*)ws, true};
                LAS int* gtab = (LAS int*)(lds + LDS_GTAB);
                { pg8::Unit u; for (int i = 0; i < 16 && S.next(i, u); ++i) { if (tid < 256) { const int lb = rt[u.pm * 4 + 1], nv = rt[u.pm * 4 + 2]; const int r = tid < nv ? tid : 0; gtab[i * 256 + tid] = MTOK[lb + r] >> 1; } } }
                __syncthreads();
                pg8::EpiSwiglu<true> E{H0, FFE, (char*)outp, (char*)ws};
                pg8::gemm_phase<pg8::EpiSwiglu<true>, pg8::MoeOrder, true, true>(tid, lds, MWGU, DM, S, E, gtab);
                if (BOTH(15 + 2 * ch)) GRID_BAR();
            }
            if (IN(16 + 2 * ch)) { asm volatile("; PHASE_MARK 16"); PHASE_BEGIN
                pg8::MoeOrder S{G, bid, nM, DM / 256, rt, (const char*)X3B, (char*)outp, (char*)ws, false};
                pg8::EpiMoeDown E{YB, MTOK, MGATE, rt};
                pg8::gemm_phase<pg8::EpiMoeDown, pg8::MoeOrder, true, false>(tid, lds, MWD, FFE, S, E, GTAB);
                if (BOTH(16 + 2 * ch)) GRID_BAR();
            }
        }
    }
    if (IN(19)) { asm volatile("; PHASE_MARK 19"); PHASE_BEGIN
        for (int m = gw; m < NTOK; m += NGW) { f32x4 v[4];
#pragma unroll
            for (int j = 0; j < 4; ++j) { const size_t o = (size_t)m * DM + 4 * lane + 256 * j; v[j] = ld_bf4(X3B + o) * ALPHA + ld_bf4(YB + o) + ld_bf4(YB + (size_t)NTOK * DM + o); }
            ln_core(v, args.in[I_OLN2G], args.in[I_OLN2B], lane);
#pragma unroll
            for (int j = 0; j < 4; ++j) *(f32x4*)(outp + (size_t)m * DM + 4 * lane + 256 * j) = v[j]; }
    }
#undef IN
#undef BOTH
}

constexpr int NPHASES = 20;
extern "C" void kernel_launch(void* const* d_in, const int* in_sizes, int n_in, void* d_out, int out_size, void* d_ws, size_t ws_size, hipStream_t stream) {
    static int grid = 0;
    if (grid == 0) {
        if (n_in != 25 || out_size != NTOK * DM || ws_size < WS_END) { fprintf(stderr, "kernel_launch: unexpected shapes (n_in %d out %d ws %zu)\n", n_in, out_size, ws_size); grid = -1; return; }
        int dev = 0, cus = 0;
        if (hipGetDevice(&dev) != hipSuccess || hipDeviceGetAttribute(&cus, hipDeviceAttributeMultiprocessorCount, dev) != hipSuccess) { grid = -1; return; }
        if (hipFuncSetAttribute((const void*)fwd_kernel, hipFuncAttributeMaxDynamicSharedMemorySize, LDS_BYTES) != hipSuccess) { fprintf(stderr, "kernel_launch: hipFuncSetAttribute failed\n"); grid = -1; return; }
        int per_cu = 0;
        if (hipOccupancyMaxActiveBlocksPerMultiprocessor(&per_cu, (const void*)fwd_kernel, NTHR, LDS_BYTES) != hipSuccess || per_cu < 1) { fprintf(stderr, "kernel_launch: occupancy query says %d\n", per_cu); }
        (void)hipGetLastError();
        grid = cus;
    }
    if (grid < 0) return;
    (void)hipMemsetAsync((char*)d_ws + WS_CTL, 0, CTL_ZERO_BYTES, stream);
    Args a{};
    for (int i = 0; i < 25; ++i) a.in[i] = (const float*)d_in[i];
    a.out = (float*)d_out; a.ws = (unsigned char*)d_ws;
#if ONE_LAUNCH
    a.ph_lo = 0; a.ph_hi = NPHASES;
    hipLaunchKernelGGL(fwd_kernel, dim3(grid), dim3(NTHR), LDS_BYTES, stream, a);
#else
    for (int ph = 0; ph < NPHASES; ++ph) { a.ph_lo = ph; a.ph_hi = ph + 1; hipLaunchKernelGGL(fwd_kernel, dim3(grid), dim3(NTHR), LDS_BYTES, stream, a); }
#endif
}
```

```cpp
#include <hip/hip_runtime.h>
#include <cstdio>
#include <cstdint>

#ifndef ONE_LAUNCH
#define ONE_LAUNCH 1
#endif

#define LAS __attribute__((address_space(3)))
typedef unsigned short bf16_t;
typedef short bf16x8 __attribute__((ext_vector_type(8)));
typedef float f32x4 __attribute__((ext_vector_type(4)));
typedef float f32x2 __attribute__((ext_vector_type(2)));
typedef unsigned u32x4 __attribute__((ext_vector_type(4)));
typedef unsigned u32x2 __attribute__((ext_vector_type(2)));
typedef unsigned long long u64;

constexpr int NB = 8, SEQ = 4096, DM = 1024, NTOK = NB * SEQ;
constexpr int IN0_SRC = 3144, IN0_N = 3328;
constexpr int FF0 = 2816, FFE = 3584, NEXP = 8;
constexpr int IN1_N = 9216;
constexpr int CHUNK_B = 4, CHUNK_T = CHUNK_B * SEQ;
constexpr int MOE_CH_TILES = 132;
constexpr int HM_DOUT_TILES = 73;
constexpr float ALPHA = 1.4142135623730951f;
constexpr float LN_EPS = 1e-5f;
constexpr int NWAVES = 8, NTHR = 512;

constexpr size_t MiB = 1u << 20;
constexpr size_t WS_CTL = 0, CTL_ZERO_BYTES = 64 * 1024;
constexpr size_t WS_BIAST = 1 * MiB;
constexpr size_t WS_MOE_TOK = 2 * MiB;
constexpr size_t WS_MOE_GATE = 3 * MiB;
constexpr size_t WS_WIN0 = 4 * MiB;
constexpr size_t WS_WOUT0 = 11 * MiB;
constexpr size_t WS_WGU0 = 13 * MiB;
constexpr size_t WS_WD0 = 24 * MiB;
constexpr size_t WS_WIN1 = 30 * MiB;
constexpr size_t WS_WOUT1 = 48 * MiB;
constexpr size_t WS_XB = 50 * MiB;
constexpr size_t WS_U = 114 * MiB;
constexpr size_t WS_Q0 = 146 * MiB, SEG0 = 32 * MiB;
constexpr size_t WS_KI = 274 * MiB;
constexpr size_t WS_WI = 278 * MiB;
constexpr size_t WS_MASK = 280 * MiB;
constexpr size_t WS_MIXIN = 296 * MiB;
constexpr size_t WS_X1B = 50 * MiB;
constexpr size_t WS_H0 = 114 * MiB;
constexpr size_t WS_X2B = 448 * MiB;
constexpr size_t WS_H1 = 50 * MiB;
constexpr size_t WS_OP = 338 * MiB;
constexpr size_t WS_LSE = 434 * MiB;
constexpr size_t WS_Y3 = 216 * MiB;
constexpr size_t WS_X3B = 152 * MiB;
constexpr size_t WS_YB = 216 * MiB;
constexpr size_t WS_MWGU = 344 * MiB;
constexpr size_t WS_MWD = 456 * MiB;
constexpr size_t WS_HM = 4 * MiB;
constexpr size_t WS_END = 512 * MiB;
constexpr size_t HM_TILE_BYTES = (size_t)256 * FFE * 2;
constexpr int CW_MOECNT = 64;
constexpr int CW_BAR = 1024;

constexpr int LDS_GTAB = 131072;
constexpr int LDS_RT = 147456;
constexpr int LDS_MISC = 155648 + 2048;
constexpr int LDS_BYTES = 159744;

__device__ __forceinline__ unsigned cvt_pk_bf16(float lo, float hi) { unsigned r; asm volatile("v_cvt_pk_bf16_f32 %0, %1, %2" : "=v"(r) : "v"(lo), "v"(hi)); return r; }
__device__ __forceinline__ float bf_lo(unsigned w) { return __uint_as_float(w << 16); }
__device__ __forceinline__ float bf_hi(unsigned w) { return __uint_as_float(w & 0xffff0000u); }
__device__ __forceinline__ float bf2f(bf16_t b) { return __uint_as_float(((unsigned)b) << 16); }
template <int M> __device__ __forceinline__ float swz_xor(float v) {
    return __int_as_float(__builtin_amdgcn_ds_swizzle(__float_as_int(v), (M << 10) | 0x1f)); }
__device__ __forceinline__ float wave_sum(float v) {
    v += swz_xor<1>(v); v += swz_xor<2>(v); v += swz_xor<4>(v); v += swz_xor<8>(v); v += swz_xor<16>(v);
    auto rr = __builtin_amdgcn_permlane32_swap(__float_as_uint(v), __float_as_uint(v), false, false);
    return __uint_as_float(rr[0]) + __uint_as_float(rr[1]);
}
__device__ __forceinline__ float wave_max(float v) {
    v = fmaxf(v, swz_xor<1>(v)); v = fmaxf(v, swz_xor<2>(v)); v = fmaxf(v, swz_xor<4>(v)); v = fmaxf(v, swz_xor<8>(v)); v = fmaxf(v, swz_xor<16>(v));
    auto rr = __builtin_amdgcn_permlane32_swap(__float_as_uint(v), __float_as_uint(v), false, false);
    return fmaxf(__uint_as_float(rr[0]), __uint_as_float(rr[1]));
}
__device__ __forceinline__ unsigned lane_get(unsigned v, int src_lane) { return (unsigned)__builtin_amdgcn_ds_bpermute(src_lane << 2, (int)v); }
__device__ __forceinline__ float sigmoidf_(float x) { return __builtin_amdgcn_rcpf(1.0f + __expf(-x)); }
#define WAVE_LDS_FENCE() do { asm volatile("s_waitcnt lgkmcnt(0)" ::: "memory"); __builtin_amdgcn_wave_barrier(); } while (0)

#define XB_TMO      128
#define XB_XCNT(j)  (256  + 64 * (j))
#define XB_XSUB(j)  (1280 + 64 * (j))
#define XB_XGEN(j)  (2304 + 64 * (j))
#define XB_TOP      3328
#define XB_TOPGEN   3392
#define XCD_BAR_WORDS 3456
#define XB_SPIN_CAP (1u << 18)
__device__ __forceinline__ unsigned xb_ld(unsigned* p)              { return __hip_atomic_load(p, __ATOMIC_RELAXED, __HIP_MEMORY_SCOPE_AGENT); }
__device__ __forceinline__ unsigned xb_add(unsigned* p, unsigned v) { return __hip_atomic_fetch_add(p, v, __ATOMIC_RELAXED, __HIP_MEMORY_SCOPE_AGENT); }
__device__ __forceinline__ unsigned xb_xcc_id() { return (unsigned)__builtin_amdgcn_s_getreg((3 << 11) | 20) & 0xFu; }
#define XB_SPIN(cond, bar) do { unsigned _sp = 0; while (cond) { __builtin_amdgcn_s_sleep(1); \
    if ((++_sp & 255u) == 0u) { if (xb_ld(&(bar)[XB_TMO])) break; if (_sp > XB_SPIN_CAP) { atomicAdd(&(bar)[XB_TMO], 1u); break; } } } } while (0)
struct XcdBarrier { unsigned* bar; unsigned x; volatile LAS unsigned* st; };
__device__ __forceinline__ XcdBarrier xcd_barrier_post(unsigned* bar, volatile LAS unsigned* st, bool leader) {
    XcdBarrier b; b.bar = bar; b.x = xb_xcc_id(); b.st = st;
    if (leader) (void)xb_add(&bar[XB_XCNT(b.x)], 1u);
    return b;
}
__device__ __forceinline__ void xcd_barrier_complete(unsigned* bar, unsigned x, unsigned& nloc, unsigned& nx) {
    const unsigned G = gridDim.x * gridDim.y * gridDim.z;
    unsigned sum, cnt, mine, sp = 0u;
    for (;;) {
        sum = 0u; cnt = 0u; mine = 0u;
#pragma unroll
        for (unsigned j = 0; j < 16; ++j) { const unsigned c = xb_ld(&bar[XB_XCNT(j)]); sum += c; cnt += (c > 0u) ? 1u : 0u; mine = (j == x) ? c : mine; }
        if (sum == G) break;
        __builtin_amdgcn_s_sleep(1);
        if ((++sp & 255u) == 0u) { if (xb_ld(&bar[XB_TMO])) break; if (sp > XB_SPIN_CAP) { atomicAdd(&bar[XB_TMO], 1u); break; } }
    }
    nloc = mine > 0u ? mine : 1u; nx = cnt > 0u ? cnt : 1u;
}
__device__ __forceinline__ void xcd_barrier(const XcdBarrier& b, bool leader) {
    asm volatile("s_waitcnt vmcnt(0)" ::: "memory");
    __syncthreads();
    if (leader) {
        unsigned* bar = b.bar;
        __builtin_amdgcn_s_waitcnt(0);
        unsigned nloc = b.st[0], nx = b.st[1];
        if (nloc == 0u) { xcd_barrier_complete(bar, b.x, nloc, nx); b.st[0] = nloc; b.st[1] = nx; }
        const unsigned old = xb_add(&bar[XB_XSUB(b.x)], 1u);
        const unsigned gen = old / nloc;
        if (old + 1u == (gen + 1u) * nloc) {
            __builtin_amdgcn_fence(__ATOMIC_RELEASE, "agent");
            asm volatile("s_waitcnt vmcnt(0)" ::: "memory");
            const unsigned og = xb_add(&bar[XB_TOP], 1u);
            const unsigned tg = og / nx;
            if (og + 1u == (tg + 1u) * nx) xb_add(&bar[XB_TOPGEN], 1u);
            else XB_SPIN(xb_ld(&bar[XB_TOPGEN]) == tg, bar);
            __builtin_amdgcn_fence(__ATOMIC_ACQUIRE, "agent");
            xb_add(&bar[XB_XGEN(b.x)], 1u);
            asm volatile("s_waitcnt vmcnt(0)" ::: "memory");
        } else {
            XB_SPIN(xb_ld(&bar[XB_XGEN(b.x)]) == gen, bar);
            __builtin_amdgcn_fence(__ATOMIC_ACQUIRE, "agent");
            asm volatile("s_waitcnt vmcnt(0)" ::: "memory");
        }
    }
    __syncthreads();
}

namespace pg8 {
constexpr int BM = 256, BK = 64, HALF = 128, HTB = HALF * BK * 2, STAGE_BYTES = 8 * HTB, NXCD = 8, WGM = 8;
__host__ __device__ __forceinline__ int lds_byte(int r, int c) { const int st = (r >> 4) * 2 + (c >> 5), rr = r & 15, cc = c & 31, ob = rr * 64 + cc * 2; return st * 1024 + (ob ^ (((ob >> 9) & 1) << 5)); }
__host__ __device__ __forceinline__ void stage_rc(int b, int& R, int& C) { const int st = b / 1024, sb = b % 1024, swz = sb ^ (((sb >> 9) & 1) << 5); R = (st >> 1) * 16 + swz / 64; C = (st & 1) * 32 + (swz % 64) / 2; }
__host__ __device__ __forceinline__ int perm32(int rho) { const int n = rho >> 4, i = rho & 15; return 8 * (i >> 2) + 4 * n + (i & 3); }

struct Unit { int pm, pn; };

__device__ __forceinline__ void remap_unit(int wgid, int nM, int nN, int& pm, int& pn) {
    const int nwg = nM * nN;
    { const int q = nwg / NXCD, r = nwg % NXCD, xcd = wgid % NXCD, off = wgid / NXCD; wgid = (xcd < r ? xcd * (q + 1) : r * (q + 1) + (xcd - r) * q) + off; }
    const int nig = WGM * nN, gid = wgid / nig, fm = gid * WGM, gsz = (nM - fm) < WGM ? (nM - fm) : WGM;
    pm = fm + ((wgid % nig) % gsz); pn = (wgid % nig) / gsz;
}
struct StaticOrder {
    int nM, nN, nwg, G, c; const char* A; size_t tstepA;
    __device__ void init(const bf16_t* A_, int M, int N, int K, int G_, int c_) { nM = M / BM; nN = N / BM; nwg = nM * nN; G = G_; c = c_; A = (const char*)A_; tstepA = (size_t)BM * K * 2; }
    __device__ __forceinline__ bool next(int i, Unit& u) const {
        const long L = (long)i * G + c; if (L >= nwg) return false;
        remap_unit((int)L, nM, nN, u.pm, u.pn); return true;
    }
    __device__ __forceinline__ const char* a_ptr(const Unit& u) const { return A + (size_t)u.pm * tstepA; }
    __device__ __forceinline__ int b_tile(const Unit& u) const { return u.pn; }
};

#define PG8_LAS __attribute__((address_space(3)))
template <class Epi, class Sched, bool ALIGN_EPI, bool GATHER>
__device__ __forceinline__ void gemm_phase(const int tid, PG8_LAS unsigned char* lds, const bf16_t* Btp, const int K, const Sched& S, const Epi& E, const PG8_LAS int* gtab) {
    const int wid = __builtin_amdgcn_readfirstlane(tid >> 6), lane = tid & 63, wr = wid >> 2, wc = wid & 3, fr = lane & 15, fq = lane >> 4;
    const int nt = K / BK;
    unsigned voffA[2], voffB[2];
#pragma unroll
    for (int i = 0; i < 2; ++i) { int R, C; stage_rc(tid * 16 + i * 8192, R, C); const int Rb = Epi::PERM ? ((R & ~31) + perm32(R & 31)) : R;
        voffA[i] = (unsigned)(R * K + C) * 2u; voffB[i] = (unsigned)(Rb * K + C) * 2u; }
    const size_t kstep = (size_t)(BK * 2);
    const size_t hstep = (size_t)HALF * K * 2;
    const size_t tstep = 2 * hstep;
    const unsigned ldsw = (unsigned)wid * 1024u;
    const int aoff = lds_byte(wr * 64 + fr, fq * 8), boff = lds_byte(wc * 32 + fr, fq * 8);
#define PG8_SA(b, h) (((b) * 2 + (h)) * HTB)
#define PG8_SB(b, h) ((4 + (b) * 2 + (h)) * HTB)
#define PG8_STAGE(bufoff, gbase, voff) do { _Pragma("unroll") for (int _i = 0; _i < 2; ++_i) \
        __builtin_amdgcn_global_load_lds((const unsigned*)((const char*)(gbase) + (voff)[_i]), (PG8_LAS unsigned*)(lds + (bufoff) + ldsw + _i * 8192), 16, 0, 0); } while (0)
#define PG8_STAGE_AC(bufoff, kt, h) do { if constexpr (GATHER) { PG8_STAGE(bufoff, cA + (size_t)(kt) * kstep, gcur[h]); } else { PG8_STAGE(bufoff, cA + (size_t)(kt) * kstep + (h) * hstep, voffA); } } while (0)
#define PG8_STAGE_AN(bufoff, d, h) do { if constexpr (GATHER) { if (last) { unsigned _g[2]; _Pragma("unroll") for (int _i = 0; _i < 2; ++_i) { int _R, _C; stage_rc(tid * 16 + _i * 8192, _R, _C); _g[_i] = (unsigned)gtab[nslot * 256 + (h) * 128 + _R] * (unsigned)(K * 2) + (unsigned)(_C * 2); } \
            PG8_STAGE(bufoff, nA + (size_t)(d) * kstep, _g); } else { PG8_STAGE(bufoff, cA + (size_t)(t + 2 + (d)) * kstep, gcur[h]); } } \
        else { PG8_STAGE(bufoff, a2 + (size_t)(d) * kstep + (h) * hstep, voffA); } } while (0)
#define PG8_LDA(dst, b, h) do { _Pragma("unroll") for (int m = 0; m < 4; ++m) _Pragma("unroll") for (int k = 0; k < 2; ++k) dst[m][k] = *(const PG8_LAS bf16x8*)(lds + PG8_SA(b, h) + aoff + m * 2048 + k * 1024); } while (0)
#define PG8_LDB(dst, b, h) do { _Pragma("unroll") for (int n = 0; n < 2; ++n) _Pragma("unroll") for (int k = 0; k < 2; ++k) dst[n][k] = *(const PG8_LAS bf16x8*)(lds + PG8_SB(b, h) + boff + n * 2048 + k * 1024); } while (0)
#define PG8_MMA(ai, bj, At, Bt) do { __builtin_amdgcn_s_setprio(1); _Pragma("unroll") for (int m = 0; m < 4; ++m) _Pragma("unroll") for (int n = 0; n < 2; ++n) _Pragma("unroll") for (int k = 0; k < 2; ++k) \
        acc[ai][bj][m][n] = __builtin_amdgcn_mfma_f32_16x16x32_bf16(Bt[n][k], At[m][k], acc[ai][bj][m][n], 0, 0, 0); __builtin_amdgcn_s_setprio(0); } while (0)
#define PG8_WAIT_V(n) asm volatile("s_waitcnt vmcnt(" #n ")" ::: "memory")
#define PG8_WAIT_L(n) asm volatile("s_waitcnt lgkmcnt(" #n ")" ::: "memory")
#define PG8_BAR __builtin_amdgcn_s_barrier()
#define PG8_SCHED __builtin_amdgcn_sched_barrier(0)
#define PG8_LOADG(dst, slot_) do { _Pragma("unroll") for (int _i = 0; _i < 2; ++_i) { int _R, _C; stage_rc(tid * 16 + _i * 8192, _R, _C); _Pragma("unroll") for (int _h = 0; _h < 2; ++_h) \
        dst[_h][_i] = (unsigned)gtab[(slot_) * 256 + _h * 128 + _R] * (unsigned)(K * 2) + (unsigned)(_C * 2); } } while (0)
    Unit cur, nxt; int ui = 0;
    if (!S.next(0, cur)) return;
    f32x4 acc[2][2][4][2];
#pragma unroll
    for (int a = 0; a < 2; ++a)
#pragma unroll
        for (int b = 0; b < 2; ++b)
#pragma unroll
            for (int m = 0; m < 4; ++m)
#pragma unroll
                for (int n = 0; n < 2; ++n) acc[a][b][m][n] = (f32x4){0.f, 0.f, 0.f, 0.f};
    bf16x8 At[4][2], B0[2][2], B1[2][2];
    unsigned gcur[2][2] = {{0u, 0u}, {0u, 0u}};
    const char* cA = S.a_ptr(cur); const char* cB = (const char*)Btp + (size_t)S.b_tile(cur) * tstep;
    if constexpr (GATHER) { PG8_LOADG(gcur, 0); PG8_WAIT_L(0); }
    PG8_STAGE(PG8_SB(0, 0), cB, voffB); PG8_STAGE(PG8_SB(0, 1), cB + hstep, voffB); PG8_STAGE_AC(PG8_SA(0, 0), 0, 0); PG8_STAGE_AC(PG8_SA(0, 1), 0, 1);
    if (wr == 1) PG8_BAR;
    PG8_WAIT_V(2); PG8_BAR;
    PG8_STAGE(PG8_SB(1, 0), cB + kstep, voffB); PG8_STAGE_AC(PG8_SA(1, 0), 1, 0); PG8_STAGE(PG8_SB(1, 1), cB + hstep + kstep, voffB);
    PG8_WAIT_V(6); PG8_BAR;
    for (;;) {
        const bool has_next = S.next(ui + 1, nxt);
        const char* nA = has_next ? S.a_ptr(nxt) : cA; const char* nB = has_next ? (const char*)Btp + (size_t)S.b_tile(nxt) * tstep : cB;
        const int nslot = has_next ? ui + 1 : ui;
        for (int t = 0; t < nt; t += 2) {
            const bool last = (t == nt - 2);
            const char* a2 = last ? nA : cA + (size_t)(t + 2) * kstep; const char* b2 = last ? nB : cB + (size_t)(t + 2) * kstep;
            const char* b3 = b2 + kstep;
            (void)a2;
            PG8_LDB(B0, 0, 0); PG8_LDB(B1, 0, 1); PG8_SCHED; PG8_LDA(At, 0, 0); PG8_STAGE_AC(PG8_SA(1, 1), t + 1, 1);
            PG8_WAIT_V(8); PG8_WAIT_L(0); PG8_BAR; PG8_MMA(0, 0, At, B0); PG8_MMA(0, 1, At, B1); PG8_BAR; PG8_SCHED;
            PG8_LDA(At, 0, 1); PG8_STAGE(PG8_SB(0, 0), b2, voffB); PG8_STAGE(PG8_SB(0, 1), b2 + hstep, voffB); PG8_STAGE_AN(PG8_SA(0, 0), 0, 0);
            PG8_WAIT_V(8); PG8_WAIT_L(0); PG8_BAR; PG8_MMA(1, 0, At, B0); PG8_MMA(1, 1, At, B1); PG8_BAR; PG8_SCHED;
            PG8_LDB(B0, 1, 0); PG8_LDB(B1, 1, 1); PG8_SCHED; PG8_LDA(At, 1, 0); PG8_STAGE_AN(PG8_SA(0, 1), 0, 1);
            PG8_WAIT_V(8); PG8_WAIT_L(0); PG8_BAR; PG8_MMA(0, 0, At, B0); PG8_MMA(0, 1, At, B1); PG8_BAR; PG8_SCHED;
            PG8_LDA(At, 1, 1); PG8_STAGE(PG8_SB(1, 0), b3, voffB); PG8_STAGE(PG8_SB(1, 1), b3 + hstep, voffB); PG8_STAGE_AN(PG8_SA(1, 0), 1, 0);
            PG8_WAIT_V(8); PG8_WAIT_L(0); PG8_BAR; PG8_MMA(1, 0, At, B0); PG8_MMA(1, 1, At, B1); PG8_BAR; PG8_SCHED;
        }
        if constexpr (ALIGN_EPI) { if (wr == 0) PG8_BAR; }
        { int fr_e = fr, fq_e = fq; asm volatile("" : "+v"(fr_e), "+v"(fq_e)); E(acc, cur, wr, wc, fr_e, fq_e); }
        if (!has_next) break;
#pragma unroll
        for (int a = 0; a < 2; ++a)
#pragma unroll
            for (int b = 0; b < 2; ++b)
#pragma unroll
                for (int m = 0; m < 4; ++m)
#pragma unroll
                    for (int n = 0; n < 2; ++n) acc[a][b][m][n] = (f32x4){0.f, 0.f, 0.f, 0.f};
        cur = nxt; cA = nA; cB = nB; ++ui;
        if constexpr (GATHER) { PG8_LOADG(gcur, ui); }
        if constexpr (ALIGN_EPI) { if (wr == 1) PG8_BAR; }
    }
    PG8_WAIT_V(0);
    if constexpr (!ALIGN_EPI) { if (wr == 0) PG8_BAR; }
    PG8_BAR;
#undef PG8_SA
#undef PG8_SB
#undef PG8_STAGE
#undef PG8_STAGE_AC
#undef PG8_STAGE_AN
#undef PG8_LDA
#undef PG8_LDB
#undef PG8_MMA
#undef PG8_WAIT_V
#undef PG8_WAIT_L
#undef PG8_BAR
#undef PG8_SCHED
#undef PG8_LOADG
}

typedef f32x4 AccT[2][2][4][2];
__device__ __forceinline__ u32x4 pack8(const f32x4 v0, const f32x4 v1) { u32x4 w; w.x = cvt_pk_bf16(v0[0], v0[1]); w.y = cvt_pk_bf16(v0[2], v0[3]); w.z = cvt_pk_bf16(v1[0], v1[1]); w.w = cvt_pk_bf16(v1[2], v1[3]); return w; }

struct EpiIn0 {
    static constexpr bool PERM = true;
    bf16_t* U; bf16_t* Q; bf16_t* KI; float* WI;
    __device__ __forceinline__ void operator()(const AccT& acc, const Unit& u, int wr, int wc, int fr, int fq) const {
        const int row0 = u.pm * BM + wr * 64 + fr;
        if (u.pn < 4) {
            const int col0 = u.pn * 128 + wc * 32 + 8 * fq;
#pragma unroll
            for (int ai = 0; ai < 2; ++ai)
#pragma unroll
                for (int m = 0; m < 4; ++m) { f32x4 o0, o1;
#pragma unroll
                    for (int j = 0; j < 4; ++j) { o0[j] = acc[ai][0][m][0][j] * sigmoidf_(acc[ai][1][m][0][j]); o1[j] = acc[ai][0][m][1][j] * sigmoidf_(acc[ai][1][m][1][j]); }
                    *(u32x4*)(U + (size_t)(row0 + ai * HALF + m * 16) * 512 + col0) = pack8(o0, o1); }
        } else if (u.pn < 12) {
            const int t = (u.pn - 4) >> 1; bf16_t* base = Q + (size_t)t * (SEG0 / 2); const float sc = (t == 0) ? 0.125f : 1.0f;
            const int col0 = ((u.pn - 4) & 1) * 256 + wc * 32 + 8 * fq;
#pragma unroll
            for (int ai = 0; ai < 2; ++ai)
#pragma unroll
                for (int m = 0; m < 4; ++m)
#pragma unroll
                    for (int bj = 0; bj < 2; ++bj)
                        *(u32x4*)(base + (size_t)(row0 + ai * HALF + m * 16) * 512 + col0 + bj * HALF) = pack8(acc[ai][bj][m][0] * sc, acc[ai][bj][m][1] * sc);
        } else {
            if (wc < 2) {
#pragma unroll
                for (int ai = 0; ai < 2; ++ai)
#pragma unroll
                    for (int m = 0; m < 4; ++m) *(u32x4*)(KI + (size_t)(row0 + ai * HALF + m * 16) * 64 + wc * 32 + 8 * fq) = pack8(acc[ai][0][m][0], acc[ai][0][m][1]);
            } else if (wc == 2 && fq == 0) {
                const float sc = 0.04419417382415922f;
#pragma unroll
                for (int ai = 0; ai < 2; ++ai)
#pragma unroll
                    for (int m = 0; m < 4; ++m) { float* p = WI + (size_t)(row0 + ai * HALF + m * 16) * 8; *(f32x4*)p = acc[ai][0][m][0] * sc; *(f32x4*)(p + 4) = acc[ai][0][m][1] * sc; }
            }
        }
    }
};
template <bool RB> struct EpiRes {
    static constexpr bool PERM = false;
    float* out; const void* resid;
    __device__ __forceinline__ void operator()(const AccT& acc, const Unit& u, int wr, int wc, int fr, int fq) const {
        const int row0 = u.pm * BM + wr * 64 + fr, col0 = u.pn * BM + wc * 32 + 4 * fq;
#pragma unroll
        for (int ai = 0; ai < 2; ++ai)
#pragma unroll
            for (int m = 0; m < 4; ++m) { const size_t off = (size_t)(row0 + ai * HALF + m * 16) * DM + col0;
#pragma unroll
                for (int bj = 0; bj < 2; ++bj)
#pragma unroll
                    for (int n = 0; n < 2; ++n) { f32x4 r;
                        if (RB) { const u32x2 w = *(const u32x2*)((const bf16_t*)resid + off + bj * HALF + n * 16); r = (f32x4){bf_lo(w.x), bf_hi(w.x), bf_lo(w.y), bf_hi(w.y)}; }
                        else r = *(const f32x4*)((const float*)resid + off + bj * HALF + n * 16);
                        *(f32x4*)(out + off + bj * HALF + n * 16) = r * ALPHA + acc[ai][bj][m][n]; } }
    }
};
__device__ __forceinline__ char* hm_tile(char* dout, char* ws, int p) { return p < HM_DOUT_TILES ? dout + (size_t)p * HM_TILE_BYTES : ws + WS_HM + (size_t)(p - HM_DOUT_TILES) * HM_TILE_BYTES; }
template <bool TILE_LOCAL> struct EpiSwiglu {
    static constexpr bool PERM = true;
    bf16_t* H; int ldh; char* dout; char* ws;
    __device__ __forceinline__ void operator()(const AccT& acc, const Unit& u, int wr, int wc, int fr, int fq) const {
        bf16_t* base; if constexpr (TILE_LOCAL) base = (bf16_t*)hm_tile(dout, ws, u.pm); else base = H + (size_t)u.pm * BM * ldh;
        const int rl0 = wr * 64 + fr, col0 = u.pn * 128 + wc * 32 + 8 * fq;
#pragma unroll
        for (int ai = 0; ai < 2; ++ai)
#pragma unroll
            for (int m = 0; m < 4; ++m) { f32x4 o0, o1;
#pragma unroll
                for (int j = 0; j < 4; ++j) { const float g0 = acc[ai][0][m][0][j], g1 = acc[ai][0][m][1][j];
                    o0[j] = g0 * sigmoidf_(g0) * acc[ai][1][m][0][j]; o1[j] = g1 * sigmoidf_(g1) * acc[ai][1][m][1][j]; }
                *(u32x4*)(base + (size_t)(rl0 + ai * HALF + m * 16) * ldh + col0) = pack8(o0, o1); }
    }
};
struct EpiQkv1 {
    static constexpr bool PERM = true;
    bf16_t* O; int ldc; float qscale;
    __device__ __forceinline__ void operator()(const AccT& acc, const Unit& u, int wr, int wc, int fr, int fq) const {
        const int row0 = u.pm * BM + wr * 64 + fr, col0 = u.pn * BM + wc * 32 + 8 * fq; const float sc = ((u.pn % 12) < 4) ? qscale : 1.0f;
#pragma unroll
        for (int ai = 0; ai < 2; ++ai)
#pragma unroll
            for (int m = 0; m < 4; ++m)
#pragma unroll
                for (int bj = 0; bj < 2; ++bj)
                    *(u32x4*)(O + (size_t)(row0 + ai * HALF + m * 16) * ldc + col0 + bj * HALF) = pack8(acc[ai][bj][m][0] * sc, acc[ai][bj][m][1] * sc);
    }
};
struct EpiMoeDown {
    static constexpr bool PERM = true;
    bf16_t* YB; const int* tokk; const float* gate; const PG8_LAS int* rt;
    __device__ __forceinline__ void operator()(const AccT& acc, const Unit& u, int wr, int wc, int fr, int fq) const {
        const int lbase = rt[u.pm * 4 + 1], nvalid = rt[u.pm * 4 + 2];
        const int rl0 = wr * 64 + fr, col0 = u.pn * BM + wc * 32 + 8 * fq;
#pragma unroll
        for (int ai = 0; ai < 2; ++ai)
#pragma unroll
            for (int m = 0; m < 4; ++m) { const int rl = rl0 + ai * HALF + m * 16;
                if (rl < nvalid) { const int tk = tokk[lbase + rl]; const float g = gate[lbase + rl];
                    bf16_t* rowp = YB + ((size_t)(tk & 1) * NTOK + (size_t)(tk >> 1)) * DM + col0;
#pragma unroll
                    for (int bj = 0; bj < 2; ++bj) *(u32x4*)(rowp + bj * HALF) = pack8(acc[ai][bj][m][0] * g, acc[ai][bj][m][1] * g); } }
    }
};
struct MoeOrder {
    int G, c, nM, nN; const PG8_LAS int* rt; const char* xbase; char* dout; char* ws; bool up;
    __device__ __forceinline__ bool next(int i, Unit& u) const {
        const long L = (long)i * G + c; if (L >= (long)nM * nN) return false;
        remap_unit((int)L, nM, nN, u.pm, u.pn); return true;
    }
    __device__ __forceinline__ const char* a_ptr(const Unit& u) const { return up ? xbase : (const char*)hm_tile(dout, ws, u.pm); }
    __device__ __forceinline__ int b_tile(const Unit& u) const { return __builtin_amdgcn_readfirstlane(rt[u.pm * 4]) * nN + u.pn; }
};
}


namespace swa {
constexpr int D = 128, NW = 8, QBLK = 32, KVBLK = 64, QB = NW * QBLK, WIN = 129;
constexpr int SHM_V = KVBLK * D * 2, SHM_K = KVBLK * D * 2;
constexpr int LDS_TB = 2 * SHM_V + 2 * SHM_K + NW * 64 * 4;
constexpr float SCALE = 0.08838834764831845f, THR = 8.f;
typedef float f32x16 __attribute__((ext_vector_type(16)));
typedef short s16x4 __attribute__((ext_vector_type(4)));
#define KSWZ(row, colB) ((row) * 256 + ((colB) ^ (((row) & 7) << 4)))
#define SBAR() __builtin_amdgcn_sched_barrier(0)
__device__ __forceinline__ int v_st(int k, int c) { const int kk = (k & ~0xC) | ((k & 4) << 1) | ((k & 8) >> 1); return ((kk >> 3) * 4 + (c >> 5)) * 512 + ((kk & 7) * 32 + (c & 31)) * 2; }
__device__ __forceinline__ int v_rd_base(int lane) { return ((lane & 3) << 3) | (((lane >> 2) & 3) << 6) | (((lane >> 4) & 1) << 5) | (((lane >> 5) & 1) << 8); }
constexpr int v_rd_off(int d0, int ks, int half) { return d0 * 512 + ks * 4096 + half * 2048; }
__device__ __forceinline__ int crow(int r, int hi) { return (r & 3) + 8 * (r >> 2) + 4 * hi; }
__device__ __forceinline__ bf16x8 load8(const bf16_t* p) { return *reinterpret_cast<const bf16x8*>(p); }
__device__ __forceinline__ void mask_bias_tile(f32x16& p0, f32x16& p1, int dq, const float* tb) {
    const float NEG = -__builtin_inff();
#pragma unroll
    for (int r = 0; r < 16; ++r) {
        const int c = (r & 3) + 8 * (r >> 2);
        p0[r] = ((unsigned)(dq - c) < (unsigned)WIN) ? p0[r] + tb[59 - c] : NEG;
        p1[r] = ((unsigned)(dq - c - 32) < (unsigned)WIN) ? p1[r] + tb[27 - c] : NEG;
    }
}
__device__ __forceinline__ void partialSM(f32x16& p0, f32x16& p1, float& m_reg, float& mn, float& alpha) {
    float pmax = p0[0];
#pragma unroll
    for (int r = 1; r < 16; ++r) pmax = fmaxf(pmax, p0[r]);
#pragma unroll
    for (int r = 0; r < 16; ++r) pmax = fmaxf(pmax, p1[r]);
    { auto rr = __builtin_amdgcn_permlane32_swap(__float_as_uint(pmax), __float_as_uint(pmax), false, false);
      pmax = fmaxf(__uint_as_float(rr[0]), __uint_as_float(rr[1])); }
    constexpr float C2 = 1.4426950408889634f * SCALE;
    if (__builtin_expect(__all((pmax - m_reg) * SCALE <= THR), 1)) { mn = m_reg; alpha = 1.f; }
    else { mn = fmaxf(m_reg, pmax); alpha = __builtin_amdgcn_exp2f((m_reg - mn) * C2); m_reg = mn; }
    const float mnL = -mn * C2;
#pragma unroll
    for (int r = 0; r < 16; ++r) p0[r] = fmaf(p0[r], C2, mnL);
#pragma unroll
    for (int r = 0; r < 16; ++r) p1[r] = fmaf(p1[r], C2, mnL);
#pragma unroll
    for (int r = 0; r < 16; ++r) p0[r] = __builtin_amdgcn_exp2f(p0[r]);
}
__device__ __forceinline__ void finishSM(f32x16& p0, f32x16& p1, float alpha, float& l_reg, bf16x8& pa0, bf16x8& pa1, bf16x8& pa2, bf16x8& pa3) {
#pragma unroll
    for (int r = 0; r < 16; ++r) p1[r] = __builtin_amdgcn_exp2f(p1[r]);
    float ps = 0;
#pragma unroll
    for (int r = 0; r < 16; ++r) ps += p0[r];
#pragma unroll
    for (int r = 0; r < 16; ++r) ps += p1[r];
    { auto rr = __builtin_amdgcn_permlane32_swap(__float_as_uint(ps), __float_as_uint(ps), false, false);
      ps = __uint_as_float(rr[0]) + __uint_as_float(rr[1]); }
    l_reg = l_reg * alpha + ps;
#define PK4(P, B_, OUT) do { unsigned a0 = cvt_pk_bf16(P[B_+0], P[B_+1]), a1 = cvt_pk_bf16(P[B_+2], P[B_+3]);                          \
        unsigned b0 = cvt_pk_bf16(P[B_+4], P[B_+5]), b1 = cvt_pk_bf16(P[B_+6], P[B_+7]);                                             \
        auto r0 = __builtin_amdgcn_permlane32_swap(a0, b0, false, false); auto r1 = __builtin_amdgcn_permlane32_swap(a1, b1, false, false); \
        u32x4 w = {r0[0], r1[0], r0[1], r1[1]}; OUT = *reinterpret_cast<bf16x8*>(&w); } while (0)
    PK4(p0, 0, pa0); PK4(p0, 8, pa1); PK4(p1, 0, pa2); PK4(p1, 8, pa3);
#undef PK4
}
template <int KB>
__device__ __forceinline__ void qkt(f32x16& p0, f32x16& p1, const char* K_lds, int r32, int hi, const bf16x8* qr, bool act) {
    if (!act) { const float NEG = -__builtin_inff();
#pragma unroll
        for (int r = 0; r < 16; ++r) { p0[r] = NEG; p1[r] = NEG; } return; }
    p0 = f32x16{}; p1 = f32x16{};
    const char* kb[4];
#pragma unroll
    for (int dd = 0; dd < 4; ++dd) kb[dd] = K_lds + KB * SHM_K + KSWZ(r32, (dd * 16 + hi * 8) * 2);
#pragma unroll
    for (int d0 = 0; d0 < 8; ++d0) { const char* a = kb[d0 & 3] + (d0 >> 2) * 128;
        bf16x8 b0 = *reinterpret_cast<const bf16x8*>(a);
        bf16x8 b1 = *reinterpret_cast<const bf16x8*>(a + 32 * 256);
        p0 = __builtin_amdgcn_mfma_f32_32x32x16_bf16(b0, qr[d0], p0, 0, 0, 0);
        p1 = __builtin_amdgcn_mfma_f32_32x32x16_bf16(b1, qr[d0], p1, 0, 0, 0); }
}
template <int VB>
__device__ __forceinline__ void pv_tile(f32x16* o, int vb0, bf16x8 pa0, bf16x8 pa1, bf16x8 pa2, bf16x8 pa3, bool act) {
    if (!act) return;
#define TRRD(dst, off) asm volatile("ds_read_b64_tr_b16 %0, %1 offset:%2" : "=&v"(dst) : "v"(vb0), "i"(off) : "memory")
#define PV_D0(d0) do { s16x4 l0, l1, l2, l3, h0, h1, h2, h3; constexpr int b_ = VB * SHM_V + v_rd_off(d0, 0, 0); \
        TRRD(l0, b_); TRRD(h0, b_ + 2048); TRRD(l1, b_ + 4096); TRRD(h1, b_ + 6144); TRRD(l2, b_ + 8192); TRRD(h2, b_ + 10240); TRRD(l3, b_ + 12288); TRRD(h3, b_ + 14336); \
        asm volatile("s_waitcnt lgkmcnt(0)" ::: "memory"); SBAR();   \
        o[d0] = __builtin_amdgcn_mfma_f32_32x32x16_bf16(pa0, (bf16x8){l0[0], l0[1], l0[2], l0[3], h0[0], h0[1], h0[2], h0[3]}, o[d0], 0, 0, 0);   \
        o[d0] = __builtin_amdgcn_mfma_f32_32x32x16_bf16(pa1, (bf16x8){l1[0], l1[1], l1[2], l1[3], h1[0], h1[1], h1[2], h1[3]}, o[d0], 0, 0, 0);   \
        o[d0] = __builtin_amdgcn_mfma_f32_32x32x16_bf16(pa2, (bf16x8){l2[0], l2[1], l2[2], l2[3], h2[0], h2[1], h2[2], h2[3]}, o[d0], 0, 0, 0);   \
        o[d0] = __builtin_amdgcn_mfma_f32_32x32x16_bf16(pa3, (bf16x8){l3[0], l3[1], l3[2], l3[3], h3[0], h3[1], h3[2], h3[3]}, o[d0], 0, 0, 0); } while (0)
    PV_D0(0); PV_D0(1); PV_D0(2); PV_D0(3);
#undef PV_D0
#undef TRRD
}
struct BlockRef { const bf16_t* Q; const bf16_t* K; bf16_t* O; float* LSE; int P0, bh, dsh;
    __device__ __forceinline__ int rs() const { return IN1_N << dsh; }
    __device__ __forceinline__ int os() const { return DM << dsh; }
    __device__ __forceinline__ int ls() const { return 8 << dsh; }
    __device__ __forceinline__ int skv() const { return SEQ >> dsh; }
    __device__ __forceinline__ const bf16_t* V() const { return K + 1024; } };
struct Seam { bf16x8 qr[8]; bf16x8 st_v0, st_v1, st_k0, st_k1; };
__device__ __forceinline__ int swa_jlo(int P0) { const int lowk = P0 - WIN + 1; return lowk > 0 ? lowk / KVBLK : 0; }
#define ROWP(p, k0, rs_, vo) ((const bf16_t*)((const char*)(p) + (size_t)(k0) * (size_t)(rs_) * 2 + (size_t)(vo)))
#define VMW() asm volatile("s_waitcnt vmcnt(0)" ::: "memory")
#define VMWN(n) asm volatile("s_waitcnt vmcnt(%0)" :: "i"(n) : "memory")
#define TIDL() int tid_l = tid; asm volatile("" : "+v"(tid_l)); const int sr = tid_l >> 4, sc = (tid_l & 15) * 8; (void)sr; (void)sc
#define SLOAD_H(Kp, Vp, k0, rs_) do { TIDL(); const unsigned vo0_ = (unsigned)(sr * (rs_) + sc) * 2u, vo1_ = vo0_ + (unsigned)(rs_) * 64u; \
                         S.st_v0 = load8(ROWP(Vp, k0, rs_, vo0_)); S.st_v1 = load8(ROWP(Vp, k0, rs_, vo1_));              \
                         S.st_k0 = load8(ROWP(Kp, k0, rs_, vo0_)); S.st_k1 = load8(ROWP(Kp, k0, rs_, vo1_)); } while (0)
#define SWRITE_HK(bf) do { TIDL(); const int kws = KSWZ(sr, sc * 2); *(bf16x8*)(K_lds + (bf) * SHM_K + kws) = S.st_k0; *(bf16x8*)(K_lds + (bf) * SHM_K + kws + 32 * 256) = S.st_k1; } while (0)
#define SWRITE_HV(bf) do { TIDL(); const int vst0 = v_st(sr, sc), vst1 = v_st(32 + sr, sc); *(bf16x8*)(V_lds + (bf) * SHM_V + vst0) = S.st_v0; *(bf16x8*)(V_lds + (bf) * SHM_V + vst1) = S.st_v1; } while (0)
#define SWRITE_H(bf) do { SWRITE_HV(bf); SWRITE_HK(bf); } while (0)
__device__ __forceinline__ void tb_load(const float* biast, int bh, int dsh, int tid, float& v0, float& v1) {
    const int d0 = tid - 384, d1 = tid + 512 - 384;
    v0 = (d0 >= 0 && d0 < WIN) ? biast[bh * 4096 + (d0 << dsh)] * (1.0f / SCALE) : 0.f;
    v1 = (d1 >= 0 && d1 < WIN) ? biast[bh * 4096 + (d1 << dsh)] * (1.0f / SCALE) : 0.f;
}
__device__ __forceinline__ void swa_prime(const BlockRef& cur, const float* biast, char* lds, Seam& S, int tid) {
    const int wid = __builtin_amdgcn_readfirstlane(tid >> 6), lane = tid & 63, r32 = lane & 31, hi = lane >> 5;
    char* K_lds = lds + 2 * SHM_V;
    const int kb0 = swa_jlo(cur.P0) * KVBLK;
    float t0, t1; tb_load(biast, cur.bh, cur.dsh, tid, t0, t1);
#pragma unroll
    for (int d0 = 0; d0 < 8; ++d0) S.qr[d0] = load8((const bf16_t*)((const char*)cur.Q + (size_t)((unsigned)((wid * QBLK + r32) * cur.rs() + hi * 8) * 2u)) + d0 * 16);
    SLOAD_H(cur.K, cur.V(), kb0, cur.rs()); VMW(); SWRITE_HK(0);
    float* tb = (float*)(lds + LDS_TB); tb[tid] = t0; tb[tid + 512] = t1;
    __syncthreads();
}
__device__ __forceinline__ void swa_block(const BlockRef& cur, const BlockRef& nxt, const float* biast, int slot, char* lds, Seam& S, int tid) {
    const int wid = __builtin_amdgcn_readfirstlane(tid >> 6), lane = tid & 63, r32 = lane & 31, hi = lane >> 5;
    const int j_lo = swa_jlo(cur.P0);
    int j_hi = (cur.P0 + QB - 1) / KVBLK + 1; if (j_hi > cur.skv() / KVBLK) j_hi = cur.skv() / KVBLK;
    const int NT = j_hi - j_lo;
    const int kbn = swa_jlo(nxt.P0) * KVBLK;
    const int qlo = cur.P0 + wid * QBLK, qm = qlo + r32 - 4 * hi;
    char* V_lds = lds; char* K_lds = lds + 2 * SHM_V;
    float* wsl = (float*)(lds + 2 * SHM_V + 2 * SHM_K) + wid * 64; float* li_l = wsl, * al_l = wsl + 32;
    const float* tbl0 = (const float*)(lds + LDS_TB + slot * 4096) + 325;
    float m_reg = -1e30f, l_reg = 0; f32x16 o[4] = {};
    const int vb0 = (int)(uintptr_t)V_lds + v_rd_base(lane);
    const bf16_t* Kh = cur.K; const bf16_t* Vh = cur.V(); const int rs = cur.rs();
#define RESC(a) do { if (__any((a) < 1.f)) { if (hi == 0) al_l[r32] = (a); asm volatile("s_waitcnt lgkmcnt(0)" ::: "memory");              \
                     _Pragma("unroll") for (int d_ = 0; d_ < 4; ++d_) _Pragma("unroll") for (int r = 0; r < 16; ++r) o[d_][r] *= al_l[crow(r, hi)]; } } while (0)
#define KBASE(t) ((j_lo + (t)) * KVBLK)
#define ACT(t) (KBASE(t) <= qlo + QBLK - 1 && KBASE(t) + KVBLK - 1 >= qlo - WIN + 1)
#define MASKT(P0_, P1_, t) do { const int kb_ = KBASE(t); if (ACT(t)) mask_bias_tile(P0_, P1_, qm - kb_, tbl0 + (qm - kb_)); } while (0)
    constexpr int NQL = 8;
#define SEAM_K0() do { VMWN(NQL); SWRITE_HK(0); SBAR(); } while (0)
    f32x16 pA0, pA1, pB0, pB1; float mnA, mnB, alA, alB; bf16x8 pa0, pa1, pa2, pa3;
    SWRITE_HV(0); SBAR();
    if (NT > 1) { SLOAD_H(Kh, Vh, KBASE(1), rs); }
    SBAR(); qkt<0>(pA0, pA1, K_lds, r32, hi, S.qr, ACT(0));
    MASKT(pA0, pA1, 0); partialSM(pA0, pA1, m_reg, mnA, alA);
    if (NT > 1) { VMW(); SWRITE_H(1); }
    __syncthreads();
#define HALF_STEP(PX0, PX1, mnX, alX, PY0, PY1, alY, t, KB, VB, SB) do {                                                      \
        SBAR(); qkt<KB>(PX0, PX1, K_lds, r32, hi, S.qr, ACT(t));                                             \
        finishSM(PY0, PY1, alY, l_reg, pa0, pa1, pa2, pa3); SBAR();                                                           \
        if ((t) + 1 < NT) { SLOAD_H(Kh, Vh, KBASE((t) + 1), rs); SBAR(); }                                               \
        pv_tile<VB>(o, vb0, pa0, pa1, pa2, pa3, ACT((t) - 1)); MASKT(PX0, PX1, (t)); partialSM(PX0, PX1, m_reg, mnX, alX);                                        \
        __syncthreads();                                                                                                      \
        if ((t) + 1 < NT) { VMW(); SWRITE_H(SB); }                                                                          \
        RESC(alX); __syncthreads(); } while (0)
    for (int t = 1; t + 1 < NT; t += 2) {
        HALF_STEP(pB0, pB1, mnB, alB, pA0, pA1, alA, t, 1, 0, 0);
        HALF_STEP(pA0, pA1, mnA, alA, pB0, pB1, alB, t + 1, 0, 1, 1);
    }
    const bool even = (NT & 1) == 0;
    if (even) { SBAR(); qkt<1>(pB0, pB1, K_lds, r32, hi, S.qr, ACT(NT - 1)); SBAR(); }
    SLOAD_H(nxt.K, nxt.V(), kbn, nxt.rs()); SBAR();
#pragma unroll
    for (int d0 = 0; d0 < 8; ++d0) S.qr[d0] = load8((const bf16_t*)((const char*)nxt.Q + (size_t)((unsigned)((wid * QBLK + r32) * nxt.rs() + hi * 8) * 2u)) + d0 * 16);
    SBAR();
    finishSM(pA0, pA1, alA, l_reg, pa0, pa1, pa2, pa3); SBAR();
    pv_tile<0>(o, vb0, pa0, pa1, pa2, pa3, ACT(even ? NT - 2 : NT - 1));
    if (even) { MASKT(pB0, pB1, NT - 1); partialSM(pB0, pB1, m_reg, mnB, alB); __syncthreads(); RESC(alB);
        finishSM(pB0, pB1, alB, l_reg, pa0, pa1, pa2, pa3); SBAR(); pv_tile<1>(o, vb0, pa0, pa1, pa2, pa3, ACT(NT - 1)); }
    SBAR(); SEAM_K0();
    float t0, t1; tb_load(biast, nxt.bh, nxt.dsh, tid, t0, t1);
    if (hi == 0) li_l[r32] = l_reg; asm volatile("s_waitcnt lgkmcnt(0)" ::: "memory");
    int r32e = r32, hie = hi; asm volatile("" : "+v"(r32e), "+v"(hie));
    if (hie == 0) cur.LSE[(size_t)(wid * QBLK + r32e) * cur.ls()] = m_reg * SCALE + __logf(l_reg);
    float rli[16];
#pragma unroll
    for (int r = 0; r < 16; ++r) rli[r] = __builtin_amdgcn_rcpf(li_l[crow(r, hie)]);
    const int os = cur.os();
    bf16_t* Ow = cur.O + (size_t)(wid * QBLK) * os;
#pragma unroll
    for (int r = 0; r < 16; ++r) { const unsigned oo = (unsigned)(crow(r, hie) * os + r32e) * 2u;
#pragma unroll
        for (int d0 = 0; d0 < 4; ++d0) { const float v = o[d0][r] * rli[r];
            const float vn = swz_xor<1>(v);
            if ((r32e & 1) == 0) *(unsigned*)((char*)Ow + oo + d0 * 64) = cvt_pk_bf16(v, vn); } }
    { float* tb = (float*)(lds + LDS_TB + (slot ^ 1) * 4096); tb[tid] = t0; tb[tid + 512] = t1; }
    __syncthreads();
#undef RESC
#undef KBASE
#undef ACT
#undef MASKT
#undef SEAM_K0
#undef HALF_STEP
}
#undef ROWP
#undef VMW
#undef VMWN
#undef SLOAD_H
#undef SWRITE_HK
#undef SWRITE_HV
#undef SWRITE_H
#undef TIDL
#undef KSWZ
#undef SBAR
}


__device__ __forceinline__ swa::BlockRef dil_ref(int u, const bf16_t* H1p, bf16_t* OPp, float* LSEp) {
    const int x = u & 15, rest = u >> 4, g = rest % 3, bh = rest / 3, h = bh & 7, bl = bh >> 3;
    const int dsh = 2 * g, dil = 1 << dsh, r = x >> (4 - dsh), blk = x & ((16 >> dsh) - 1), P0 = blk * 256;
    const size_t row0 = (size_t)bl * SEQ + r, rowq = row0 + (size_t)dil * P0;
    swa::BlockRef R;
    R.K = H1p + row0 * IN1_N + g * 3072 + 1024 + h * 128; R.Q = H1p + rowq * IN1_N + g * 3072 + h * 128;
    R.O = OPp + ((size_t)g * CHUNK_T + rowq) * DM + h * 128; R.LSE = LSEp + ((size_t)g * CHUNK_T + rowq) * 8 + h;
    R.P0 = P0; R.bh = h; R.dsh = dsh;
    return R;
}

struct Args {
    const float* in[25]; float* out; unsigned char* ws; int ph_lo, ph_hi;
};
enum { I_X = 0, I_RELB, I_EWIN, I_CONVW, I_CONVB, I_CLNG, I_CLNB, I_EWOUT, I_ELN1G, I_ELN1B, I_FWG, I_FWU, I_FWD, I_ELN2G, I_ELN2B,
       I_OWIN, I_OWOUT, I_OLN1G, I_OLN1B, I_ROUTER, I_MWG, I_MWU, I_MWD, I_OLN2G, I_OLN2B };

__device__ __forceinline__ void transpose_item(const float* W, int ldw, int src_c0, int nvalid, int k0, bf16_t* WT, int K, int dst_row0, LAS float* scr, int lane) {
#pragma unroll 8
    for (int i = 0; i < 32; ++i) { const int kk = 2 * i + (lane >> 5), j = lane & 31; scr[kk * 33 + j] = (j < nvalid) ? W[(size_t)(k0 + kk) * ldw + src_c0 + j] : 0.f; }
    WAVE_LDS_FENCE();
    const int c = lane & 7;
#pragma unroll
    for (int jj = 0; jj < 4; ++jj) { const int n = (lane >> 3) + 8 * jj; const LAS float* s = scr + (8 * c) * 33 + n;
        u32x4 o; o.x = cvt_pk_bf16(s[0 * 33], s[1 * 33]); o.y = cvt_pk_bf16(s[2 * 33], s[3 * 33]); o.z = cvt_pk_bf16(s[4 * 33], s[5 * 33]); o.w = cvt_pk_bf16(s[6 * 33], s[7 * 33]);
        *(u32x4*)(WT + (size_t)(dst_row0 + n) * K + k0 + 8 * c) = o; }
    WAVE_LDS_FENCE();
}
__device__ __forceinline__ void gu_item(const float* wg, const float* wu, int FF, int K, bf16_t* WT, int item, LAS float* scr, int lane) {
    const int nblk = 2 * FF / 32, kb = item / nblk, nb = item % nblk, tile = nb >> 3, sub = nb & 7;
    transpose_item(sub < 4 ? wg : wu, FF, tile * 128 + (sub & 3) * 32, 32, kb * 64, WT, K, nb * 32, scr, lane);
}
__device__ __forceinline__ void plain_item(const float* W, int K, int N, bf16_t* WT, int item, LAS float* scr, int lane) {
    const int nblk = N / 32, kb = item / nblk, nb = item % nblk;
    transpose_item(W, N, nb * 32, 32, kb * 64, WT, K, nb * 32, scr, lane);
}
__device__ __forceinline__ void in0_item(const float* W, bf16_t* WT, int item, LAS float* scr, int lane) {
    const int nblk = IN0_N / 32, kb = item / nblk, nb = item % nblk, tile = nb >> 3, sub = nb & 7;
    int src_c0, nvalid = 32;
    if (tile < 4) src_c0 = (sub < 4) ? tile * 128 + sub * 32 : 512 + tile * 128 + (sub - 4) * 32;
    else { src_c0 = nb * 32; nvalid = IN0_SRC - src_c0; nvalid = nvalid < 0 ? 0 : (nvalid > 32 ? 32 : nvalid); if (nvalid == 0) src_c0 = 0; }
    transpose_item(W, IN0_SRC, src_c0, nvalid, kb * 64, WT, DM, nb * 32, scr, lane);
}
__device__ __forceinline__ int rel_bucket(int n) {
    if (n < 16) return n;
    const float nf = (float)n;
    int large = 16 + (int)(logf(nf / 16.0f) / logf(128.0f) * 16.0f);
    return large < 31 ? large : 31;
}

__device__ __forceinline__ void ln_core(f32x4 (&v)[4], const float* g, const float* b, int lane) {
    float s = 0.f;
#pragma unroll
    for (int j = 0; j < 4; ++j) s += (v[j][0] + v[j][1]) + (v[j][2] + v[j][3]);
    const float mean = wave_sum(s) * (1.f / DM); float s2 = 0.f;
#pragma unroll
    for (int j = 0; j < 4; ++j) { v[j] = v[j] - mean; s2 += (v[j][0] * v[j][0] + v[j][1] * v[j][1]) + (v[j][2] * v[j][2] + v[j][3] * v[j][3]); }
    const float rstd = 1.f / sqrtf(wave_sum(s2) * (1.f / DM) + LN_EPS);
#pragma unroll
    for (int j = 0; j < 4; ++j) { const f32x4 gg = *(const f32x4*)(g + 4 * lane + 256 * j), bb = *(const f32x4*)(b + 4 * lane + 256 * j); v[j] = v[j] * rstd * gg + bb; }
}
__device__ __forceinline__ void store_row_bf16(bf16_t* orow, const f32x4 (&v)[4], int lane) {
#pragma unroll
    for (int j = 0; j < 4; ++j) { u32x2 w; w.x = cvt_pk_bf16(v[j][0], v[j][1]); w.y = cvt_pk_bf16(v[j][2], v[j][3]); *(u32x2*)(orow + 4 * lane + 256 * j) = w; }
}
__device__ __forceinline__ f32x4 ld_bf4(const bf16_t* p) { const u32x2 w = *(const u32x2*)p; return (f32x4){bf_lo(w.x), bf_hi(w.x), bf_lo(w.y), bf_hi(w.y)}; }

__device__ __forceinline__ int my_lane_asm() { int l; asm volatile("v_mbcnt_lo_u32_b32 %0, -1, 0\n\tv_mbcnt_hi_u32_b32 %0, -1, %0" : "=v"(l)); return l; }
__global__ void __launch_bounds__(NTHR, 2) fwd_kernel(Args args) {
    extern __shared__ __attribute__((aligned(16))) unsigned char lds_raw[];
    LAS unsigned char* lds = (LAS unsigned char*)lds_raw;
    const int G = gridDim.x, bid = blockIdx.x;
    const int NGW = G * NWAVES;
    volatile LAS unsigned* MISC = (volatile LAS unsigned*)(lds + LDS_MISC);
    int wave_id;
    {
        const int l0 = my_lane_asm();
        if (l0 < 16) MISC[l0] = 0u;
        __syncthreads();
        unsigned id = 0u; if (l0 == 0) id = atomicAdd((unsigned*)(MISC + 2), 1u);
        wave_id = __builtin_amdgcn_readfirstlane((int)id);
        __syncthreads();
    }
#define MY_LANE() my_lane_asm()
#if ONE_LAUNCH
    (void)xcd_barrier_post((unsigned*)(args.ws + WS_CTL) + CW_BAR, MISC, wave_id == 0 && MY_LANE() == 0);
#define GRID_BAR() do { XcdBarrier _b; _b.bar = (unsigned*)(ws + WS_CTL) + CW_BAR; _b.x = xb_xcc_id(); _b.st = (volatile LAS unsigned*)(lds + LDS_MISC); xcd_barrier(_b, tid == 0); } while (0)
#else
#define GRID_BAR() do { } while (0)
#endif
    const int lo = args.ph_lo, hi = args.ph_hi;
#ifndef PH_MASK
#define PH_MASK 0xFFFFFFu
#endif
#define IN(k) ((((PH_MASK) >> (k)) & 1u) && lo <= (k) && (k) < hi)
#define BOTH(k) (IN(k) && IN((k) + 1))
#define PHASE_BEGIN int lane = MY_LANE(); asm volatile("" : "+v"(lane)); const int wave = wave_id; const int tid = wave * 64 + lane; const int gw = bid * NWAVES + wave; \
    size_t zoff_ = 0; asm volatile("" : "+s"(zoff_)); unsigned char* ws = args.ws + zoff_; float* outp = (float*)((unsigned char*)args.out + zoff_); unsigned* ctl = (unsigned*)(ws + WS_CTL); (void)lane; (void)wave; (void)gw; (void)ctl; (void)outp;
#define x_in (args.in[I_X])
#define WIN0 ((bf16_t*)(ws + WS_WIN0))
#define WOUT0 ((bf16_t*)(ws + WS_WOUT0))
#define WGU0 ((bf16_t*)(ws + WS_WGU0))
#define WD0 ((bf16_t*)(ws + WS_WD0))
#define WIN1 ((bf16_t*)(ws + WS_WIN1))
#define WOUT1 ((bf16_t*)(ws + WS_WOUT1))
#define MWGU ((bf16_t*)(ws + WS_MWGU))
#define MWD ((bf16_t*)(ws + WS_MWD))
#define BIAST ((float*)(ws + WS_BIAST))
#define XB ((bf16_t*)(ws + WS_XB))
#define Ub ((bf16_t*)(ws + WS_U))
#define Q0 ((bf16_t*)(ws + WS_Q0))
#define K0 ((bf16_t*)(ws + WS_Q0 + SEG0))
#define V0 ((bf16_t*)(ws + WS_Q0 + 2 * SEG0))
#define QI ((bf16_t*)(ws + WS_Q0 + 3 * SEG0))
#define KI ((bf16_t*)(ws + WS_KI))
#define WI ((float*)(ws + WS_WI))
#define MASK ((u64*)(ws + WS_MASK))
#define MIXIN ((bf16_t*)(ws + WS_MIXIN))
#define X1B ((bf16_t*)(ws + WS_X1B))
#define H0 ((bf16_t*)(ws + WS_H0))
#define X2B ((bf16_t*)(ws + WS_X2B))
#define H1 ((bf16_t*)(ws + WS_H1))
#define O1 ((bf16_t*)outp)
#define Y3 ((float*)(ws + WS_Y3))
#define X3B ((bf16_t*)(ws + WS_X3B))
#define YB ((bf16_t*)(ws + WS_YB))
#define MTOK ((int*)(ws + WS_MOE_TOK))
#define MGATE ((float*)(ws + WS_MOE_GATE))
#define GTAB ((const LAS int*)(lds + LDS_GTAB))

    if (IN(0)) { asm volatile("; PHASE_MARK 0"); PHASE_BEGIN
        LAS float* scr = (LAS float*)(lds + wave * 16384);
        constexpr int I_IN0 = 16 * (IN0_N / 32), I_OUT = 16 * 32, I_GU0 = 16 * (2 * FF0 / 32), I_D0 = (FF0 / 64) * 32, I_IN1 = 16 * (IN1_N / 32);
        constexpr int NIT = I_IN0 + I_OUT + I_GU0 + I_D0 + I_IN1 + I_OUT;
        for (int it = gw; it < NIT; it += NGW) {
            int r = it;
            if (r < I_IN0) { in0_item(args.in[I_EWIN], WIN0, r, scr, lane); continue; } r -= I_IN0;
            if (r < I_OUT) { plain_item(args.in[I_EWOUT], DM, DM, WOUT0, r, scr, lane); continue; } r -= I_OUT;
            if (r < I_GU0) { gu_item(args.in[I_FWG], args.in[I_FWU], FF0, DM, WGU0, r, scr, lane); continue; } r -= I_GU0;
            if (r < I_D0) { plain_item(args.in[I_FWD], FF0, DM, WD0, r, scr, lane); continue; } r -= I_D0;
            if (r < I_IN1) { plain_item(args.in[I_OWIN], DM, IN1_N, WIN1, r, scr, lane); continue; } r -= I_IN1;
            plain_item(args.in[I_OWOUT], DM, DM, WOUT1, r, scr, lane);
        }
        for (size_t i = (size_t)bid * NTHR + tid; i < (size_t)NTOK * DM / 8; i += (size_t)G * NTHR) {
            const f32x4 a = *(const f32x4*)(x_in + i * 8), b = *(const f32x4*)(x_in + i * 8 + 4);
            *(u32x4*)(XB + i * 8) = pg8::pack8(a, b);
        }
        for (int i = bid * NTHR + tid; i < 8 * 4096; i += G * NTHR) { const int h = i >> 12, d = i & 4095; BIAST[i] = args.in[I_RELB][rel_bucket(d) * 8 + h]; }
        if (BOTH(0)) GRID_BAR();
    }

    if (IN(1)) { asm volatile("; PHASE_MARK 1"); PHASE_BEGIN
        pg8::StaticOrder S; S.init(XB, NTOK, IN0_N, DM, G, bid);
        pg8::EpiIn0 E{Ub, Q0, KI, WI};
        pg8::gemm_phase<pg8::EpiIn0, pg8::StaticOrder, true, false>(tid, lds, WIN0, DM, S, E, GTAB);
        if (BOTH(1)) GRID_BAR();
    }

    if (IN(2)) { asm volatile("; PHASE_MARK 2"); PHASE_BEGIN
        {
            LAS bf16_t* ut = (LAS bf16_t*)lds;
            LAS float* yt = (LAS float*)(lds + 65536);
            const float* cw = args.in[I_CONVW]; const int c = tid;
            float w[31];
#pragma unroll
            for (int j = 0; j < 31; ++j) w[j] = cw[j * 512 + c];
            const float cb = args.in[I_CONVB][c];
            for (int tile = bid; tile < NTOK / 32; tile += G) {
                const int t0 = tile * 32, s0 = t0 & (SEQ - 1);
                for (int i = tid; i < 62 * 64; i += NTHR) { const int r = i >> 6, c8 = i & 63; const int sr = s0 - 30 + r;
                    u32x4 v = (u32x4){0u, 0u, 0u, 0u}; if (sr >= 0) v = *(const u32x4*)(Ub + (size_t)(t0 - 30 + r) * 512 + c8 * 8);
                    *(LAS u32x4*)(ut + r * 512 + c8 * 8) = v; }
                __syncthreads();
                for (int t = 0; t < 32; ++t) { float a = cb;
#pragma unroll
                    for (int j = 0; j < 31; ++j) a += w[j] * bf2f(ut[(t + j) * 512 + c]);
                    yt[t * 512 + c] = a; }
                __syncthreads();
                const float* lg = args.in[I_CLNG]; const float* lb = args.in[I_CLNB];
#pragma unroll
                for (int tt = 0; tt < 4; ++tt) { const int t = wave * 4 + tt;
                    f32x4 a = *(LAS f32x4*)(yt + t * 512 + lane * 8), b = *(LAS f32x4*)(yt + t * 512 + lane * 8 + 4);
                    float s = (a[0] + a[1]) + (a[2] + a[3]) + (b[0] + b[1]) + (b[2] + b[3]); const float mean = wave_sum(s) * (1.f / 512.f);
                    a = a - mean; b = b - mean; float s2 = a[0] * a[0] + a[1] * a[1] + a[2] * a[2] + a[3] * a[3] + b[0] * b[0] + b[1] * b[1] + b[2] * b[2] + b[3] * b[3];
                    const float rstd = 1.f / sqrtf(wave_sum(s2) * (1.f / 512.f) + LN_EPS);
                    const f32x4 g0 = *(const f32x4*)(lg + lane * 8), g1 = *(const f32x4*)(lg + lane * 8 + 4), b0 = *(const f32x4*)(lb + lane * 8), b1 = *(const f32x4*)(lb + lane * 8 + 4);
                    a = a * rstd * g0 + b0; b = b * rstd * g1 + b1;
#pragma unroll
                    for (int j = 0; j < 4; ++j) { a[j] = a[j] * sigmoidf_(a[j]); b[j] = b[j] * sigmoidf_(b[j]); }
                    *(u32x4*)(MIXIN + (size_t)(t0 + t) * DM + lane * 8) = pg8::pack8(a, b); }
                __syncthreads();
            }
        }
        {
            LAS float* sc = (LAS float*)lds;
            LAS float* qf = (LAS float*)(lds + 131072);
            LAS unsigned* hist = (LAS unsigned*)(lds + 147456);
            LAS float* wq = (LAS float*)(lds + 155648);
            for (int item = bid; item < NTOK / 8; item += G) {
                const int tok0 = item * 8, b0 = tok0 & ~(SEQ - 1), q0 = tok0 & (SEQ - 1);
                for (int i = tid; i < 8 * 512; i += NTHR) qf[i] = bf2f(QI[(size_t)tok0 * 512 + i]);
                if (tid < 64) wq[tid] = WI[(size_t)tok0 * 8 + tid];
                __syncthreads();
                const int nk = q0 + 8;
                for (int kc = 0; kc * 512 < nk; ++kc) {
                    const int k = kc * 512 + tid;
                    if (k < nk) {
                        float kf[64];
#pragma unroll
                        for (int d8 = 0; d8 < 8; ++d8) { const u32x4 v = *(const u32x4*)(KI + (size_t)(b0 + k) * 64 + d8 * 8);
                            kf[d8 * 8 + 0] = bf_lo(v.x); kf[d8 * 8 + 1] = bf_hi(v.x); kf[d8 * 8 + 2] = bf_lo(v.y); kf[d8 * 8 + 3] = bf_hi(v.y);
                            kf[d8 * 8 + 4] = bf_lo(v.z); kf[d8 * 8 + 5] = bf_hi(v.z); kf[d8 * 8 + 6] = bf_lo(v.w); kf[d8 * 8 + 7] = bf_hi(v.w); }
                        for (int qq = 0; qq < 8; ++qq) { float s = 0.f;
                            for (int h = 0; h < 8; ++h) { float dot = 0.f;
#pragma unroll
                                for (int d4 = 0; d4 < 16; ++d4) { const f32x4 q4 = *(LAS f32x4*)(qf + qq * 512 + h * 64 + d4 * 4);
                                    dot += q4[0] * kf[d4 * 4] + q4[1] * kf[d4 * 4 + 1] + q4[2] * kf[d4 * 4 + 2] + q4[3] * kf[d4 * 4 + 3]; }
                                s += wq[qq * 8 + h] * fmaxf(dot, 0.f); }
                            sc[qq * 4096 + k] = s; }
                    }
                }
                __syncthreads();
                {
                    const int q = q0 + wave, n = q + 1; LAS float* row = sc + wave * 4096; LAS unsigned* hh = hist + wave * 256;
                    u64* mrow = MASK + (size_t)(tok0 + wave) * 64;
                    unsigned thr = 0u; int need = 0;
                    if (n > 256) {
                        unsigned prefix = 0u; int kk = 256;
                        for (int pass = 0; pass < 4; ++pass) {
                            const int shift = 24 - 8 * pass;
#pragma unroll
                            for (int j = 0; j < 4; ++j) hh[lane * 4 + j] = 0u;
                            WAVE_LDS_FENCE();
                            for (int i = lane; i < n; i += 64) { const unsigned u = __float_as_uint(row[i] + 0.0f); const unsigned key = (u & 0x80000000u) ? ~u : (u | 0x80000000u);
                                const bool match = (pass == 0) || ((key >> (shift + 8)) == (prefix >> (shift + 8)));
                                if (match) atomicAdd((unsigned*)(hh + ((key >> shift) & 255u)), 1u); }
                            WAVE_LDS_FENCE();
                            unsigned c0 = hh[lane * 4 + 0], c1 = hh[lane * 4 + 1], c2 = hh[lane * 4 + 2], c3 = hh[lane * 4 + 3];
                            const unsigned sl = c0 + c1 + c2 + c3; unsigned inc = sl;
#pragma unroll
                            for (int o = 1; o < 64; o <<= 1) { const unsigned t = lane_get(inc, (lane + o) & 63); if (lane + o < 64) inc += t; }
                            const unsigned exc = inc - sl;
                            const bool found = (exc < (unsigned)kk) && (inc >= (unsigned)kk);
                            int bin = 0, kn = 0;
                            { unsigned cum = exc;
                              if (cum + c3 >= (unsigned)kk) { bin = 3; kn = kk - (int)cum; } else { cum += c3;
                              if (cum + c2 >= (unsigned)kk) { bin = 2; kn = kk - (int)cum; } else { cum += c2;
                              if (cum + c1 >= (unsigned)kk) { bin = 1; kn = kk - (int)cum; } else { cum += c1; bin = 0; kn = kk - (int)cum; } } } }
                            const u64 fm = __ballot(found); const int src = fm ? (__ffsll((long long)fm) - 1) : 0;
                            bin = (int)lane_get((unsigned)(lane * 4 + bin), src); kk = (int)lane_get((unsigned)kn, src);
                            prefix |= ((unsigned)bin) << shift;
                            WAVE_LDS_FENCE();
                        }
                        thr = prefix; need = kk;
                    }
                    int tie_run = 0;
                    for (int j = 0; j < 64; ++j) { const int i = j * 64 + lane; u64 word;
                        if (n <= 256) word = __ballot(i < n);
                        else { bool gt = false, eq = false;
                            if (i < n) { const unsigned u = __float_as_uint(row[i] + 0.0f); const unsigned key = (u & 0x80000000u) ? ~u : (u | 0x80000000u); gt = key > thr; eq = key == thr; }
                            const u64 eqm = __ballot(eq); const int rank = tie_run + __popcll(eqm & ((1ull << lane) - 1ull));
                            word = __ballot(gt || (eq && rank < need)); tie_run += __popcll(eqm); }
                        if (lane == 0) mrow[j] = word; }
                }
                __syncthreads();
            }
        }
        if (BOTH(2)) GRID_BAR();
    }

    if (IN(3)) { asm volatile("; PHASE_MARK 3"); PHASE_BEGIN
        LAS int* list = (LAS int*)lds;
        LAS unsigned* base = (LAS unsigned*)(lds + 1024);
        LAS u64* words = (LAS u64*)(lds + 1536);
        LAS float* pw = (LAS float*)(lds + 2048 + wave * 1024);
        for (int item = bid; item < NTOK; item += G) {
            const int tok = item, b0 = tok & ~(SEQ - 1), t = tok & (SEQ - 1), n = t + 1, cnt = n < 256 ? n : 256;
            if (tid < 64) { const u64 w = MASK[(size_t)tok * 64 + tid]; words[tid] = w; const unsigned c = (unsigned)__popcll(w); unsigned inc = c;
#pragma unroll
                for (int o = 1; o < 64; o <<= 1) { const unsigned tt = lane_get(inc, (lane - o) & 63); if (lane >= o) inc += tt; }
                base[tid] = inc - c; }
            __syncthreads();
            { const int j = tid >> 3, bb0 = (tid & 7) * 8; const u64 w = words[j]; const unsigned bs = base[j];
#pragma unroll
              for (int bb = 0; bb < 8; ++bb) { const int bit = bb0 + bb; if ((w >> bit) & 1ull) { const int pos = (int)bs + __popcll(w & ((1ull << bit) - 1ull)); if (pos < 256) list[pos] = j * 64 + bit; } } }
            __syncthreads();
            {
                const int h = wave; float qv[64];
#pragma unroll
                for (int d8 = 0; d8 < 8; ++d8) { const u32x4 v = *(const u32x4*)(Q0 + (size_t)tok * 512 + h * 64 + d8 * 8);
                    qv[d8 * 8 + 0] = bf_lo(v.x); qv[d8 * 8 + 1] = bf_hi(v.x); qv[d8 * 8 + 2] = bf_lo(v.y); qv[d8 * 8 + 3] = bf_hi(v.y);
                    qv[d8 * 8 + 4] = bf_lo(v.z); qv[d8 * 8 + 5] = bf_hi(v.z); qv[d8 * 8 + 6] = bf_lo(v.w); qv[d8 * 8 + 7] = bf_hi(v.w); }
                float lg[4]; float mx = -INFINITY;
#pragma unroll
                for (int i = 0; i < 4; ++i) { const int idx = lane + 64 * i; lg[i] = -INFINITY;
                    if (idx < cnt) { const int key = list[idx]; const bf16_t* kp = K0 + (size_t)(b0 + key) * 512 + h * 64; float dot = 0.f;
#pragma unroll
                        for (int d8 = 0; d8 < 8; ++d8) { const u32x4 v = *(const u32x4*)(kp + d8 * 8);
                            dot += qv[d8 * 8 + 0] * bf_lo(v.x) + qv[d8 * 8 + 1] * bf_hi(v.x) + qv[d8 * 8 + 2] * bf_lo(v.y) + qv[d8 * 8 + 3] * bf_hi(v.y)
                                 + qv[d8 * 8 + 4] * bf_lo(v.z) + qv[d8 * 8 + 5] * bf_hi(v.z) + qv[d8 * 8 + 6] * bf_lo(v.w) + qv[d8 * 8 + 7] * bf_hi(v.w); }
                        lg[i] = dot + BIAST[h * 4096 + (t - key)]; }
                    mx = fmaxf(mx, lg[i]); }
                mx = wave_max(mx); float sum = 0.f;
#pragma unroll
                for (int i = 0; i < 4; ++i) { const float p = (lg[i] == -INFINITY) ? 0.f : __expf(lg[i] - mx); sum += p; pw[lane + 64 * i] = p; }
                sum = wave_sum(sum);
                WAVE_LDS_FENCE();
                float acc = 0.f;
                for (int i = 0; i < cnt; ++i) { const int key = list[i]; acc += pw[i] * bf2f(V0[(size_t)(b0 + key) * 512 + h * 64 + lane]); }
                MIXIN[(size_t)tok * DM + 512 + h * 64 + lane] = (bf16_t)(cvt_pk_bf16(acc / sum, 0.f) & 0xffffu);
            }
            __syncthreads();
        }
        if (BOTH(3)) GRID_BAR();
    }

    if (IN(4)) { asm volatile("; PHASE_MARK 4"); PHASE_BEGIN
        pg8::StaticOrder S; S.init(MIXIN, NTOK, DM, DM, G, bid);
        pg8::EpiRes<false> E{outp, x_in};
        pg8::gemm_phase<pg8::EpiRes<false>, pg8::StaticOrder, true, false>(tid, lds, WOUT0, DM, S, E, GTAB);
        if (BOTH(4)) GRID_BAR();
    }
    if (IN(5)) { asm volatile("; PHASE_MARK 5"); PHASE_BEGIN
        for (int m = gw; m < NTOK; m += NGW) { f32x4 v[4];
#pragma unroll
            for (int j = 0; j < 4; ++j) v[j] = *(const f32x4*)(outp + (size_t)m * DM + 4 * lane + 256 * j);
            ln_core(v, args.in[I_ELN1G], args.in[I_ELN1B], lane); store_row_bf16(X1B + (size_t)m * DM, v, lane); }
        if (BOTH(5)) GRID_BAR();
    }
    if (IN(6)) { asm volatile("; PHASE_MARK 6"); PHASE_BEGIN
        pg8::StaticOrder S; S.init(X1B, NTOK, 2 * FF0, DM, G, bid);
        pg8::EpiSwiglu<false> E{H0, FF0, (char*)outp, (char*)ws};
        pg8::gemm_phase<pg8::EpiSwiglu<false>, pg8::StaticOrder, true, false>(tid, lds, WGU0, DM, S, E, GTAB);
        if (BOTH(6)) GRID_BAR();
    }
    if (IN(7)) { asm volatile("; PHASE_MARK 7"); PHASE_BEGIN
        pg8::StaticOrder S; S.init(H0, NTOK, DM, FF0, G, bid);
        pg8::EpiRes<true> E{outp, X1B};
        pg8::gemm_phase<pg8::EpiRes<true>, pg8::StaticOrder, true, false>(tid, lds, WD0, FF0, S, E, GTAB);
        if (BOTH(7)) GRID_BAR();
    }
    if (IN(8)) { asm volatile("; PHASE_MARK 8"); PHASE_BEGIN
        for (int m = gw; m < NTOK; m += NGW) { f32x4 v[4];
#pragma unroll
            for (int j = 0; j < 4; ++j) v[j] = *(const f32x4*)(outp + (size_t)m * DM + 4 * lane + 256 * j);
            ln_core(v, args.in[I_ELN2G], args.in[I_ELN2B], lane); store_row_bf16(X2B + (size_t)m * DM, v, lane); }
        if (BOTH(8)) GRID_BAR();
    }
#define MERGE_CHUNK(chm) do { \
        const bf16_t* OPp = (const bf16_t*)(ws + WS_OP); const float* LSEp = (const float*)(ws + WS_LSE); \
        for (int tl = gw; tl < CHUNK_T; tl += NGW) { const int hh = lane >> 3; \
            const float l0 = LSEp[(size_t)tl * 8 + hh], l1 = LSEp[((size_t)CHUNK_T + tl) * 8 + hh], l2 = LSEp[((size_t)2 * CHUNK_T + tl) * 8 + hh]; \
            const float mm = fmaxf(l0, fmaxf(l1, l2)); float w0 = __expf(l0 - mm), w1 = __expf(l1 - mm), w2 = __expf(l2 - mm); const float inv = 1.f / (w0 + w1 + w2); w0 *= inv; w1 *= inv; w2 *= inv; \
            const bf16_t* p0 = OPp + (size_t)tl * DM + lane * 16; const bf16_t* p1 = p0 + (size_t)CHUNK_T * DM; const bf16_t* p2 = p1 + (size_t)CHUNK_T * DM; \
            _Pragma("unroll") for (int q = 0; q < 2; ++q) { const u32x4 a = *(const u32x4*)(p0 + q * 8), b = *(const u32x4*)(p1 + q * 8), c = *(const u32x4*)(p2 + q * 8); u32x4 o; \
                o.x = cvt_pk_bf16(w0 * bf_lo(a.x) + w1 * bf_lo(b.x) + w2 * bf_lo(c.x), w0 * bf_hi(a.x) + w1 * bf_hi(b.x) + w2 * bf_hi(c.x)); \
                o.y = cvt_pk_bf16(w0 * bf_lo(a.y) + w1 * bf_lo(b.y) + w2 * bf_lo(c.y), w0 * bf_hi(a.y) + w1 * bf_hi(b.y) + w2 * bf_hi(c.y)); \
                o.z = cvt_pk_bf16(w0 * bf_lo(a.z) + w1 * bf_lo(b.z) + w2 * bf_lo(c.z), w0 * bf_hi(a.z) + w1 * bf_hi(b.z) + w2 * bf_hi(c.z)); \
                o.w = cvt_pk_bf16(w0 * bf_lo(a.w) + w1 * bf_lo(b.w) + w2 * bf_lo(c.w), w0 * bf_hi(a.w) + w1 * bf_hi(b.w) + w2 * bf_hi(c.w)); \
                *(u32x4*)(O1 + ((size_t)(chm) * CHUNK_T + tl) * DM + lane * 16 + q * 8) = o; } } } while (0)
#pragma unroll
    for (int ch = 0; ch < 2; ++ch) {
        if (IN(9 + 2 * ch)) { asm volatile("; PHASE_MARK 9"); PHASE_BEGIN
            if (ch == 1) { MERGE_CHUNK(0); }
            pg8::StaticOrder S; S.init(X2B + (size_t)ch * CHUNK_T * DM, CHUNK_T, IN1_N, DM, G, bid);
            pg8::EpiQkv1 E{H1, IN1_N, 1.0f};
            pg8::gemm_phase<pg8::EpiQkv1, pg8::StaticOrder, true, false>(tid, lds, WIN1, DM, S, E, GTAB);
            if (BOTH(9 + 2 * ch)) GRID_BAR();
        }
        if (IN(10 + 2 * ch)) { asm volatile("; PHASE_MARK 10"); PHASE_BEGIN
            constexpr int NU = CHUNK_B * 8 * 3 * 16;
            const int vcu = (G % 8 == 0) ? (bid % 8) * (G / 8) + bid / 8 : bid;
            bf16_t* OPp = (bf16_t*)(ws + WS_OP); float* LSEp = (float*)(ws + WS_LSE);
            int L0 = vcu;
            if (L0 < NU) {
                swa::Seam SS; swa::BlockRef cur = dil_ref(L0, H1, OPp, LSEp);
                swa::swa_prime(cur, BIAST, (char*)lds_raw, SS, tid);
                int slot = 0;
                for (;;) {
                    const int Ln = L0 + G; const bool last = Ln >= NU;
                    const swa::BlockRef nxt = last ? cur : dil_ref(Ln, H1, OPp, LSEp);
                    swa::swa_block(cur, nxt, BIAST, slot, (char*)lds_raw, SS, tid);
                    if (last) break;
                    cur = nxt; L0 = Ln; slot ^= 1;
                }
            }
            if (BOTH(10 + 2 * ch)) GRID_BAR();
        }
    }
    if (IN(13)) { asm volatile("; PHASE_MARK 13"); PHASE_BEGIN
        MERGE_CHUNK(1);
        if (BOTH(13)) GRID_BAR();
    }
    if (IN(14)) { asm volatile("; PHASE_MARK 14"); PHASE_BEGIN
        pg8::StaticOrder S; S.init(O1, NTOK, DM, DM, G, bid);
        pg8::EpiRes<true> E{Y3, X2B};
        pg8::gemm_phase<pg8::EpiRes<true>, pg8::StaticOrder, true, false>(tid, lds, WOUT1, DM, S, E, GTAB);
        if (BOTH(14)) GRID_BAR();
    }
    if (IN(15)) { asm volatile("; PHASE_MARK 15"); PHASE_BEGIN
        const float* rt = args.in[I_ROUTER];
        for (int m = gw; m < NTOK; m += NGW) { f32x4 v[4];
#pragma unroll
            for (int j = 0; j < 4; ++j) v[j] = *(const f32x4*)(Y3 + (size_t)m * DM + 4 * lane + 256 * j);
            ln_core(v, args.in[I_OLN1G], args.in[I_OLN1B], lane); store_row_bf16(X3B + (size_t)m * DM, v, lane);
            float lgt[8];
#pragma unroll
            for (int e = 0; e < 8; ++e) lgt[e] = 0.f;
#pragma unroll
            for (int j = 0; j < 4; ++j)
#pragma unroll
                for (int i = 0; i < 4; ++i) { const float* rr = rt + (size_t)(4 * lane + 256 * j + i) * 8; const f32x4 r0 = *(const f32x4*)rr, r1 = *(const f32x4*)(rr + 4); const float xv = v[j][i];
                    lgt[0] += xv * r0[0]; lgt[1] += xv * r0[1]; lgt[2] += xv * r0[2]; lgt[3] += xv * r0[3]; lgt[4] += xv * r1[0]; lgt[5] += xv * r1[1]; lgt[6] += xv * r1[2]; lgt[7] += xv * r1[3]; }
#pragma unroll
            for (int e = 0; e < 8; ++e) lgt[e] = wave_sum(lgt[e]);
            int e1 = 0; float v1 = lgt[0];
#pragma unroll
            for (int e = 1; e < 8; ++e) if (lgt[e] > v1) { v1 = lgt[e]; e1 = e; }
            int e2 = -1; float v2 = -INFINITY;
#pragma unroll
            for (int e = 0; e < 8; ++e) if (e != e1 && lgt[e] > v2) { v2 = lgt[e]; e2 = e; }
            const float g2 = 1.f / (1.f + __expf(v1 - v2)), g1 = 1.f - g2;
            if (lane == 0) {
                const unsigned p1 = atomicAdd(ctl + CW_MOECNT + e1, 1u), p2 = atomicAdd(ctl + CW_MOECNT + e2, 1u);
                if (p1 < (unsigned)NTOK) { MTOK[e1 * NTOK + p1] = m * 2; MGATE[e1 * NTOK + p1] = g1; }
                if (p2 < (unsigned)NTOK) { MTOK[e2 * NTOK + p2] = m * 2 + 1; MGATE[e2 * NTOK + p2] = g2; }
            }
        }
        __syncthreads();
        {
            LAS float* scr = (LAS float*)(lds + wave * 16384);
            constexpr int I_GU = 16 * (2 * FFE / 32), I_D = (FFE / 64) * 32;
            for (int it = gw; it < NEXP * (I_GU + I_D); it += NGW) {
                const int e = it / (I_GU + I_D), r = it % (I_GU + I_D);
                if (r < I_GU) gu_item(args.in[I_MWG] + (size_t)e * DM * FFE, args.in[I_MWU] + (size_t)e * DM * FFE, FFE, DM, MWGU + (size_t)e * 2 * FFE * DM, r, scr, lane);
                else plain_item(args.in[I_MWD] + (size_t)e * FFE * DM, FFE, DM, MWD + (size_t)e * DM * FFE, r - I_GU, scr, lane);
            }
        }
        if (BOTH(15)) GRID_BAR();
    }
#pragma unroll
    for (int ch = 0; ch < 2; ++ch) {
        if (IN(16 + 2 * ch) || IN(17 + 2 * ch)) {
            LAS int* rt = (LAS int*)(lds + LDS_RT);
            int nM;
            { PHASE_BEGIN int ts[9]; int cn[8]; ts[0] = 0;
#pragma unroll
              for (int e = 0; e < 8; ++e) { int ce = __builtin_amdgcn_readfirstlane((int)ctl[CW_MOECNT + e]); ce = ce > NTOK ? NTOK : ce; cn[e] = ce; ts[e + 1] = ts[e] + (ce + 255) / 256; }
              const int t0 = ch * MOE_CH_TILES; int t1 = t0 + MOE_CH_TILES; if (t1 > ts[8]) t1 = ts[8]; nM = __builtin_amdgcn_readfirstlane(t1 > t0 ? t1 - t0 : 0);
              if (tid < nM) { const int g = t0 + tid; int e = 0;
#pragma unroll
                  for (int k = 1; k < 8; ++k) e += (g >= ts[k]) ? 1 : 0;
                  int ce = cn[0], tse = ts[0];
#pragma unroll
                  for (int k = 1; k < 8; ++k) { ce = (e == k) ? cn[k] : ce; tse = (e == k) ? ts[k] : tse; }
                  const int j = g - tse; int nv = ce - j * 256; nv = nv > 256 ? 256 : nv;
                  rt[tid * 4 + 0] = e; rt[tid * 4 + 1] = e * NTOK + j * 256; rt[tid * 4 + 2] = nv; rt[tid * 4 + 3] = 0; } }
            __syncthreads();
            if (IN(16 + 2 * ch)) { asm volatile("; PHASE_MARK 16"); PHASE_BEGIN
                pg8::MoeOrder S{G, bid, nM, 2 * FFE / 256, rt, (const char*)X3B, (char*)outp, (char*)ws, true};
                LAS int* gtab = (LAS int*)(lds + LDS_GTAB);
                { pg8::Unit u; for (int i = 0; i < 16 && S.next(i, u); ++i) { if (tid < 256) { const int lb = rt[u.pm * 4 + 1], nv = rt[u.pm * 4 + 2]; const int r = tid < nv ? tid : 0; gtab[i * 256 + tid] = MTOK[lb + r] >> 1; } } }
                __syncthreads();
                pg8::EpiSwiglu<true> E{H0, FFE, (char*)outp, (char*)ws};
                pg8::gemm_phase<pg8::EpiSwiglu<true>, pg8::MoeOrder, true, true>(tid, lds, MWGU, DM, S, E, gtab);
                if (BOTH(16 + 2 * ch)) GRID_BAR();
            }
            if (IN(17 + 2 * ch)) { asm volatile("; PHASE_MARK 17"); PHASE_BEGIN
                pg8::MoeOrder S{G, bid, nM, DM / 256, rt, (const char*)X3B, (char*)outp, (char*)ws, false};
                pg8::EpiMoeDown E{YB, MTOK, MGATE, rt};
                pg8::gemm_phase<pg8::EpiMoeDown, pg8::MoeOrder, true, false>(tid, lds, MWD, FFE, S, E, GTAB);
                if (BOTH(17 + 2 * ch)) GRID_BAR();
            }
        }
    }
    if (IN(20)) { asm volatile("; PHASE_MARK 20"); PHASE_BEGIN
        for (int m = gw; m < NTOK; m += NGW) { f32x4 v[4];
#pragma unroll
            for (int j = 0; j < 4; ++j) { const size_t o = (size_t)m * DM + 4 * lane + 256 * j; v[j] = ld_bf4(X3B + o) * ALPHA + ld_bf4(YB + o) + ld_bf4(YB + (size_t)NTOK * DM + o); }
            ln_core(v, args.in[I_OLN2G], args.in[I_OLN2B], lane);
#pragma unroll
            for (int j = 0; j < 4; ++j) *(f32x4*)(outp + (size_t)m * DM + 4 * lane + 256 * j) = v[j]; }
    }
#undef IN
#undef BOTH
}

constexpr int NPHASES = 21;
extern "C" void kernel_launch(void* const* d_in, const int* in_sizes, int n_in, void* d_out, int out_size, void* d_ws, size_t ws_size, hipStream_t stream) {
    static int grid = 0;
    if (grid == 0) {
        if (n_in != 25 || out_size != NTOK * DM || ws_size < WS_END) { fprintf(stderr, "kernel_launch: unexpected shapes (n_in %d out %d ws %zu)\n", n_in, out_size, ws_size); grid = -1; return; }
        int dev = 0, cus = 0;
        if (hipGetDevice(&dev) != hipSuccess || hipDeviceGetAttribute(&cus, hipDeviceAttributeMultiprocessorCount, dev) != hipSuccess) { grid = -1; return; }
        if (hipFuncSetAttribute((const void*)fwd_kernel, hipFuncAttributeMaxDynamicSharedMemorySize, LDS_BYTES) != hipSuccess) { fprintf(stderr, "kernel_launch: hipFuncSetAttribute failed\n"); grid = -1; return; }
        int per_cu = 0;
        if (hipOccupancyMaxActiveBlocksPerMultiprocessor(&per_cu, (const void*)fwd_kernel, NTHR, LDS_BYTES) != hipSuccess || per_cu < 1) { fprintf(stderr, "kernel_launch: occupancy query says %d\n", per_cu); }
        (void)hipGetLastError();
        grid = cus;
    }
    if (grid < 0) return;
    (void)hipMemsetAsync((char*)d_ws + WS_CTL, 0, CTL_ZERO_BYTES, stream);
    Args a{};
    for (int i = 0; i < 25; ++i) a.in[i] = (const float*)d_in[i];
    a.out = (float*)d_out; a.ws = (unsigned char*)d_ws;
#if ONE_LAUNCH
    a.ph_lo = 0; a.ph_hi = NPHASES;
    hipLaunchKernelGGL(fwd_kernel, dim3(grid), dim3(NTHR), LDS_BYTES, stream, a);
#else
    for (int ph = 0; ph < NPHASES; ++ph) { a.ph_lo = ph; a.ph_hi = ph + 1; hipLaunchKernelGGL(fwd_kernel, dim3(grid), dim3(NTHR), LDS_BYTES, stream, a); }
#endif
}
```

```cpp
#include <hip/hip_runtime.h>
#include <cstdio>
#include <cstdint>

#ifndef ONE_LAUNCH
#define ONE_LAUNCH 1
#endif

#define LAS __attribute__((address_space(3)))
typedef unsigned short bf16_t;
typedef short bf16x8 __attribute__((ext_vector_type(8)));
typedef float f32x4 __attribute__((ext_vector_type(4)));
typedef float f32x2 __attribute__((ext_vector_type(2)));
typedef unsigned u32x4 __attribute__((ext_vector_type(4)));
typedef unsigned u32x2 __attribute__((ext_vector_type(2)));
typedef unsigned long long u64;

constexpr int NB = 8, SEQ = 4096, DM = 1024, NTOK = NB * SEQ;
constexpr int IN0_SRC = 3144, IN0_N = 3328;
constexpr int FF0 = 2816, FFE = 3584, NEXP = 8;
constexpr int IN1_N = 9216;
constexpr int CHUNK_B = 4, CHUNK_T = CHUNK_B * SEQ;
constexpr int MOE_CH_TILES = 132;
constexpr int HM_DOUT_TILES = 73;
constexpr float ALPHA = 1.4142135623730951f;
constexpr float LN_EPS = 1e-5f;
constexpr int NWAVES = 8, NTHR = 512;

constexpr size_t MiB = 1u << 20;
constexpr size_t WS_CTL = 0, CTL_ZERO_BYTES = 64 * 1024;
constexpr size_t WS_BIAST = 1 * MiB;
constexpr size_t WS_MOE_TOK = 2 * MiB;
constexpr size_t WS_MOE_GATE = 3 * MiB;
constexpr size_t WS_WIN0 = 4 * MiB;
constexpr size_t WS_WOUT0 = 11 * MiB;
constexpr size_t WS_WGU0 = 13 * MiB;
constexpr size_t WS_WD0 = 24 * MiB;
constexpr size_t WS_WIN1 = 30 * MiB;
constexpr size_t WS_WOUT1 = 48 * MiB;
constexpr size_t WS_XB = 50 * MiB;
constexpr size_t WS_U = 114 * MiB;
constexpr size_t WS_Q0 = 146 * MiB, SEG0 = 32 * MiB;
constexpr size_t WS_KI = 274 * MiB;
constexpr size_t WS_WI = 278 * MiB;
constexpr size_t WS_MASK = 280 * MiB;
constexpr size_t WS_MIXIN = 296 * MiB;
constexpr size_t WS_X1B = 50 * MiB;
constexpr size_t WS_H0 = 114 * MiB;
constexpr size_t WS_X2B = 448 * MiB;
constexpr size_t WS_H1 = 50 * MiB;
constexpr size_t WS_OP = 338 * MiB;
constexpr size_t WS_LSE = 434 * MiB;
constexpr size_t WS_Y3 = 216 * MiB;
constexpr size_t WS_X3B = 152 * MiB;
constexpr size_t WS_YB = 216 * MiB;
constexpr size_t WS_MWGU = 344 * MiB;
constexpr size_t WS_MWD = 456 * MiB;
constexpr size_t WS_HM = 4 * MiB;
constexpr size_t WS_END = 512 * MiB;
constexpr size_t HM_TILE_BYTES = (size_t)256 * FFE * 2;
constexpr int CW_MOECNT = 64;
constexpr int CW_BAR = 1024;

constexpr int LDS_GTAB = 131072;
constexpr int LDS_RT = 147456;
constexpr int LDS_MISC = 155648 + 2048;
constexpr int LDS_BYTES = 159744;

__device__ __forceinline__ unsigned cvt_pk_bf16(float lo, float hi) { unsigned r; asm volatile("v_cvt_pk_bf16_f32 %0, %1, %2" : "=v"(r) : "v"(lo), "v"(hi)); return r; }
__device__ __forceinline__ float bf_lo(unsigned w) { return __uint_as_float(w << 16); }
__device__ __forceinline__ float bf_hi(unsigned w) { return __uint_as_float(w & 0xffff0000u); }
__device__ __forceinline__ float bf2f(bf16_t b) { return __uint_as_float(((unsigned)b) << 16); }
template <int M> __device__ __forceinline__ float swz_xor(float v) {
    return __int_as_float(__builtin_amdgcn_ds_swizzle(__float_as_int(v), (M << 10) | 0x1f)); }
__device__ __forceinline__ float wave_sum(float v) {
    v += swz_xor<1>(v); v += swz_xor<2>(v); v += swz_xor<4>(v); v += swz_xor<8>(v); v += swz_xor<16>(v);
    auto rr = __builtin_amdgcn_permlane32_swap(__float_as_uint(v), __float_as_uint(v), false, false);
    return __uint_as_float(rr[0]) + __uint_as_float(rr[1]);
}
__device__ __forceinline__ float wave_max(float v) {
    v = fmaxf(v, swz_xor<1>(v)); v = fmaxf(v, swz_xor<2>(v)); v = fmaxf(v, swz_xor<4>(v)); v = fmaxf(v, swz_xor<8>(v)); v = fmaxf(v, swz_xor<16>(v));
    auto rr = __builtin_amdgcn_permlane32_swap(__float_as_uint(v), __float_as_uint(v), false, false);
    return fmaxf(__uint_as_float(rr[0]), __uint_as_float(rr[1]));
}
__device__ __forceinline__ unsigned lane_get(unsigned v, int src_lane) { return (unsigned)__builtin_amdgcn_ds_bpermute(src_lane << 2, (int)v); }
__device__ __forceinline__ float sigmoidf_(float x) { return __builtin_amdgcn_rcpf(1.0f + __expf(-x)); }
#define WAVE_LDS_FENCE() do { asm volatile("s_waitcnt lgkmcnt(0)" ::: "memory"); __builtin_amdgcn_wave_barrier(); } while (0)

#define XB_TMO      128
#define XB_XCNT(j)  (256  + 64 * (j))
#define XB_XSUB(j)  (1280 + 64 * (j))
#define XB_XGEN(j)  (2304 + 64 * (j))
#define XB_TOP      3328
#define XB_TOPGEN   3392
#define XCD_BAR_WORDS 3456
#define XB_SPIN_CAP (1u << 18)
__device__ __forceinline__ unsigned xb_ld(unsigned* p)              { return __hip_atomic_load(p, __ATOMIC_RELAXED, __HIP_MEMORY_SCOPE_AGENT); }
__device__ __forceinline__ unsigned xb_add(unsigned* p, unsigned v) { return __hip_atomic_fetch_add(p, v, __ATOMIC_RELAXED, __HIP_MEMORY_SCOPE_AGENT); }
__device__ __forceinline__ unsigned xb_xcc_id() { return (unsigned)__builtin_amdgcn_s_getreg((3 << 11) | 20) & 0xFu; }
#define XB_SPIN(cond, bar) do { unsigned _sp = 0; while (cond) { __builtin_amdgcn_s_sleep(1); \
    if ((++_sp & 255u) == 0u) { if (xb_ld(&(bar)[XB_TMO])) break; if (_sp > XB_SPIN_CAP) { atomicAdd(&(bar)[XB_TMO], 1u); break; } } } } while (0)
struct XcdBarrier { unsigned* bar; unsigned x; volatile LAS unsigned* st; };
__device__ __forceinline__ XcdBarrier xcd_barrier_post(unsigned* bar, volatile LAS unsigned* st, bool leader) {
    XcdBarrier b; b.bar = bar; b.x = xb_xcc_id(); b.st = st;
    if (leader) (void)xb_add(&bar[XB_XCNT(b.x)], 1u);
    return b;
}
__device__ __forceinline__ void xcd_barrier_complete(unsigned* bar, unsigned x, unsigned& nloc, unsigned& nx) {
    const unsigned G = gridDim.x * gridDim.y * gridDim.z;
    unsigned sum, cnt, mine, sp = 0u;
    for (;;) {
        sum = 0u; cnt = 0u; mine = 0u;
#pragma unroll
        for (unsigned j = 0; j < 16; ++j) { const unsigned c = xb_ld(&bar[XB_XCNT(j)]); sum += c; cnt += (c > 0u) ? 1u : 0u; mine = (j == x) ? c : mine; }
        if (sum == G) break;
        __builtin_amdgcn_s_sleep(1);
        if ((++sp & 255u) == 0u) { if (xb_ld(&bar[XB_TMO])) break; if (sp > XB_SPIN_CAP) { atomicAdd(&bar[XB_TMO], 1u); break; } }
    }
    nloc = mine > 0u ? mine : 1u; nx = cnt > 0u ? cnt : 1u;
}
__device__ __forceinline__ void xcd_barrier(const XcdBarrier& b, bool leader) {
    asm volatile("s_waitcnt vmcnt(0)" ::: "memory");
    __syncthreads();
    if (leader) {
        unsigned* bar = b.bar;
        __builtin_amdgcn_s_waitcnt(0);
        unsigned nloc = b.st[0], nx = b.st[1];
        if (nloc == 0u) { xcd_barrier_complete(bar, b.x, nloc, nx); b.st[0] = nloc; b.st[1] = nx; }
        const unsigned old = xb_add(&bar[XB_XSUB(b.x)], 1u);
        const unsigned gen = old / nloc;
        if (old + 1u == (gen + 1u) * nloc) {
            __builtin_amdgcn_fence(__ATOMIC_RELEASE, "agent");
            asm volatile("s_waitcnt vmcnt(0)" ::: "memory");
            const unsigned og = xb_add(&bar[XB_TOP], 1u);
            const unsigned tg = og / nx;
            if (og + 1u == (tg + 1u) * nx) xb_add(&bar[XB_TOPGEN], 1u);
            else XB_SPIN(xb_ld(&bar[XB_TOPGEN]) == tg, bar);
            __builtin_amdgcn_fence(__ATOMIC_ACQUIRE, "agent");
            xb_add(&bar[XB_XGEN(b.x)], 1u);
            asm volatile("s_waitcnt vmcnt(0)" ::: "memory");
        } else {
            XB_SPIN(xb_ld(&bar[XB_XGEN(b.x)]) == gen, bar);
            __builtin_amdgcn_fence(__ATOMIC_ACQUIRE, "agent");
            asm volatile("s_waitcnt vmcnt(0)" ::: "memory");
        }
    }
    __syncthreads();
}

namespace pg8 {
constexpr int BM = 256, BK = 64, HALF = 128, HTB = HALF * BK * 2, STAGE_BYTES = 8 * HTB, NXCD = 8, WGM = 8;
__host__ __device__ __forceinline__ int lds_byte(int r, int c) { const int st = (r >> 4) * 2 + (c >> 5), rr = r & 15, cc = c & 31, ob = rr * 64 + cc * 2; return st * 1024 + (ob ^ (((ob >> 9) & 1) << 5)); }
__host__ __device__ __forceinline__ void stage_rc(int b, int& R, int& C) { const int st = b / 1024, sb = b % 1024, swz = sb ^ (((sb >> 9) & 1) << 5); R = (st >> 1) * 16 + swz / 64; C = (st & 1) * 32 + (swz % 64) / 2; }
__host__ __device__ __forceinline__ int perm32(int rho) { const int n = rho >> 4, i = rho & 15; return 8 * (i >> 2) + 4 * n + (i & 3); }

struct Unit { int pm, pn; };

__device__ __forceinline__ void remap_unit(int wgid, int nM, int nN, int& pm, int& pn) {
    const int nwg = nM * nN;
    { const int q = nwg / NXCD, r = nwg % NXCD, xcd = wgid % NXCD, off = wgid / NXCD; wgid = (xcd < r ? xcd * (q + 1) : r * (q + 1) + (xcd - r) * q) + off; }
    const int nig = WGM * nN, gid = wgid / nig, fm = gid * WGM, gsz = (nM - fm) < WGM ? (nM - fm) : WGM;
    pm = fm + ((wgid % nig) % gsz); pn = (wgid % nig) / gsz;
}
struct StaticOrder {
    int nM, nN, nwg, G, c; const char* A; size_t tstepA;
    __device__ void init(const bf16_t* A_, int M, int N, int K, int G_, int c_) { nM = M / BM; nN = N / BM; nwg = nM * nN; G = G_; c = c_; A = (const char*)A_; tstepA = (size_t)BM * K * 2; }
    __device__ __forceinline__ bool next(int i, Unit& u) const {
        const long L = (long)i * G + c; if (L >= nwg) return false;
        remap_unit((int)L, nM, nN, u.pm, u.pn); return true;
    }
    __device__ __forceinline__ const char* a_ptr(const Unit& u) const { return A + (size_t)u.pm * tstepA; }
    __device__ __forceinline__ int b_tile(const Unit& u) const { return u.pn; }
};

#define PG8_LAS __attribute__((address_space(3)))
template <class Epi, class Sched, bool ALIGN_EPI, bool GATHER>
__device__ __forceinline__ void gemm_phase(const int tid, PG8_LAS unsigned char* lds, const bf16_t* Btp, const int K, const Sched& S, const Epi& E, const PG8_LAS int* gtab) {
    const int wid = __builtin_amdgcn_readfirstlane(tid >> 6), lane = tid & 63, wr = wid >> 2, wc = wid & 3, fr = lane & 15, fq = lane >> 4;
    const int nt = K / BK;
    unsigned voffA[2], voffB[2];
#pragma unroll
    for (int i = 0; i < 2; ++i) { int R, C; stage_rc(tid * 16 + i * 8192, R, C); const int Rb = Epi::PERM ? ((R & ~31) + perm32(R & 31)) : R;
        voffA[i] = (unsigned)(R * K + C) * 2u; voffB[i] = (unsigned)(Rb * K + C) * 2u; }
    const size_t kstep = (size_t)(BK * 2);
    const size_t hstep = (size_t)HALF * K * 2;
    const size_t tstep = 2 * hstep;
    const unsigned ldsw = (unsigned)wid * 1024u;
    const int aoff = lds_byte(wr * 64 + fr, fq * 8), boff = lds_byte(wc * 32 + fr, fq * 8);
#define PG8_SA(b, h) (((b) * 2 + (h)) * HTB)
#define PG8_SB(b, h) ((4 + (b) * 2 + (h)) * HTB)
#define PG8_STAGE(bufoff, gbase, voff) do { _Pragma("unroll") for (int _i = 0; _i < 2; ++_i) \
        __builtin_amdgcn_global_load_lds((const unsigned*)((const char*)(gbase) + (voff)[_i]), (PG8_LAS unsigned*)(lds + (bufoff) + ldsw + _i * 8192), 16, 0, 0); } while (0)
#define PG8_STAGE_AC(bufoff, kt, h) do { if constexpr (GATHER) { PG8_STAGE(bufoff, cA + (size_t)(kt) * kstep, gcur[h]); } else { PG8_STAGE(bufoff, cA + (size_t)(kt) * kstep + (h) * hstep, voffA); } } while (0)
#define PG8_STAGE_AN(bufoff, d, h) do { if constexpr (GATHER) { if (last) { unsigned _g[2]; _Pragma("unroll") for (int _i = 0; _i < 2; ++_i) { int _R, _C; stage_rc(tid * 16 + _i * 8192, _R, _C); _g[_i] = (unsigned)gtab[nslot * 256 + (h) * 128 + _R] * (unsigned)(K * 2) + (unsigned)(_C * 2); } \
            PG8_STAGE(bufoff, nA + (size_t)(d) * kstep, _g); } else { PG8_STAGE(bufoff, cA + (size_t)(t + 2 + (d)) * kstep, gcur[h]); } } \
        else { PG8_STAGE(bufoff, a2 + (size_t)(d) * kstep + (h) * hstep, voffA); } } while (0)
#define PG8_LDA(dst, b, h) do { _Pragma("unroll") for (int m = 0; m < 4; ++m) _Pragma("unroll") for (int k = 0; k < 2; ++k) dst[m][k] = *(const PG8_LAS bf16x8*)(lds + PG8_SA(b, h) + aoff + m * 2048 + k * 1024); } while (0)
#define PG8_LDB(dst, b, h) do { _Pragma("unroll") for (int n = 0; n < 2; ++n) _Pragma("unroll") for (int k = 0; k < 2; ++k) dst[n][k] = *(const PG8_LAS bf16x8*)(lds + PG8_SB(b, h) + boff + n * 2048 + k * 1024); } while (0)
#define PG8_MMA(ai, bj, At, Bt) do { __builtin_amdgcn_s_setprio(1); _Pragma("unroll") for (int m = 0; m < 4; ++m) _Pragma("unroll") for (int n = 0; n < 2; ++n) _Pragma("unroll") for (int k = 0; k < 2; ++k) \
        acc[ai][bj][m][n] = __builtin_amdgcn_mfma_f32_16x16x32_bf16(Bt[n][k], At[m][k], acc[ai][bj][m][n], 0, 0, 0); __builtin_amdgcn_s_setprio(0); } while (0)
#define PG8_WAIT_V(n) asm volatile("s_waitcnt vmcnt(" #n ")" ::: "memory")
#define PG8_WAIT_L(n) asm volatile("s_waitcnt lgkmcnt(" #n ")" ::: "memory")
#define PG8_BAR __builtin_amdgcn_s_barrier()
#define PG8_SCHED __builtin_amdgcn_sched_barrier(0)
#define PG8_LOADG(dst, slot_) do { _Pragma("unroll") for (int _i = 0; _i < 2; ++_i) { int _R, _C; stage_rc(tid * 16 + _i * 8192, _R, _C); _Pragma("unroll") for (int _h = 0; _h < 2; ++_h) \
        dst[_h][_i] = (unsigned)gtab[(slot_) * 256 + _h * 128 + _R] * (unsigned)(K * 2) + (unsigned)(_C * 2); } } while (0)
    Unit cur, nxt; int ui = 0;
    if (!S.next(0, cur)) return;
    f32x4 acc[2][2][4][2];
#pragma unroll
    for (int a = 0; a < 2; ++a)
#pragma unroll
        for (int b = 0; b < 2; ++b)
#pragma unroll
            for (int m = 0; m < 4; ++m)
#pragma unroll
                for (int n = 0; n < 2; ++n) acc[a][b][m][n] = (f32x4){0.f, 0.f, 0.f, 0.f};
    bf16x8 At[4][2], B0[2][2], B1[2][2];
    unsigned gcur[2][2] = {{0u, 0u}, {0u, 0u}};
    const char* cA = S.a_ptr(cur); const char* cB = (const char*)Btp + (size_t)S.b_tile(cur) * tstep;
    if constexpr (GATHER) { PG8_LOADG(gcur, 0); PG8_WAIT_L(0); }
    PG8_STAGE(PG8_SB(0, 0), cB, voffB); PG8_STAGE(PG8_SB(0, 1), cB + hstep, voffB); PG8_STAGE_AC(PG8_SA(0, 0), 0, 0); PG8_STAGE_AC(PG8_SA(0, 1), 0, 1);
    if (wr == 1) PG8_BAR;
    PG8_WAIT_V(2); PG8_BAR;
    PG8_STAGE(PG8_SB(1, 0), cB + kstep, voffB); PG8_STAGE_AC(PG8_SA(1, 0), 1, 0); PG8_STAGE(PG8_SB(1, 1), cB + hstep + kstep, voffB);
    PG8_WAIT_V(6); PG8_BAR;
    for (;;) {
        const bool has_next = S.next(ui + 1, nxt);
        const char* nA = has_next ? S.a_ptr(nxt) : cA; const char* nB = has_next ? (const char*)Btp + (size_t)S.b_tile(nxt) * tstep : cB;
        const int nslot = has_next ? ui + 1 : ui;
        for (int t = 0; t < nt; t += 2) {
            const bool last = (t == nt - 2);
            const char* a2 = last ? nA : cA + (size_t)(t + 2) * kstep; const char* b2 = last ? nB : cB + (size_t)(t + 2) * kstep;
            const char* b3 = b2 + kstep;
            (void)a2;
            PG8_LDB(B0, 0, 0); PG8_LDB(B1, 0, 1); PG8_SCHED; PG8_LDA(At, 0, 0); PG8_STAGE_AC(PG8_SA(1, 1), t + 1, 1);
            PG8_WAIT_V(8); PG8_WAIT_L(0); PG8_BAR; PG8_MMA(0, 0, At, B0); PG8_MMA(0, 1, At, B1); PG8_BAR; PG8_SCHED;
            PG8_LDA(At, 0, 1); PG8_STAGE(PG8_SB(0, 0), b2, voffB); PG8_STAGE(PG8_SB(0, 1), b2 + hstep, voffB); PG8_STAGE_AN(PG8_SA(0, 0), 0, 0);
            PG8_WAIT_V(8); PG8_WAIT_L(0); PG8_BAR; PG8_MMA(1, 0, At, B0); PG8_MMA(1, 1, At, B1); PG8_BAR; PG8_SCHED;
            PG8_LDB(B0, 1, 0); PG8_LDB(B1, 1, 1); PG8_SCHED; PG8_LDA(At, 1, 0); PG8_STAGE_AN(PG8_SA(0, 1), 0, 1);
            PG8_WAIT_V(8); PG8_WAIT_L(0); PG8_BAR; PG8_MMA(0, 0, At, B0); PG8_MMA(0, 1, At, B1); PG8_BAR; PG8_SCHED;
            PG8_LDA(At, 1, 1); PG8_STAGE(PG8_SB(1, 0), b3, voffB); PG8_STAGE(PG8_SB(1, 1), b3 + hstep, voffB); PG8_STAGE_AN(PG8_SA(1, 0), 1, 0);
            PG8_WAIT_V(8); PG8_WAIT_L(0); PG8_BAR; PG8_MMA(1, 0, At, B0); PG8_MMA(1, 1, At, B1); PG8_BAR; PG8_SCHED;
        }
        if constexpr (ALIGN_EPI) { if (wr == 0) PG8_BAR; }
        { int fr_e = fr, fq_e = fq; asm volatile("" : "+v"(fr_e), "+v"(fq_e)); E(acc, cur, wr, wc, fr_e, fq_e); }
        if (!has_next) break;
#pragma unroll
        for (int a = 0; a < 2; ++a)
#pragma unroll
            for (int b = 0; b < 2; ++b)
#pragma unroll
                for (int m = 0; m < 4; ++m)
#pragma unroll
                    for (int n = 0; n < 2; ++n) acc[a][b][m][n] = (f32x4){0.f, 0.f, 0.f, 0.f};
        cur = nxt; cA = nA; cB = nB; ++ui;
        if constexpr (GATHER) { PG8_LOADG(gcur, ui); }
        if constexpr (ALIGN_EPI) { if (wr == 1) PG8_BAR; }
    }
    PG8_WAIT_V(0);
    if constexpr (!ALIGN_EPI) { if (wr == 0) PG8_BAR; }
    PG8_BAR;
#undef PG8_SA
#undef PG8_SB
#undef PG8_STAGE
#undef PG8_STAGE_AC
#undef PG8_STAGE_AN
#undef PG8_LDA
#undef PG8_LDB
#undef PG8_MMA
#undef PG8_WAIT_V
#undef PG8_WAIT_L
#undef PG8_BAR
#undef PG8_SCHED
#undef PG8_LOADG
}

typedef f32x4 AccT[2][2][4][2];
__device__ __forceinline__ u32x4 pack8(const f32x4 v0, const f32x4 v1) { u32x4 w; w.x = cvt_pk_bf16(v0[0], v0[1]); w.y = cvt_pk_bf16(v0[2], v0[3]); w.z = cvt_pk_bf16(v1[0], v1[1]); w.w = cvt_pk_bf16(v1[2], v1[3]); return w; }

struct EpiIn0 {
    static constexpr bool PERM = true;
    bf16_t* U; bf16_t* Q; bf16_t* KI; float* WI;
    __device__ __forceinline__ void operator()(const AccT& acc, const Unit& u, int wr, int wc, int fr, int fq) const {
        const int row0 = u.pm * BM + wr * 64 + fr;
        if (u.pn < 4) {
            const int col0 = u.pn * 128 + wc * 32 + 8 * fq;
#pragma unroll
            for (int ai = 0; ai < 2; ++ai)
#pragma unroll
                for (int m = 0; m < 4; ++m) { f32x4 o0, o1;
#pragma unroll
                    for (int j = 0; j < 4; ++j) { o0[j] = acc[ai][0][m][0][j] * sigmoidf_(acc[ai][1][m][0][j]); o1[j] = acc[ai][0][m][1][j] * sigmoidf_(acc[ai][1][m][1][j]); }
                    *(u32x4*)(U + (size_t)(row0 + ai * HALF + m * 16) * 512 + col0) = pack8(o0, o1); }
        } else if (u.pn < 12) {
            const int t = (u.pn - 4) >> 1; bf16_t* base = Q + (size_t)t * (SEG0 / 2); const float sc = 1.0f;
            const int col0 = ((u.pn - 4) & 1) * 256 + wc * 32 + 8 * fq;
#pragma unroll
            for (int ai = 0; ai < 2; ++ai)
#pragma unroll
                for (int m = 0; m < 4; ++m)
#pragma unroll
                    for (int bj = 0; bj < 2; ++bj)
                        *(u32x4*)(base + (size_t)(row0 + ai * HALF + m * 16) * 512 + col0 + bj * HALF) = pack8(acc[ai][bj][m][0] * sc, acc[ai][bj][m][1] * sc);
        } else {
            if (wc < 2) {
#pragma unroll
                for (int ai = 0; ai < 2; ++ai)
#pragma unroll
                    for (int m = 0; m < 4; ++m) *(u32x4*)(KI + (size_t)(row0 + ai * HALF + m * 16) * 64 + wc * 32 + 8 * fq) = pack8(acc[ai][0][m][0], acc[ai][0][m][1]);
            } else if (wc == 2 && fq == 0) {
                const float sc = 0.04419417382415922f;
#pragma unroll
                for (int ai = 0; ai < 2; ++ai)
#pragma unroll
                    for (int m = 0; m < 4; ++m) { float* p = WI + (size_t)(row0 + ai * HALF + m * 16) * 8; *(f32x4*)p = acc[ai][0][m][0] * sc; *(f32x4*)(p + 4) = acc[ai][0][m][1] * sc; }
            }
        }
    }
};
template <bool RB> struct EpiRes {
    static constexpr bool PERM = false;
    float* out; const void* resid;
    __device__ __forceinline__ void operator()(const AccT& acc, const Unit& u, int wr, int wc, int fr, int fq) const {
        const int row0 = u.pm * BM + wr * 64 + fr, col0 = u.pn * BM + wc * 32 + 4 * fq;
#pragma unroll
        for (int ai = 0; ai < 2; ++ai)
#pragma unroll
            for (int m = 0; m < 4; ++m) { const size_t off = (size_t)(row0 + ai * HALF + m * 16) * DM + col0;
#pragma unroll
                for (int bj = 0; bj < 2; ++bj)
#pragma unroll
                    for (int n = 0; n < 2; ++n) { f32x4 r;
                        if (RB) { const u32x2 w = *(const u32x2*)((const bf16_t*)resid + off + bj * HALF + n * 16); r = (f32x4){bf_lo(w.x), bf_hi(w.x), bf_lo(w.y), bf_hi(w.y)}; }
                        else r = *(const f32x4*)((const float*)resid + off + bj * HALF + n * 16);
                        *(f32x4*)(out + off + bj * HALF + n * 16) = r * ALPHA + acc[ai][bj][m][n]; } }
    }
};
__device__ __forceinline__ char* hm_tile(char* dout, char* ws, int p) { return p < HM_DOUT_TILES ? dout + (size_t)p * HM_TILE_BYTES : ws + WS_HM + (size_t)(p - HM_DOUT_TILES) * HM_TILE_BYTES; }
template <bool TILE_LOCAL> struct EpiSwiglu {
    static constexpr bool PERM = true;
    bf16_t* H; int ldh; char* dout; char* ws;
    __device__ __forceinline__ void operator()(const AccT& acc, const Unit& u, int wr, int wc, int fr, int fq) const {
        bf16_t* base; if constexpr (TILE_LOCAL) base = (bf16_t*)hm_tile(dout, ws, u.pm); else base = H + (size_t)u.pm * BM * ldh;
        const int rl0 = wr * 64 + fr, col0 = u.pn * 128 + wc * 32 + 8 * fq;
#pragma unroll
        for (int ai = 0; ai < 2; ++ai)
#pragma unroll
            for (int m = 0; m < 4; ++m) { f32x4 o0, o1;
#pragma unroll
                for (int j = 0; j < 4; ++j) { const float g0 = acc[ai][0][m][0][j], g1 = acc[ai][0][m][1][j];
                    o0[j] = g0 * sigmoidf_(g0) * acc[ai][1][m][0][j]; o1[j] = g1 * sigmoidf_(g1) * acc[ai][1][m][1][j]; }
                *(u32x4*)(base + (size_t)(rl0 + ai * HALF + m * 16) * ldh + col0) = pack8(o0, o1); }
    }
};
struct EpiQkv1 {
    static constexpr bool PERM = true;
    bf16_t* O; int ldc; float qscale;
    __device__ __forceinline__ void operator()(const AccT& acc, const Unit& u, int wr, int wc, int fr, int fq) const {
        const int row0 = u.pm * BM + wr * 64 + fr, col0 = u.pn * BM + wc * 32 + 8 * fq; const float sc = ((u.pn % 12) < 4) ? qscale : 1.0f;
#pragma unroll
        for (int ai = 0; ai < 2; ++ai)
#pragma unroll
            for (int m = 0; m < 4; ++m)
#pragma unroll
                for (int bj = 0; bj < 2; ++bj)
                    *(u32x4*)(O + (size_t)(row0 + ai * HALF + m * 16) * ldc + col0 + bj * HALF) = pack8(acc[ai][bj][m][0] * sc, acc[ai][bj][m][1] * sc);
    }
};
struct EpiMoeDown {
    static constexpr bool PERM = true;
    bf16_t* YB; const int* tokk; const float* gate; const PG8_LAS int* rt;
    __device__ __forceinline__ void operator()(const AccT& acc, const Unit& u, int wr, int wc, int fr, int fq) const {
        const int lbase = rt[u.pm * 4 + 1], nvalid = rt[u.pm * 4 + 2];
        const int rl0 = wr * 64 + fr, col0 = u.pn * BM + wc * 32 + 8 * fq;
#pragma unroll
        for (int ai = 0; ai < 2; ++ai)
#pragma unroll
            for (int m = 0; m < 4; ++m) { const int rl = rl0 + ai * HALF + m * 16;
                if (rl < nvalid) { const int tk = tokk[lbase + rl]; const float g = gate[lbase + rl];
                    bf16_t* rowp = YB + ((size_t)(tk & 1) * NTOK + (size_t)(tk >> 1)) * DM + col0;
#pragma unroll
                    for (int bj = 0; bj < 2; ++bj) *(u32x4*)(rowp + bj * HALF) = pack8(acc[ai][bj][m][0] * g, acc[ai][bj][m][1] * g); } }
    }
};
struct MoeOrder {
    int G, c, nM, nN; const PG8_LAS int* rt; const char* xbase; char* dout; char* ws; bool up;
    __device__ __forceinline__ bool next(int i, Unit& u) const {
        const long L = (long)i * G + c; if (L >= (long)nM * nN) return false;
        remap_unit((int)L, nM, nN, u.pm, u.pn); return true;
    }
    __device__ __forceinline__ const char* a_ptr(const Unit& u) const { return up ? xbase : (const char*)hm_tile(dout, ws, u.pm); }
    __device__ __forceinline__ int b_tile(const Unit& u) const { return __builtin_amdgcn_readfirstlane(rt[u.pm * 4]) * nN + u.pn; }
};
}


namespace swa {
constexpr int D = 128, NW = 8, QBLK = 32, KVBLK = 64, QB = NW * QBLK, WIN = 129;
constexpr int SHM_V = KVBLK * D * 2, SHM_K = KVBLK * D * 2;
constexpr int LDS_TB = 2 * SHM_V + 2 * SHM_K + NW * 64 * 4;
constexpr float SCALE = 0.08838834764831845f, THR = 8.f;
typedef float f32x16 __attribute__((ext_vector_type(16)));
typedef short s16x4 __attribute__((ext_vector_type(4)));
#define KSWZ(row, colB) ((row) * 256 + ((colB) ^ (((row) & 7) << 4)))
#define SBAR() __builtin_amdgcn_sched_barrier(0)
__device__ __forceinline__ int v_st(int k, int c) { const int kk = (k & ~0xC) | ((k & 4) << 1) | ((k & 8) >> 1); return ((kk >> 3) * 4 + (c >> 5)) * 512 + ((kk & 7) * 32 + (c & 31)) * 2; }
__device__ __forceinline__ int v_rd_base(int lane) { return ((lane & 3) << 3) | (((lane >> 2) & 3) << 6) | (((lane >> 4) & 1) << 5) | (((lane >> 5) & 1) << 8); }
constexpr int v_rd_off(int d0, int ks, int half) { return d0 * 512 + ks * 4096 + half * 2048; }
__device__ __forceinline__ int crow(int r, int hi) { return (r & 3) + 8 * (r >> 2) + 4 * hi; }
__device__ __forceinline__ bf16x8 load8(const bf16_t* p) { return *reinterpret_cast<const bf16x8*>(p); }
__device__ __forceinline__ void mask_bias_tile(f32x16& p0, f32x16& p1, int dq, const float* tb) {
    const float NEG = -__builtin_inff();
#pragma unroll
    for (int r = 0; r < 16; ++r) {
        const int c = (r & 3) + 8 * (r >> 2);
        p0[r] = ((unsigned)(dq - c) < (unsigned)WIN) ? p0[r] + tb[59 - c] : NEG;
        p1[r] = ((unsigned)(dq - c - 32) < (unsigned)WIN) ? p1[r] + tb[27 - c] : NEG;
    }
}
__device__ __forceinline__ void partialSM(f32x16& p0, f32x16& p1, float& m_reg, float& mn, float& alpha) {
    float pmax = p0[0];
#pragma unroll
    for (int r = 1; r < 16; ++r) pmax = fmaxf(pmax, p0[r]);
#pragma unroll
    for (int r = 0; r < 16; ++r) pmax = fmaxf(pmax, p1[r]);
    { auto rr = __builtin_amdgcn_permlane32_swap(__float_as_uint(pmax), __float_as_uint(pmax), false, false);
      pmax = fmaxf(__uint_as_float(rr[0]), __uint_as_float(rr[1])); }
    constexpr float C2 = 1.4426950408889634f * SCALE;
    if (__builtin_expect(__all((pmax - m_reg) * SCALE <= THR), 1)) { mn = m_reg; alpha = 1.f; }
    else { mn = fmaxf(m_reg, pmax); alpha = __builtin_amdgcn_exp2f((m_reg - mn) * C2); m_reg = mn; }
    const float mnL = -mn * C2;
#pragma unroll
    for (int r = 0; r < 16; ++r) p0[r] = fmaf(p0[r], C2, mnL);
#pragma unroll
    for (int r = 0; r < 16; ++r) p1[r] = fmaf(p1[r], C2, mnL);
#pragma unroll
    for (int r = 0; r < 16; ++r) p0[r] = __builtin_amdgcn_exp2f(p0[r]);
}
__device__ __forceinline__ void finishSM(f32x16& p0, f32x16& p1, float alpha, float& l_reg, bf16x8& pa0, bf16x8& pa1, bf16x8& pa2, bf16x8& pa3) {
#pragma unroll
    for (int r = 0; r < 16; ++r) p1[r] = __builtin_amdgcn_exp2f(p1[r]);
    float ps = 0;
#pragma unroll
    for (int r = 0; r < 16; ++r) ps += p0[r];
#pragma unroll
    for (int r = 0; r < 16; ++r) ps += p1[r];
    { auto rr = __builtin_amdgcn_permlane32_swap(__float_as_uint(ps), __float_as_uint(ps), false, false);
      ps = __uint_as_float(rr[0]) + __uint_as_float(rr[1]); }
    l_reg = l_reg * alpha + ps;
#define PK4(P, B_, OUT) do { unsigned a0 = cvt_pk_bf16(P[B_+0], P[B_+1]), a1 = cvt_pk_bf16(P[B_+2], P[B_+3]);                          \
        unsigned b0 = cvt_pk_bf16(P[B_+4], P[B_+5]), b1 = cvt_pk_bf16(P[B_+6], P[B_+7]);                                             \
        auto r0 = __builtin_amdgcn_permlane32_swap(a0, b0, false, false); auto r1 = __builtin_amdgcn_permlane32_swap(a1, b1, false, false); \
        u32x4 w = {r0[0], r1[0], r0[1], r1[1]}; OUT = *reinterpret_cast<bf16x8*>(&w); } while (0)
    PK4(p0, 0, pa0); PK4(p0, 8, pa1); PK4(p1, 0, pa2); PK4(p1, 8, pa3);
#undef PK4
}
template <int KB>
__device__ __forceinline__ void qkt(f32x16& p0, f32x16& p1, const char* K_lds, int r32, int hi, const bf16x8* qr, bool act) {
    if (!act) { const float NEG = -__builtin_inff();
#pragma unroll
        for (int r = 0; r < 16; ++r) { p0[r] = NEG; p1[r] = NEG; } return; }
    p0 = f32x16{}; p1 = f32x16{};
    const char* kb[4];
#pragma unroll
    for (int dd = 0; dd < 4; ++dd) kb[dd] = K_lds + KB * SHM_K + KSWZ(r32, (dd * 16 + hi * 8) * 2);
#pragma unroll
    for (int d0 = 0; d0 < 8; ++d0) { const char* a = kb[d0 & 3] + (d0 >> 2) * 128;
        bf16x8 b0 = *reinterpret_cast<const bf16x8*>(a);
        bf16x8 b1 = *reinterpret_cast<const bf16x8*>(a + 32 * 256);
        p0 = __builtin_amdgcn_mfma_f32_32x32x16_bf16(b0, qr[d0], p0, 0, 0, 0);
        p1 = __builtin_amdgcn_mfma_f32_32x32x16_bf16(b1, qr[d0], p1, 0, 0, 0); }
}
template <int VB>
__device__ __forceinline__ void pv_tile(f32x16* o, int vb0, bf16x8 pa0, bf16x8 pa1, bf16x8 pa2, bf16x8 pa3, bool act) {
    if (!act) return;
#define TRRD(dst, off) asm volatile("ds_read_b64_tr_b16 %0, %1 offset:%2" : "=&v"(dst) : "v"(vb0), "i"(off) : "memory")
#define PV_D0(d0) do { s16x4 l0, l1, l2, l3, h0, h1, h2, h3; constexpr int b_ = VB * SHM_V + v_rd_off(d0, 0, 0); \
        TRRD(l0, b_); TRRD(h0, b_ + 2048); TRRD(l1, b_ + 4096); TRRD(h1, b_ + 6144); TRRD(l2, b_ + 8192); TRRD(h2, b_ + 10240); TRRD(l3, b_ + 12288); TRRD(h3, b_ + 14336); \
        asm volatile("s_waitcnt lgkmcnt(0)" ::: "memory"); SBAR();   \
        o[d0] = __builtin_amdgcn_mfma_f32_32x32x16_bf16(pa0, (bf16x8){l0[0], l0[1], l0[2], l0[3], h0[0], h0[1], h0[2], h0[3]}, o[d0], 0, 0, 0);   \
        o[d0] = __builtin_amdgcn_mfma_f32_32x32x16_bf16(pa1, (bf16x8){l1[0], l1[1], l1[2], l1[3], h1[0], h1[1], h1[2], h1[3]}, o[d0], 0, 0, 0);   \
        o[d0] = __builtin_amdgcn_mfma_f32_32x32x16_bf16(pa2, (bf16x8){l2[0], l2[1], l2[2], l2[3], h2[0], h2[1], h2[2], h2[3]}, o[d0], 0, 0, 0);   \
        o[d0] = __builtin_amdgcn_mfma_f32_32x32x16_bf16(pa3, (bf16x8){l3[0], l3[1], l3[2], l3[3], h3[0], h3[1], h3[2], h3[3]}, o[d0], 0, 0, 0); } while (0)
    PV_D0(0); PV_D0(1); PV_D0(2); PV_D0(3);
#undef PV_D0
#undef TRRD
}
struct BlockRef { const bf16_t* Q; const bf16_t* K; bf16_t* O; float* LSE; int P0, bh, dsh;
    __device__ __forceinline__ int rs() const { return IN1_N << dsh; }
    __device__ __forceinline__ int os() const { return DM << dsh; }
    __device__ __forceinline__ int ls() const { return 8 << dsh; }
    __device__ __forceinline__ int skv() const { return SEQ >> dsh; }
    __device__ __forceinline__ const bf16_t* V() const { return K + 1024; } };
struct Seam { bf16x8 qr[8]; bf16x8 st_v0, st_v1, st_k0, st_k1; };
__device__ __forceinline__ int swa_jlo(int P0) { const int lowk = P0 - WIN + 1; return lowk > 0 ? lowk / KVBLK : 0; }
#define ROWP(p, k0, rs_, vo) ((const bf16_t*)((const char*)(p) + (size_t)(k0) * (size_t)(rs_) * 2 + (size_t)(vo)))
#define VMW() asm volatile("s_waitcnt vmcnt(0)" ::: "memory")
#define VMWN(n) asm volatile("s_waitcnt vmcnt(%0)" :: "i"(n) : "memory")
#define TIDL() int tid_l = tid; asm volatile("" : "+v"(tid_l)); const int sr = tid_l >> 4, sc = (tid_l & 15) * 8; (void)sr; (void)sc
#define SLOAD_H(Kp, Vp, k0, rs_) do { TIDL(); const unsigned vo0_ = (unsigned)(sr * (rs_) + sc) * 2u, vo1_ = vo0_ + (unsigned)(rs_) * 64u; \
                         S.st_v0 = load8(ROWP(Vp, k0, rs_, vo0_)); S.st_v1 = load8(ROWP(Vp, k0, rs_, vo1_));              \
                         S.st_k0 = load8(ROWP(Kp, k0, rs_, vo0_)); S.st_k1 = load8(ROWP(Kp, k0, rs_, vo1_)); } while (0)
#define SWRITE_HK(bf) do { TIDL(); const int kws = KSWZ(sr, sc * 2); *(bf16x8*)(K_lds + (bf) * SHM_K + kws) = S.st_k0; *(bf16x8*)(K_lds + (bf) * SHM_K + kws + 32 * 256) = S.st_k1; } while (0)
#define SWRITE_HV(bf) do { TIDL(); const int vst0 = v_st(sr, sc), vst1 = v_st(32 + sr, sc); *(bf16x8*)(V_lds + (bf) * SHM_V + vst0) = S.st_v0; *(bf16x8*)(V_lds + (bf) * SHM_V + vst1) = S.st_v1; } while (0)
#define SWRITE_H(bf) do { SWRITE_HV(bf); SWRITE_HK(bf); } while (0)
__device__ __forceinline__ void tb_load(const float* biast, int bh, int dsh, int tid, float& v0, float& v1) {
    const int d0 = tid - 384, d1 = tid + 512 - 384;
    v0 = (d0 >= 0 && d0 < WIN) ? biast[bh * 4096 + (d0 << dsh)] * (1.0f / SCALE) : 0.f;
    v1 = (d1 >= 0 && d1 < WIN) ? biast[bh * 4096 + (d1 << dsh)] * (1.0f / SCALE) : 0.f;
}
__device__ __forceinline__ void swa_prime(const BlockRef& cur, const float* biast, char* lds, Seam& S, int tid) {
    const int wid = __builtin_amdgcn_readfirstlane(tid >> 6), lane = tid & 63, r32 = lane & 31, hi = lane >> 5;
    char* K_lds = lds + 2 * SHM_V;
    const int kb0 = swa_jlo(cur.P0) * KVBLK;
    float t0, t1; tb_load(biast, cur.bh, cur.dsh, tid, t0, t1);
#pragma unroll
    for (int d0 = 0; d0 < 8; ++d0) S.qr[d0] = load8((const bf16_t*)((const char*)cur.Q + (size_t)((unsigned)((wid * QBLK + r32) * cur.rs() + hi * 8) * 2u)) + d0 * 16);
    SLOAD_H(cur.K, cur.V(), kb0, cur.rs()); VMW(); SWRITE_HK(0);
    float* tb = (float*)(lds + LDS_TB); tb[tid] = t0; tb[tid + 512] = t1;
    __syncthreads();
}
__device__ __forceinline__ void swa_block(const BlockRef& cur, const BlockRef& nxt, const float* biast, int slot, char* lds, Seam& S, int tid) {
    const int wid = __builtin_amdgcn_readfirstlane(tid >> 6), lane = tid & 63, r32 = lane & 31, hi = lane >> 5;
    const int j_lo = swa_jlo(cur.P0);
    int j_hi = (cur.P0 + QB - 1) / KVBLK + 1; if (j_hi > cur.skv() / KVBLK) j_hi = cur.skv() / KVBLK;
    const int NT = j_hi - j_lo;
    const int kbn = swa_jlo(nxt.P0) * KVBLK;
    const int qlo = cur.P0 + wid * QBLK, qm = qlo + r32 - 4 * hi;
    char* V_lds = lds; char* K_lds = lds + 2 * SHM_V;
    float* wsl = (float*)(lds + 2 * SHM_V + 2 * SHM_K) + wid * 64; float* li_l = wsl, * al_l = wsl + 32;
    const float* tbl0 = (const float*)(lds + LDS_TB + slot * 4096) + 325;
    float m_reg = -1e30f, l_reg = 0; f32x16 o[4] = {};
    const int vb0 = (int)(uintptr_t)V_lds + v_rd_base(lane);
    const bf16_t* Kh = cur.K; const bf16_t* Vh = cur.V(); const int rs = cur.rs();
#define RESC(a) do { if (__any((a) < 1.f)) { if (hi == 0) al_l[r32] = (a); asm volatile("s_waitcnt lgkmcnt(0)" ::: "memory");              \
                     _Pragma("unroll") for (int d_ = 0; d_ < 4; ++d_) _Pragma("unroll") for (int r = 0; r < 16; ++r) o[d_][r] *= al_l[crow(r, hi)]; } } while (0)
#define KBASE(t) ((j_lo + (t)) * KVBLK)
#define ACT(t) (KBASE(t) <= qlo + QBLK - 1 && KBASE(t) + KVBLK - 1 >= qlo - WIN + 1)
#define MASKT(P0_, P1_, t) do { const int kb_ = KBASE(t); if (ACT(t)) mask_bias_tile(P0_, P1_, qm - kb_, tbl0 + (qm - kb_)); } while (0)
    constexpr int NQL = 8;
#define SEAM_K0() do { VMWN(NQL); SWRITE_HK(0); SBAR(); } while (0)
    f32x16 pA0, pA1, pB0, pB1; float mnA, mnB, alA, alB; bf16x8 pa0, pa1, pa2, pa3;
    SWRITE_HV(0); SBAR();
    if (NT > 1) { SLOAD_H(Kh, Vh, KBASE(1), rs); }
    SBAR(); qkt<0>(pA0, pA1, K_lds, r32, hi, S.qr, ACT(0));
    MASKT(pA0, pA1, 0); partialSM(pA0, pA1, m_reg, mnA, alA);
    if (NT > 1) { VMW(); SWRITE_H(1); }
    __syncthreads();
#define HALF_STEP(PX0, PX1, mnX, alX, PY0, PY1, alY, t, KB, VB, SB) do {                                                      \
        SBAR(); qkt<KB>(PX0, PX1, K_lds, r32, hi, S.qr, ACT(t));                                             \
        finishSM(PY0, PY1, alY, l_reg, pa0, pa1, pa2, pa3); SBAR();                                                           \
        if ((t) + 1 < NT) { SLOAD_H(Kh, Vh, KBASE((t) + 1), rs); SBAR(); }                                               \
        pv_tile<VB>(o, vb0, pa0, pa1, pa2, pa3, ACT((t) - 1)); MASKT(PX0, PX1, (t)); partialSM(PX0, PX1, m_reg, mnX, alX);                                        \
        __syncthreads();                                                                                                      \
        if ((t) + 1 < NT) { VMW(); SWRITE_H(SB); }                                                                          \
        RESC(alX); __syncthreads(); } while (0)
    for (int t = 1; t + 1 < NT; t += 2) {
        HALF_STEP(pB0, pB1, mnB, alB, pA0, pA1, alA, t, 1, 0, 0);
        HALF_STEP(pA0, pA1, mnA, alA, pB0, pB1, alB, t + 1, 0, 1, 1);
    }
    const bool even = (NT & 1) == 0;
    if (even) { SBAR(); qkt<1>(pB0, pB1, K_lds, r32, hi, S.qr, ACT(NT - 1)); SBAR(); }
    SLOAD_H(nxt.K, nxt.V(), kbn, nxt.rs()); SBAR();
#pragma unroll
    for (int d0 = 0; d0 < 8; ++d0) S.qr[d0] = load8((const bf16_t*)((const char*)nxt.Q + (size_t)((unsigned)((wid * QBLK + r32) * nxt.rs() + hi * 8) * 2u)) + d0 * 16);
    SBAR();
    finishSM(pA0, pA1, alA, l_reg, pa0, pa1, pa2, pa3); SBAR();
    pv_tile<0>(o, vb0, pa0, pa1, pa2, pa3, ACT(even ? NT - 2 : NT - 1));
    if (even) { MASKT(pB0, pB1, NT - 1); partialSM(pB0, pB1, m_reg, mnB, alB); __syncthreads(); RESC(alB);
        finishSM(pB0, pB1, alB, l_reg, pa0, pa1, pa2, pa3); SBAR(); pv_tile<1>(o, vb0, pa0, pa1, pa2, pa3, ACT(NT - 1)); }
    SBAR(); SEAM_K0();
    float t0, t1; tb_load(biast, nxt.bh, nxt.dsh, tid, t0, t1);
    if (hi == 0) li_l[r32] = l_reg; asm volatile("s_waitcnt lgkmcnt(0)" ::: "memory");
    int r32e = r32, hie = hi; asm volatile("" : "+v"(r32e), "+v"(hie));
    if (hie == 0) cur.LSE[(size_t)(wid * QBLK + r32e) * cur.ls()] = m_reg * SCALE + __logf(l_reg);
    float rli[16];
#pragma unroll
    for (int r = 0; r < 16; ++r) rli[r] = __builtin_amdgcn_rcpf(li_l[crow(r, hie)]);
    const int os = cur.os();
    bf16_t* Ow = cur.O + (size_t)(wid * QBLK) * os;
#pragma unroll
    for (int r = 0; r < 16; ++r) { const unsigned oo = (unsigned)(crow(r, hie) * os + r32e) * 2u;
#pragma unroll
        for (int d0 = 0; d0 < 4; ++d0) { const float v = o[d0][r] * rli[r];
            const float vn = swz_xor<1>(v);
            if ((r32e & 1) == 0) *(unsigned*)((char*)Ow + oo + d0 * 64) = cvt_pk_bf16(v, vn); } }
    { float* tb = (float*)(lds + LDS_TB + (slot ^ 1) * 4096); tb[tid] = t0; tb[tid + 512] = t1; }
    __syncthreads();
#undef RESC
#undef KBASE
#undef ACT
#undef MASKT
#undef SEAM_K0
#undef HALF_STEP
}
#undef ROWP
#undef VMW
#undef VMWN
#undef SLOAD_H
#undef SWRITE_HK
#undef SWRITE_HV
#undef SWRITE_H
#undef TIDL
#undef KSWZ
#undef SBAR
}


namespace dsa {
constexpr int D = 64, NW = 8, QBLK = 32, KVBLK = 64, QB = NW * QBLK;
constexpr int SHM_V = KVBLK * D * 2, SHM_K = KVBLK * D * 2;
constexpr int LDS_TB = 2 * SHM_V + 2 * SHM_K + NW * 64 * 4;
constexpr int TB_PAD = 128;
constexpr float SCALE = 0.125f, THR = 8.f;
typedef float f32x16 __attribute__((ext_vector_type(16)));
typedef short s16x4 __attribute__((ext_vector_type(4)));
#define KSWZ(row, colB) ((row) * 128 + ((colB) ^ (((row) & 7) << 4)))
#define SBAR() __builtin_amdgcn_sched_barrier(0)
__device__ __forceinline__ int v_st(int k, int c) { const int kk = (k & ~0xC) | ((k & 4) << 1) | ((k & 8) >> 1); return ((kk >> 3) * 2 + (c >> 5)) * 512 + ((kk & 7) * 32 + (c & 31)) * 2; }
__device__ __forceinline__ int v_rd_base(int lane) { return ((lane & 3) << 3) | (((lane >> 2) & 3) << 6) | (((lane >> 4) & 1) << 5) | (((lane >> 5) & 1) << 8); }
__device__ __forceinline__ int crow(int r, int hi) { return (r & 3) + 8 * (r >> 2) + 4 * hi; }
__device__ __forceinline__ bf16x8 load8(const bf16_t* p) { return *reinterpret_cast<const bf16x8*>(p); }
__device__ __forceinline__ void mask_bias_tile(f32x16& p0, f32x16& p1, const float* tb, unsigned lo4, unsigned hi4) {
    const float NEG = -__builtin_inff();
#pragma unroll
    for (int r = 0; r < 16; ++r) {
        const int c = (r & 3) + 8 * (r >> 2);
        p0[r] = ((lo4 >> c) & 1u) ? p0[r] + tb[63 - c] : NEG;
        p1[r] = ((hi4 >> c) & 1u) ? p1[r] + tb[31 - c] : NEG;
    }
}
__device__ __forceinline__ void partialSM(f32x16& p0, f32x16& p1, float& m_reg, float& mn, float& alpha) {
    float pmax = p0[0];
#pragma unroll
    for (int r = 1; r < 16; ++r) pmax = fmaxf(pmax, p0[r]);
#pragma unroll
    for (int r = 0; r < 16; ++r) pmax = fmaxf(pmax, p1[r]);
    { auto rr = __builtin_amdgcn_permlane32_swap(__float_as_uint(pmax), __float_as_uint(pmax), false, false);
      pmax = fmaxf(__uint_as_float(rr[0]), __uint_as_float(rr[1])); }
    constexpr float C2 = 1.4426950408889634f * SCALE;
    if (__builtin_expect(__all((pmax - m_reg) * SCALE <= THR), 1)) { mn = m_reg; alpha = 1.f; }
    else { mn = fmaxf(m_reg, pmax); alpha = __builtin_amdgcn_exp2f((m_reg - mn) * C2); m_reg = mn; }
    const float mnL = -mn * C2;
#pragma unroll
    for (int r = 0; r < 16; ++r) p0[r] = fmaf(p0[r], C2, mnL);
#pragma unroll
    for (int r = 0; r < 16; ++r) p1[r] = fmaf(p1[r], C2, mnL);
#pragma unroll
    for (int r = 0; r < 16; ++r) p0[r] = __builtin_amdgcn_exp2f(p0[r]);
}
__device__ __forceinline__ void finishSM(f32x16& p0, f32x16& p1, float alpha, float& l_reg, bf16x8& pa0, bf16x8& pa1, bf16x8& pa2, bf16x8& pa3) {
#pragma unroll
    for (int r = 0; r < 16; ++r) p1[r] = __builtin_amdgcn_exp2f(p1[r]);
    float ps = 0;
#pragma unroll
    for (int r = 0; r < 16; ++r) ps += p0[r];
#pragma unroll
    for (int r = 0; r < 16; ++r) ps += p1[r];
    { auto rr = __builtin_amdgcn_permlane32_swap(__float_as_uint(ps), __float_as_uint(ps), false, false);
      ps = __uint_as_float(rr[0]) + __uint_as_float(rr[1]); }
    l_reg = l_reg * alpha + ps;
#define PK4(P, B_, OUT) do { unsigned a0 = cvt_pk_bf16(P[B_+0], P[B_+1]), a1 = cvt_pk_bf16(P[B_+2], P[B_+3]);                          \
        unsigned b0 = cvt_pk_bf16(P[B_+4], P[B_+5]), b1 = cvt_pk_bf16(P[B_+6], P[B_+7]);                                             \
        auto r0 = __builtin_amdgcn_permlane32_swap(a0, b0, false, false); auto r1 = __builtin_amdgcn_permlane32_swap(a1, b1, false, false); \
        u32x4 w = {r0[0], r1[0], r0[1], r1[1]}; OUT = *reinterpret_cast<bf16x8*>(&w); } while (0)
    PK4(p0, 0, pa0); PK4(p0, 8, pa1); PK4(p1, 0, pa2); PK4(p1, 8, pa3);
#undef PK4
}
template <int KB>
__device__ __forceinline__ void qkt(f32x16& p0, f32x16& p1, const char* K_lds, int r32, int hi, const bf16x8* qr, bool act) {
    if (!act) { const float NEG = -__builtin_inff();
#pragma unroll
        for (int r = 0; r < 16; ++r) { p0[r] = NEG; p1[r] = NEG; } return; }
    p0 = f32x16{}; p1 = f32x16{};
#pragma unroll
    for (int d0 = 0; d0 < 4; ++d0) { const char* a = K_lds + KB * SHM_K + KSWZ(r32, (d0 * 16 + hi * 8) * 2);
        bf16x8 b0 = *reinterpret_cast<const bf16x8*>(a);
        bf16x8 b1 = *reinterpret_cast<const bf16x8*>(a + 32 * 128);
        p0 = __builtin_amdgcn_mfma_f32_32x32x16_bf16(b0, qr[d0], p0, 0, 0, 0);
        p1 = __builtin_amdgcn_mfma_f32_32x32x16_bf16(b1, qr[d0], p1, 0, 0, 0); }
}
template <int VB>
__device__ __forceinline__ void pv_tile(f32x16* o, int vb0, bf16x8 pa0, bf16x8 pa1, bf16x8 pa2, bf16x8 pa3, bool act) {
    if (!act) return;
#define TRRD(dst, off) asm volatile("ds_read_b64_tr_b16 %0, %1 offset:%2" : "=&v"(dst) : "v"(vb0), "i"(off) : "memory")
#define PV_D0(d0) do { s16x4 l0, l1, l2, l3, h0, h1, h2, h3; constexpr int b_ = VB * SHM_V + (d0) * 512; \
        TRRD(l0, b_); TRRD(h0, b_ + 1024); TRRD(l1, b_ + 2048); TRRD(h1, b_ + 3072); TRRD(l2, b_ + 4096); TRRD(h2, b_ + 5120); TRRD(l3, b_ + 6144); TRRD(h3, b_ + 7168); \
        asm volatile("s_waitcnt lgkmcnt(0)" ::: "memory"); SBAR();   \
        o[d0] = __builtin_amdgcn_mfma_f32_32x32x16_bf16(pa0, (bf16x8){l0[0], l0[1], l0[2], l0[3], h0[0], h0[1], h0[2], h0[3]}, o[d0], 0, 0, 0);   \
        o[d0] = __builtin_amdgcn_mfma_f32_32x32x16_bf16(pa1, (bf16x8){l1[0], l1[1], l1[2], l1[3], h1[0], h1[1], h1[2], h1[3]}, o[d0], 0, 0, 0);   \
        o[d0] = __builtin_amdgcn_mfma_f32_32x32x16_bf16(pa2, (bf16x8){l2[0], l2[1], l2[2], l2[3], h2[0], h2[1], h2[2], h2[3]}, o[d0], 0, 0, 0);   \
        o[d0] = __builtin_amdgcn_mfma_f32_32x32x16_bf16(pa3, (bf16x8){l3[0], l3[1], l3[2], l3[3], h3[0], h3[1], h3[2], h3[3]}, o[d0], 0, 0, 0); } while (0)
    PV_D0(0); PV_D0(1);
#undef PV_D0
#undef TRRD
}
struct BlockRef { const bf16_t* Q; const bf16_t* K; const bf16_t* V; bf16_t* O; const u64* MW; int P0; };
struct Seam { bf16x8 qr[4]; bf16x8 st_v0, st_k0; u64 mw; };
#define VMW() asm volatile("s_waitcnt vmcnt(0)" ::: "memory")
#define VMWN(n) asm volatile("s_waitcnt vmcnt(%0)" :: "i"(n) : "memory")
#define TIDL() int tid_l = tid; asm volatile("" : "+v"(tid_l)); const int sr = tid_l >> 3, sc = (tid_l & 7) * 8; (void)sr; (void)sc
#define SLOAD_H(Kp, Vp, k0) do { TIDL(); const unsigned vo_ = (unsigned)((k0 + sr) * 512 + sc) * 2u; \
        S.st_v0 = load8((const bf16_t*)((const char*)(Vp) + vo_)); S.st_k0 = load8((const bf16_t*)((const char*)(Kp) + vo_)); } while (0)
#define SWRITE_HK(bf) do { TIDL(); *(bf16x8*)(K_lds + (bf) * SHM_K + KSWZ(sr, sc * 2)) = S.st_k0; } while (0)
#define SWRITE_HV(bf) do { TIDL(); *(bf16x8*)(V_lds + (bf) * SHM_V + v_st(sr, sc)) = S.st_v0; } while (0)
#define SWRITE_H(bf) do { SWRITE_HV(bf); SWRITE_HK(bf); } while (0)
#define MWLOAD(ref, tile) ((ref).MW[(size_t)(tile) * SEQ + wid * QBLK + r32])
__device__ __forceinline__ void dsa_prime(const BlockRef& cur, char* lds, Seam& S, int tid) {
    const int wid = __builtin_amdgcn_readfirstlane(tid >> 6), lane = tid & 63, r32 = lane & 31, hi = lane >> 5;
    char* K_lds = lds + 2 * SHM_V;
#pragma unroll
    for (int d0 = 0; d0 < 4; ++d0) S.qr[d0] = load8(cur.Q + (size_t)(wid * QBLK + r32) * 512 + d0 * 16 + hi * 8);
    S.mw = MWLOAD(cur, 0);
    SLOAD_H(cur.K, cur.V, 0); VMW(); SWRITE_HK(0);
    __syncthreads();
}
__device__ __forceinline__ void dsa_block(const BlockRef& cur, const BlockRef& nxt, char* lds, Seam& S, int tid) {
    const int wid = __builtin_amdgcn_readfirstlane(tid >> 6), lane = tid & 63, r32 = lane & 31, hi = lane >> 5;
    const int NT = (cur.P0 + QB - 1) / KVBLK + 1;
    const int qlo = cur.P0 + wid * QBLK, qm = qlo + r32 - 4 * hi;
    char* V_lds = lds; char* K_lds = lds + 2 * SHM_V;
    float* wsl = (float*)(lds + 2 * SHM_V + 2 * SHM_K) + wid * 64; float* li_l = wsl, * al_l = wsl + 32;
    const float* tbl0 = (const float*)(lds + LDS_TB) + (TB_PAD - 63);
    float m_reg = -1e30f, l_reg = 0; f32x16 o[2] = {};
    const int vb0 = (int)(uintptr_t)V_lds + v_rd_base(lane);
    const bf16_t* Kh = cur.K; const bf16_t* Vh = cur.V;
#define RESC(a) do { if (__any((a) < 1.f)) { if (hi == 0) al_l[r32] = (a); asm volatile("s_waitcnt lgkmcnt(0)" ::: "memory");              \
                     _Pragma("unroll") for (int d_ = 0; d_ < 2; ++d_) _Pragma("unroll") for (int r = 0; r < 16; ++r) o[d_][r] *= al_l[crow(r, hi)]; } } while (0)
#define KBASE(t) ((t) * KVBLK)
#define ACT(t) (KBASE(t) <= qlo + QBLK - 1)
#define MASKT(P0_, P1_, t, MWX) do { const int kb_ = KBASE(t); if (ACT(t)) mask_bias_tile(P0_, P1_, tbl0 + (qm - kb_), (unsigned)(MWX) >> (4 * hi), (unsigned)((MWX) >> 32) >> (4 * hi)); } while (0)
    constexpr int NQL = 5;
#define SEAM_K0() do { VMWN(NQL); SWRITE_HK(0); SBAR(); } while (0)
    f32x16 pA0, pA1, pB0, pB1; float mnA, mnB, alA, alB; bf16x8 pa0, pa1, pa2, pa3;
    u64 mwA = S.mw, mwB = 0;
    SWRITE_HV(0); SBAR();
    if (NT > 1) { SLOAD_H(Kh, Vh, KBASE(1)); mwB = MWLOAD(cur, 1); }
    SBAR(); qkt<0>(pA0, pA1, K_lds, r32, hi, S.qr, ACT(0));
    MASKT(pA0, pA1, 0, mwA); partialSM(pA0, pA1, m_reg, mnA, alA);
    if (NT > 1) { VMW(); SWRITE_H(1); }
    __syncthreads();
#define HALF_STEP(PX0, PX1, mnX, alX, PY0, PY1, alY, t, KB, VB, SB, MWX, MWY) do {                                                      \
        SBAR(); qkt<KB>(PX0, PX1, K_lds, r32, hi, S.qr, ACT(t));                                             \
        finishSM(PY0, PY1, alY, l_reg, pa0, pa1, pa2, pa3); SBAR();                                                           \
        if ((t) + 1 < NT) { SLOAD_H(Kh, Vh, KBASE((t) + 1)); MWY = MWLOAD(cur, (t) + 1); SBAR(); }                                               \
        pv_tile<VB>(o, vb0, pa0, pa1, pa2, pa3, ACT((t) - 1)); MASKT(PX0, PX1, (t), MWX); partialSM(PX0, PX1, m_reg, mnX, alX);                                        \
        __syncthreads();                                                                                                      \
        if ((t) + 1 < NT) { VMW(); SWRITE_H(SB); }                                                                          \
        RESC(alX); __syncthreads(); } while (0)
    for (int t = 1; t + 1 < NT; t += 2) {
        HALF_STEP(pB0, pB1, mnB, alB, pA0, pA1, alA, t, 1, 0, 0, mwB, mwA);
        HALF_STEP(pA0, pA1, mnA, alA, pB0, pB1, alB, t + 1, 0, 1, 1, mwA, mwB);
    }
    const bool even = (NT & 1) == 0;
    if (even) { SBAR(); qkt<1>(pB0, pB1, K_lds, r32, hi, S.qr, ACT(NT - 1)); SBAR(); }
    SLOAD_H(nxt.K, nxt.V, 0); SBAR();
#pragma unroll
    for (int d0 = 0; d0 < 4; ++d0) S.qr[d0] = load8(nxt.Q + (size_t)(wid * QBLK + r32) * 512 + d0 * 16 + hi * 8);
    S.mw = MWLOAD(nxt, 0);
    SBAR();
    finishSM(pA0, pA1, alA, l_reg, pa0, pa1, pa2, pa3); SBAR();
    pv_tile<0>(o, vb0, pa0, pa1, pa2, pa3, ACT(even ? NT - 2 : NT - 1));
    if (even) { MASKT(pB0, pB1, NT - 1, mwB); partialSM(pB0, pB1, m_reg, mnB, alB); __syncthreads(); RESC(alB);
        finishSM(pB0, pB1, alB, l_reg, pa0, pa1, pa2, pa3); SBAR(); pv_tile<1>(o, vb0, pa0, pa1, pa2, pa3, ACT(NT - 1)); }
    SBAR(); SEAM_K0();
    if (hi == 0) li_l[r32] = l_reg; asm volatile("s_waitcnt lgkmcnt(0)" ::: "memory");
    int r32e = r32, hie = hi; asm volatile("" : "+v"(r32e), "+v"(hie));
    float rli[16];
#pragma unroll
    for (int r = 0; r < 16; ++r) rli[r] = __builtin_amdgcn_rcpf(li_l[crow(r, hie)]);
    bf16_t* Ow = cur.O + (size_t)(wid * QBLK) * DM;
#pragma unroll
    for (int r = 0; r < 16; ++r) { const unsigned oo = (unsigned)(crow(r, hie) * DM + r32e) * 2u;
#pragma unroll
        for (int d0 = 0; d0 < 2; ++d0) { const float v = o[d0][r] * rli[r];
            const float vn = swz_xor<1>(v);
            if ((r32e & 1) == 0) *(unsigned*)((char*)Ow + oo + d0 * 64) = cvt_pk_bf16(v, vn); } }
    __syncthreads();
#undef RESC
#undef KBASE
#undef ACT
#undef MASKT
#undef SEAM_K0
#undef HALF_STEP
}
#undef VMW
#undef VMWN
#undef TIDL
#undef SLOAD_H
#undef SWRITE_HK
#undef SWRITE_HV
#undef SWRITE_H
#undef MWLOAD
#undef KSWZ
#undef SBAR
}

__device__ __forceinline__ swa::BlockRef dil_ref(int u, const bf16_t* H1p, bf16_t* OPp, float* LSEp) {
    const int x = u & 15, rest = u >> 4, g = rest % 3, bh = rest / 3, h = bh & 7, bl = bh >> 3;
    const int dsh = 2 * g, dil = 1 << dsh, r = x >> (4 - dsh), blk = x & ((16 >> dsh) - 1), P0 = blk * 256;
    const size_t row0 = (size_t)bl * SEQ + r, rowq = row0 + (size_t)dil * P0;
    swa::BlockRef R;
    R.K = H1p + row0 * IN1_N + g * 3072 + 1024 + h * 128; R.Q = H1p + rowq * IN1_N + g * 3072 + h * 128;
    R.O = OPp + ((size_t)g * CHUNK_T + rowq) * DM + h * 128; R.LSE = LSEp + ((size_t)g * CHUNK_T + rowq) * 8 + h;
    R.P0 = P0; R.bh = h; R.dsh = dsh;
    return R;
}

struct Args {
    const float* in[25]; float* out; unsigned char* ws; int ph_lo, ph_hi;
};
enum { I_X = 0, I_RELB, I_EWIN, I_CONVW, I_CONVB, I_CLNG, I_CLNB, I_EWOUT, I_ELN1G, I_ELN1B, I_FWG, I_FWU, I_FWD, I_ELN2G, I_ELN2B,
       I_OWIN, I_OWOUT, I_OLN1G, I_OLN1B, I_ROUTER, I_MWG, I_MWU, I_MWD, I_OLN2G, I_OLN2B };

__device__ __forceinline__ void transpose_item(const float* W, int ldw, int src_c0, int nvalid, int k0, bf16_t* WT, int K, int dst_row0, LAS float* scr, int lane) {
#pragma unroll 8
    for (int i = 0; i < 32; ++i) { const int kk = 2 * i + (lane >> 5), j = lane & 31; scr[kk * 33 + j] = (j < nvalid) ? W[(size_t)(k0 + kk) * ldw + src_c0 + j] : 0.f; }
    WAVE_LDS_FENCE();
    const int c = lane & 7;
#pragma unroll
    for (int jj = 0; jj < 4; ++jj) { const int n = (lane >> 3) + 8 * jj; const LAS float* s = scr + (8 * c) * 33 + n;
        u32x4 o; o.x = cvt_pk_bf16(s[0 * 33], s[1 * 33]); o.y = cvt_pk_bf16(s[2 * 33], s[3 * 33]); o.z = cvt_pk_bf16(s[4 * 33], s[5 * 33]); o.w = cvt_pk_bf16(s[6 * 33], s[7 * 33]);
        *(u32x4*)(WT + (size_t)(dst_row0 + n) * K + k0 + 8 * c) = o; }
    WAVE_LDS_FENCE();
}
__device__ __forceinline__ void gu_item(const float* wg, const float* wu, int FF, int K, bf16_t* WT, int item, LAS float* scr, int lane) {
    const int nblk = 2 * FF / 32, kb = item / nblk, nb = item % nblk, tile = nb >> 3, sub = nb & 7;
    transpose_item(sub < 4 ? wg : wu, FF, tile * 128 + (sub & 3) * 32, 32, kb * 64, WT, K, nb * 32, scr, lane);
}
__device__ __forceinline__ void plain_item(const float* W, int K, int N, bf16_t* WT, int item, LAS float* scr, int lane) {
    const int nblk = N / 32, kb = item / nblk, nb = item % nblk;
    transpose_item(W, N, nb * 32, 32, kb * 64, WT, K, nb * 32, scr, lane);
}
__device__ __forceinline__ void in0_item(const float* W, bf16_t* WT, int item, LAS float* scr, int lane) {
    const int nblk = IN0_N / 32, kb = item / nblk, nb = item % nblk, tile = nb >> 3, sub = nb & 7;
    int src_c0, nvalid = 32;
    if (tile < 4) src_c0 = (sub < 4) ? tile * 128 + sub * 32 : 512 + tile * 128 + (sub - 4) * 32;
    else { src_c0 = nb * 32; nvalid = IN0_SRC - src_c0; nvalid = nvalid < 0 ? 0 : (nvalid > 32 ? 32 : nvalid); if (nvalid == 0) src_c0 = 0; }
    transpose_item(W, IN0_SRC, src_c0, nvalid, kb * 64, WT, DM, nb * 32, scr, lane);
}
__device__ __forceinline__ int rel_bucket(int n) {
    if (n < 16) return n;
    const float nf = (float)n;
    int large = 16 + (int)(logf(nf / 16.0f) / logf(128.0f) * 16.0f);
    return large < 31 ? large : 31;
}

__device__ __forceinline__ void ln_core(f32x4 (&v)[4], const float* g, const float* b, int lane) {
    float s = 0.f;
#pragma unroll
    for (int j = 0; j < 4; ++j) s += (v[j][0] + v[j][1]) + (v[j][2] + v[j][3]);
    const float mean = wave_sum(s) * (1.f / DM); float s2 = 0.f;
#pragma unroll
    for (int j = 0; j < 4; ++j) { v[j] = v[j] - mean; s2 += (v[j][0] * v[j][0] + v[j][1] * v[j][1]) + (v[j][2] * v[j][2] + v[j][3] * v[j][3]); }
    const float rstd = 1.f / sqrtf(wave_sum(s2) * (1.f / DM) + LN_EPS);
#pragma unroll
    for (int j = 0; j < 4; ++j) { const f32x4 gg = *(const f32x4*)(g + 4 * lane + 256 * j), bb = *(const f32x4*)(b + 4 * lane + 256 * j); v[j] = v[j] * rstd * gg + bb; }
}
__device__ __forceinline__ void store_row_bf16(bf16_t* orow, const f32x4 (&v)[4], int lane) {
#pragma unroll
    for (int j = 0; j < 4; ++j) { u32x2 w; w.x = cvt_pk_bf16(v[j][0], v[j][1]); w.y = cvt_pk_bf16(v[j][2], v[j][3]); *(u32x2*)(orow + 4 * lane + 256 * j) = w; }
}
__device__ __forceinline__ f32x4 ld_bf4(const bf16_t* p) { const u32x2 w = *(const u32x2*)p; return (f32x4){bf_lo(w.x), bf_hi(w.x), bf_lo(w.y), bf_hi(w.y)}; }

__device__ __forceinline__ int my_lane_asm() { int l; asm volatile("v_mbcnt_lo_u32_b32 %0, -1, 0\n\tv_mbcnt_hi_u32_b32 %0, -1, %0" : "=v"(l)); return l; }
__global__ void __launch_bounds__(NTHR, 2) fwd_kernel(Args args) {
    extern __shared__ __attribute__((aligned(16))) unsigned char lds_raw[];
    LAS unsigned char* lds = (LAS unsigned char*)lds_raw;
    const int G = gridDim.x, bid = blockIdx.x;
    const int NGW = G * NWAVES;
    volatile LAS unsigned* MISC = (volatile LAS unsigned*)(lds + LDS_MISC);
    int wave_id;
    {
        const int l0 = my_lane_asm();
        if (l0 < 16) MISC[l0] = 0u;
        __syncthreads();
        unsigned id = 0u; if (l0 == 0) id = atomicAdd((unsigned*)(MISC + 2), 1u);
        wave_id = __builtin_amdgcn_readfirstlane((int)id);
        __syncthreads();
    }
#define MY_LANE() my_lane_asm()
#if ONE_LAUNCH
    (void)xcd_barrier_post((unsigned*)(args.ws + WS_CTL) + CW_BAR, MISC, wave_id == 0 && MY_LANE() == 0);
#define GRID_BAR() do { XcdBarrier _b; _b.bar = (unsigned*)(ws + WS_CTL) + CW_BAR; _b.x = xb_xcc_id(); _b.st = (volatile LAS unsigned*)(lds + LDS_MISC); xcd_barrier(_b, tid == 0); } while (0)
#else
#define GRID_BAR() do { } while (0)
#endif
    const int lo = args.ph_lo, hi = args.ph_hi;
#ifndef PH_MASK
#define PH_MASK 0xFFFFFFu
#endif
#define IN(k) ((((PH_MASK) >> (k)) & 1u) && lo <= (k) && (k) < hi)
#define BOTH(k) (IN(k) && IN((k) + 1))
#define PHASE_BEGIN int lane = MY_LANE(); asm volatile("" : "+v"(lane)); const int wave = wave_id; const int tid = wave * 64 + lane; const int gw = bid * NWAVES + wave; \
    size_t zoff_ = 0; asm volatile("" : "+s"(zoff_)); unsigned char* ws = args.ws + zoff_; float* outp = (float*)((unsigned char*)args.out + zoff_); unsigned* ctl = (unsigned*)(ws + WS_CTL); (void)lane; (void)wave; (void)gw; (void)ctl; (void)outp;
#define x_in (args.in[I_X])
#define WIN0 ((bf16_t*)(ws + WS_WIN0))
#define WOUT0 ((bf16_t*)(ws + WS_WOUT0))
#define WGU0 ((bf16_t*)(ws + WS_WGU0))
#define WD0 ((bf16_t*)(ws + WS_WD0))
#define WIN1 ((bf16_t*)(ws + WS_WIN1))
#define WOUT1 ((bf16_t*)(ws + WS_WOUT1))
#define MWGU ((bf16_t*)(ws + WS_MWGU))
#define MWD ((bf16_t*)(ws + WS_MWD))
#define BIAST ((float*)(ws + WS_BIAST))
#define XB ((bf16_t*)(ws + WS_XB))
#define Ub ((bf16_t*)(ws + WS_U))
#define Q0 ((bf16_t*)(ws + WS_Q0))
#define K0 ((bf16_t*)(ws + WS_Q0 + SEG0))
#define V0 ((bf16_t*)(ws + WS_Q0 + 2 * SEG0))
#define QI ((bf16_t*)(ws + WS_Q0 + 3 * SEG0))
#define KI ((bf16_t*)(ws + WS_KI))
#define WI ((float*)(ws + WS_WI))
#define MASK ((u64*)(ws + WS_MASK))
#define MIXIN ((bf16_t*)(ws + WS_MIXIN))
#define X1B ((bf16_t*)(ws + WS_X1B))
#define H0 ((bf16_t*)(ws + WS_H0))
#define X2B ((bf16_t*)(ws + WS_X2B))
#define H1 ((bf16_t*)(ws + WS_H1))
#define O1 ((bf16_t*)outp)
#define Y3 ((float*)(ws + WS_Y3))
#define X3B ((bf16_t*)(ws + WS_X3B))
#define YB ((bf16_t*)(ws + WS_YB))
#define MTOK ((int*)(ws + WS_MOE_TOK))
#define MGATE ((float*)(ws + WS_MOE_GATE))
#define GTAB ((const LAS int*)(lds + LDS_GTAB))

    if (IN(0)) { asm volatile("; PHASE_MARK 0"); PHASE_BEGIN
        LAS float* scr = (LAS float*)(lds + wave * 16384);
        constexpr int I_IN0 = 16 * (IN0_N / 32), I_OUT = 16 * 32, I_GU0 = 16 * (2 * FF0 / 32), I_D0 = (FF0 / 64) * 32, I_IN1 = 16 * (IN1_N / 32);
        constexpr int NIT = I_IN0 + I_OUT + I_GU0 + I_D0 + I_IN1 + I_OUT;
        for (int it = gw; it < NIT; it += NGW) {
            int r = it;
            if (r < I_IN0) { in0_item(args.in[I_EWIN], WIN0, r, scr, lane); continue; } r -= I_IN0;
            if (r < I_OUT) { plain_item(args.in[I_EWOUT], DM, DM, WOUT0, r, scr, lane); continue; } r -= I_OUT;
            if (r < I_GU0) { gu_item(args.in[I_FWG], args.in[I_FWU], FF0, DM, WGU0, r, scr, lane); continue; } r -= I_GU0;
            if (r < I_D0) { plain_item(args.in[I_FWD], FF0, DM, WD0, r, scr, lane); continue; } r -= I_D0;
            if (r < I_IN1) { plain_item(args.in[I_OWIN], DM, IN1_N, WIN1, r, scr, lane); continue; } r -= I_IN1;
            plain_item(args.in[I_OWOUT], DM, DM, WOUT1, r, scr, lane);
        }
        for (size_t i = (size_t)bid * NTHR + tid; i < (size_t)NTOK * DM / 8; i += (size_t)G * NTHR) {
            const f32x4 a = *(const f32x4*)(x_in + i * 8), b = *(const f32x4*)(x_in + i * 8 + 4);
            *(u32x4*)(XB + i * 8) = pg8::pack8(a, b);
        }
        for (int i = bid * NTHR + tid; i < 8 * 4096; i += G * NTHR) { const int h = i >> 12, d = i & 4095; BIAST[i] = args.in[I_RELB][rel_bucket(d) * 8 + h]; }
        if (BOTH(0)) GRID_BAR();
    }

    if (IN(1)) { asm volatile("; PHASE_MARK 1"); PHASE_BEGIN
        pg8::StaticOrder S; S.init(XB, NTOK, IN0_N, DM, G, bid);
        pg8::EpiIn0 E{Ub, Q0, KI, WI};
        pg8::gemm_phase<pg8::EpiIn0, pg8::StaticOrder, true, false>(tid, lds, WIN0, DM, S, E, GTAB);
        if (BOTH(1)) GRID_BAR();
    }

    if (IN(2)) { asm volatile("; PHASE_MARK 2"); PHASE_BEGIN
        {
            LAS bf16_t* ut = (LAS bf16_t*)lds;
            LAS float* yt = (LAS float*)(lds + 65536);
            const float* cw = args.in[I_CONVW]; const int c = tid;
            float w[31];
#pragma unroll
            for (int j = 0; j < 31; ++j) w[j] = cw[j * 512 + c];
            const float cb = args.in[I_CONVB][c];
            for (int tile = bid; tile < NTOK / 32; tile += G) {
                const int t0 = tile * 32, s0 = t0 & (SEQ - 1);
                for (int i = tid; i < 62 * 64; i += NTHR) { const int r = i >> 6, c8 = i & 63; const int sr = s0 - 30 + r;
                    u32x4 v = (u32x4){0u, 0u, 0u, 0u}; if (sr >= 0) v = *(const u32x4*)(Ub + (size_t)(t0 - 30 + r) * 512 + c8 * 8);
                    *(LAS u32x4*)(ut + r * 512 + c8 * 8) = v; }
                __syncthreads();
                for (int t = 0; t < 32; ++t) { float a = cb;
#pragma unroll
                    for (int j = 0; j < 31; ++j) a += w[j] * bf2f(ut[(t + j) * 512 + c]);
                    yt[t * 512 + c] = a; }
                __syncthreads();
                const float* lg = args.in[I_CLNG]; const float* lb = args.in[I_CLNB];
#pragma unroll
                for (int tt = 0; tt < 4; ++tt) { const int t = wave * 4 + tt;
                    f32x4 a = *(LAS f32x4*)(yt + t * 512 + lane * 8), b = *(LAS f32x4*)(yt + t * 512 + lane * 8 + 4);
                    float s = (a[0] + a[1]) + (a[2] + a[3]) + (b[0] + b[1]) + (b[2] + b[3]); const float mean = wave_sum(s) * (1.f / 512.f);
                    a = a - mean; b = b - mean; float s2 = a[0] * a[0] + a[1] * a[1] + a[2] * a[2] + a[3] * a[3] + b[0] * b[0] + b[1] * b[1] + b[2] * b[2] + b[3] * b[3];
                    const float rstd = 1.f / sqrtf(wave_sum(s2) * (1.f / 512.f) + LN_EPS);
                    const f32x4 g0 = *(const f32x4*)(lg + lane * 8), g1 = *(const f32x4*)(lg + lane * 8 + 4), b0 = *(const f32x4*)(lb + lane * 8), b1 = *(const f32x4*)(lb + lane * 8 + 4);
                    a = a * rstd * g0 + b0; b = b * rstd * g1 + b1;
#pragma unroll
                    for (int j = 0; j < 4; ++j) { a[j] = a[j] * sigmoidf_(a[j]); b[j] = b[j] * sigmoidf_(b[j]); }
                    *(u32x4*)(MIXIN + (size_t)(t0 + t) * DM + lane * 8) = pg8::pack8(a, b); }
                __syncthreads();
            }
        }
        {
            LAS float* sc = (LAS float*)lds;
            LAS float* qf = (LAS float*)(lds + 131072);
            LAS unsigned* hist = (LAS unsigned*)(lds + 147456);
            LAS float* wq = (LAS float*)(lds + 155648);
            for (int item = bid; item < NTOK / 8; item += G) {
                const int tok0 = item * 8, b0 = tok0 & ~(SEQ - 1), q0 = tok0 & (SEQ - 1);
                for (int i = tid; i < 8 * 512; i += NTHR) qf[i] = bf2f(QI[(size_t)tok0 * 512 + i]);
                if (tid < 64) wq[tid] = WI[(size_t)tok0 * 8 + tid];
                __syncthreads();
                const int nk = q0 + 8;
                for (int kc = 0; kc * 512 < nk; ++kc) {
                    const int k = kc * 512 + tid;
                    if (k < nk) {
                        float kf[64];
#pragma unroll
                        for (int d8 = 0; d8 < 8; ++d8) { const u32x4 v = *(const u32x4*)(KI + (size_t)(b0 + k) * 64 + d8 * 8);
                            kf[d8 * 8 + 0] = bf_lo(v.x); kf[d8 * 8 + 1] = bf_hi(v.x); kf[d8 * 8 + 2] = bf_lo(v.y); kf[d8 * 8 + 3] = bf_hi(v.y);
                            kf[d8 * 8 + 4] = bf_lo(v.z); kf[d8 * 8 + 5] = bf_hi(v.z); kf[d8 * 8 + 6] = bf_lo(v.w); kf[d8 * 8 + 7] = bf_hi(v.w); }
                        for (int qq = 0; qq < 8; ++qq) { float s = 0.f;
                            for (int h = 0; h < 8; ++h) { float dot = 0.f;
#pragma unroll
                                for (int d4 = 0; d4 < 16; ++d4) { const f32x4 q4 = *(LAS f32x4*)(qf + qq * 512 + h * 64 + d4 * 4);
                                    dot += q4[0] * kf[d4 * 4] + q4[1] * kf[d4 * 4 + 1] + q4[2] * kf[d4 * 4 + 2] + q4[3] * kf[d4 * 4 + 3]; }
                                s += wq[qq * 8 + h] * fmaxf(dot, 0.f); }
                            sc[qq * 4096 + k] = s; }
                    }
                }
                __syncthreads();
                {
                    const int q = q0 + wave, n = q + 1; LAS float* row = sc + wave * 4096; LAS unsigned* hh = hist + wave * 256;
                    u64* mrow = MASK + (size_t)(b0 >> 12) * 64 * SEQ + (q0 + wave);
                    unsigned thr = 0u; int need = 0;
                    if (n > 256) {
                        unsigned prefix = 0u; int kk = 256;
                        for (int pass = 0; pass < 4; ++pass) {
                            const int shift = 24 - 8 * pass;
#pragma unroll
                            for (int j = 0; j < 4; ++j) hh[lane * 4 + j] = 0u;
                            WAVE_LDS_FENCE();
                            for (int i = lane; i < n; i += 64) { const unsigned u = __float_as_uint(row[i] + 0.0f); const unsigned key = (u & 0x80000000u) ? ~u : (u | 0x80000000u);
                                const bool match = (pass == 0) || ((key >> (shift + 8)) == (prefix >> (shift + 8)));
                                if (match) atomicAdd((unsigned*)(hh + ((key >> shift) & 255u)), 1u); }
                            WAVE_LDS_FENCE();
                            unsigned c0 = hh[lane * 4 + 0], c1 = hh[lane * 4 + 1], c2 = hh[lane * 4 + 2], c3 = hh[lane * 4 + 3];
                            const unsigned sl = c0 + c1 + c2 + c3; unsigned inc = sl;
#pragma unroll
                            for (int o = 1; o < 64; o <<= 1) { const unsigned t = lane_get(inc, (lane + o) & 63); if (lane + o < 64) inc += t; }
                            const unsigned exc = inc - sl;
                            const bool found = (exc < (unsigned)kk) && (inc >= (unsigned)kk);
                            int bin = 0, kn = 0;
                            { unsigned cum = exc;
                              if (cum + c3 >= (unsigned)kk) { bin = 3; kn = kk - (int)cum; } else { cum += c3;
                              if (cum + c2 >= (unsigned)kk) { bin = 2; kn = kk - (int)cum; } else { cum += c2;
                              if (cum + c1 >= (unsigned)kk) { bin = 1; kn = kk - (int)cum; } else { cum += c1; bin = 0; kn = kk - (int)cum; } } } }
                            const u64 fm = __ballot(found); const int src = fm ? (__ffsll((long long)fm) - 1) : 0;
                            bin = (int)lane_get((unsigned)(lane * 4 + bin), src); kk = (int)lane_get((unsigned)kn, src);
                            prefix |= ((unsigned)bin) << shift;
                            WAVE_LDS_FENCE();
                        }
                        thr = prefix; need = kk;
                    }
                    int tie_run = 0;
                    for (int j = 0; j < 64; ++j) { const int i = j * 64 + lane; u64 word;
                        if (n <= 256) word = __ballot(i < n);
                        else { bool gt = false, eq = false;
                            if (i < n) { const unsigned u = __float_as_uint(row[i] + 0.0f); const unsigned key = (u & 0x80000000u) ? ~u : (u | 0x80000000u); gt = key > thr; eq = key == thr; }
                            const u64 eqm = __ballot(eq); const int rank = tie_run + __popcll(eqm & ((1ull << lane) - 1ull));
                            word = __ballot(gt || (eq && rank < need)); tie_run += __popcll(eqm); }
                        if (lane == 0) mrow[(size_t)j * SEQ] = word; }
                }
                __syncthreads();
            }
        }
        if (BOTH(2)) GRID_BAR();
    }

    if (IN(3)) { asm volatile("; PHASE_MARK 3"); PHASE_BEGIN
        const int vcu = (G % 8 == 0) ? (bid % 8) * (G / 8) + bid / 8 : bid;
        if (vcu < 256) {
            const int pp = vcu & 3, h = (vcu >> 2) & 7, b = vcu >> 5;
            { float* tb = (float*)(lds_raw + dsa::LDS_TB);
              for (int i = tid; i < dsa::TB_PAD + 4096; i += NTHR) tb[i] = (i >= dsa::TB_PAD) ? BIAST[h * 4096 + (i - dsa::TB_PAD)] * 8.0f : 0.f; }
            const bf16_t* Kp = K0 + (size_t)b * SEQ * 512 + h * 64; const bf16_t* Vp = V0 + (size_t)b * SEQ * 512 + h * 64;
#define DSA_REF(R, i_) do { const int qb_ = ((i_) == 0) ? pp : ((i_) == 1) ? 15 - pp : ((i_) == 2) ? pp + 4 : 11 - pp; const int P0_ = qb_ * 256; \
            R.Q = Q0 + ((size_t)b * SEQ + P0_) * 512 + h * 64; R.K = Kp; R.V = Vp; R.O = MIXIN + ((size_t)b * SEQ + P0_) * DM + 512 + h * 64; \
            R.MW = MASK + (size_t)b * 64 * SEQ + P0_; R.P0 = P0_; } while (0)
            dsa::Seam SS; dsa::BlockRef cur, nxt; DSA_REF(cur, 0);
            dsa::dsa_prime(cur, (char*)lds_raw, SS, tid);
            for (int i = 0; i < 4; ++i) {
                if (i < 3) { DSA_REF(nxt, i + 1); } else nxt = cur;
                dsa::dsa_block(cur, nxt, (char*)lds_raw, SS, tid);
                cur = nxt;
            }
#undef DSA_REF
        }
        if (BOTH(3)) GRID_BAR();
    }
    if (IN(4)) { asm volatile("; PHASE_MARK 4"); PHASE_BEGIN
        pg8::StaticOrder S; S.init(MIXIN, NTOK, DM, DM, G, bid);
        pg8::EpiRes<false> E{outp, x_in};
        pg8::gemm_phase<pg8::EpiRes<false>, pg8::StaticOrder, true, false>(tid, lds, WOUT0, DM, S, E, GTAB);
        if (BOTH(4)) GRID_BAR();
    }
    if (IN(5)) { asm volatile("; PHASE_MARK 5"); PHASE_BEGIN
        for (int m = gw; m < NTOK; m += NGW) { f32x4 v[4];
#pragma unroll
            for (int j = 0; j < 4; ++j) v[j] = *(const f32x4*)(outp + (size_t)m * DM + 4 * lane + 256 * j);
            ln_core(v, args.in[I_ELN1G], args.in[I_ELN1B], lane); store_row_bf16(X1B + (size_t)m * DM, v, lane); }
        if (BOTH(5)) GRID_BAR();
    }
    if (IN(6)) { asm volatile("; PHASE_MARK 6"); PHASE_BEGIN
        pg8::StaticOrder S; S.init(X1B, NTOK, 2 * FF0, DM, G, bid);
        pg8::EpiSwiglu<false> E{H0, FF0, (char*)outp, (char*)ws};
        pg8::gemm_phase<pg8::EpiSwiglu<false>, pg8::StaticOrder, true, false>(tid, lds, WGU0, DM, S, E, GTAB);
        if (BOTH(6)) GRID_BAR();
    }
    if (IN(7)) { asm volatile("; PHASE_MARK 7"); PHASE_BEGIN
        pg8::StaticOrder S; S.init(H0, NTOK, DM, FF0, G, bid);
        pg8::EpiRes<true> E{outp, X1B};
        pg8::gemm_phase<pg8::EpiRes<true>, pg8::StaticOrder, true, false>(tid, lds, WD0, FF0, S, E, GTAB);
        if (BOTH(7)) GRID_BAR();
    }
    if (IN(8)) { asm volatile("; PHASE_MARK 8"); PHASE_BEGIN
        for (int m = gw; m < NTOK; m += NGW) { f32x4 v[4];
#pragma unroll
            for (int j = 0; j < 4; ++j) v[j] = *(const f32x4*)(outp + (size_t)m * DM + 4 * lane + 256 * j);
            ln_core(v, args.in[I_ELN2G], args.in[I_ELN2B], lane); store_row_bf16(X2B + (size_t)m * DM, v, lane); }
        if (BOTH(8)) GRID_BAR();
    }
#define MERGE_CHUNK(chm) do { \
        const bf16_t* OPp = (const bf16_t*)(ws + WS_OP); const float* LSEp = (const float*)(ws + WS_LSE); \
        for (int tl = gw; tl < CHUNK_T; tl += NGW) { const int hh = lane >> 3; \
            const float l0 = LSEp[(size_t)tl * 8 + hh], l1 = LSEp[((size_t)CHUNK_T + tl) * 8 + hh], l2 = LSEp[((size_t)2 * CHUNK_T + tl) * 8 + hh]; \
            const float mm = fmaxf(l0, fmaxf(l1, l2)); float w0 = __expf(l0 - mm), w1 = __expf(l1 - mm), w2 = __expf(l2 - mm); const float inv = 1.f / (w0 + w1 + w2); w0 *= inv; w1 *= inv; w2 *= inv; \
            const bf16_t* p0 = OPp + (size_t)tl * DM + lane * 16; const bf16_t* p1 = p0 + (size_t)CHUNK_T * DM; const bf16_t* p2 = p1 + (size_t)CHUNK_T * DM; \
            _Pragma("unroll") for (int q = 0; q < 2; ++q) { const u32x4 a = *(const u32x4*)(p0 + q * 8), b = *(const u32x4*)(p1 + q * 8), c = *(const u32x4*)(p2 + q * 8); u32x4 o; \
                o.x = cvt_pk_bf16(w0 * bf_lo(a.x) + w1 * bf_lo(b.x) + w2 * bf_lo(c.x), w0 * bf_hi(a.x) + w1 * bf_hi(b.x) + w2 * bf_hi(c.x)); \
                o.y = cvt_pk_bf16(w0 * bf_lo(a.y) + w1 * bf_lo(b.y) + w2 * bf_lo(c.y), w0 * bf_hi(a.y) + w1 * bf_hi(b.y) + w2 * bf_hi(c.y)); \
                o.z = cvt_pk_bf16(w0 * bf_lo(a.z) + w1 * bf_lo(b.z) + w2 * bf_lo(c.z), w0 * bf_hi(a.z) + w1 * bf_hi(b.z) + w2 * bf_hi(c.z)); \
                o.w = cvt_pk_bf16(w0 * bf_lo(a.w) + w1 * bf_lo(b.w) + w2 * bf_lo(c.w), w0 * bf_hi(a.w) + w1 * bf_hi(b.w) + w2 * bf_hi(c.w)); \
                *(u32x4*)(O1 + ((size_t)(chm) * CHUNK_T + tl) * DM + lane * 16 + q * 8) = o; } } } while (0)
#pragma unroll
    for (int ch = 0; ch < 2; ++ch) {
        if (IN(9 + 2 * ch)) { asm volatile("; PHASE_MARK 9"); PHASE_BEGIN
            if (ch == 1) { MERGE_CHUNK(0); }
            pg8::StaticOrder S; S.init(X2B + (size_t)ch * CHUNK_T * DM, CHUNK_T, IN1_N, DM, G, bid);
            pg8::EpiQkv1 E{H1, IN1_N, 1.0f};
            pg8::gemm_phase<pg8::EpiQkv1, pg8::StaticOrder, true, false>(tid, lds, WIN1, DM, S, E, GTAB);
            if (BOTH(9 + 2 * ch)) GRID_BAR();
        }
        if (IN(10 + 2 * ch)) { asm volatile("; PHASE_MARK 10"); PHASE_BEGIN
            constexpr int NU = CHUNK_B * 8 * 3 * 16;
            const int vcu = (G % 8 == 0) ? (bid % 8) * (G / 8) + bid / 8 : bid;
            bf16_t* OPp = (bf16_t*)(ws + WS_OP); float* LSEp = (float*)(ws + WS_LSE);
            int L0 = vcu;
            if (L0 < NU) {
                swa::Seam SS; swa::BlockRef cur = dil_ref(L0, H1, OPp, LSEp);
                swa::swa_prime(cur, BIAST, (char*)lds_raw, SS, tid);
                int slot = 0;
                for (;;) {
                    const int Ln = L0 + G; const bool last = Ln >= NU;
                    const swa::BlockRef nxt = last ? cur : dil_ref(Ln, H1, OPp, LSEp);
                    swa::swa_block(cur, nxt, BIAST, slot, (char*)lds_raw, SS, tid);
                    if (last) break;
                    cur = nxt; L0 = Ln; slot ^= 1;
                }
            }
            if (BOTH(10 + 2 * ch)) GRID_BAR();
        }
    }
    if (IN(13)) { asm volatile("; PHASE_MARK 13"); PHASE_BEGIN
        MERGE_CHUNK(1);
        if (BOTH(13)) GRID_BAR();
    }
    if (IN(14)) { asm volatile("; PHASE_MARK 14"); PHASE_BEGIN
        pg8::StaticOrder S; S.init(O1, NTOK, DM, DM, G, bid);
        pg8::EpiRes<true> E{Y3, X2B};
        pg8::gemm_phase<pg8::EpiRes<true>, pg8::StaticOrder, true, false>(tid, lds, WOUT1, DM, S, E, GTAB);
        if (BOTH(14)) GRID_BAR();
    }
    if (IN(15)) { asm volatile("; PHASE_MARK 15"); PHASE_BEGIN
        const float* rt = args.in[I_ROUTER];
        for (int m = gw; m < NTOK; m += NGW) { f32x4 v[4];
#pragma unroll
            for (int j = 0; j < 4; ++j) v[j] = *(const f32x4*)(Y3 + (size_t)m * DM + 4 * lane + 256 * j);
            ln_core(v, args.in[I_OLN1G], args.in[I_OLN1B], lane); store_row_bf16(X3B + (size_t)m * DM, v, lane);
            float lgt[8];
#pragma unroll
            for (int e = 0; e < 8; ++e) lgt[e] = 0.f;
#pragma unroll
            for (int j = 0; j < 4; ++j)
#pragma unroll
                for (int i = 0; i < 4; ++i) { const float* rr = rt + (size_t)(4 * lane + 256 * j + i) * 8; const f32x4 r0 = *(const f32x4*)rr, r1 = *(const f32x4*)(rr + 4); const float xv = v[j][i];
                    lgt[0] += xv * r0[0]; lgt[1] += xv * r0[1]; lgt[2] += xv * r0[2]; lgt[3] += xv * r0[3]; lgt[4] += xv * r1[0]; lgt[5] += xv * r1[1]; lgt[6] += xv * r1[2]; lgt[7] += xv * r1[3]; }
#pragma unroll
            for (int e = 0; e < 8; ++e) lgt[e] = wave_sum(lgt[e]);
            int e1 = 0; float v1 = lgt[0];
#pragma unroll
            for (int e = 1; e < 8; ++e) if (lgt[e] > v1) { v1 = lgt[e]; e1 = e; }
            int e2 = -1; float v2 = -INFINITY;
#pragma unroll
            for (int e = 0; e < 8; ++e) if (e != e1 && lgt[e] > v2) { v2 = lgt[e]; e2 = e; }
            const float g2 = 1.f / (1.f + __expf(v1 - v2)), g1 = 1.f - g2;
            if (lane == 0) {
                const unsigned p1 = atomicAdd(ctl + CW_MOECNT + e1, 1u), p2 = atomicAdd(ctl + CW_MOECNT + e2, 1u);
                if (p1 < (unsigned)NTOK) { MTOK[e1 * NTOK + p1] = m * 2; MGATE[e1 * NTOK + p1] = g1; }
                if (p2 < (unsigned)NTOK) { MTOK[e2 * NTOK + p2] = m * 2 + 1; MGATE[e2 * NTOK + p2] = g2; }
            }
        }
        __syncthreads();
        {
            LAS float* scr = (LAS float*)(lds + wave * 16384);
            constexpr int I_GU = 16 * (2 * FFE / 32), I_D = (FFE / 64) * 32;
            for (int it = gw; it < NEXP * (I_GU + I_D); it += NGW) {
                const int e = it / (I_GU + I_D), r = it % (I_GU + I_D);
                if (r < I_GU) gu_item(args.in[I_MWG] + (size_t)e * DM * FFE, args.in[I_MWU] + (size_t)e * DM * FFE, FFE, DM, MWGU + (size_t)e * 2 * FFE * DM, r, scr, lane);
                else plain_item(args.in[I_MWD] + (size_t)e * FFE * DM, FFE, DM, MWD + (size_t)e * DM * FFE, r - I_GU, scr, lane);
            }
        }
        if (BOTH(15)) GRID_BAR();
    }
#pragma unroll
    for (int ch = 0; ch < 2; ++ch) {
        if (IN(16 + 2 * ch) || IN(17 + 2 * ch)) {
            LAS int* rt = (LAS int*)(lds + LDS_RT);
            int nM;
            { PHASE_BEGIN int ts[9]; int cn[8]; ts[0] = 0;
#pragma unroll
              for (int e = 0; e < 8; ++e) { int ce = __builtin_amdgcn_readfirstlane((int)ctl[CW_MOECNT + e]); ce = ce > NTOK ? NTOK : ce; cn[e] = ce; ts[e + 1] = ts[e] + (ce + 255) / 256; }
              const int t0 = ch * MOE_CH_TILES; int t1 = t0 + MOE_CH_TILES; if (t1 > ts[8]) t1 = ts[8]; nM = __builtin_amdgcn_readfirstlane(t1 > t0 ? t1 - t0 : 0);
              if (tid < nM) { const int g = t0 + tid; int e = 0;
#pragma unroll
                  for (int k = 1; k < 8; ++k) e += (g >= ts[k]) ? 1 : 0;
                  int ce = cn[0], tse = ts[0];
#pragma unroll
                  for (int k = 1; k < 8; ++k) { ce = (e == k) ? cn[k] : ce; tse = (e == k) ? ts[k] : tse; }
                  const int j = g - tse; int nv = ce - j * 256; nv = nv > 256 ? 256 : nv;
                  rt[tid * 4 + 0] = e; rt[tid * 4 + 1] = e * NTOK + j * 256; rt[tid * 4 + 2] = nv; rt[tid * 4 + 3] = 0; } }
            __syncthreads();
            if (IN(16 + 2 * ch)) { asm volatile("; PHASE_MARK 16"); PHASE_BEGIN
                pg8::MoeOrder S{G, bid, nM, 2 * FFE / 256, rt, (const char*)X3B, (char*)outp, (char*)ws, true};
                LAS int* gtab = (LAS int*)(lds + LDS_GTAB);
                { pg8::Unit u; for (int i = 0; i < 16 && S.next(i, u); ++i) { if (tid < 256) { const int lb = rt[u.pm * 4 + 1], nv = rt[u.pm * 4 + 2]; const int r = tid < nv ? tid : 0; gtab[i * 256 + tid] = MTOK[lb + r] >> 1; } } }
                __syncthreads();
                pg8::EpiSwiglu<true> E{H0, FFE, (char*)outp, (char*)ws};
                pg8::gemm_phase<pg8::EpiSwiglu<true>, pg8::MoeOrder, true, true>(tid, lds, MWGU, DM, S, E, gtab);
                if (BOTH(16 + 2 * ch)) GRID_BAR();
            }
            if (IN(17 + 2 * ch)) { asm volatile("; PHASE_MARK 17"); PHASE_BEGIN
                pg8::MoeOrder S{G, bid, nM, DM / 256, rt, (const char*)X3B, (char*)outp, (char*)ws, false};
                pg8::EpiMoeDown E{YB, MTOK, MGATE, rt};
                pg8::gemm_phase<pg8::EpiMoeDown, pg8::MoeOrder, true, false>(tid, lds, MWD, FFE, S, E, GTAB);
                if (BOTH(17 + 2 * ch)) GRID_BAR();
            }
        }
    }
    if (IN(20)) { asm volatile("; PHASE_MARK 20"); PHASE_BEGIN
        for (int m = gw; m < NTOK; m += NGW) { f32x4 v[4];
#pragma unroll
            for (int j = 0; j < 4; ++j) { const size_t o = (size_t)m * DM + 4 * lane + 256 * j; v[j] = ld_bf4(X3B + o) * ALPHA + ld_bf4(YB + o) + ld_bf4(YB + (size_t)NTOK * DM + o); }
            ln_core(v, args.in[I_OLN2G], args.in[I_OLN2B], lane);
#pragma unroll
            for (int j = 0; j < 4; ++j) *(f32x4*)(outp + (size_t)m * DM + 4 * lane + 256 * j) = v[j]; }
    }
#undef IN
#undef BOTH
}

constexpr int NPHASES = 21;
extern "C" void kernel_launch(void* const* d_in, const int* in_sizes, int n_in, void* d_out, int out_size, void* d_ws, size_t ws_size, hipStream_t stream) {
    static int grid = 0;
    if (grid == 0) {
        if (n_in != 25 || out_size != NTOK * DM || ws_size < WS_END) { fprintf(stderr, "kernel_launch: unexpected shapes (n_in %d out %d ws %zu)\n", n_in, out_size, ws_size); grid = -1; return; }
        int dev = 0, cus = 0;
        if (hipGetDevice(&dev) != hipSuccess || hipDeviceGetAttribute(&cus, hipDeviceAttributeMultiprocessorCount, dev) != hipSuccess) { grid = -1; return; }
        if (hipFuncSetAttribute((const void*)fwd_kernel, hipFuncAttributeMaxDynamicSharedMemorySize, LDS_BYTES) != hipSuccess) { fprintf(stderr, "kernel_launch: hipFuncSetAttribute failed\n"); grid = -1; return; }
        int per_cu = 0;
        if (hipOccupancyMaxActiveBlocksPerMultiprocessor(&per_cu, (const void*)fwd_kernel, NTHR, LDS_BYTES) != hipSuccess || per_cu < 1) { fprintf(stderr, "kernel_launch: occupancy query says %d\n", per_cu); }
        (void)hipGetLastError();
        grid = cus;
    }
    if (grid < 0) return;
    (void)hipMemsetAsync((char*)d_ws + WS_CTL, 0, CTL_ZERO_BYTES, stream);
    Args a{};
    for (int i = 0; i < 25; ++i) a.in[i] = (const float*)d_in[i];
    a.out = (float*)d_out; a.ws = (unsigned char*)d_ws;
#if ONE_LAUNCH
    a.ph_lo = 0; a.ph_hi = NPHASES;
    hipLaunchKernelGGL(fwd_kernel, dim3(grid), dim3(NTHR), LDS_BYTES, stream, a);
#else
    for (int ph = 0; ph < NPHASES; ++ph) { a.ph_lo = ph; a.ph_hi = ph + 1; hipLaunchKernelGGL(fwd_kernel, dim3(grid), dim3(NTHR), LDS_BYTES, stream, a); }
#endif
}
```

```cpp
#include <hip/hip_runtime.h>
#include <cstdio>
#include <cstdint>

#ifndef ONE_LAUNCH
#define ONE_LAUNCH 1
#endif

#define LAS __attribute__((address_space(3)))
typedef unsigned short bf16_t;
typedef short bf16x8 __attribute__((ext_vector_type(8)));
typedef float f32x4 __attribute__((ext_vector_type(4)));
typedef float f32x2 __attribute__((ext_vector_type(2)));
typedef unsigned u32x4 __attribute__((ext_vector_type(4)));
typedef unsigned u32x2 __attribute__((ext_vector_type(2)));
typedef unsigned long long u64;

constexpr int NB = 8, SEQ = 4096, DM = 1024, NTOK = NB * SEQ;
constexpr int IN0_SRC = 3144, IN0_N = 3328;
constexpr int FF0 = 2816, FFE = 3584, NEXP = 8;
constexpr int IN1_N = 9216;
constexpr int CHUNK_B = 4, CHUNK_T = CHUNK_B * SEQ;
constexpr int MOE_CH_TILES = 132;
constexpr int HM_DOUT_TILES = 73;
constexpr float ALPHA = 1.4142135623730951f;
constexpr float LN_EPS = 1e-5f;
constexpr int NWAVES = 8, NTHR = 512;

constexpr size_t MiB = 1u << 20;
constexpr size_t WS_CTL = 0, CTL_ZERO_BYTES = 64 * 1024;
constexpr size_t WS_BIAST = 1 * MiB;
constexpr size_t WS_MOE_TOK = 2 * MiB;
constexpr size_t WS_MOE_GATE = 3 * MiB;
constexpr size_t WS_WIN0 = 4 * MiB;
constexpr size_t WS_WOUT0 = 11 * MiB;
constexpr size_t WS_WGU0 = 13 * MiB;
constexpr size_t WS_WD0 = 24 * MiB;
constexpr size_t WS_WIN1 = 30 * MiB;
constexpr size_t WS_WOUT1 = 48 * MiB;
constexpr size_t WS_XB = 50 * MiB;
constexpr size_t WS_U = 114 * MiB;
constexpr size_t WS_Q0 = 146 * MiB, SEG0 = 32 * MiB;
constexpr size_t WS_KI = 274 * MiB;
constexpr size_t WS_WI = 278 * MiB;
constexpr size_t WS_MASK = 280 * MiB;
constexpr size_t WS_MIXIN = 296 * MiB;
constexpr size_t WS_X1B = 50 * MiB;
constexpr size_t WS_H0 = 114 * MiB;
constexpr size_t WS_X2B = 448 * MiB;
constexpr size_t WS_H1 = 50 * MiB;
constexpr size_t WS_OP = 338 * MiB;
constexpr size_t WS_LSE = 434 * MiB;
constexpr size_t WS_Y3 = 216 * MiB;
constexpr size_t WS_X3B = 152 * MiB;
constexpr size_t WS_YB = 216 * MiB;
constexpr size_t WS_MWGU = 344 * MiB;
constexpr size_t WS_MWD = 456 * MiB;
constexpr size_t WS_HM = 4 * MiB;
constexpr size_t WS_END = 512 * MiB;
constexpr size_t HM_TILE_BYTES = (size_t)256 * FFE * 2;
constexpr int CW_MOECNT = 64;
constexpr int CW_BAR = 1024;

constexpr int LDS_GTAB = 131072;
constexpr int LDS_RT = 147456;
constexpr int LDS_MISC = 155648 + 2048;
constexpr int LDS_BYTES = 159744;

__device__ __forceinline__ unsigned cvt_pk_bf16(float lo, float hi) { unsigned r; asm volatile("v_cvt_pk_bf16_f32 %0, %1, %2" : "=v"(r) : "v"(lo), "v"(hi)); return r; }
__device__ __forceinline__ float bf_lo(unsigned w) { return __uint_as_float(w << 16); }
__device__ __forceinline__ float bf_hi(unsigned w) { return __uint_as_float(w & 0xffff0000u); }
__device__ __forceinline__ float bf2f(bf16_t b) { return __uint_as_float(((unsigned)b) << 16); }
template <int M> __device__ __forceinline__ float swz_xor(float v) {
    return __int_as_float(__builtin_amdgcn_ds_swizzle(__float_as_int(v), (M << 10) | 0x1f)); }
__device__ __forceinline__ float wave_sum(float v) {
    v += swz_xor<1>(v); v += swz_xor<2>(v); v += swz_xor<4>(v); v += swz_xor<8>(v); v += swz_xor<16>(v);
    auto rr = __builtin_amdgcn_permlane32_swap(__float_as_uint(v), __float_as_uint(v), false, false);
    return __uint_as_float(rr[0]) + __uint_as_float(rr[1]);
}
__device__ __forceinline__ float wave_max(float v) {
    v = fmaxf(v, swz_xor<1>(v)); v = fmaxf(v, swz_xor<2>(v)); v = fmaxf(v, swz_xor<4>(v)); v = fmaxf(v, swz_xor<8>(v)); v = fmaxf(v, swz_xor<16>(v));
    auto rr = __builtin_amdgcn_permlane32_swap(__float_as_uint(v), __float_as_uint(v), false, false);
    return fmaxf(__uint_as_float(rr[0]), __uint_as_float(rr[1]));
}
__device__ __forceinline__ unsigned lane_get(unsigned v, int src_lane) { return (unsigned)__builtin_amdgcn_ds_bpermute(src_lane << 2, (int)v); }
__device__ __forceinline__ float sigmoidf_(float x) { return __builtin_amdgcn_rcpf(1.0f + __expf(-x)); }
#define WAVE_LDS_FENCE() do { asm volatile("s_waitcnt lgkmcnt(0)" ::: "memory"); __builtin_amdgcn_wave_barrier(); } while (0)

#define XB_TMO      128
#define XB_XCNT(j)  (256  + 64 * (j))
#define XB_XSUB(j)  (1280 + 64 * (j))
#define XB_XGEN(j)  (2304 + 64 * (j))
#define XB_TOP      3328
#define XB_TOPGEN   3392
#define XCD_BAR_WORDS 3456
#define XB_SPIN_CAP (1u << 18)
__device__ __forceinline__ unsigned xb_ld(unsigned* p)              { return __hip_atomic_load(p, __ATOMIC_RELAXED, __HIP_MEMORY_SCOPE_AGENT); }
__device__ __forceinline__ unsigned xb_add(unsigned* p, unsigned v) { return __hip_atomic_fetch_add(p, v, __ATOMIC_RELAXED, __HIP_MEMORY_SCOPE_AGENT); }
__device__ __forceinline__ unsigned xb_xcc_id() { return (unsigned)__builtin_amdgcn_s_getreg((3 << 11) | 20) & 0xFu; }
#define XB_SPIN(cond, bar) do { unsigned _sp = 0; while (cond) { __builtin_amdgcn_s_sleep(1); \
    if ((++_sp & 255u) == 0u) { if (xb_ld(&(bar)[XB_TMO])) break; if (_sp > XB_SPIN_CAP) { atomicAdd(&(bar)[XB_TMO], 1u); break; } } } } while (0)
struct XcdBarrier { unsigned* bar; unsigned x; volatile LAS unsigned* st; };
__device__ __forceinline__ XcdBarrier xcd_barrier_post(unsigned* bar, volatile LAS unsigned* st, bool leader) {
    XcdBarrier b; b.bar = bar; b.x = xb_xcc_id(); b.st = st;
    if (leader) (void)xb_add(&bar[XB_XCNT(b.x)], 1u);
    return b;
}
__device__ __forceinline__ void xcd_barrier_complete(unsigned* bar, unsigned x, unsigned& nloc, unsigned& nx) {
    const unsigned G = gridDim.x * gridDim.y * gridDim.z;
    unsigned sum, cnt, mine, sp = 0u;
    for (;;) {
        sum = 0u; cnt = 0u; mine = 0u;
#pragma unroll
        for (unsigned j = 0; j < 16; ++j) { const unsigned c = xb_ld(&bar[XB_XCNT(j)]); sum += c; cnt += (c > 0u) ? 1u : 0u; mine = (j == x) ? c : mine; }
        if (sum == G) break;
        __builtin_amdgcn_s_sleep(1);
        if ((++sp & 255u) == 0u) { if (xb_ld(&bar[XB_TMO])) break; if (sp > XB_SPIN_CAP) { atomicAdd(&bar[XB_TMO], 1u); break; } }
    }
    nloc = mine > 0u ? mine : 1u; nx = cnt > 0u ? cnt : 1u;
}
__device__ __forceinline__ void xcd_barrier(const XcdBarrier& b, bool leader) {
    asm volatile("s_waitcnt vmcnt(0)" ::: "memory");
    __syncthreads();
    if (leader) {
        unsigned* bar = b.bar;
        __builtin_amdgcn_s_waitcnt(0);
        unsigned nloc = b.st[0], nx = b.st[1];
        if (nloc == 0u) { xcd_barrier_complete(bar, b.x, nloc, nx); b.st[0] = nloc; b.st[1] = nx; }
        const unsigned old = xb_add(&bar[XB_XSUB(b.x)], 1u);
        const unsigned gen = old / nloc;
        if (old + 1u == (gen + 1u) * nloc) {
            __builtin_amdgcn_fence(__ATOMIC_RELEASE, "agent");
            asm volatile("s_waitcnt vmcnt(0)" ::: "memory");
            const unsigned og = xb_add(&bar[XB_TOP], 1u);
            const unsigned tg = og / nx;
            if (og + 1u == (tg + 1u) * nx) xb_add(&bar[XB_TOPGEN], 1u);
            else XB_SPIN(xb_ld(&bar[XB_TOPGEN]) == tg, bar);
            __builtin_amdgcn_fence(__ATOMIC_ACQUIRE, "agent");
            xb_add(&bar[XB_XGEN(b.x)], 1u);
            asm volatile("s_waitcnt vmcnt(0)" ::: "memory");
        } else {
            XB_SPIN(xb_ld(&bar[XB_XGEN(b.x)]) == gen, bar);
            __builtin_amdgcn_fence(__ATOMIC_ACQUIRE, "agent");
            asm volatile("s_waitcnt vmcnt(0)" ::: "memory");
        }
    }
    __syncthreads();
}

namespace pg8 {
constexpr int BM = 256, BK = 64, HALF = 128, HTB = HALF * BK * 2, STAGE_BYTES = 8 * HTB, NXCD = 8, WGM = 8;
__host__ __device__ __forceinline__ int lds_byte(int r, int c) { const int st = (r >> 4) * 2 + (c >> 5), rr = r & 15, cc = c & 31, ob = rr * 64 + cc * 2; return st * 1024 + (ob ^ (((ob >> 9) & 1) << 5)); }
__host__ __device__ __forceinline__ void stage_rc(int b, int& R, int& C) { const int st = b / 1024, sb = b % 1024, swz = sb ^ (((sb >> 9) & 1) << 5); R = (st >> 1) * 16 + swz / 64; C = (st & 1) * 32 + (swz % 64) / 2; }
__host__ __device__ __forceinline__ int perm32(int rho) { const int n = rho >> 4, i = rho & 15; return 8 * (i >> 2) + 4 * n + (i & 3); }

struct Unit { int pm, pn; };

__device__ __forceinline__ void remap_unit(int wgid, int nM, int nN, int& pm, int& pn) {
    const int nwg = nM * nN;
    { const int q = nwg / NXCD, r = nwg % NXCD, xcd = wgid % NXCD, off = wgid / NXCD; wgid = (xcd < r ? xcd * (q + 1) : r * (q + 1) + (xcd - r) * q) + off; }
    const int nig = WGM * nN, gid = wgid / nig, fm = gid * WGM, gsz = (nM - fm) < WGM ? (nM - fm) : WGM;
    pm = fm + ((wgid % nig) % gsz); pn = (wgid % nig) / gsz;
}
struct StaticOrder {
    int nM, nN, nwg, G, c; const char* A; size_t tstepA;
    __device__ void init(const bf16_t* A_, int M, int N, int K, int G_, int c_) { nM = M / BM; nN = N / BM; nwg = nM * nN; G = G_; c = c_; A = (const char*)A_; tstepA = (size_t)BM * K * 2; }
    __device__ __forceinline__ bool next(int i, Unit& u) const {
        const long L = (long)i * G + c; if (L >= nwg) return false;
        remap_unit((int)L, nM, nN, u.pm, u.pn); return true;
    }
    __device__ __forceinline__ const char* a_ptr(const Unit& u) const { return A + (size_t)u.pm * tstepA; }
    __device__ __forceinline__ int b_tile(const Unit& u) const { return u.pn; }
};

#define PG8_LAS __attribute__((address_space(3)))
template <class Epi, class Sched, bool ALIGN_EPI, bool GATHER>
__device__ __forceinline__ void gemm_phase(const int tid, PG8_LAS unsigned char* lds, const bf16_t* Btp, const int K, const Sched& S, const Epi& E, const PG8_LAS int* gtab) {
    const int wid = __builtin_amdgcn_readfirstlane(tid >> 6), lane = tid & 63, wr = wid >> 2, wc = wid & 3, fr = lane & 15, fq = lane >> 4;
    const int nt = K / BK;
    unsigned voffA[2], voffB[2];
#pragma unroll
    for (int i = 0; i < 2; ++i) { int R, C; stage_rc(tid * 16 + i * 8192, R, C); const int Rb = Epi::PERM ? ((R & ~31) + perm32(R & 31)) : R;
        voffA[i] = (unsigned)(R * K + C) * 2u; voffB[i] = (unsigned)(Rb * K + C) * 2u; }
    const size_t kstep = (size_t)(BK * 2);
    const size_t hstep = (size_t)HALF * K * 2;
    const size_t tstep = 2 * hstep;
    const unsigned ldsw = (unsigned)wid * 1024u;
    const int aoff = lds_byte(wr * 64 + fr, fq * 8), boff = lds_byte(wc * 32 + fr, fq * 8);
#define PG8_SA(b, h) (((b) * 2 + (h)) * HTB)
#define PG8_SB(b, h) ((4 + (b) * 2 + (h)) * HTB)
#define PG8_STAGE(bufoff, gbase, voff) do { _Pragma("unroll") for (int _i = 0; _i < 2; ++_i) \
        __builtin_amdgcn_global_load_lds((const unsigned*)((const char*)(gbase) + (voff)[_i]), (PG8_LAS unsigned*)(lds + (bufoff) + ldsw + _i * 8192), 16, 0, 0); } while (0)
#define PG8_STAGE_AC(bufoff, kt, h) do { if constexpr (GATHER) { PG8_STAGE(bufoff, cA + (size_t)(kt) * kstep, gcur[h]); } else { PG8_STAGE(bufoff, cA + (size_t)(kt) * kstep + (h) * hstep, voffA); } } while (0)
#define PG8_STAGE_AN(bufoff, d, h) do { if constexpr (GATHER) { if (last) { unsigned _g[2]; _Pragma("unroll") for (int _i = 0; _i < 2; ++_i) { int _R, _C; stage_rc(tid * 16 + _i * 8192, _R, _C); _g[_i] = (unsigned)gtab[nslot * 256 + (h) * 128 + _R] * (unsigned)(K * 2) + (unsigned)(_C * 2); } \
            PG8_STAGE(bufoff, nA + (size_t)(d) * kstep, _g); } else { PG8_STAGE(bufoff, cA + (size_t)(t + 2 + (d)) * kstep, gcur[h]); } } \
        else { PG8_STAGE(bufoff, a2 + (size_t)(d) * kstep + (h) * hstep, voffA); } } while (0)
#define PG8_LDA(dst, b, h) do { _Pragma("unroll") for (int m = 0; m < 4; ++m) _Pragma("unroll") for (int k = 0; k < 2; ++k) dst[m][k] = *(const PG8_LAS bf16x8*)(lds + PG8_SA(b, h) + aoff + m * 2048 + k * 1024); } while (0)
#define PG8_LDB(dst, b, h) do { _Pragma("unroll") for (int n = 0; n < 2; ++n) _Pragma("unroll") for (int k = 0; k < 2; ++k) dst[n][k] = *(const PG8_LAS bf16x8*)(lds + PG8_SB(b, h) + boff + n * 2048 + k * 1024); } while (0)
#define PG8_MMA(ai, bj, At, Bt) do { __builtin_amdgcn_s_setprio(1); _Pragma("unroll") for (int m = 0; m < 4; ++m) _Pragma("unroll") for (int n = 0; n < 2; ++n) _Pragma("unroll") for (int k = 0; k < 2; ++k) \
        acc[ai][bj][m][n] = __builtin_amdgcn_mfma_f32_16x16x32_bf16(Bt[n][k], At[m][k], acc[ai][bj][m][n], 0, 0, 0); __builtin_amdgcn_s_setprio(0); } while (0)
#define PG8_WAIT_V(n) asm volatile("s_waitcnt vmcnt(" #n ")" ::: "memory")
#define PG8_WAIT_L(n) asm volatile("s_waitcnt lgkmcnt(" #n ")" ::: "memory")
#define PG8_BAR __builtin_amdgcn_s_barrier()
#define PG8_SCHED __builtin_amdgcn_sched_barrier(0)
#define PG8_LOADG(dst, slot_) do { _Pragma("unroll") for (int _i = 0; _i < 2; ++_i) { int _R, _C; stage_rc(tid * 16 + _i * 8192, _R, _C); _Pragma("unroll") for (int _h = 0; _h < 2; ++_h) \
        dst[_h][_i] = (unsigned)gtab[(slot_) * 256 + _h * 128 + _R] * (unsigned)(K * 2) + (unsigned)(_C * 2); } } while (0)
    Unit cur, nxt; int ui = 0;
    if (!S.next(0, cur)) return;
    f32x4 acc[2][2][4][2];
#pragma unroll
    for (int a = 0; a < 2; ++a)
#pragma unroll
        for (int b = 0; b < 2; ++b)
#pragma unroll
            for (int m = 0; m < 4; ++m)
#pragma unroll
                for (int n = 0; n < 2; ++n) acc[a][b][m][n] = (f32x4){0.f, 0.f, 0.f, 0.f};
    bf16x8 At[4][2], B0[2][2], B1[2][2];
    unsigned gcur[2][2] = {{0u, 0u}, {0u, 0u}};
    const char* cA = S.a_ptr(cur); const char* cB = (const char*)Btp + (size_t)S.b_tile(cur) * tstep;
    if constexpr (GATHER) { PG8_LOADG(gcur, 0); PG8_WAIT_L(0); }
    PG8_STAGE(PG8_SB(0, 0), cB, voffB); PG8_STAGE(PG8_SB(0, 1), cB + hstep, voffB); PG8_STAGE_AC(PG8_SA(0, 0), 0, 0); PG8_STAGE_AC(PG8_SA(0, 1), 0, 1);
    if (wr == 1) PG8_BAR;
    PG8_WAIT_V(2); PG8_BAR;
    PG8_STAGE(PG8_SB(1, 0), cB + kstep, voffB); PG8_STAGE_AC(PG8_SA(1, 0), 1, 0); PG8_STAGE(PG8_SB(1, 1), cB + hstep + kstep, voffB);
    PG8_WAIT_V(6); PG8_BAR;
    for (;;) {
        const bool has_next = S.next(ui + 1, nxt);
        const char* nA = has_next ? S.a_ptr(nxt) : cA; const char* nB = has_next ? (const char*)Btp + (size_t)S.b_tile(nxt) * tstep : cB;
        const int nslot = has_next ? ui + 1 : ui;
        for (int t = 0; t < nt; t += 2) {
            const bool last = (t == nt - 2);
            const char* a2 = last ? nA : cA + (size_t)(t + 2) * kstep; const char* b2 = last ? nB : cB + (size_t)(t + 2) * kstep;
            const char* b3 = b2 + kstep;
            (void)a2;
            PG8_LDB(B0, 0, 0); PG8_LDB(B1, 0, 1); PG8_SCHED; PG8_LDA(At, 0, 0); PG8_STAGE_AC(PG8_SA(1, 1), t + 1, 1);
            PG8_WAIT_V(8); PG8_WAIT_L(0); PG8_BAR; PG8_MMA(0, 0, At, B0); PG8_MMA(0, 1, At, B1); PG8_BAR; PG8_SCHED;
            PG8_LDA(At, 0, 1); PG8_STAGE(PG8_SB(0, 0), b2, voffB); PG8_STAGE(PG8_SB(0, 1), b2 + hstep, voffB); PG8_STAGE_AN(PG8_SA(0, 0), 0, 0);
            PG8_WAIT_V(8); PG8_WAIT_L(0); PG8_BAR; PG8_MMA(1, 0, At, B0); PG8_MMA(1, 1, At, B1); PG8_BAR; PG8_SCHED;
            PG8_LDB(B0, 1, 0); PG8_LDB(B1, 1, 1); PG8_SCHED; PG8_LDA(At, 1, 0); PG8_STAGE_AN(PG8_SA(0, 1), 0, 1);
            PG8_WAIT_V(8); PG8_WAIT_L(0); PG8_BAR; PG8_MMA(0, 0, At, B0); PG8_MMA(0, 1, At, B1); PG8_BAR; PG8_SCHED;
            PG8_LDA(At, 1, 1); PG8_STAGE(PG8_SB(1, 0), b3, voffB); PG8_STAGE(PG8_SB(1, 1), b3 + hstep, voffB); PG8_STAGE_AN(PG8_SA(1, 0), 1, 0);
            PG8_WAIT_V(8); PG8_WAIT_L(0); PG8_BAR; PG8_MMA(1, 0, At, B0); PG8_MMA(1, 1, At, B1); PG8_BAR; PG8_SCHED;
        }
        if constexpr (ALIGN_EPI) { if (wr == 0) PG8_BAR; }
        { int fr_e = fr, fq_e = fq; asm volatile("" : "+v"(fr_e), "+v"(fq_e)); E(acc, cur, wr, wc, fr_e, fq_e); }
        if (!has_next) break;
#pragma unroll
        for (int a = 0; a < 2; ++a)
#pragma unroll
            for (int b = 0; b < 2; ++b)
#pragma unroll
                for (int m = 0; m < 4; ++m)
#pragma unroll
                    for (int n = 0; n < 2; ++n) acc[a][b][m][n] = (f32x4){0.f, 0.f, 0.f, 0.f};
        cur = nxt; cA = nA; cB = nB; ++ui;
        if constexpr (GATHER) { PG8_LOADG(gcur, ui); }
        if constexpr (ALIGN_EPI) { if (wr == 1) PG8_BAR; }
    }
    PG8_WAIT_V(0);
    if constexpr (!ALIGN_EPI) { if (wr == 0) PG8_BAR; }
    PG8_BAR;
#undef PG8_SA
#undef PG8_SB
#undef PG8_STAGE
#undef PG8_STAGE_AC
#undef PG8_STAGE_AN
#undef PG8_LDA
#undef PG8_LDB
#undef PG8_MMA
#undef PG8_WAIT_V
#undef PG8_WAIT_L
#undef PG8_BAR
#undef PG8_SCHED
#undef PG8_LOADG
}

typedef f32x4 AccT[2][2][4][2];
__device__ __forceinline__ u32x4 pack8(const f32x4 v0, const f32x4 v1) { u32x4 w; w.x = cvt_pk_bf16(v0[0], v0[1]); w.y = cvt_pk_bf16(v0[2], v0[3]); w.z = cvt_pk_bf16(v1[0], v1[1]); w.w = cvt_pk_bf16(v1[2], v1[3]); return w; }

struct EpiIn0 {
    static constexpr bool PERM = true;
    bf16_t* U; bf16_t* Q; bf16_t* KI; float* WI;
    __device__ __forceinline__ void operator()(const AccT& acc, const Unit& u, int wr, int wc, int fr, int fq) const {
        const int row0 = u.pm * BM + wr * 64 + fr;
        if (u.pn < 4) {
            const int col0 = u.pn * 128 + wc * 32 + 8 * fq;
#pragma unroll
            for (int ai = 0; ai < 2; ++ai)
#pragma unroll
                for (int m = 0; m < 4; ++m) { f32x4 o0, o1;
#pragma unroll
                    for (int j = 0; j < 4; ++j) { o0[j] = acc[ai][0][m][0][j] * sigmoidf_(acc[ai][1][m][0][j]); o1[j] = acc[ai][0][m][1][j] * sigmoidf_(acc[ai][1][m][1][j]); }
                    *(u32x4*)(U + (size_t)(row0 + ai * HALF + m * 16) * 512 + col0) = pack8(o0, o1); }
        } else if (u.pn < 12) {
            const int t = (u.pn - 4) >> 1; bf16_t* base = Q + (size_t)t * (SEG0 / 2); const float sc = 1.0f;
            const int col0 = ((u.pn - 4) & 1) * 256 + wc * 32 + 8 * fq;
#pragma unroll
            for (int ai = 0; ai < 2; ++ai)
#pragma unroll
                for (int m = 0; m < 4; ++m)
#pragma unroll
                    for (int bj = 0; bj < 2; ++bj)
                        *(u32x4*)(base + (size_t)(row0 + ai * HALF + m * 16) * 512 + col0 + bj * HALF) = pack8(acc[ai][bj][m][0] * sc, acc[ai][bj][m][1] * sc);
        } else {
            if (wc < 2) {
#pragma unroll
                for (int ai = 0; ai < 2; ++ai)
#pragma unroll
                    for (int m = 0; m < 4; ++m) *(u32x4*)(KI + (size_t)(row0 + ai * HALF + m * 16) * 64 + wc * 32 + 8 * fq) = pack8(acc[ai][0][m][0], acc[ai][0][m][1]);
            } else if (wc == 2 && fq == 0) {
                const float sc = 0.04419417382415922f;
#pragma unroll
                for (int ai = 0; ai < 2; ++ai)
#pragma unroll
                    for (int m = 0; m < 4; ++m) { float* p = WI + (size_t)(row0 + ai * HALF + m * 16) * 8; *(f32x4*)p = acc[ai][0][m][0] * sc; *(f32x4*)(p + 4) = acc[ai][0][m][1] * sc; }
            }
        }
    }
};
template <bool RB> struct EpiRes {
    static constexpr bool PERM = false;
    float* out; const void* resid;
    __device__ __forceinline__ void operator()(const AccT& acc, const Unit& u, int wr, int wc, int fr, int fq) const {
        const int row0 = u.pm * BM + wr * 64 + fr, col0 = u.pn * BM + wc * 32 + 4 * fq;
#pragma unroll
        for (int ai = 0; ai < 2; ++ai)
#pragma unroll
            for (int m = 0; m < 4; ++m) { const size_t off = (size_t)(row0 + ai * HALF + m * 16) * DM + col0;
#pragma unroll
                for (int bj = 0; bj < 2; ++bj)
#pragma unroll
                    for (int n = 0; n < 2; ++n) { f32x4 r;
                        if (RB) { const u32x2 w = *(const u32x2*)((const bf16_t*)resid + off + bj * HALF + n * 16); r = (f32x4){bf_lo(w.x), bf_hi(w.x), bf_lo(w.y), bf_hi(w.y)}; }
                        else r = *(const f32x4*)((const float*)resid + off + bj * HALF + n * 16);
                        *(f32x4*)(out + off + bj * HALF + n * 16) = r * ALPHA + acc[ai][bj][m][n]; } }
    }
};
__device__ __forceinline__ char* hm_tile(char* dout, char* ws, int p) { return p < HM_DOUT_TILES ? dout + (size_t)p * HM_TILE_BYTES : ws + WS_HM + (size_t)(p - HM_DOUT_TILES) * HM_TILE_BYTES; }
template <bool TILE_LOCAL> struct EpiSwiglu {
    static constexpr bool PERM = true;
    bf16_t* H; int ldh; char* dout; char* ws;
    __device__ __forceinline__ void operator()(const AccT& acc, const Unit& u, int wr, int wc, int fr, int fq) const {
        bf16_t* base; if constexpr (TILE_LOCAL) base = (bf16_t*)hm_tile(dout, ws, u.pm); else base = H + (size_t)u.pm * BM * ldh;
        const int rl0 = wr * 64 + fr, col0 = u.pn * 128 + wc * 32 + 8 * fq;
#pragma unroll
        for (int ai = 0; ai < 2; ++ai)
#pragma unroll
            for (int m = 0; m < 4; ++m) { f32x4 o0, o1;
#pragma unroll
                for (int j = 0; j < 4; ++j) { const float g0 = acc[ai][0][m][0][j], g1 = acc[ai][0][m][1][j];
                    o0[j] = g0 * sigmoidf_(g0) * acc[ai][1][m][0][j]; o1[j] = g1 * sigmoidf_(g1) * acc[ai][1][m][1][j]; }
                *(u32x4*)(base + (size_t)(rl0 + ai * HALF + m * 16) * ldh + col0) = pack8(o0, o1); }
    }
};
struct EpiQkv1 {
    static constexpr bool PERM = true;
    bf16_t* O; int ldc; float qscale;
    __device__ __forceinline__ void operator()(const AccT& acc, const Unit& u, int wr, int wc, int fr, int fq) const {
        const int row0 = u.pm * BM + wr * 64 + fr, col0 = u.pn * BM + wc * 32 + 8 * fq; const float sc = ((u.pn % 12) < 4) ? qscale : 1.0f;
#pragma unroll
        for (int ai = 0; ai < 2; ++ai)
#pragma unroll
            for (int m = 0; m < 4; ++m)
#pragma unroll
                for (int bj = 0; bj < 2; ++bj)
                    *(u32x4*)(O + (size_t)(row0 + ai * HALF + m * 16) * ldc + col0 + bj * HALF) = pack8(acc[ai][bj][m][0] * sc, acc[ai][bj][m][1] * sc);
    }
};
struct EpiMoeDown {
    static constexpr bool PERM = true;
    bf16_t* YB; const int* tokk; const float* gate; const PG8_LAS int* rt;
    __device__ __forceinline__ void operator()(const AccT& acc, const Unit& u, int wr, int wc, int fr, int fq) const {
        const int lbase = rt[u.pm * 4 + 1], nvalid = rt[u.pm * 4 + 2];
        const int rl0 = wr * 64 + fr, col0 = u.pn * BM + wc * 32 + 8 * fq;
#pragma unroll
        for (int ai = 0; ai < 2; ++ai)
#pragma unroll
            for (int m = 0; m < 4; ++m) { const int rl = rl0 + ai * HALF + m * 16;
                if (rl < nvalid) { const int tk = tokk[lbase + rl]; const float g = gate[lbase + rl];
                    bf16_t* rowp = YB + ((size_t)(tk & 1) * NTOK + (size_t)(tk >> 1)) * DM + col0;
#pragma unroll
                    for (int bj = 0; bj < 2; ++bj) *(u32x4*)(rowp + bj * HALF) = pack8(acc[ai][bj][m][0] * g, acc[ai][bj][m][1] * g); } }
    }
};
struct MoeOrder {
    int G, c, nM, nN; const PG8_LAS int* rt; const char* xbase; char* dout; char* ws; bool up;
    __device__ __forceinline__ bool next(int i, Unit& u) const {
        const long L = (long)i * G + c; if (L >= (long)nM * nN) return false;
        remap_unit((int)L, nM, nN, u.pm, u.pn); return true;
    }
    __device__ __forceinline__ const char* a_ptr(const Unit& u) const { return up ? xbase : (const char*)hm_tile(dout, ws, u.pm); }
    __device__ __forceinline__ int b_tile(const Unit& u) const { return __builtin_amdgcn_readfirstlane(rt[u.pm * 4]) * nN + u.pn; }
};
}


namespace swa {
constexpr int D = 128, NW = 8, QBLK = 32, KVBLK = 64, QB = NW * QBLK, WIN = 129;
constexpr int SHM_V = KVBLK * D * 2, SHM_K = KVBLK * D * 2;
constexpr int LDS_TB = 2 * SHM_V + 2 * SHM_K + NW * 64 * 4;
constexpr float SCALE = 0.08838834764831845f, THR = 8.f;
typedef float f32x16 __attribute__((ext_vector_type(16)));
typedef short s16x4 __attribute__((ext_vector_type(4)));
#define KSWZ(row, colB) ((row) * 256 + ((colB) ^ (((row) & 7) << 4)))
#define SBAR() __builtin_amdgcn_sched_barrier(0)
__device__ __forceinline__ int v_st(int k, int c) { const int kk = (k & ~0xC) | ((k & 4) << 1) | ((k & 8) >> 1); return ((kk >> 3) * 4 + (c >> 5)) * 512 + ((kk & 7) * 32 + (c & 31)) * 2; }
__device__ __forceinline__ int v_rd_base(int lane) { return ((lane & 3) << 3) | (((lane >> 2) & 3) << 6) | (((lane >> 4) & 1) << 5) | (((lane >> 5) & 1) << 8); }
constexpr int v_rd_off(int d0, int ks, int half) { return d0 * 512 + ks * 4096 + half * 2048; }
__device__ __forceinline__ int crow(int r, int hi) { return (r & 3) + 8 * (r >> 2) + 4 * hi; }
__device__ __forceinline__ bf16x8 load8(const bf16_t* p) { return *reinterpret_cast<const bf16x8*>(p); }
__device__ __forceinline__ void mask_bias_tile(f32x16& p0, f32x16& p1, int dq, const float* tb) {
    const float NEG = -__builtin_inff();
#pragma unroll
    for (int r = 0; r < 16; ++r) {
        const int c = (r & 3) + 8 * (r >> 2);
        p0[r] = ((unsigned)(dq - c) < (unsigned)WIN) ? p0[r] + tb[59 - c] : NEG;
        p1[r] = ((unsigned)(dq - c - 32) < (unsigned)WIN) ? p1[r] + tb[27 - c] : NEG;
    }
}
__device__ __forceinline__ void partialSM(f32x16& p0, f32x16& p1, float& m_reg, float& mn, float& alpha) {
    float pmax = p0[0];
#pragma unroll
    for (int r = 1; r < 16; ++r) pmax = fmaxf(pmax, p0[r]);
#pragma unroll
    for (int r = 0; r < 16; ++r) pmax = fmaxf(pmax, p1[r]);
    { auto rr = __builtin_amdgcn_permlane32_swap(__float_as_uint(pmax), __float_as_uint(pmax), false, false);
      pmax = fmaxf(__uint_as_float(rr[0]), __uint_as_float(rr[1])); }
    constexpr float C2 = 1.4426950408889634f * SCALE;
    if (__builtin_expect(__all((pmax - m_reg) * SCALE <= THR), 1)) { mn = m_reg; alpha = 1.f; }
    else { mn = fmaxf(m_reg, pmax); alpha = __builtin_amdgcn_exp2f((m_reg - mn) * C2); m_reg = mn; }
    const float mnL = -mn * C2;
#pragma unroll
    for (int r = 0; r < 16; ++r) p0[r] = fmaf(p0[r], C2, mnL);
#pragma unroll
    for (int r = 0; r < 16; ++r) p1[r] = fmaf(p1[r], C2, mnL);
#pragma unroll
    for (int r = 0; r < 16; ++r) p0[r] = __builtin_amdgcn_exp2f(p0[r]);
}
__device__ __forceinline__ void finishSM(f32x16& p0, f32x16& p1, float alpha, float& l_reg, bf16x8& pa0, bf16x8& pa1, bf16x8& pa2, bf16x8& pa3) {
#pragma unroll
    for (int r = 0; r < 16; ++r) p1[r] = __builtin_amdgcn_exp2f(p1[r]);
    float ps = 0;
#pragma unroll
    for (int r = 0; r < 16; ++r) ps += p0[r];
#pragma unroll
    for (int r = 0; r < 16; ++r) ps += p1[r];
    { auto rr = __builtin_amdgcn_permlane32_swap(__float_as_uint(ps), __float_as_uint(ps), false, false);
      ps = __uint_as_float(rr[0]) + __uint_as_float(rr[1]); }
    l_reg = l_reg * alpha + ps;
#define PK4(P, B_, OUT) do { unsigned a0 = cvt_pk_bf16(P[B_+0], P[B_+1]), a1 = cvt_pk_bf16(P[B_+2], P[B_+3]);                          \
        unsigned b0 = cvt_pk_bf16(P[B_+4], P[B_+5]), b1 = cvt_pk_bf16(P[B_+6], P[B_+7]);                                             \
        auto r0 = __builtin_amdgcn_permlane32_swap(a0, b0, false, false); auto r1 = __builtin_amdgcn_permlane32_swap(a1, b1, false, false); \
        u32x4 w = {r0[0], r1[0], r0[1], r1[1]}; OUT = *reinterpret_cast<bf16x8*>(&w); } while (0)
    PK4(p0, 0, pa0); PK4(p0, 8, pa1); PK4(p1, 0, pa2); PK4(p1, 8, pa3);
#undef PK4
}
template <int KB>
__device__ __forceinline__ void qkt(f32x16& p0, f32x16& p1, const char* K_lds, int r32, int hi, const bf16x8* qr, bool act) {
    if (!act) { const float NEG = -__builtin_inff();
#pragma unroll
        for (int r = 0; r < 16; ++r) { p0[r] = NEG; p1[r] = NEG; } return; }
    p0 = f32x16{}; p1 = f32x16{};
    const char* kb[4];
#pragma unroll
    for (int dd = 0; dd < 4; ++dd) kb[dd] = K_lds + KB * SHM_K + KSWZ(r32, (dd * 16 + hi * 8) * 2);
#pragma unroll
    for (int d0 = 0; d0 < 8; ++d0) { const char* a = kb[d0 & 3] + (d0 >> 2) * 128;
        bf16x8 b0 = *reinterpret_cast<const bf16x8*>(a);
        bf16x8 b1 = *reinterpret_cast<const bf16x8*>(a + 32 * 256);
        p0 = __builtin_amdgcn_mfma_f32_32x32x16_bf16(b0, qr[d0], p0, 0, 0, 0);
        p1 = __builtin_amdgcn_mfma_f32_32x32x16_bf16(b1, qr[d0], p1, 0, 0, 0); }
}
template <int VB>
__device__ __forceinline__ void pv_tile(f32x16* o, int vb0, bf16x8 pa0, bf16x8 pa1, bf16x8 pa2, bf16x8 pa3, bool act) {
    if (!act) return;
#define TRRD(dst, off) asm volatile("ds_read_b64_tr_b16 %0, %1 offset:%2" : "=&v"(dst) : "v"(vb0), "i"(off) : "memory")
#define PV_D0(d0) do { s16x4 l0, l1, l2, l3, h0, h1, h2, h3; constexpr int b_ = VB * SHM_V + v_rd_off(d0, 0, 0); \
        TRRD(l0, b_); TRRD(h0, b_ + 2048); TRRD(l1, b_ + 4096); TRRD(h1, b_ + 6144); TRRD(l2, b_ + 8192); TRRD(h2, b_ + 10240); TRRD(l3, b_ + 12288); TRRD(h3, b_ + 14336); \
        asm volatile("s_waitcnt lgkmcnt(0)" ::: "memory"); SBAR();   \
        o[d0] = __builtin_amdgcn_mfma_f32_32x32x16_bf16(pa0, (bf16x8){l0[0], l0[1], l0[2], l0[3], h0[0], h0[1], h0[2], h0[3]}, o[d0], 0, 0, 0);   \
        o[d0] = __builtin_amdgcn_mfma_f32_32x32x16_bf16(pa1, (bf16x8){l1[0], l1[1], l1[2], l1[3], h1[0], h1[1], h1[2], h1[3]}, o[d0], 0, 0, 0);   \
        o[d0] = __builtin_amdgcn_mfma_f32_32x32x16_bf16(pa2, (bf16x8){l2[0], l2[1], l2[2], l2[3], h2[0], h2[1], h2[2], h2[3]}, o[d0], 0, 0, 0);   \
        o[d0] = __builtin_amdgcn_mfma_f32_32x32x16_bf16(pa3, (bf16x8){l3[0], l3[1], l3[2], l3[3], h3[0], h3[1], h3[2], h3[3]}, o[d0], 0, 0, 0); } while (0)
    PV_D0(0); PV_D0(1); PV_D0(2); PV_D0(3);
#undef PV_D0
#undef TRRD
}
struct BlockRef { const bf16_t* Q; const bf16_t* K; bf16_t* O; float* LSE; int P0, bh, dsh;
    __device__ __forceinline__ int rs() const { return IN1_N << dsh; }
    __device__ __forceinline__ int os() const { return DM << dsh; }
    __device__ __forceinline__ int ls() const { return 8 << dsh; }
    __device__ __forceinline__ int skv() const { return SEQ >> dsh; }
    __device__ __forceinline__ const bf16_t* V() const { return K + 1024; } };
struct Seam { bf16x8 qr[8]; bf16x8 st_v0, st_v1, st_k0, st_k1; };
__device__ __forceinline__ int swa_jlo(int P0) { const int lowk = P0 - WIN + 1; return lowk > 0 ? lowk / KVBLK : 0; }
#define ROWP(p, k0, rs_, vo) ((const bf16_t*)((const char*)(p) + (size_t)(k0) * (size_t)(rs_) * 2 + (size_t)(vo)))
#define VMW() asm volatile("s_waitcnt vmcnt(0)" ::: "memory")
#define VMWN(n) asm volatile("s_waitcnt vmcnt(%0)" :: "i"(n) : "memory")
#define TIDL() int tid_l = tid; asm volatile("" : "+v"(tid_l)); const int sr = tid_l >> 4, sc = (tid_l & 15) * 8; (void)sr; (void)sc
#define SLOAD_H(Kp, Vp, k0, rs_) do { TIDL(); const unsigned vo0_ = (unsigned)(sr * (rs_) + sc) * 2u, vo1_ = vo0_ + (unsigned)(rs_) * 64u; \
                         S.st_v0 = load8(ROWP(Vp, k0, rs_, vo0_)); S.st_v1 = load8(ROWP(Vp, k0, rs_, vo1_));              \
                         S.st_k0 = load8(ROWP(Kp, k0, rs_, vo0_)); S.st_k1 = load8(ROWP(Kp, k0, rs_, vo1_)); } while (0)
#define SWRITE_HK(bf) do { TIDL(); const int kws = KSWZ(sr, sc * 2); *(bf16x8*)(K_lds + (bf) * SHM_K + kws) = S.st_k0; *(bf16x8*)(K_lds + (bf) * SHM_K + kws + 32 * 256) = S.st_k1; } while (0)
#define SWRITE_HV(bf) do { TIDL(); const int vst0 = v_st(sr, sc), vst1 = v_st(32 + sr, sc); *(bf16x8*)(V_lds + (bf) * SHM_V + vst0) = S.st_v0; *(bf16x8*)(V_lds + (bf) * SHM_V + vst1) = S.st_v1; } while (0)
#define SWRITE_H(bf) do { SWRITE_HV(bf); SWRITE_HK(bf); } while (0)
__device__ __forceinline__ void tb_load(const float* biast, int bh, int dsh, int tid, float& v0, float& v1) {
    const int d0 = tid - 384, d1 = tid + 512 - 384;
    v0 = (d0 >= 0 && d0 < WIN) ? biast[bh * 4096 + (d0 << dsh)] * (1.0f / SCALE) : 0.f;
    v1 = (d1 >= 0 && d1 < WIN) ? biast[bh * 4096 + (d1 << dsh)] * (1.0f / SCALE) : 0.f;
}
__device__ __forceinline__ void swa_prime(const BlockRef& cur, const float* biast, char* lds, Seam& S, int tid) {
    const int wid = __builtin_amdgcn_readfirstlane(tid >> 6), lane = tid & 63, r32 = lane & 31, hi = lane >> 5;
    char* K_lds = lds + 2 * SHM_V;
    const int kb0 = swa_jlo(cur.P0) * KVBLK;
    float t0, t1; tb_load(biast, cur.bh, cur.dsh, tid, t0, t1);
#pragma unroll
    for (int d0 = 0; d0 < 8; ++d0) S.qr[d0] = load8((const bf16_t*)((const char*)cur.Q + (size_t)((unsigned)((wid * QBLK + r32) * cur.rs() + hi * 8) * 2u)) + d0 * 16);
    SLOAD_H(cur.K, cur.V(), kb0, cur.rs()); VMW(); SWRITE_HK(0);
    float* tb = (float*)(lds + LDS_TB); tb[tid] = t0; tb[tid + 512] = t1;
    __syncthreads();
}
__device__ __forceinline__ void swa_block(const BlockRef& cur, const BlockRef& nxt, const float* biast, int slot, char* lds, Seam& S, int tid) {
    const int wid = __builtin_amdgcn_readfirstlane(tid >> 6), lane = tid & 63, r32 = lane & 31, hi = lane >> 5;
    const int j_lo = swa_jlo(cur.P0);
    int j_hi = (cur.P0 + QB - 1) / KVBLK + 1; if (j_hi > cur.skv() / KVBLK) j_hi = cur.skv() / KVBLK;
    const int NT = j_hi - j_lo;
    const int kbn = swa_jlo(nxt.P0) * KVBLK;
    const int qlo = cur.P0 + wid * QBLK, qm = qlo + r32 - 4 * hi;
    char* V_lds = lds; char* K_lds = lds + 2 * SHM_V;
    float* wsl = (float*)(lds + 2 * SHM_V + 2 * SHM_K) + wid * 64; float* li_l = wsl, * al_l = wsl + 32;
    const float* tbl0 = (const float*)(lds + LDS_TB + slot * 4096) + 325;
    float m_reg = -1e30f, l_reg = 0; f32x16 o[4] = {};
    const int vb0 = (int)(uintptr_t)V_lds + v_rd_base(lane);
    const bf16_t* Kh = cur.K; const bf16_t* Vh = cur.V(); const int rs = cur.rs();
#define RESC(a) do { if (__any((a) < 1.f)) { if (hi == 0) al_l[r32] = (a); asm volatile("s_waitcnt lgkmcnt(0)" ::: "memory");              \
                     _Pragma("unroll") for (int d_ = 0; d_ < 4; ++d_) _Pragma("unroll") for (int r = 0; r < 16; ++r) o[d_][r] *= al_l[crow(r, hi)]; } } while (0)
#define KBASE(t) ((j_lo + (t)) * KVBLK)
#define ACT(t) (KBASE(t) <= qlo + QBLK - 1 && KBASE(t) + KVBLK - 1 >= qlo - WIN + 1)
#define MASKT(P0_, P1_, t) do { const int kb_ = KBASE(t); if (ACT(t)) mask_bias_tile(P0_, P1_, qm - kb_, tbl0 + (qm - kb_)); } while (0)
    constexpr int NQL = 8;
#define SEAM_K0() do { VMWN(NQL); SWRITE_HK(0); SBAR(); } while (0)
    f32x16 pA0, pA1, pB0, pB1; float mnA, mnB, alA, alB; bf16x8 pa0, pa1, pa2, pa3;
    SWRITE_HV(0); SBAR();
    if (NT > 1) { SLOAD_H(Kh, Vh, KBASE(1), rs); }
    SBAR(); qkt<0>(pA0, pA1, K_lds, r32, hi, S.qr, ACT(0));
    MASKT(pA0, pA1, 0); partialSM(pA0, pA1, m_reg, mnA, alA);
    if (NT > 1) { VMW(); SWRITE_H(1); }
    __syncthreads();
#define HALF_STEP(PX0, PX1, mnX, alX, PY0, PY1, alY, t, KB, VB, SB) do {                                                      \
        SBAR(); qkt<KB>(PX0, PX1, K_lds, r32, hi, S.qr, ACT(t));                                             \
        finishSM(PY0, PY1, alY, l_reg, pa0, pa1, pa2, pa3); SBAR();                                                           \
        if ((t) + 1 < NT) { SLOAD_H(Kh, Vh, KBASE((t) + 1), rs); SBAR(); }                                               \
        pv_tile<VB>(o, vb0, pa0, pa1, pa2, pa3, ACT((t) - 1)); MASKT(PX0, PX1, (t)); partialSM(PX0, PX1, m_reg, mnX, alX);                                        \
        __syncthreads();                                                                                                      \
        if ((t) + 1 < NT) { VMW(); SWRITE_H(SB); }                                                                          \
        RESC(alX); __syncthreads(); } while (0)
    for (int t = 1; t + 1 < NT; t += 2) {
        HALF_STEP(pB0, pB1, mnB, alB, pA0, pA1, alA, t, 1, 0, 0);
        HALF_STEP(pA0, pA1, mnA, alA, pB0, pB1, alB, t + 1, 0, 1, 1);
    }
    const bool even = (NT & 1) == 0;
    if (even) { SBAR(); qkt<1>(pB0, pB1, K_lds, r32, hi, S.qr, ACT(NT - 1)); SBAR(); }
    SLOAD_H(nxt.K, nxt.V(), kbn, nxt.rs()); SBAR();
#pragma unroll
    for (int d0 = 0; d0 < 8; ++d0) S.qr[d0] = load8((const bf16_t*)((const char*)nxt.Q + (size_t)((unsigned)((wid * QBLK + r32) * nxt.rs() + hi * 8) * 2u)) + d0 * 16);
    SBAR();
    finishSM(pA0, pA1, alA, l_reg, pa0, pa1, pa2, pa3); SBAR();
    pv_tile<0>(o, vb0, pa0, pa1, pa2, pa3, ACT(even ? NT - 2 : NT - 1));
    if (even) { MASKT(pB0, pB1, NT - 1); partialSM(pB0, pB1, m_reg, mnB, alB); __syncthreads(); RESC(alB);
        finishSM(pB0, pB1, alB, l_reg, pa0, pa1, pa2, pa3); SBAR(); pv_tile<1>(o, vb0, pa0, pa1, pa2, pa3, ACT(NT - 1)); }
    SBAR(); SEAM_K0();
    float t0, t1; tb_load(biast, nxt.bh, nxt.dsh, tid, t0, t1);
    if (hi == 0) li_l[r32] = l_reg; asm volatile("s_waitcnt lgkmcnt(0)" ::: "memory");
    int r32e = r32, hie = hi; asm volatile("" : "+v"(r32e), "+v"(hie));
    if (hie == 0) cur.LSE[(size_t)(wid * QBLK + r32e) * cur.ls()] = m_reg * SCALE + __logf(l_reg);
    float rli[16];
#pragma unroll
    for (int r = 0; r < 16; ++r) rli[r] = __builtin_amdgcn_rcpf(li_l[crow(r, hie)]);
    const int os = cur.os();
    bf16_t* Ow = cur.O + (size_t)(wid * QBLK) * os;
#pragma unroll
    for (int r = 0; r < 16; ++r) { const unsigned oo = (unsigned)(crow(r, hie) * os + r32e) * 2u;
#pragma unroll
        for (int d0 = 0; d0 < 4; ++d0) { const float v = o[d0][r] * rli[r];
            const float vn = swz_xor<1>(v);
            if ((r32e & 1) == 0) *(unsigned*)((char*)Ow + oo + d0 * 64) = cvt_pk_bf16(v, vn); } }
    { float* tb = (float*)(lds + LDS_TB + (slot ^ 1) * 4096); tb[tid] = t0; tb[tid + 512] = t1; }
    __syncthreads();
#undef RESC
#undef KBASE
#undef ACT
#undef MASKT
#undef SEAM_K0
#undef HALF_STEP
}
#undef ROWP
#undef VMW
#undef VMWN
#undef SLOAD_H
#undef SWRITE_HK
#undef SWRITE_HV
#undef SWRITE_H
#undef TIDL
#undef KSWZ
#undef SBAR
}


namespace dsa {
constexpr int D = 64, NW = 8, QBLK = 32, KVBLK = 64, QB = NW * QBLK;
constexpr int SHM_V = KVBLK * D * 2, SHM_K = KVBLK * D * 2;
constexpr int LDS_TB = 2 * SHM_V + 2 * SHM_K + NW * 64 * 4;
constexpr int TB_PAD = 128;
constexpr float SCALE = 0.125f, THR = 8.f;
typedef float f32x16 __attribute__((ext_vector_type(16)));
typedef short s16x4 __attribute__((ext_vector_type(4)));
#define KSWZ(row, colB) ((row) * 128 + ((colB) ^ (((row) & 7) << 4)))
#define SBAR() __builtin_amdgcn_sched_barrier(0)
__device__ __forceinline__ int v_st(int k, int c) { const int kk = (k & ~0xC) | ((k & 4) << 1) | ((k & 8) >> 1); return ((kk >> 3) * 2 + (c >> 5)) * 512 + ((kk & 7) * 32 + (c & 31)) * 2; }
__device__ __forceinline__ int v_rd_base(int lane) { return ((lane & 3) << 3) | (((lane >> 2) & 3) << 6) | (((lane >> 4) & 1) << 5) | (((lane >> 5) & 1) << 8); }
__device__ __forceinline__ int crow(int r, int hi) { return (r & 3) + 8 * (r >> 2) + 4 * hi; }
__device__ __forceinline__ bf16x8 load8(const bf16_t* p) { return *reinterpret_cast<const bf16x8*>(p); }
__device__ __forceinline__ void mask_bias_tile(f32x16& p0, f32x16& p1, const float* tb, unsigned lo4, unsigned hi4) {
    const float NEG = -__builtin_inff();
#pragma unroll
    for (int r = 0; r < 16; ++r) {
        const int c = (r & 3) + 8 * (r >> 2);
        p0[r] = ((lo4 >> c) & 1u) ? p0[r] + tb[63 - c] : NEG;
        p1[r] = ((hi4 >> c) & 1u) ? p1[r] + tb[31 - c] : NEG;
    }
}
__device__ __forceinline__ void partialSM(f32x16& p0, f32x16& p1, float& m_reg, float& mn, float& alpha) {
    float pmax = p0[0];
#pragma unroll
    for (int r = 1; r < 16; ++r) pmax = fmaxf(pmax, p0[r]);
#pragma unroll
    for (int r = 0; r < 16; ++r) pmax = fmaxf(pmax, p1[r]);
    { auto rr = __builtin_amdgcn_permlane32_swap(__float_as_uint(pmax), __float_as_uint(pmax), false, false);
      pmax = fmaxf(__uint_as_float(rr[0]), __uint_as_float(rr[1])); }
    constexpr float C2 = 1.4426950408889634f * SCALE;
    if (__builtin_expect(__all((pmax - m_reg) * SCALE <= THR), 1)) { mn = m_reg; alpha = 1.f; }
    else { mn = fmaxf(m_reg, pmax); alpha = __builtin_amdgcn_exp2f((m_reg - mn) * C2); m_reg = mn; }
    const float mnL = -mn * C2;
#pragma unroll
    for (int r = 0; r < 16; ++r) p0[r] = fmaf(p0[r], C2, mnL);
#pragma unroll
    for (int r = 0; r < 16; ++r) p1[r] = fmaf(p1[r], C2, mnL);
#pragma unroll
    for (int r = 0; r < 16; ++r) p0[r] = __builtin_amdgcn_exp2f(p0[r]);
}
__device__ __forceinline__ void finishSM(f32x16& p0, f32x16& p1, float alpha, float& l_reg, bf16x8& pa0, bf16x8& pa1, bf16x8& pa2, bf16x8& pa3) {
#pragma unroll
    for (int r = 0; r < 16; ++r) p1[r] = __builtin_amdgcn_exp2f(p1[r]);
    float ps = 0;
#pragma unroll
    for (int r = 0; r < 16; ++r) ps += p0[r];
#pragma unroll
    for (int r = 0; r < 16; ++r) ps += p1[r];
    { auto rr = __builtin_amdgcn_permlane32_swap(__float_as_uint(ps), __float_as_uint(ps), false, false);
      ps = __uint_as_float(rr[0]) + __uint_as_float(rr[1]); }
    l_reg = l_reg * alpha + ps;
#define PK4(P, B_, OUT) do { unsigned a0 = cvt_pk_bf16(P[B_+0], P[B_+1]), a1 = cvt_pk_bf16(P[B_+2], P[B_+3]);                          \
        unsigned b0 = cvt_pk_bf16(P[B_+4], P[B_+5]), b1 = cvt_pk_bf16(P[B_+6], P[B_+7]);                                             \
        auto r0 = __builtin_amdgcn_permlane32_swap(a0, b0, false, false); auto r1 = __builtin_amdgcn_permlane32_swap(a1, b1, false, false); \
        u32x4 w = {r0[0], r1[0], r0[1], r1[1]}; OUT = *reinterpret_cast<bf16x8*>(&w); } while (0)
    PK4(p0, 0, pa0); PK4(p0, 8, pa1); PK4(p1, 0, pa2); PK4(p1, 8, pa3);
#undef PK4
}
template <int KB>
__device__ __forceinline__ void qkt(f32x16& p0, f32x16& p1, const char* K_lds, int r32, int hi, const bf16x8* qr, bool act) {
    if (!act) { const float NEG = -__builtin_inff();
#pragma unroll
        for (int r = 0; r < 16; ++r) { p0[r] = NEG; p1[r] = NEG; } return; }
    p0 = f32x16{}; p1 = f32x16{};
#pragma unroll
    for (int d0 = 0; d0 < 4; ++d0) { const char* a = K_lds + KB * SHM_K + KSWZ(r32, (d0 * 16 + hi * 8) * 2);
        bf16x8 b0 = *reinterpret_cast<const bf16x8*>(a);
        bf16x8 b1 = *reinterpret_cast<const bf16x8*>(a + 32 * 128);
        p0 = __builtin_amdgcn_mfma_f32_32x32x16_bf16(b0, qr[d0], p0, 0, 0, 0);
        p1 = __builtin_amdgcn_mfma_f32_32x32x16_bf16(b1, qr[d0], p1, 0, 0, 0); }
}
template <int VB>
__device__ __forceinline__ void pv_tile(f32x16* o, int vb0, bf16x8 pa0, bf16x8 pa1, bf16x8 pa2, bf16x8 pa3, bool act) {
    if (!act) return;
#define TRRD(dst, off) asm volatile("ds_read_b64_tr_b16 %0, %1 offset:%2" : "=&v"(dst) : "v"(vb0), "i"(off) : "memory")
#define PV_D0(d0) do { s16x4 l0, l1, l2, l3, h0, h1, h2, h3; constexpr int b_ = VB * SHM_V + (d0) * 512; \
        TRRD(l0, b_); TRRD(h0, b_ + 1024); TRRD(l1, b_ + 2048); TRRD(h1, b_ + 3072); TRRD(l2, b_ + 4096); TRRD(h2, b_ + 5120); TRRD(l3, b_ + 6144); TRRD(h3, b_ + 7168); \
        asm volatile("s_waitcnt lgkmcnt(0)" ::: "memory"); SBAR();   \
        o[d0] = __builtin_amdgcn_mfma_f32_32x32x16_bf16(pa0, (bf16x8){l0[0], l0[1], l0[2], l0[3], h0[0], h0[1], h0[2], h0[3]}, o[d0], 0, 0, 0);   \
        o[d0] = __builtin_amdgcn_mfma_f32_32x32x16_bf16(pa1, (bf16x8){l1[0], l1[1], l1[2], l1[3], h1[0], h1[1], h1[2], h1[3]}, o[d0], 0, 0, 0);   \
        o[d0] = __builtin_amdgcn_mfma_f32_32x32x16_bf16(pa2, (bf16x8){l2[0], l2[1], l2[2], l2[3], h2[0], h2[1], h2[2], h2[3]}, o[d0], 0, 0, 0);   \
        o[d0] = __builtin_amdgcn_mfma_f32_32x32x16_bf16(pa3, (bf16x8){l3[0], l3[1], l3[2], l3[3], h3[0], h3[1], h3[2], h3[3]}, o[d0], 0, 0, 0); } while (0)
    PV_D0(0); PV_D0(1);
#undef PV_D0
#undef TRRD
}
struct BlockRef { const bf16_t* Q; const bf16_t* K; const bf16_t* V; bf16_t* O; const u64* MW; int P0; };
struct Seam { bf16x8 qr[4]; bf16x8 st_v0, st_k0; u64 mw; };
#define VMW() asm volatile("s_waitcnt vmcnt(0)" ::: "memory")
#define VMWN(n) asm volatile("s_waitcnt vmcnt(%0)" :: "i"(n) : "memory")
#define TIDL() int tid_l = tid; asm volatile("" : "+v"(tid_l)); const int sr = tid_l >> 3, sc = (tid_l & 7) * 8; (void)sr; (void)sc
#define SLOAD_H(Kp, Vp, k0) do { TIDL(); const unsigned vo_ = (unsigned)((k0 + sr) * 512 + sc) * 2u; \
        S.st_v0 = load8((const bf16_t*)((const char*)(Vp) + vo_)); S.st_k0 = load8((const bf16_t*)((const char*)(Kp) + vo_)); } while (0)
#define SWRITE_HK(bf) do { TIDL(); *(bf16x8*)(K_lds + (bf) * SHM_K + KSWZ(sr, sc * 2)) = S.st_k0; } while (0)
#define SWRITE_HV(bf) do { TIDL(); *(bf16x8*)(V_lds + (bf) * SHM_V + v_st(sr, sc)) = S.st_v0; } while (0)
#define SWRITE_H(bf) do { SWRITE_HV(bf); SWRITE_HK(bf); } while (0)
#define MWLOAD(ref, tile) ((ref).MW[(size_t)(tile) * SEQ + wid * QBLK + r32])
__device__ __forceinline__ void dsa_prime(const BlockRef& cur, char* lds, Seam& S, int tid) {
    const int wid = __builtin_amdgcn_readfirstlane(tid >> 6), lane = tid & 63, r32 = lane & 31, hi = lane >> 5;
    char* K_lds = lds + 2 * SHM_V;
#pragma unroll
    for (int d0 = 0; d0 < 4; ++d0) S.qr[d0] = load8(cur.Q + (size_t)(wid * QBLK + r32) * 512 + d0 * 16 + hi * 8);
    S.mw = MWLOAD(cur, 0);
    SLOAD_H(cur.K, cur.V, 0); VMW(); SWRITE_HK(0);
    __syncthreads();
}
__device__ __forceinline__ void dsa_block(const BlockRef& cur, const BlockRef& nxt, char* lds, Seam& S, int tid) {
    const int wid = __builtin_amdgcn_readfirstlane(tid >> 6), lane = tid & 63, r32 = lane & 31, hi = lane >> 5;
    const int NT = (cur.P0 + QB - 1) / KVBLK + 1;
    const int qlo = cur.P0 + wid * QBLK, qm = qlo + r32 - 4 * hi;
    char* V_lds = lds; char* K_lds = lds + 2 * SHM_V;
    float* wsl = (float*)(lds + 2 * SHM_V + 2 * SHM_K) + wid * 64; float* li_l = wsl, * al_l = wsl + 32;
    const float* tbl0 = (const float*)(lds + LDS_TB) + (TB_PAD - 63);
    float m_reg = -1e30f, l_reg = 0; f32x16 o[2] = {};
    const int vb0 = (int)(uintptr_t)V_lds + v_rd_base(lane);
    const bf16_t* Kh = cur.K; const bf16_t* Vh = cur.V;
#define RESC(a) do { if (__any((a) < 1.f)) { if (hi == 0) al_l[r32] = (a); asm volatile("s_waitcnt lgkmcnt(0)" ::: "memory");              \
                     _Pragma("unroll") for (int d_ = 0; d_ < 2; ++d_) _Pragma("unroll") for (int r = 0; r < 16; ++r) o[d_][r] *= al_l[crow(r, hi)]; } } while (0)
#define KBASE(t) ((t) * KVBLK)
#define ACT(t) (KBASE(t) <= qlo + QBLK - 1)
#define MASKT(P0_, P1_, t, MWX) do { const int kb_ = KBASE(t); if (ACT(t)) mask_bias_tile(P0_, P1_, tbl0 + (qm - kb_), (unsigned)(MWX) >> (4 * hi), (unsigned)((MWX) >> 32) >> (4 * hi)); } while (0)
    constexpr int NQL = 5;
#define SEAM_K0() do { VMWN(NQL); SWRITE_HK(0); SBAR(); } while (0)
    f32x16 pA0, pA1, pB0, pB1; float mnA, mnB, alA, alB; bf16x8 pa0, pa1, pa2, pa3;
    u64 mwA = S.mw, mwB = 0;
    SWRITE_HV(0); SBAR();
    if (NT > 1) { SLOAD_H(Kh, Vh, KBASE(1)); mwB = MWLOAD(cur, 1); }
    SBAR(); qkt<0>(pA0, pA1, K_lds, r32, hi, S.qr, ACT(0));
    MASKT(pA0, pA1, 0, mwA); partialSM(pA0, pA1, m_reg, mnA, alA);
    if (NT > 1) { VMW(); SWRITE_H(1); }
    __syncthreads();
#define HALF_STEP(PX0, PX1, mnX, alX, PY0, PY1, alY, t, KB, VB, SB, MWX, MWY) do {                                                      \
        SBAR(); qkt<KB>(PX0, PX1, K_lds, r32, hi, S.qr, ACT(t));                                             \
        finishSM(PY0, PY1, alY, l_reg, pa0, pa1, pa2, pa3); SBAR();                                                           \
        if ((t) + 1 < NT) { SLOAD_H(Kh, Vh, KBASE((t) + 1)); MWY = MWLOAD(cur, (t) + 1); SBAR(); }                                               \
        pv_tile<VB>(o, vb0, pa0, pa1, pa2, pa3, ACT((t) - 1)); MASKT(PX0, PX1, (t), MWX); partialSM(PX0, PX1, m_reg, mnX, alX);                                        \
        __syncthreads();                                                                                                      \
        if ((t) + 1 < NT) { VMW(); SWRITE_H(SB); }                                                                          \
        RESC(alX); __syncthreads(); } while (0)
    for (int t = 1; t + 1 < NT; t += 2) {
        HALF_STEP(pB0, pB1, mnB, alB, pA0, pA1, alA, t, 1, 0, 0, mwB, mwA);
        HALF_STEP(pA0, pA1, mnA, alA, pB0, pB1, alB, t + 1, 0, 1, 1, mwA, mwB);
    }
    const bool even = (NT & 1) == 0;
    if (even) { SBAR(); qkt<1>(pB0, pB1, K_lds, r32, hi, S.qr, ACT(NT - 1)); SBAR(); }
    SLOAD_H(nxt.K, nxt.V, 0); SBAR();
#pragma unroll
    for (int d0 = 0; d0 < 4; ++d0) S.qr[d0] = load8(nxt.Q + (size_t)(wid * QBLK + r32) * 512 + d0 * 16 + hi * 8);
    S.mw = MWLOAD(nxt, 0);
    SBAR();
    finishSM(pA0, pA1, alA, l_reg, pa0, pa1, pa2, pa3); SBAR();
    pv_tile<0>(o, vb0, pa0, pa1, pa2, pa3, ACT(even ? NT - 2 : NT - 1));
    if (even) { MASKT(pB0, pB1, NT - 1, mwB); partialSM(pB0, pB1, m_reg, mnB, alB); __syncthreads(); RESC(alB);
        finishSM(pB0, pB1, alB, l_reg, pa0, pa1, pa2, pa3); SBAR(); pv_tile<1>(o, vb0, pa0, pa1, pa2, pa3, ACT(NT - 1)); }
    SBAR(); SEAM_K0();
    if (hi == 0) li_l[r32] = l_reg; asm volatile("s_waitcnt lgkmcnt(0)" ::: "memory");
    int r32e = r32, hie = hi; asm volatile("" : "+v"(r32e), "+v"(hie));
    float rli[16];
#pragma unroll
    for (int r = 0; r < 16; ++r) rli[r] = __builtin_amdgcn_rcpf(li_l[crow(r, hie)]);
    bf16_t* Ow = cur.O + (size_t)(wid * QBLK) * DM;
#pragma unroll
    for (int r = 0; r < 16; ++r) { const unsigned oo = (unsigned)(crow(r, hie) * DM + r32e) * 2u;
#pragma unroll
        for (int d0 = 0; d0 < 2; ++d0) { const float v = o[d0][r] * rli[r];
            const float vn = swz_xor<1>(v);
            if ((r32e & 1) == 0) *(unsigned*)((char*)Ow + oo + d0 * 64) = cvt_pk_bf16(v, vn); } }
    __syncthreads();
#undef RESC
#undef KBASE
#undef ACT
#undef MASKT
#undef SEAM_K0
#undef HALF_STEP
}
#undef VMW
#undef VMWN
#undef TIDL
#undef SLOAD_H
#undef SWRITE_HK
#undef SWRITE_HV
#undef SWRITE_H
#undef MWLOAD
#undef KSWZ
#undef SBAR
}

__device__ __forceinline__ swa::BlockRef dil_ref(int u, const bf16_t* H1p, bf16_t* OPp, float* LSEp) {
    const int x = u & 15, rest = u >> 4, g = rest % 3, bh = rest / 3, h = bh & 7, bl = bh >> 3;
    const int dsh = 2 * g, dil = 1 << dsh, r = x >> (4 - dsh), blk = x & ((16 >> dsh) - 1), P0 = blk * 256;
    const size_t row0 = (size_t)bl * SEQ + r, rowq = row0 + (size_t)dil * P0;
    swa::BlockRef R;
    R.K = H1p + row0 * IN1_N + g * 3072 + 1024 + h * 128; R.Q = H1p + rowq * IN1_N + g * 3072 + h * 128;
    R.O = OPp + ((size_t)g * CHUNK_T + rowq) * DM + h * 128; R.LSE = LSEp + ((size_t)g * CHUNK_T + rowq) * 8 + h;
    R.P0 = P0; R.bh = h; R.dsh = dsh;
    return R;
}

struct Args {
    const float* in[25]; float* out; unsigned char* ws; int ph_lo, ph_hi;
};
enum { I_X = 0, I_RELB, I_EWIN, I_CONVW, I_CONVB, I_CLNG, I_CLNB, I_EWOUT, I_ELN1G, I_ELN1B, I_FWG, I_FWU, I_FWD, I_ELN2G, I_ELN2B,
       I_OWIN, I_OWOUT, I_OLN1G, I_OLN1B, I_ROUTER, I_MWG, I_MWU, I_MWD, I_OLN2G, I_OLN2B };

__device__ __forceinline__ void transpose_item(const float* W, int ldw, int src_c0, int nvalid, int k0, bf16_t* WT, int K, int dst_row0, LAS float* scr, int lane) {
#pragma unroll 8
    for (int i = 0; i < 32; ++i) { const int kk = 2 * i + (lane >> 5), j = lane & 31; scr[kk * 33 + j] = (j < nvalid) ? W[(size_t)(k0 + kk) * ldw + src_c0 + j] : 0.f; }
    WAVE_LDS_FENCE();
    const int c = lane & 7;
#pragma unroll
    for (int jj = 0; jj < 4; ++jj) { const int n = (lane >> 3) + 8 * jj; const LAS float* s = scr + (8 * c) * 33 + n;
        u32x4 o; o.x = cvt_pk_bf16(s[0 * 33], s[1 * 33]); o.y = cvt_pk_bf16(s[2 * 33], s[3 * 33]); o.z = cvt_pk_bf16(s[4 * 33], s[5 * 33]); o.w = cvt_pk_bf16(s[6 * 33], s[7 * 33]);
        *(u32x4*)(WT + (size_t)(dst_row0 + n) * K + k0 + 8 * c) = o; }
    WAVE_LDS_FENCE();
}
__device__ __forceinline__ void gu_item(const float* wg, const float* wu, int FF, int K, bf16_t* WT, int item, LAS float* scr, int lane) {
    const int nblk = 2 * FF / 32, kb = item / nblk, nb = item % nblk, tile = nb >> 3, sub = nb & 7;
    transpose_item(sub < 4 ? wg : wu, FF, tile * 128 + (sub & 3) * 32, 32, kb * 64, WT, K, nb * 32, scr, lane);
}
__device__ __forceinline__ void plain_item(const float* W, int K, int N, bf16_t* WT, int item, LAS float* scr, int lane) {
    const int nblk = N / 32, kb = item / nblk, nb = item % nblk;
    transpose_item(W, N, nb * 32, 32, kb * 64, WT, K, nb * 32, scr, lane);
}
__device__ __forceinline__ void in0_item(const float* W, bf16_t* WT, int item, LAS float* scr, int lane) {
    const int nblk = IN0_N / 32, kb = item / nblk, nb = item % nblk, tile = nb >> 3, sub = nb & 7;
    int src_c0, nvalid = 32;
    if (tile < 4) src_c0 = (sub < 4) ? tile * 128 + sub * 32 : 512 + tile * 128 + (sub - 4) * 32;
    else { src_c0 = nb * 32; nvalid = IN0_SRC - src_c0; nvalid = nvalid < 0 ? 0 : (nvalid > 32 ? 32 : nvalid); if (nvalid == 0) src_c0 = 0; }
    transpose_item(W, IN0_SRC, src_c0, nvalid, kb * 64, WT, DM, nb * 32, scr, lane);
}
__device__ __forceinline__ int rel_bucket(int n) {
    if (n < 16) return n;
    const float nf = (float)n;
    int large = 16 + (int)(logf(nf / 16.0f) / logf(128.0f) * 16.0f);
    return large < 31 ? large : 31;
}

__device__ __forceinline__ void ln_core(f32x4 (&v)[4], const float* g, const float* b, int lane) {
    float s = 0.f;
#pragma unroll
    for (int j = 0; j < 4; ++j) s += (v[j][0] + v[j][1]) + (v[j][2] + v[j][3]);
    const float mean = wave_sum(s) * (1.f / DM); float s2 = 0.f;
#pragma unroll
    for (int j = 0; j < 4; ++j) { v[j] = v[j] - mean; s2 += (v[j][0] * v[j][0] + v[j][1] * v[j][1]) + (v[j][2] * v[j][2] + v[j][3] * v[j][3]); }
    const float rstd = 1.f / sqrtf(wave_sum(s2) * (1.f / DM) + LN_EPS);
#pragma unroll
    for (int j = 0; j < 4; ++j) { const f32x4 gg = *(const f32x4*)(g + 4 * lane + 256 * j), bb = *(const f32x4*)(b + 4 * lane + 256 * j); v[j] = v[j] * rstd * gg + bb; }
}
__device__ __forceinline__ void store_row_bf16(bf16_t* orow, const f32x4 (&v)[4], int lane) {
#pragma unroll
    for (int j = 0; j < 4; ++j) { u32x2 w; w.x = cvt_pk_bf16(v[j][0], v[j][1]); w.y = cvt_pk_bf16(v[j][2], v[j][3]); *(u32x2*)(orow + 4 * lane + 256 * j) = w; }
}
__device__ __forceinline__ f32x4 ld_bf4(const bf16_t* p) { const u32x2 w = *(const u32x2*)p; return (f32x4){bf_lo(w.x), bf_hi(w.x), bf_lo(w.y), bf_hi(w.y)}; }

__device__ __forceinline__ int my_lane_asm() { int l; asm volatile("v_mbcnt_lo_u32_b32 %0, -1, 0\n\tv_mbcnt_hi_u32_b32 %0, -1, %0" : "=v"(l)); return l; }
__global__ void __launch_bounds__(NTHR, 2) fwd_kernel(Args args) {
    extern __shared__ __attribute__((aligned(16))) unsigned char lds_raw[];
    LAS unsigned char* lds = (LAS unsigned char*)lds_raw;
    const int G = gridDim.x, bid = blockIdx.x;
    const int NGW = G * NWAVES;
    volatile LAS unsigned* MISC = (volatile LAS unsigned*)(lds + LDS_MISC);
    int wave_id;
    {
        const int l0 = my_lane_asm();
        if (l0 < 16) MISC[l0] = 0u;
        __syncthreads();
        unsigned id = 0u; if (l0 == 0) id = atomicAdd((unsigned*)(MISC + 2), 1u);
        wave_id = __builtin_amdgcn_readfirstlane((int)id);
        __syncthreads();
    }
#define MY_LANE() my_lane_asm()
#if ONE_LAUNCH
    (void)xcd_barrier_post((unsigned*)(args.ws + WS_CTL) + CW_BAR, MISC, wave_id == 0 && MY_LANE() == 0);
#define GRID_BAR() do { XcdBarrier _b; _b.bar = (unsigned*)(ws + WS_CTL) + CW_BAR; _b.x = xb_xcc_id(); _b.st = (volatile LAS unsigned*)(lds + LDS_MISC); xcd_barrier(_b, tid == 0); } while (0)
#else
#define GRID_BAR() do { } while (0)
#endif
    const int lo = args.ph_lo, hi = args.ph_hi;
#ifndef PH_MASK
#define PH_MASK 0xFFFFFFu
#endif
#define IN(k) ((((PH_MASK) >> (k)) & 1u) && lo <= (k) && (k) < hi)
#define BOTH(k) (IN(k) && IN((k) + 1))
#define PHASE_BEGIN int lane = MY_LANE(); asm volatile("" : "+v"(lane)); const int wave = wave_id; const int tid = wave * 64 + lane; const int gw = bid * NWAVES + wave; \
    size_t zoff_ = 0; asm volatile("" : "+s"(zoff_)); unsigned char* ws = args.ws + zoff_; float* outp = (float*)((unsigned char*)args.out + zoff_); unsigned* ctl = (unsigned*)(ws + WS_CTL); (void)lane; (void)wave; (void)gw; (void)ctl; (void)outp;
#define x_in (args.in[I_X])
#define WIN0 ((bf16_t*)(ws + WS_WIN0))
#define WOUT0 ((bf16_t*)(ws + WS_WOUT0))
#define WGU0 ((bf16_t*)(ws + WS_WGU0))
#define WD0 ((bf16_t*)(ws + WS_WD0))
#define WIN1 ((bf16_t*)(ws + WS_WIN1))
#define WOUT1 ((bf16_t*)(ws + WS_WOUT1))
#define MWGU ((bf16_t*)(ws + WS_MWGU))
#define MWD ((bf16_t*)(ws + WS_MWD))
#define BIAST ((float*)(ws + WS_BIAST))
#define XB ((bf16_t*)(ws + WS_XB))
#define Ub ((bf16_t*)(ws + WS_U))
#define Q0 ((bf16_t*)(ws + WS_Q0))
#define K0 ((bf16_t*)(ws + WS_Q0 + SEG0))
#define V0 ((bf16_t*)(ws + WS_Q0 + 2 * SEG0))
#define QI ((bf16_t*)(ws + WS_Q0 + 3 * SEG0))
#define KI ((bf16_t*)(ws + WS_KI))
#define WI ((float*)(ws + WS_WI))
#define MASK ((u64*)(ws + WS_MASK))
#define MIXIN ((bf16_t*)(ws + WS_MIXIN))
#define X1B ((bf16_t*)(ws + WS_X1B))
#define H0 ((bf16_t*)(ws + WS_H0))
#define X2B ((bf16_t*)(ws + WS_X2B))
#define H1 ((bf16_t*)(ws + WS_H1))
#define O1 ((bf16_t*)outp)
#define Y3 ((float*)(ws + WS_Y3))
#define X3B ((bf16_t*)(ws + WS_X3B))
#define YB ((bf16_t*)(ws + WS_YB))
#define MTOK ((int*)(ws + WS_MOE_TOK))
#define MGATE ((float*)(ws + WS_MOE_GATE))
#define GTAB ((const LAS int*)(lds + LDS_GTAB))

    if (IN(0)) { asm volatile("; PHASE_MARK 0"); PHASE_BEGIN
        LAS float* scr = (LAS float*)(lds + wave * 16384);
        constexpr int I_IN0 = 16 * (IN0_N / 32), I_OUT = 16 * 32, I_GU0 = 16 * (2 * FF0 / 32), I_D0 = (FF0 / 64) * 32, I_IN1 = 16 * (IN1_N / 32);
        constexpr int NIT = I_IN0 + I_OUT + I_GU0 + I_D0 + I_IN1 + I_OUT;
        for (int it = gw; it < NIT; it += NGW) {
            int r = it;
            if (r < I_IN0) { in0_item(args.in[I_EWIN], WIN0, r, scr, lane); continue; } r -= I_IN0;
            if (r < I_OUT) { plain_item(args.in[I_EWOUT], DM, DM, WOUT0, r, scr, lane); continue; } r -= I_OUT;
            if (r < I_GU0) { gu_item(args.in[I_FWG], args.in[I_FWU], FF0, DM, WGU0, r, scr, lane); continue; } r -= I_GU0;
            if (r < I_D0) { plain_item(args.in[I_FWD], FF0, DM, WD0, r, scr, lane); continue; } r -= I_D0;
            if (r < I_IN1) { plain_item(args.in[I_OWIN], DM, IN1_N, WIN1, r, scr, lane); continue; } r -= I_IN1;
            plain_item(args.in[I_OWOUT], DM, DM, WOUT1, r, scr, lane);
        }
        for (size_t i = (size_t)bid * NTHR + tid; i < (size_t)NTOK * DM / 8; i += (size_t)G * NTHR) {
            const f32x4 a = *(const f32x4*)(x_in + i * 8), b = *(const f32x4*)(x_in + i * 8 + 4);
            *(u32x4*)(XB + i * 8) = pg8::pack8(a, b);
        }
        for (int i = bid * NTHR + tid; i < 8 * 4096; i += G * NTHR) { const int h = i >> 12, d = i & 4095; BIAST[i] = args.in[I_RELB][rel_bucket(d) * 8 + h]; }
        if (BOTH(0)) GRID_BAR();
    }

    if (IN(1)) { asm volatile("; PHASE_MARK 1"); PHASE_BEGIN
        pg8::StaticOrder S; S.init(XB, NTOK, IN0_N, DM, G, bid);
        pg8::EpiIn0 E{Ub, Q0, KI, WI};
        pg8::gemm_phase<pg8::EpiIn0, pg8::StaticOrder, true, false>(tid, lds, WIN0, DM, S, E, GTAB);
        if (BOTH(1)) GRID_BAR();
    }

    if (IN(2)) { asm volatile("; PHASE_MARK 2"); PHASE_BEGIN
        {
            LAS bf16_t* ut = (LAS bf16_t*)lds;
            LAS float* yt = (LAS float*)(lds + 65536);
            const float* cw = args.in[I_CONVW]; const int c = tid;
            float w[31];
#pragma unroll
            for (int j = 0; j < 31; ++j) w[j] = cw[j * 512 + c];
            const float cb = args.in[I_CONVB][c];
            for (int tile = bid; tile < NTOK / 32; tile += G) {
                const int t0 = tile * 32, s0 = t0 & (SEQ - 1);
                for (int i = tid; i < 62 * 64; i += NTHR) { const int r = i >> 6, c8 = i & 63; const int sr = s0 - 30 + r;
                    u32x4 v = (u32x4){0u, 0u, 0u, 0u}; if (sr >= 0) v = *(const u32x4*)(Ub + (size_t)(t0 - 30 + r) * 512 + c8 * 8);
                    *(LAS u32x4*)(ut + r * 512 + c8 * 8) = v; }
                __syncthreads();
                for (int t = 0; t < 32; ++t) { float a = cb;
#pragma unroll
                    for (int j = 0; j < 31; ++j) a += w[j] * bf2f(ut[(t + j) * 512 + c]);
                    yt[t * 512 + c] = a; }
                __syncthreads();
                const float* lg = args.in[I_CLNG]; const float* lb = args.in[I_CLNB];
#pragma unroll
                for (int tt = 0; tt < 4; ++tt) { const int t = wave * 4 + tt;
                    f32x4 a = *(LAS f32x4*)(yt + t * 512 + lane * 8), b = *(LAS f32x4*)(yt + t * 512 + lane * 8 + 4);
                    float s = (a[0] + a[1]) + (a[2] + a[3]) + (b[0] + b[1]) + (b[2] + b[3]); const float mean = wave_sum(s) * (1.f / 512.f);
                    a = a - mean; b = b - mean; float s2 = a[0] * a[0] + a[1] * a[1] + a[2] * a[2] + a[3] * a[3] + b[0] * b[0] + b[1] * b[1] + b[2] * b[2] + b[3] * b[3];
                    const float rstd = 1.f / sqrtf(wave_sum(s2) * (1.f / 512.f) + LN_EPS);
                    const f32x4 g0 = *(const f32x4*)(lg + lane * 8), g1 = *(const f32x4*)(lg + lane * 8 + 4), b0 = *(const f32x4*)(lb + lane * 8), b1 = *(const f32x4*)(lb + lane * 8 + 4);
                    a = a * rstd * g0 + b0; b = b * rstd * g1 + b1;
#pragma unroll
                    for (int j = 0; j < 4; ++j) { a[j] = a[j] * sigmoidf_(a[j]); b[j] = b[j] * sigmoidf_(b[j]); }
                    *(u32x4*)(MIXIN + (size_t)(t0 + t) * DM + lane * 8) = pg8::pack8(a, b); }
                __syncthreads();
            }
        }
        {
            constexpr int CAP = 512;
            LAS unsigned char* kbuf = lds;
            LAS unsigned* hist = (LAS unsigned*)(lds + 65536);
            LAS unsigned* clist = hist;
            LAS unsigned* mtile = (LAS unsigned*)(lds + 131072);
            LAS unsigned* rinfo = (LAS unsigned*)(lds + 131072 + 8192);
            LAS unsigned* ccnt = rinfo + 64;
            LAS unsigned* flag = rinfo + 80;
            LAS unsigned* rsel = rinfo + 96;
            LAS unsigned* whist = (LAS unsigned*)lds + wave * 256;
            const int vcu = (G % 8 == 0) ? (bid % 8) * (G / 8) + bid / 8 : bid;
            const int g4 = lane >> 4, r16 = lane & 15;
            for (int it = 0; it < 8 && vcu < 256; ++it) {
                const int b = it, qt = (it & 1) ? 255 - vcu : vcu;
                const int q0 = qt * 16, tok0 = b * SEQ + q0, nwords = (q0 + 15) / 64 + 1, nch = (nwords + 3) >> 2, q = q0 + r16;
                if (q0 < 256) {
                    for (int i = tid; i < 16 * nwords; i += NTHR) { const int r = i & 15, W = i >> 4; const int d = q0 + r - 64 * W;
                        const u64 word = d >= 63 ? ~0ull : (d < 0 ? 0ull : ((2ull << d) - 1ull));
                        MASK[((size_t)b * 64 + W) * SEQ + q0 + r] = word; }
                    continue;
                }
                bf16x8 Qf[8][2]; float wq[8];
#pragma unroll
                for (int h = 0; h < 8; ++h)
#pragma unroll
                    for (int c2 = 0; c2 < 2; ++c2) Qf[h][c2] = *(const bf16x8*)(QI + (size_t)(tok0 + r16) * 512 + h * 64 + c2 * 32 + g4 * 8);
                { const f32x4 w0 = *(const f32x4*)(WI + (size_t)(tok0 + r16) * 8), w1 = *(const f32x4*)(WI + (size_t)(tok0 + r16) * 8 + 4);
                  wq[0] = w0[0]; wq[1] = w0[1]; wq[2] = w0[2]; wq[3] = w0[3]; wq[4] = w1[0]; wq[5] = w1[1]; wq[6] = w1[2]; wq[7] = w1[3]; }
                for (int i = tid; i < 16 * 64 * 2; i += NTHR) mtile[i] = 0u;
                if (tid < 16) ccnt[tid] = 0u;
                unsigned prefix = 0u; int shift = 21, shift_prev = 32, level = 0; bool collect = false;
#define KDMA(c_) do { _Pragma("unroll") for (int k_ = 0; k_ < 4; ++k_) { const int wc_ = wave * 4 + k_; const int kl_ = lane >> 3, cp_ = lane & 7; \
                    const bf16_t* src_ = KI + ((size_t)b * SEQ + (c_) * 256 + wc_ * 8 + kl_) * 64 + ((cp_ ^ kl_) * 8); \
                    __builtin_amdgcn_global_load_lds((const unsigned*)src_, (LAS unsigned*)(kbuf + ((c_) & 1) * 32768 + wc_ * 1024), 16, 0, 0); } } while (0)
                for (int pass = 0; pass < 4; ++pass) {
                    if (!collect) { for (int i = tid; i < 16 * 1024; i += NTHR) hist[i] = 0u; if (tid < 4) flag[tid] = 0u; }
                    const unsigned bmask = (level == 2) ? 1023u : 2047u;
                    KDMA(0);
                    asm volatile("s_waitcnt vmcnt(0)" ::: "memory"); __syncthreads();
                    for (int c = 0; c < nch; ++c) {
                        if (c + 1 < nch) KDMA(c + 1);
                        const int W = 4 * c + (wave >> 1);
                        if (W < nwords) {
                            unsigned bits = 0u;
#pragma unroll
                            for (int tu = 0; tu < 2; ++tu) {
                                const int u = 2 * (wave & 1) + tu;
                                const LAS unsigned char* kp = kbuf + (c & 1) * 32768 + ((wave >> 1) * 64 + u * 16 + r16) * 128;
                                const bf16x8 Ka = *(const LAS bf16x8*)(kp + ((g4 ^ (r16 & 7)) * 16));
                                const bf16x8 Kb = *(const LAS bf16x8*)(kp + (((4 + g4) ^ (r16 & 7)) * 16));
                                f32x4 sc = (f32x4){0.f, 0.f, 0.f, 0.f};
#pragma unroll
                                for (int h = 0; h < 8; ++h) {
                                    f32x4 t = __builtin_amdgcn_mfma_f32_16x16x32_bf16(Ka, Qf[h][0], (f32x4){0.f, 0.f, 0.f, 0.f}, 0, 0, 0);
                                    t = __builtin_amdgcn_mfma_f32_16x16x32_bf16(Kb, Qf[h][1], t, 0, 0, 0);
#pragma unroll
                                    for (int i = 0; i < 4; ++i) sc[i] += wq[h] * fmaxf(t[i], 0.f);
                                }
#pragma unroll
                                for (int i = 0; i < 4; ++i) {
                                    const int kidx = 64 * W + 16 * u + 4 * g4 + i; const unsigned uu = __float_as_uint(sc[i] + 0.0f);
                                    const unsigned key = (uu & 0x80000000u) ? ~uu : (uu | 0x80000000u);
                                    if (kidx <= q) {
                                        if (!collect) {
                                            if (level == 0 || (key >> shift_prev) == (prefix >> shift_prev)) { const unsigned bin = (key >> shift) & bmask;
                                                __hip_atomic_fetch_add((unsigned*)(hist + r16 * 1024 + (bin >> 1)), 1u << (16 * (bin & 1u)), __ATOMIC_RELAXED, __HIP_MEMORY_SCOPE_WORKGROUP); }
                                        } else {
                                            const unsigned kb_ = key >> shift, pb_ = prefix >> shift;
                                            if (kb_ > pb_) bits |= 1u << (16 * tu + 4 * g4 + i);
                                            else if (kb_ == pb_) { const unsigned pos = __hip_atomic_fetch_add((unsigned*)(ccnt + r16), 1u, __ATOMIC_RELAXED, __HIP_MEMORY_SCOPE_WORKGROUP);
                                                if (pos < (unsigned)CAP) { clist[(r16 * CAP + pos) * 2] = key; clist[(r16 * CAP + pos) * 2 + 1] = (unsigned)kidx; } }
                                        }
                                    }
                                }
                            }
                            if (collect) {
                                bits |= (unsigned)__builtin_amdgcn_ds_swizzle((int)bits, (16 << 10) | 0x1f);
                                { auto r0 = __builtin_amdgcn_permlane32_swap(bits, bits, false, false); bits = r0[0] | r0[1]; }
                                if (lane < 16) mtile[(lane * 64 + W) * 2 + (wave & 1)] = bits;
                            }
                        }
                        asm volatile("s_waitcnt vmcnt(0)" ::: "memory"); __syncthreads();
                    }
                    if (collect) break;
                    {
                        const int row = tid >> 5, seg = tid & 31; const LAS unsigned* hr = hist + row * 1024 + seg * 32;
                        unsigned tot = 0u;
                        for (int j = 0; j < 32; ++j) { const unsigned w = hr[j]; tot += (w & 0xffffu) + (w >> 16); }
                        unsigned inc = tot;
#pragma unroll
                        for (int o = 1; o < 32; o <<= 1) { const unsigned t = lane_get(inc, (lane & 32) | ((seg + o) & 31)); if (seg + o < 32) inc += t; }
                        const unsigned exc = inc - tot, kk = (level == 0) ? 256u : rinfo[row * 4 + 1], pfx = (level == 0) ? 0u : rinfo[row * 4 + 0];
                        if (exc < kk && inc >= kk) {
                            unsigned cum = exc, bin = 0u, kn = kk, cb = 0u; bool done = false;
                            for (int j = 31; j >= 0 && !done; --j) { const unsigned w = hr[j]; const unsigned chi = w >> 16, clo = w & 0xffffu;
                                if (cum + chi >= kk) { bin = seg * 64 + 2 * j + 1; kn = kk - cum; cb = chi; done = true; }
                                else { cum += chi; if (cum + clo >= kk) { bin = seg * 64 + 2 * j; kn = kk - cum; cb = clo; done = true; } else cum += clo; } }
                            rinfo[row * 4 + 0] = pfx | (bin << shift); rinfo[row * 4 + 1] = kn; rinfo[row * 4 + 2] = cb;
                            if (cb > (unsigned)CAP && level < 2) __hip_atomic_fetch_or((unsigned*)flag, 1u, __ATOMIC_RELAXED, __HIP_MEMORY_SCOPE_WORKGROUP);
                        }
                    }
                    __syncthreads();
                    prefix = rinfo[r16 * 4 + 0];
                    const unsigned more = flag[0];
                    __syncthreads();
                    if (more) { shift_prev = shift; ++level; shift = (level == 1) ? 10 : 0; } else collect = true;
                }
#undef KDMA
                for (int rr = 0; rr < 2; ++rr) {
                    const int row = wave * 2 + rr; unsigned cc = ccnt[row]; cc = cc > (unsigned)CAP ? (unsigned)CAP : cc; const int cn = (int)cc;
                    const LAS unsigned* cl = clist + row * CAP * 2;
                    unsigned pf = 0u; int kk = (int)rinfo[row * 4 + 1]; unsigned ties = 0u;
                    if (kk > cn) kk = cn;
                    if (kk > 0) {
                    for (int ps = 0; ps < 4; ++ps) {
                        const int sh = 24 - 8 * ps;
#pragma unroll
                        for (int j = 0; j < 4; ++j) whist[lane * 4 + j] = 0u;
                        WAVE_LDS_FENCE();
                        for (int i = lane; i < cn; i += 64) { const unsigned key = cl[i * 2];
                            const bool m = (ps == 0) || ((key >> (sh + 8)) == (pf >> (sh + 8)));
                            if (m) __hip_atomic_fetch_add((unsigned*)(whist + ((key >> sh) & 255u)), 1u, __ATOMIC_RELAXED, __HIP_MEMORY_SCOPE_WORKGROUP); }
                        WAVE_LDS_FENCE();
                        const unsigned c0 = whist[lane * 4 + 0], c1 = whist[lane * 4 + 1], c2 = whist[lane * 4 + 2], c3 = whist[lane * 4 + 3];
                        const unsigned sl = c0 + c1 + c2 + c3; unsigned inc = sl;
#pragma unroll
                        for (int o = 1; o < 64; o <<= 1) { const unsigned t = lane_get(inc, (lane + o) & 63); if (lane + o < 64) inc += t; }
                        const unsigned exc = inc - sl;
                        const bool found = (exc < (unsigned)kk) && (inc >= (unsigned)kk);
                        int bin = 0, kn = 0; unsigned cb = 0u;
                        { unsigned cum = exc;
                          if (cum + c3 >= (unsigned)kk) { bin = 3; kn = kk - (int)cum; cb = c3; } else { cum += c3;
                          if (cum + c2 >= (unsigned)kk) { bin = 2; kn = kk - (int)cum; cb = c2; } else { cum += c2;
                          if (cum + c1 >= (unsigned)kk) { bin = 1; kn = kk - (int)cum; cb = c1; } else { cum += c1; bin = 0; kn = kk - (int)cum; cb = c0; } } } }
                        const u64 fm = __ballot(found); const int src = fm ? (__ffsll((long long)fm) - 1) : 0;
                        bin = (int)lane_get((unsigned)(lane * 4 + bin), src); kk = (int)lane_get((unsigned)kn, src); ties = lane_get(cb, src);
                        pf |= ((unsigned)bin) << sh;
                        WAVE_LDS_FENCE();
                    }
                    unsigned cut = 0xFFFFFFFFu;
                    if (ties > (unsigned)kk) {
                        for (int i = lane; i < cn; i += 64) { if (cl[i * 2] == pf) { const unsigned myi = cl[i * 2 + 1]; int rank = 0;
                                for (int j = 0; j < cn; ++j) rank += (cl[j * 2] == pf && cl[j * 2 + 1] < myi) ? 1 : 0;
                                if (rank == kk - 1) rsel[row * 2 + 1] = myi; } }
                        WAVE_LDS_FENCE();
                        cut = rsel[row * 2 + 1];
                    }
                    for (int i = lane; i < cn; i += 64) { const unsigned key = cl[i * 2], kidx = cl[i * 2 + 1];
                        if (key > pf || (key == pf && kidx <= cut)) __hip_atomic_fetch_or((unsigned*)(mtile + (row * 64 + (kidx >> 6)) * 2 + ((kidx >> 5) & 1u)), 1u << (kidx & 31u), __ATOMIC_RELAXED, __HIP_MEMORY_SCOPE_WORKGROUP); }
                    }
                }
                __syncthreads();
                for (int i = tid; i < 16 * nwords; i += NTHR) { const int r = i & 15, W = i >> 4;
                    MASK[((size_t)b * 64 + W) * SEQ + q0 + r] = (u64)mtile[(r * 64 + W) * 2] | ((u64)mtile[(r * 64 + W) * 2 + 1] << 32); }
                __syncthreads();
            }
        }
        if (BOTH(2)) GRID_BAR();
    }

    if (IN(3)) { asm volatile("; PHASE_MARK 3"); PHASE_BEGIN
        const int vcu = (G % 8 == 0) ? (bid % 8) * (G / 8) + bid / 8 : bid;
        if (vcu < 256) {
            const int pp = vcu & 3, h = (vcu >> 2) & 7, b = vcu >> 5;
            { float* tb = (float*)(lds_raw + dsa::LDS_TB);
              for (int i = tid; i < dsa::TB_PAD + 4096; i += NTHR) tb[i] = (i >= dsa::TB_PAD) ? BIAST[h * 4096 + (i - dsa::TB_PAD)] * 8.0f : 0.f; }
            const bf16_t* Kp = K0 + (size_t)b * SEQ * 512 + h * 64; const bf16_t* Vp = V0 + (size_t)b * SEQ * 512 + h * 64;
#define DSA_REF(R, i_) do { const int qb_ = ((i_) == 0) ? pp : ((i_) == 1) ? 15 - pp : ((i_) == 2) ? pp + 4 : 11 - pp; const int P0_ = qb_ * 256; \
            R.Q = Q0 + ((size_t)b * SEQ + P0_) * 512 + h * 64; R.K = Kp; R.V = Vp; R.O = MIXIN + ((size_t)b * SEQ + P0_) * DM + 512 + h * 64; \
            R.MW = MASK + (size_t)b * 64 * SEQ + P0_; R.P0 = P0_; } while (0)
            dsa::Seam SS; dsa::BlockRef cur, nxt; DSA_REF(cur, 0);
            dsa::dsa_prime(cur, (char*)lds_raw, SS, tid);
            for (int i = 0; i < 4; ++i) {
                if (i < 3) { DSA_REF(nxt, i + 1); } else nxt = cur;
                dsa::dsa_block(cur, nxt, (char*)lds_raw, SS, tid);
                cur = nxt;
            }
#undef DSA_REF
        }
        if (BOTH(3)) GRID_BAR();
    }
    if (IN(4)) { asm volatile("; PHASE_MARK 4"); PHASE_BEGIN
        pg8::StaticOrder S; S.init(MIXIN, NTOK, DM, DM, G, bid);
        pg8::EpiRes<false> E{outp, x_in};
        pg8::gemm_phase<pg8::EpiRes<false>, pg8::StaticOrder, true, false>(tid, lds, WOUT0, DM, S, E, GTAB);
        if (BOTH(4)) GRID_BAR();
    }
    if (IN(5)) { asm volatile("; PHASE_MARK 5"); PHASE_BEGIN
        for (int m = gw; m < NTOK; m += NGW) { f32x4 v[4];
#pragma unroll
            for (int j = 0; j < 4; ++j) v[j] = *(const f32x4*)(outp + (size_t)m * DM + 4 * lane + 256 * j);
            ln_core(v, args.in[I_ELN1G], args.in[I_ELN1B], lane); store_row_bf16(X1B + (size_t)m * DM, v, lane); }
        if (BOTH(5)) GRID_BAR();
    }
    if (IN(6)) { asm volatile("; PHASE_MARK 6"); PHASE_BEGIN
        pg8::StaticOrder S; S.init(X1B, NTOK, 2 * FF0, DM, G, bid);
        pg8::EpiSwiglu<false> E{H0, FF0, (char*)outp, (char*)ws};
        pg8::gemm_phase<pg8::EpiSwiglu<false>, pg8::StaticOrder, true, false>(tid, lds, WGU0, DM, S, E, GTAB);
        if (BOTH(6)) GRID_BAR();
    }
    if (IN(7)) { asm volatile("; PHASE_MARK 7"); PHASE_BEGIN
        pg8::StaticOrder S; S.init(H0, NTOK, DM, FF0, G, bid);
        pg8::EpiRes<true> E{outp, X1B};
        pg8::gemm_phase<pg8::EpiRes<true>, pg8::StaticOrder, true, false>(tid, lds, WD0, FF0, S, E, GTAB);
        if (BOTH(7)) GRID_BAR();
    }
    if (IN(8)) { asm volatile("; PHASE_MARK 8"); PHASE_BEGIN
        for (int m = gw; m < NTOK; m += NGW) { f32x4 v[4];
#pragma unroll
            for (int j = 0; j < 4; ++j) v[j] = *(const f32x4*)(outp + (size_t)m * DM + 4 * lane + 256 * j);
            ln_core(v, args.in[I_ELN2G], args.in[I_ELN2B], lane); store_row_bf16(X2B + (size_t)m * DM, v, lane); }
        if (BOTH(8)) GRID_BAR();
    }
#define MERGE_CHUNK(chm) do { \
        const bf16_t* OPp = (const bf16_t*)(ws + WS_OP); const float* LSEp = (const float*)(ws + WS_LSE); \
        for (int tl = gw; tl < CHUNK_T; tl += NGW) { const int hh = lane >> 3; \
            const float l0 = LSEp[(size_t)tl * 8 + hh], l1 = LSEp[((size_t)CHUNK_T + tl) * 8 + hh], l2 = LSEp[((size_t)2 * CHUNK_T + tl) * 8 + hh]; \
            const float mm = fmaxf(l0, fmaxf(l1, l2)); float w0 = __expf(l0 - mm), w1 = __expf(l1 - mm), w2 = __expf(l2 - mm); const float inv = 1.f / (w0 + w1 + w2); w0 *= inv; w1 *= inv; w2 *= inv; \
            const bf16_t* p0 = OPp + (size_t)tl * DM + lane * 16; const bf16_t* p1 = p0 + (size_t)CHUNK_T * DM; const bf16_t* p2 = p1 + (size_t)CHUNK_T * DM; \
            _Pragma("unroll") for (int q = 0; q < 2; ++q) { const u32x4 a = *(const u32x4*)(p0 + q * 8), b = *(const u32x4*)(p1 + q * 8), c = *(const u32x4*)(p2 + q * 8); u32x4 o; \
                o.x = cvt_pk_bf16(w0 * bf_lo(a.x) + w1 * bf_lo(b.x) + w2 * bf_lo(c.x), w0 * bf_hi(a.x) + w1 * bf_hi(b.x) + w2 * bf_hi(c.x)); \
                o.y = cvt_pk_bf16(w0 * bf_lo(a.y) + w1 * bf_lo(b.y) + w2 * bf_lo(c.y), w0 * bf_hi(a.y) + w1 * bf_hi(b.y) + w2 * bf_hi(c.y)); \
                o.z = cvt_pk_bf16(w0 * bf_lo(a.z) + w1 * bf_lo(b.z) + w2 * bf_lo(c.z), w0 * bf_hi(a.z) + w1 * bf_hi(b.z) + w2 * bf_hi(c.z)); \
                o.w = cvt_pk_bf16(w0 * bf_lo(a.w) + w1 * bf_lo(b.w) + w2 * bf_lo(c.w), w0 * bf_hi(a.w) + w1 * bf_hi(b.w) + w2 * bf_hi(c.w)); \
                *(u32x4*)(O1 + ((size_t)(chm) * CHUNK_T + tl) * DM + lane * 16 + q * 8) = o; } } } while (0)
#pragma unroll
    for (int ch = 0; ch < 2; ++ch) {
        if (IN(9 + 2 * ch)) { asm volatile("; PHASE_MARK 9"); PHASE_BEGIN
            if (ch == 1) { MERGE_CHUNK(0); }
            pg8::StaticOrder S; S.init(X2B + (size_t)ch * CHUNK_T * DM, CHUNK_T, IN1_N, DM, G, bid);
            pg8::EpiQkv1 E{H1, IN1_N, 1.0f};
            pg8::gemm_phase<pg8::EpiQkv1, pg8::StaticOrder, true, false>(tid, lds, WIN1, DM, S, E, GTAB);
            if (BOTH(9 + 2 * ch)) GRID_BAR();
        }
        if (IN(10 + 2 * ch)) { asm volatile("; PHASE_MARK 10"); PHASE_BEGIN
            constexpr int NU = CHUNK_B * 8 * 3 * 16;
            const int vcu = (G % 8 == 0) ? (bid % 8) * (G / 8) + bid / 8 : bid;
            bf16_t* OPp = (bf16_t*)(ws + WS_OP); float* LSEp = (float*)(ws + WS_LSE);
            int L0 = vcu;
            if (L0 < NU) {
                swa::Seam SS; swa::BlockRef cur = dil_ref(L0, H1, OPp, LSEp);
                swa::swa_prime(cur, BIAST, (char*)lds_raw, SS, tid);
                int slot = 0;
                for (;;) {
                    const int Ln = L0 + G; const bool last = Ln >= NU;
                    const swa::BlockRef nxt = last ? cur : dil_ref(Ln, H1, OPp, LSEp);
                    swa::swa_block(cur, nxt, BIAST, slot, (char*)lds_raw, SS, tid);
                    if (last) break;
                    cur = nxt; L0 = Ln; slot ^= 1;
                }
            }
            if (BOTH(10 + 2 * ch)) GRID_BAR();
        }
    }
    if (IN(13)) { asm volatile("; PHASE_MARK 13"); PHASE_BEGIN
        MERGE_CHUNK(1);
        if (BOTH(13)) GRID_BAR();
    }
    if (IN(14)) { asm volatile("; PHASE_MARK 14"); PHASE_BEGIN
        pg8::StaticOrder S; S.init(O1, NTOK, DM, DM, G, bid);
        pg8::EpiRes<true> E{Y3, X2B};
        pg8::gemm_phase<pg8::EpiRes<true>, pg8::StaticOrder, true, false>(tid, lds, WOUT1, DM, S, E, GTAB);
        if (BOTH(14)) GRID_BAR();
    }
    if (IN(15)) { asm volatile("; PHASE_MARK 15"); PHASE_BEGIN
        const float* rt = args.in[I_ROUTER];
        for (int m = gw; m < NTOK; m += NGW) { f32x4 v[4];
#pragma unroll
            for (int j = 0; j < 4; ++j) v[j] = *(const f32x4*)(Y3 + (size_t)m * DM + 4 * lane + 256 * j);
            ln_core(v, args.in[I_OLN1G], args.in[I_OLN1B], lane); store_row_bf16(X3B + (size_t)m * DM, v, lane);
            float lgt[8];
#pragma unroll
            for (int e = 0; e < 8; ++e) lgt[e] = 0.f;
#pragma unroll
            for (int j = 0; j < 4; ++j)
#pragma unroll
                for (int i = 0; i < 4; ++i) { const float* rr = rt + (size_t)(4 * lane + 256 * j + i) * 8; const f32x4 r0 = *(const f32x4*)rr, r1 = *(const f32x4*)(rr + 4); const float xv = v[j][i];
                    lgt[0] += xv * r0[0]; lgt[1] += xv * r0[1]; lgt[2] += xv * r0[2]; lgt[3] += xv * r0[3]; lgt[4] += xv * r1[0]; lgt[5] += xv * r1[1]; lgt[6] += xv * r1[2]; lgt[7] += xv * r1[3]; }
#pragma unroll
            for (int e = 0; e < 8; ++e) lgt[e] = wave_sum(lgt[e]);
            int e1 = 0; float v1 = lgt[0];
#pragma unroll
            for (int e = 1; e < 8; ++e) if (lgt[e] > v1) { v1 = lgt[e]; e1 = e; }
            int e2 = -1; float v2 = -INFINITY;
#pragma unroll
            for (int e = 0; e < 8; ++e) if (e != e1 && lgt[e] > v2) { v2 = lgt[e]; e2 = e; }
            const float g2 = 1.f / (1.f + __expf(v1 - v2)), g1 = 1.f - g2;
            if (lane == 0) {
                const unsigned p1 = atomicAdd(ctl + CW_MOECNT + e1, 1u), p2 = atomicAdd(ctl + CW_MOECNT + e2, 1u);
                if (p1 < (unsigned)NTOK) { MTOK[e1 * NTOK + p1] = m * 2; MGATE[e1 * NTOK + p1] = g1; }
                if (p2 < (unsigned)NTOK) { MTOK[e2 * NTOK + p2] = m * 2 + 1; MGATE[e2 * NTOK + p2] = g2; }
            }
        }
        __syncthreads();
        {
            LAS float* scr = (LAS float*)(lds + wave * 16384);
            constexpr int I_GU = 16 * (2 * FFE / 32), I_D = (FFE / 64) * 32;
            for (int it = gw; it < NEXP * (I_GU + I_D); it += NGW) {
                const int e = it / (I_GU + I_D), r = it % (I_GU + I_D);
                if (r < I_GU) gu_item(args.in[I_MWG] + (size_t)e * DM * FFE, args.in[I_MWU] + (size_t)e * DM * FFE, FFE, DM, MWGU + (size_t)e * 2 * FFE * DM, r, scr, lane);
                else plain_item(args.in[I_MWD] + (size_t)e * FFE * DM, FFE, DM, MWD + (size_t)e * DM * FFE, r - I_GU, scr, lane);
            }
        }
        if (BOTH(15)) GRID_BAR();
    }
#pragma unroll
    for (int ch = 0; ch < 2; ++ch) {
        if (IN(16 + 2 * ch) || IN(17 + 2 * ch)) {
            LAS int* rt = (LAS int*)(lds + LDS_RT);
            int nM;
            { PHASE_BEGIN int ts[9]; int cn[8]; ts[0] = 0;
#pragma unroll
              for (int e = 0; e < 8; ++e) { int ce = __builtin_amdgcn_readfirstlane((int)ctl[CW_MOECNT + e]); ce = ce > NTOK ? NTOK : ce; cn[e] = ce; ts[e + 1] = ts[e] + (ce + 255) / 256; }
              const int t0 = ch * MOE_CH_TILES; int t1 = t0 + MOE_CH_TILES; if (t1 > ts[8]) t1 = ts[8]; nM = __builtin_amdgcn_readfirstlane(t1 > t0 ? t1 - t0 : 0);
              if (tid < nM) { const int g = t0 + tid; int e = 0;
#pragma unroll
                  for (int k = 1; k < 8; ++k) e += (g >= ts[k]) ? 1 : 0;
                  int ce = cn[0], tse = ts[0];
#pragma unroll
                  for (int k = 1; k < 8; ++k) { ce = (e == k) ? cn[k] : ce; tse = (e == k) ? ts[k] : tse; }
                  const int j = g - tse; int nv = ce - j * 256; nv = nv > 256 ? 256 : nv;
                  rt[tid * 4 + 0] = e; rt[tid * 4 + 1] = e * NTOK + j * 256; rt[tid * 4 + 2] = nv; rt[tid * 4 + 3] = 0; } }
            __syncthreads();
            if (IN(16 + 2 * ch)) { asm volatile("; PHASE_MARK 16"); PHASE_BEGIN
                pg8::MoeOrder S{G, bid, nM, 2 * FFE / 256, rt, (const char*)X3B, (char*)outp, (char*)ws, true};
                LAS int* gtab = (LAS int*)(lds + LDS_GTAB);
                { pg8::Unit u; for (int i = 0; i < 16 && S.next(i, u); ++i) { if (tid < 256) { const int lb = rt[u.pm * 4 + 1], nv = rt[u.pm * 4 + 2]; const int r = tid < nv ? tid : 0; gtab[i * 256 + tid] = MTOK[lb + r] >> 1; } } }
                __syncthreads();
                pg8::EpiSwiglu<true> E{H0, FFE, (char*)outp, (char*)ws};
                pg8::gemm_phase<pg8::EpiSwiglu<true>, pg8::MoeOrder, true, true>(tid, lds, MWGU, DM, S, E, gtab);
                if (BOTH(16 + 2 * ch)) GRID_BAR();
            }
            if (IN(17 + 2 * ch)) { asm volatile("; PHASE_MARK 17"); PHASE_BEGIN
                pg8::MoeOrder S{G, bid, nM, DM / 256, rt, (const char*)X3B, (char*)outp, (char*)ws, false};
                pg8::EpiMoeDown E{YB, MTOK, MGATE, rt};
                pg8::gemm_phase<pg8::EpiMoeDown, pg8::MoeOrder, true, false>(tid, lds, MWD, FFE, S, E, GTAB);
                if (BOTH(17 + 2 * ch)) GRID_BAR();
            }
        }
    }
    if (IN(20)) { asm volatile("; PHASE_MARK 20"); PHASE_BEGIN
        for (int m = gw; m < NTOK; m += NGW) { f32x4 v[4];
#pragma unroll
            for (int j = 0; j < 4; ++j) { const size_t o = (size_t)m * DM + 4 * lane + 256 * j; v[j] = ld_bf4(X3B + o) * ALPHA + ld_bf4(YB + o) + ld_bf4(YB + (size_t)NTOK * DM + o); }
            ln_core(v, args.in[I_OLN2G], args.in[I_OLN2B], lane);
#pragma unroll
            for (int j = 0; j < 4; ++j) *(f32x4*)(outp + (size_t)m * DM + 4 * lane + 256 * j) = v[j]; }
    }
#undef IN
#undef BOTH
}

constexpr int NPHASES = 21;
extern "C" void kernel_launch(void* const* d_in, const int* in_sizes, int n_in, void* d_out, int out_size, void* d_ws, size_t ws_size, hipStream_t stream) {
    static int grid = 0;
    if (grid == 0) {
        if (n_in != 25 || out_size != NTOK * DM || ws_size < WS_END) { fprintf(stderr, "kernel_launch: unexpected shapes (n_in %d out %d ws %zu)\n", n_in, out_size, ws_size); grid = -1; return; }
        int dev = 0, cus = 0;
        if (hipGetDevice(&dev) != hipSuccess || hipDeviceGetAttribute(&cus, hipDeviceAttributeMultiprocessorCount, dev) != hipSuccess) { grid = -1; return; }
        if (hipFuncSetAttribute((const void*)fwd_kernel, hipFuncAttributeMaxDynamicSharedMemorySize, LDS_BYTES) != hipSuccess) { fprintf(stderr, "kernel_launch: hipFuncSetAttribute failed\n"); grid = -1; return; }
        int per_cu = 0;
        if (hipOccupancyMaxActiveBlocksPerMultiprocessor(&per_cu, (const void*)fwd_kernel, NTHR, LDS_BYTES) != hipSuccess || per_cu < 1) { fprintf(stderr, "kernel_launch: occupancy query says %d\n", per_cu); }
        (void)hipGetLastError();
        grid = cus;
    }
    if (grid < 0) return;
    (void)hipMemsetAsync((char*)d_ws + WS_CTL, 0, CTL_ZERO_BYTES, stream);
    Args a{};
    for (int i = 0; i < 25; ++i) a.in[i] = (const float*)d_in[i];
    a.out = (float*)d_out; a.ws = (unsigned char*)d_ws;
#if ONE_LAUNCH
    a.ph_lo = 0; a.ph_hi = NPHASES;
    hipLaunchKernelGGL(fwd_kernel, dim3(grid), dim3(NTHR), LDS_BYTES, stream, a);
#else
    for (int ph = 0; ph < NPHASES; ++ph) { a.ph_lo = ph; a.ph_hi = ph + 1; hipLaunchKernelGGL(fwd_kernel, dim3(grid), dim3(NTHR), LDS_BYTES, stream, a); }
#endif
}
```

```cpp
#include <hip/hip_runtime.h>
#include <cstdio>
#include <cstdint>

#ifndef ONE_LAUNCH
#define ONE_LAUNCH 1
#endif
#ifndef DUP_MASK
#define DUP_MASK 0u
#endif

#define LAS __attribute__((address_space(3)))
typedef unsigned short bf16_t;
typedef short bf16x8 __attribute__((ext_vector_type(8)));
typedef float f32x4 __attribute__((ext_vector_type(4)));
typedef float f32x2 __attribute__((ext_vector_type(2)));
typedef unsigned u32x4 __attribute__((ext_vector_type(4)));
typedef unsigned u32x2 __attribute__((ext_vector_type(2)));
typedef unsigned long long u64;

constexpr int NB = 8, SEQ = 4096, DM = 1024, NTOK = NB * SEQ;
constexpr int IN0_SRC = 3144, IN0_N = 3328;
constexpr int FF0 = 2816, FFE = 3584, NEXP = 8;
constexpr int IN1_N = 9216;
constexpr int CHUNK_B = 4, CHUNK_T = CHUNK_B * SEQ;
constexpr int MOE_CH_TILES = 132;
constexpr int HM_DOUT_TILES = 73;
constexpr float ALPHA = 1.4142135623730951f;
constexpr float LN_EPS = 1e-5f;
constexpr int NWAVES = 8, NTHR = 512;

constexpr size_t MiB = 1u << 20;
constexpr size_t WS_CTL = 0, CTL_ZERO_BYTES = 64 * 1024;
constexpr size_t WS_BIAST = 1 * MiB;
constexpr size_t WS_MOE_TOK = 2 * MiB;
constexpr size_t WS_MOE_GATE = 3 * MiB;
constexpr size_t WS_WIN0 = 4 * MiB;
constexpr size_t WS_WOUT0 = 11 * MiB;
constexpr size_t WS_WGU0 = 13 * MiB;
constexpr size_t WS_WD0 = 24 * MiB;
constexpr size_t WS_WIN1 = 30 * MiB;
constexpr size_t WS_WOUT1 = 48 * MiB;
constexpr size_t WS_XB = 50 * MiB;
constexpr size_t WS_U = 114 * MiB;
constexpr size_t WS_Q0 = 146 * MiB, SEG0 = 32 * MiB;
constexpr size_t WS_KI = 274 * MiB;
constexpr size_t WS_WI = 278 * MiB;
constexpr size_t WS_MASK = 280 * MiB;
constexpr size_t WS_MIXIN = 296 * MiB;
constexpr size_t WS_X1B = 50 * MiB;
constexpr size_t WS_H0 = 114 * MiB;
constexpr size_t WS_X2B = 448 * MiB;
constexpr size_t WS_H1 = 50 * MiB;
constexpr size_t WS_OP = 338 * MiB;
constexpr size_t WS_LSE = 434 * MiB;
constexpr size_t WS_Y3 = 216 * MiB;
constexpr size_t WS_X3B = 152 * MiB;
constexpr size_t WS_YB = 216 * MiB;
constexpr size_t WS_MWGU = 344 * MiB;
constexpr size_t WS_MWD = 456 * MiB;
constexpr size_t WS_HM = 4 * MiB;
constexpr size_t WS_END = 512 * MiB;
constexpr size_t HM_TILE_BYTES = (size_t)256 * FFE * 2;
constexpr int CW_MOECNT = 64;
constexpr int CW_BAR = 1024;

constexpr int LDS_GTAB = 131072;
constexpr int LDS_RT = 147456;
constexpr int LDS_MISC = 155648 + 2048;
constexpr int LDS_BYTES = 159744;

__device__ __forceinline__ unsigned cvt_pk_bf16(float lo, float hi) { unsigned r; asm volatile("v_cvt_pk_bf16_f32 %0, %1, %2" : "=v"(r) : "v"(lo), "v"(hi)); return r; }
__device__ __forceinline__ float bf_lo(unsigned w) { return __uint_as_float(w << 16); }
__device__ __forceinline__ float bf_hi(unsigned w) { return __uint_as_float(w & 0xffff0000u); }
__device__ __forceinline__ float bf2f(bf16_t b) { return __uint_as_float(((unsigned)b) << 16); }
template <int M> __device__ __forceinline__ float swz_xor(float v) {
    return __int_as_float(__builtin_amdgcn_ds_swizzle(__float_as_int(v), (M << 10) | 0x1f)); }
__device__ __forceinline__ float wave_sum(float v) {
    v += swz_xor<1>(v); v += swz_xor<2>(v); v += swz_xor<4>(v); v += swz_xor<8>(v); v += swz_xor<16>(v);
    auto rr = __builtin_amdgcn_permlane32_swap(__float_as_uint(v), __float_as_uint(v), false, false);
    return __uint_as_float(rr[0]) + __uint_as_float(rr[1]);
}
__device__ __forceinline__ float wave_max(float v) {
    v = fmaxf(v, swz_xor<1>(v)); v = fmaxf(v, swz_xor<2>(v)); v = fmaxf(v, swz_xor<4>(v)); v = fmaxf(v, swz_xor<8>(v)); v = fmaxf(v, swz_xor<16>(v));
    auto rr = __builtin_amdgcn_permlane32_swap(__float_as_uint(v), __float_as_uint(v), false, false);
    return fmaxf(__uint_as_float(rr[0]), __uint_as_float(rr[1]));
}
__device__ __forceinline__ unsigned lane_get(unsigned v, int src_lane) { return (unsigned)__builtin_amdgcn_ds_bpermute(src_lane << 2, (int)v); }
__device__ __forceinline__ float sigmoidf_(float x) { return __builtin_amdgcn_rcpf(1.0f + __expf(-x)); }
#define WAVE_LDS_FENCE() do { asm volatile("s_waitcnt lgkmcnt(0)" ::: "memory"); __builtin_amdgcn_wave_barrier(); } while (0)

#define XB_TMO      128
#define XB_XCNT(j)  (256  + 64 * (j))
#define XB_XSUB(j)  (1280 + 64 * (j))
#define XB_XGEN(j)  (2304 + 64 * (j))
#define XB_TOP      3328
#define XB_TOPGEN   3392
#define XCD_BAR_WORDS 3456
#define XB_SPIN_CAP (1u << 18)
__device__ __forceinline__ unsigned xb_ld(unsigned* p)              { return __hip_atomic_load(p, __ATOMIC_RELAXED, __HIP_MEMORY_SCOPE_AGENT); }
__device__ __forceinline__ unsigned xb_add(unsigned* p, unsigned v) { return __hip_atomic_fetch_add(p, v, __ATOMIC_RELAXED, __HIP_MEMORY_SCOPE_AGENT); }
__device__ __forceinline__ unsigned xb_xcc_id() { return (unsigned)__builtin_amdgcn_s_getreg((3 << 11) | 20) & 0xFu; }
#define XB_SPIN(cond, bar) do { unsigned _sp = 0; while (cond) { __builtin_amdgcn_s_sleep(1); \
    if ((++_sp & 255u) == 0u) { if (xb_ld(&(bar)[XB_TMO])) break; if (_sp > XB_SPIN_CAP) { atomicAdd(&(bar)[XB_TMO], 1u); break; } } } } while (0)
struct XcdBarrier { unsigned* bar; unsigned x; volatile LAS unsigned* st; };
__device__ __forceinline__ XcdBarrier xcd_barrier_post(unsigned* bar, volatile LAS unsigned* st, bool leader) {
    XcdBarrier b; b.bar = bar; b.x = xb_xcc_id(); b.st = st;
    if (leader) (void)xb_add(&bar[XB_XCNT(b.x)], 1u);
    return b;
}
__device__ __forceinline__ void xcd_barrier_complete(unsigned* bar, unsigned x, unsigned& nloc, unsigned& nx) {
    const unsigned G = gridDim.x * gridDim.y * gridDim.z;
    unsigned sum, cnt, mine, sp = 0u;
    for (;;) {
        sum = 0u; cnt = 0u; mine = 0u;
#pragma unroll
        for (unsigned j = 0; j < 16; ++j) { const unsigned c = xb_ld(&bar[XB_XCNT(j)]); sum += c; cnt += (c > 0u) ? 1u : 0u; mine = (j == x) ? c : mine; }
        if (sum == G) break;
        __builtin_amdgcn_s_sleep(1);
        if ((++sp & 255u) == 0u) { if (xb_ld(&bar[XB_TMO])) break; if (sp > XB_SPIN_CAP) { atomicAdd(&bar[XB_TMO], 1u); break; } }
    }
    nloc = mine > 0u ? mine : 1u; nx = cnt > 0u ? cnt : 1u;
}
__device__ __forceinline__ void xcd_barrier(const XcdBarrier& b, bool leader) {
    asm volatile("s_waitcnt vmcnt(0)" ::: "memory");
    __syncthreads();
    if (leader) {
        unsigned* bar = b.bar;
        __builtin_amdgcn_s_waitcnt(0);
        unsigned nloc = b.st[0], nx = b.st[1];
        if (nloc == 0u) { xcd_barrier_complete(bar, b.x, nloc, nx); b.st[0] = nloc; b.st[1] = nx; }
        const unsigned old = xb_add(&bar[XB_XSUB(b.x)], 1u);
        const unsigned gen = old / nloc;
        if (old + 1u == (gen + 1u) * nloc) {
            __builtin_amdgcn_fence(__ATOMIC_RELEASE, "agent");
            asm volatile("s_waitcnt vmcnt(0)" ::: "memory");
            const unsigned og = xb_add(&bar[XB_TOP], 1u);
            const unsigned tg = og / nx;
            if (og + 1u == (tg + 1u) * nx) xb_add(&bar[XB_TOPGEN], 1u);
            else XB_SPIN(xb_ld(&bar[XB_TOPGEN]) == tg, bar);
            __builtin_amdgcn_fence(__ATOMIC_ACQUIRE, "agent");
            xb_add(&bar[XB_XGEN(b.x)], 1u);
            asm volatile("s_waitcnt vmcnt(0)" ::: "memory");
        } else {
            XB_SPIN(xb_ld(&bar[XB_XGEN(b.x)]) == gen, bar);
            __builtin_amdgcn_fence(__ATOMIC_ACQUIRE, "agent");
            asm volatile("s_waitcnt vmcnt(0)" ::: "memory");
        }
    }
    __syncthreads();
}

namespace pg8 {
constexpr int BM = 256, BK = 64, HALF = 128, HTB = HALF * BK * 2, STAGE_BYTES = 8 * HTB, NXCD = 8, WGM = 8;
__host__ __device__ __forceinline__ int lds_byte(int r, int c) { const int st = (r >> 4) * 2 + (c >> 5), rr = r & 15, cc = c & 31, ob = rr * 64 + cc * 2; return st * 1024 + (ob ^ (((ob >> 9) & 1) << 5)); }
__host__ __device__ __forceinline__ void stage_rc(int b, int& R, int& C) { const int st = b / 1024, sb = b % 1024, swz = sb ^ (((sb >> 9) & 1) << 5); R = (st >> 1) * 16 + swz / 64; C = (st & 1) * 32 + (swz % 64) / 2; }
__host__ __device__ __forceinline__ int perm32(int rho) { const int n = rho >> 4, i = rho & 15; return 8 * (i >> 2) + 4 * n + (i & 3); }

struct Unit { int pm, pn; };

__device__ __forceinline__ void remap_unit(int wgid, int nM, int nN, int& pm, int& pn) {
    const int nwg = nM * nN;
    { const int q = nwg / NXCD, r = nwg % NXCD, xcd = wgid % NXCD, off = wgid / NXCD; wgid = (xcd < r ? xcd * (q + 1) : r * (q + 1) + (xcd - r) * q) + off; }
    const int nig = WGM * nN, gid = wgid / nig, fm = gid * WGM, gsz = (nM - fm) < WGM ? (nM - fm) : WGM;
    pm = fm + ((wgid % nig) % gsz); pn = (wgid % nig) / gsz;
}
struct StaticOrder {
    int nM, nN, nwg, G, c; const char* A; size_t tstepA;
    __device__ void init(const bf16_t* A_, int M, int N, int K, int G_, int c_) { nM = M / BM; nN = N / BM; nwg = nM * nN; G = G_; c = c_; A = (const char*)A_; tstepA = (size_t)BM * K * 2; }
    __device__ __forceinline__ bool next(int i, Unit& u) const {
        const long L = (long)i * G + c; if (L >= nwg) return false;
        remap_unit((int)L, nM, nN, u.pm, u.pn); return true;
    }
    __device__ __forceinline__ const char* a_ptr(const Unit& u) const { return A + (size_t)u.pm * tstepA; }
    __device__ __forceinline__ int b_tile(const Unit& u) const { return u.pn; }
};

#define PG8_LAS __attribute__((address_space(3)))
template <class Epi, class Sched, bool ALIGN_EPI, bool GATHER>
__device__ __forceinline__ void gemm_phase(const int tid, PG8_LAS unsigned char* lds, const bf16_t* Btp, const int K, const Sched& S, const Epi& E, const PG8_LAS int* gtab) {
    const int wid = __builtin_amdgcn_readfirstlane(tid >> 6), lane = tid & 63, wr = wid >> 2, wc = wid & 3, fr = lane & 15, fq = lane >> 4;
    const int nt = K / BK;
    unsigned voffA[2], voffB[2];
#pragma unroll
    for (int i = 0; i < 2; ++i) { int R, C; stage_rc(tid * 16 + i * 8192, R, C); const int Rb = Epi::PERM ? ((R & ~31) + perm32(R & 31)) : R;
        voffA[i] = (unsigned)(R * K + C) * 2u; voffB[i] = (unsigned)(Rb * K + C) * 2u; }
    const size_t kstep = (size_t)(BK * 2);
    const size_t hstep = (size_t)HALF * K * 2;
    const size_t tstep = 2 * hstep;
    const unsigned ldsw = (unsigned)wid * 1024u;
    const int aoff = lds_byte(wr * 64 + fr, fq * 8), boff = lds_byte(wc * 32 + fr, fq * 8);
#define PG8_SA(b, h) (((b) * 2 + (h)) * HTB)
#define PG8_SB(b, h) ((4 + (b) * 2 + (h)) * HTB)
#define PG8_STAGE(bufoff, gbase, voff) do { _Pragma("unroll") for (int _i = 0; _i < 2; ++_i) \
        __builtin_amdgcn_global_load_lds((const unsigned*)((const char*)(gbase) + (voff)[_i]), (PG8_LAS unsigned*)(lds + (bufoff) + ldsw + _i * 8192), 16, 0, 0); } while (0)
#define PG8_STAGE_AC(bufoff, kt, h) do { if constexpr (GATHER) { PG8_STAGE(bufoff, cA + (size_t)(kt) * kstep, gcur[h]); } else { PG8_STAGE(bufoff, cA + (size_t)(kt) * kstep + (h) * hstep, voffA); } } while (0)
#define PG8_STAGE_AN(bufoff, d, h) do { if constexpr (GATHER) { if (last) { unsigned _g[2]; _Pragma("unroll") for (int _i = 0; _i < 2; ++_i) { int _R, _C; stage_rc(tid * 16 + _i * 8192, _R, _C); _g[_i] = (unsigned)gtab[nslot * 256 + (h) * 128 + _R] * (unsigned)(K * 2) + (unsigned)(_C * 2); } \
            PG8_STAGE(bufoff, nA + (size_t)(d) * kstep, _g); } else { PG8_STAGE(bufoff, cA + (size_t)(t + 2 + (d)) * kstep, gcur[h]); } } \
        else { PG8_STAGE(bufoff, a2 + (size_t)(d) * kstep + (h) * hstep, voffA); } } while (0)
#define PG8_LDA(dst, b, h) do { _Pragma("unroll") for (int m = 0; m < 4; ++m) _Pragma("unroll") for (int k = 0; k < 2; ++k) dst[m][k] = *(const PG8_LAS bf16x8*)(lds + PG8_SA(b, h) + aoff + m * 2048 + k * 1024); } while (0)
#define PG8_LDB(dst, b, h) do { _Pragma("unroll") for (int n = 0; n < 2; ++n) _Pragma("unroll") for (int k = 0; k < 2; ++k) dst[n][k] = *(const PG8_LAS bf16x8*)(lds + PG8_SB(b, h) + boff + n * 2048 + k * 1024); } while (0)
#define PG8_MMA(ai, bj, At, Bt) do { __builtin_amdgcn_s_setprio(1); _Pragma("unroll") for (int m = 0; m < 4; ++m) _Pragma("unroll") for (int n = 0; n < 2; ++n) _Pragma("unroll") for (int k = 0; k < 2; ++k) \
        acc[ai][bj][m][n] = __builtin_amdgcn_mfma_f32_16x16x32_bf16(Bt[n][k], At[m][k], acc[ai][bj][m][n], 0, 0, 0); __builtin_amdgcn_s_setprio(0); } while (0)
#define PG8_WAIT_V(n) asm volatile("s_waitcnt vmcnt(" #n ")" ::: "memory")
#define PG8_WAIT_L(n) asm volatile("s_waitcnt lgkmcnt(" #n ")" ::: "memory")
#define PG8_BAR __builtin_amdgcn_s_barrier()
#define PG8_SCHED __builtin_amdgcn_sched_barrier(0)
#define PG8_LOADG(dst, slot_) do { _Pragma("unroll") for (int _i = 0; _i < 2; ++_i) { int _R, _C; stage_rc(tid * 16 + _i * 8192, _R, _C); _Pragma("unroll") for (int _h = 0; _h < 2; ++_h) \
        dst[_h][_i] = (unsigned)gtab[(slot_) * 256 + _h * 128 + _R] * (unsigned)(K * 2) + (unsigned)(_C * 2); } } while (0)
    Unit cur, nxt; int ui = 0;
    if (!S.next(0, cur)) return;
    f32x4 acc[2][2][4][2];
#pragma unroll
    for (int a = 0; a < 2; ++a)
#pragma unroll
        for (int b = 0; b < 2; ++b)
#pragma unroll
            for (int m = 0; m < 4; ++m)
#pragma unroll
                for (int n = 0; n < 2; ++n) acc[a][b][m][n] = (f32x4){0.f, 0.f, 0.f, 0.f};
    bf16x8 At[4][2], B0[2][2], B1[2][2];
    unsigned gcur[2][2] = {{0u, 0u}, {0u, 0u}};
    const char* cA = S.a_ptr(cur); const char* cB = (const char*)Btp + (size_t)S.b_tile(cur) * tstep;
    if constexpr (GATHER) { PG8_LOADG(gcur, 0); PG8_WAIT_L(0); }
    PG8_STAGE(PG8_SB(0, 0), cB, voffB); PG8_STAGE(PG8_SB(0, 1), cB + hstep, voffB); PG8_STAGE_AC(PG8_SA(0, 0), 0, 0); PG8_STAGE_AC(PG8_SA(0, 1), 0, 1);
    if (wr == 1) PG8_BAR;
    PG8_WAIT_V(2); PG8_BAR;
    PG8_STAGE(PG8_SB(1, 0), cB + kstep, voffB); PG8_STAGE_AC(PG8_SA(1, 0), 1, 0); PG8_STAGE(PG8_SB(1, 1), cB + hstep + kstep, voffB);
    PG8_WAIT_V(6); PG8_BAR;
    for (;;) {
        const bool has_next = S.next(ui + 1, nxt);
        const char* nA = has_next ? S.a_ptr(nxt) : cA; const char* nB = has_next ? (const char*)Btp + (size_t)S.b_tile(nxt) * tstep : cB;
        const int nslot = has_next ? ui + 1 : ui;
        for (int t = 0; t < nt; t += 2) {
            const bool last = (t == nt - 2);
            const char* a2 = last ? nA : cA + (size_t)(t + 2) * kstep; const char* b2 = last ? nB : cB + (size_t)(t + 2) * kstep;
            const char* b3 = b2 + kstep;
            (void)a2;
            PG8_LDB(B0, 0, 0); PG8_LDB(B1, 0, 1); PG8_SCHED; PG8_LDA(At, 0, 0); PG8_STAGE_AC(PG8_SA(1, 1), t + 1, 1);
            PG8_WAIT_V(8); PG8_WAIT_L(0); PG8_BAR; PG8_MMA(0, 0, At, B0); PG8_MMA(0, 1, At, B1); PG8_BAR; PG8_SCHED;
            PG8_LDA(At, 0, 1); PG8_STAGE(PG8_SB(0, 0), b2, voffB); PG8_STAGE(PG8_SB(0, 1), b2 + hstep, voffB); PG8_STAGE_AN(PG8_SA(0, 0), 0, 0);
            PG8_WAIT_V(8); PG8_WAIT_L(0); PG8_BAR; PG8_MMA(1, 0, At, B0); PG8_MMA(1, 1, At, B1); PG8_BAR; PG8_SCHED;
            PG8_LDB(B0, 1, 0); PG8_LDB(B1, 1, 1); PG8_SCHED; PG8_LDA(At, 1, 0); PG8_STAGE_AN(PG8_SA(0, 1), 0, 1);
            PG8_WAIT_V(8); PG8_WAIT_L(0); PG8_BAR; PG8_MMA(0, 0, At, B0); PG8_MMA(0, 1, At, B1); PG8_BAR; PG8_SCHED;
            PG8_LDA(At, 1, 1); PG8_STAGE(PG8_SB(1, 0), b3, voffB); PG8_STAGE(PG8_SB(1, 1), b3 + hstep, voffB); PG8_STAGE_AN(PG8_SA(1, 0), 1, 0);
            PG8_WAIT_V(8); PG8_WAIT_L(0); PG8_BAR; PG8_MMA(1, 0, At, B0); PG8_MMA(1, 1, At, B1); PG8_BAR; PG8_SCHED;
        }
        if constexpr (ALIGN_EPI) { if (wr == 0) PG8_BAR; }
        { int fr_e = fr, fq_e = fq; asm volatile("" : "+v"(fr_e), "+v"(fq_e)); E(acc, cur, wr, wc, fr_e, fq_e); }
        if (!has_next) break;
#pragma unroll
        for (int a = 0; a < 2; ++a)
#pragma unroll
            for (int b = 0; b < 2; ++b)
#pragma unroll
                for (int m = 0; m < 4; ++m)
#pragma unroll
                    for (int n = 0; n < 2; ++n) acc[a][b][m][n] = (f32x4){0.f, 0.f, 0.f, 0.f};
        cur = nxt; cA = nA; cB = nB; ++ui;
        if constexpr (GATHER) { PG8_LOADG(gcur, ui); }
        if constexpr (ALIGN_EPI) { if (wr == 1) PG8_BAR; }
    }
    PG8_WAIT_V(0);
    if constexpr (!ALIGN_EPI) { if (wr == 0) PG8_BAR; }
    PG8_BAR;
#undef PG8_SA
#undef PG8_SB
#undef PG8_STAGE
#undef PG8_STAGE_AC
#undef PG8_STAGE_AN
#undef PG8_LDA
#undef PG8_LDB
#undef PG8_MMA
#undef PG8_WAIT_V
#undef PG8_WAIT_L
#undef PG8_BAR
#undef PG8_SCHED
#undef PG8_LOADG
}

typedef f32x4 AccT[2][2][4][2];
__device__ __forceinline__ u32x4 pack8(const f32x4 v0, const f32x4 v1) { u32x4 w; w.x = cvt_pk_bf16(v0[0], v0[1]); w.y = cvt_pk_bf16(v0[2], v0[3]); w.z = cvt_pk_bf16(v1[0], v1[1]); w.w = cvt_pk_bf16(v1[2], v1[3]); return w; }

struct EpiIn0 {
    static constexpr bool PERM = true;
    bf16_t* U; bf16_t* Q; bf16_t* KI; float* WI;
    __device__ __forceinline__ void operator()(const AccT& acc, const Unit& u, int wr, int wc, int fr, int fq) const {
        const int row0 = u.pm * BM + wr * 64 + fr;
        if (u.pn < 4) {
            const int col0 = u.pn * 128 + wc * 32 + 8 * fq;
#pragma unroll
            for (int ai = 0; ai < 2; ++ai)
#pragma unroll
                for (int m = 0; m < 4; ++m) { f32x4 o0, o1;
#pragma unroll
                    for (int j = 0; j < 4; ++j) { o0[j] = acc[ai][0][m][0][j] * sigmoidf_(acc[ai][1][m][0][j]); o1[j] = acc[ai][0][m][1][j] * sigmoidf_(acc[ai][1][m][1][j]); }
                    *(u32x4*)(U + (size_t)(row0 + ai * HALF + m * 16) * 512 + col0) = pack8(o0, o1); }
        } else if (u.pn < 12) {
            const int t = (u.pn - 4) >> 1; bf16_t* base = Q + (size_t)t * (SEG0 / 2); const float sc = 1.0f;
            const int col0 = ((u.pn - 4) & 1) * 256 + wc * 32 + 8 * fq;
#pragma unroll
            for (int ai = 0; ai < 2; ++ai)
#pragma unroll
                for (int m = 0; m < 4; ++m)
#pragma unroll
                    for (int bj = 0; bj < 2; ++bj)
                        *(u32x4*)(base + (size_t)(row0 + ai * HALF + m * 16) * 512 + col0 + bj * HALF) = pack8(acc[ai][bj][m][0] * sc, acc[ai][bj][m][1] * sc);
        } else {
            if (wc < 2) {
#pragma unroll
                for (int ai = 0; ai < 2; ++ai)
#pragma unroll
                    for (int m = 0; m < 4; ++m) *(u32x4*)(KI + (size_t)(row0 + ai * HALF + m * 16) * 64 + wc * 32 + 8 * fq) = pack8(acc[ai][0][m][0], acc[ai][0][m][1]);
            } else if (wc == 2 && fq == 0) {
                const float sc = 0.04419417382415922f;
#pragma unroll
                for (int ai = 0; ai < 2; ++ai)
#pragma unroll
                    for (int m = 0; m < 4; ++m) { float* p = WI + (size_t)(row0 + ai * HALF + m * 16) * 8; *(f32x4*)p = acc[ai][0][m][0] * sc; *(f32x4*)(p + 4) = acc[ai][0][m][1] * sc; }
            }
        }
    }
};
template <bool RB> struct EpiRes {
    static constexpr bool PERM = false;
    float* out; const void* resid;
    __device__ __forceinline__ void operator()(const AccT& acc, const Unit& u, int wr, int wc, int fr, int fq) const {
        const int row0 = u.pm * BM + wr * 64 + fr, col0 = u.pn * BM + wc * 32 + 4 * fq;
#pragma unroll
        for (int ai = 0; ai < 2; ++ai)
#pragma unroll
            for (int m = 0; m < 4; ++m) { const size_t off = (size_t)(row0 + ai * HALF + m * 16) * DM + col0;
#pragma unroll
                for (int bj = 0; bj < 2; ++bj)
#pragma unroll
                    for (int n = 0; n < 2; ++n) { f32x4 r;
                        if (RB) { const u32x2 w = *(const u32x2*)((const bf16_t*)resid + off + bj * HALF + n * 16); r = (f32x4){bf_lo(w.x), bf_hi(w.x), bf_lo(w.y), bf_hi(w.y)}; }
                        else r = *(const f32x4*)((const float*)resid + off + bj * HALF + n * 16);
                        *(f32x4*)(out + off + bj * HALF + n * 16) = r * ALPHA + acc[ai][bj][m][n]; } }
    }
};
__device__ __forceinline__ char* hm_tile(char* dout, char* ws, int p) { return p < HM_DOUT_TILES ? dout + (size_t)p * HM_TILE_BYTES : ws + WS_HM + (size_t)(p - HM_DOUT_TILES) * HM_TILE_BYTES; }
template <bool TILE_LOCAL> struct EpiSwiglu {
    static constexpr bool PERM = true;
    bf16_t* H; int ldh; char* dout; char* ws;
    __device__ __forceinline__ void operator()(const AccT& acc, const Unit& u, int wr, int wc, int fr, int fq) const {
        bf16_t* base; if constexpr (TILE_LOCAL) base = (bf16_t*)hm_tile(dout, ws, u.pm); else base = H + (size_t)u.pm * BM * ldh;
        const int rl0 = wr * 64 + fr, col0 = u.pn * 128 + wc * 32 + 8 * fq;
#pragma unroll
        for (int ai = 0; ai < 2; ++ai)
#pragma unroll
            for (int m = 0; m < 4; ++m) { f32x4 o0, o1;
#pragma unroll
                for (int j = 0; j < 4; ++j) { const float g0 = acc[ai][0][m][0][j], g1 = acc[ai][0][m][1][j];
                    o0[j] = g0 * sigmoidf_(g0) * acc[ai][1][m][0][j]; o1[j] = g1 * sigmoidf_(g1) * acc[ai][1][m][1][j]; }
                *(u32x4*)(base + (size_t)(rl0 + ai * HALF + m * 16) * ldh + col0) = pack8(o0, o1); }
    }
};
struct EpiQkv1 {
    static constexpr bool PERM = true;
    bf16_t* O; int ldc; float qscale;
    __device__ __forceinline__ void operator()(const AccT& acc, const Unit& u, int wr, int wc, int fr, int fq) const {
        const int row0 = u.pm * BM + wr * 64 + fr, col0 = u.pn * BM + wc * 32 + 8 * fq; const float sc = ((u.pn % 12) < 4) ? qscale : 1.0f;
#pragma unroll
        for (int ai = 0; ai < 2; ++ai)
#pragma unroll
            for (int m = 0; m < 4; ++m)
#pragma unroll
                for (int bj = 0; bj < 2; ++bj)
                    *(u32x4*)(O + (size_t)(row0 + ai * HALF + m * 16) * ldc + col0 + bj * HALF) = pack8(acc[ai][bj][m][0] * sc, acc[ai][bj][m][1] * sc);
    }
};
struct EpiMoeDown {
    static constexpr bool PERM = true;
    bf16_t* YB; const int* tokk; const float* gate; const PG8_LAS int* rt;
    __device__ __forceinline__ void operator()(const AccT& acc, const Unit& u, int wr, int wc, int fr, int fq) const {
        const int lbase = rt[u.pm * 4 + 1], nvalid = rt[u.pm * 4 + 2];
        const int rl0 = wr * 64 + fr, col0 = u.pn * BM + wc * 32 + 8 * fq;
#pragma unroll
        for (int ai = 0; ai < 2; ++ai)
#pragma unroll
            for (int m = 0; m < 4; ++m) { const int rl = rl0 + ai * HALF + m * 16;
                if (rl < nvalid) { const int tk = tokk[lbase + rl]; const float g = gate[lbase + rl];
                    bf16_t* rowp = YB + ((size_t)(tk & 1) * NTOK + (size_t)(tk >> 1)) * DM + col0;
#pragma unroll
                    for (int bj = 0; bj < 2; ++bj) *(u32x4*)(rowp + bj * HALF) = pack8(acc[ai][bj][m][0] * g, acc[ai][bj][m][1] * g); } }
    }
};
struct MoeOrder {
    int G, c, nM, nN; const PG8_LAS int* rt; const char* xbase; char* dout; char* ws; bool up;
    __device__ __forceinline__ bool next(int i, Unit& u) const {
        const long L = (long)i * G + c; if (L >= (long)nM * nN) return false;
        remap_unit((int)L, nM, nN, u.pm, u.pn); return true;
    }
    __device__ __forceinline__ const char* a_ptr(const Unit& u) const { return up ? xbase : (const char*)hm_tile(dout, ws, u.pm); }
    __device__ __forceinline__ int b_tile(const Unit& u) const { return __builtin_amdgcn_readfirstlane(rt[u.pm * 4]) * nN + u.pn; }
};
}


namespace swa {
constexpr int D = 128, NW = 8, QBLK = 32, KVBLK = 64, QB = NW * QBLK, WIN = 129;
constexpr int SHM_V = KVBLK * D * 2, SHM_K = KVBLK * D * 2;
constexpr int LDS_TB = 2 * SHM_V + 2 * SHM_K + NW * 64 * 4;
constexpr float SCALE = 0.08838834764831845f, THR = 8.f;
typedef float f32x16 __attribute__((ext_vector_type(16)));
typedef short s16x4 __attribute__((ext_vector_type(4)));
#define KSWZ(row, colB) ((row) * 256 + ((colB) ^ (((row) & 7) << 4)))
#define SBAR() __builtin_amdgcn_sched_barrier(0)
__device__ __forceinline__ int v_st(int k, int c) { const int kk = (k & ~0xC) | ((k & 4) << 1) | ((k & 8) >> 1); return ((kk >> 3) * 4 + (c >> 5)) * 512 + ((kk & 7) * 32 + (c & 31)) * 2; }
__device__ __forceinline__ int v_rd_base(int lane) { return ((lane & 3) << 3) | (((lane >> 2) & 3) << 6) | (((lane >> 4) & 1) << 5) | (((lane >> 5) & 1) << 8); }
constexpr int v_rd_off(int d0, int ks, int half) { return d0 * 512 + ks * 4096 + half * 2048; }
__device__ __forceinline__ int crow(int r, int hi) { return (r & 3) + 8 * (r >> 2) + 4 * hi; }
__device__ __forceinline__ bf16x8 load8(const bf16_t* p) { return *reinterpret_cast<const bf16x8*>(p); }
__device__ __forceinline__ void mask_bias_tile(f32x16& p0, f32x16& p1, int dq, const float* tb) {
    const float NEG = -__builtin_inff();
#pragma unroll
    for (int r = 0; r < 16; ++r) {
        const int c = (r & 3) + 8 * (r >> 2);
        p0[r] = ((unsigned)(dq - c) < (unsigned)WIN) ? p0[r] + tb[59 - c] : NEG;
        p1[r] = ((unsigned)(dq - c - 32) < (unsigned)WIN) ? p1[r] + tb[27 - c] : NEG;
    }
}
__device__ __forceinline__ void partialSM(f32x16& p0, f32x16& p1, float& m_reg, float& mn, float& alpha) {
    float pmax = p0[0];
#pragma unroll
    for (int r = 1; r < 16; ++r) pmax = fmaxf(pmax, p0[r]);
#pragma unroll
    for (int r = 0; r < 16; ++r) pmax = fmaxf(pmax, p1[r]);
    { auto rr = __builtin_amdgcn_permlane32_swap(__float_as_uint(pmax), __float_as_uint(pmax), false, false);
      pmax = fmaxf(__uint_as_float(rr[0]), __uint_as_float(rr[1])); }
    constexpr float C2 = 1.4426950408889634f * SCALE;
    if (__builtin_expect(__all((pmax - m_reg) * SCALE <= THR), 1)) { mn = m_reg; alpha = 1.f; }
    else { mn = fmaxf(m_reg, pmax); alpha = __builtin_amdgcn_exp2f((m_reg - mn) * C2); m_reg = mn; }
    const float mnL = -mn * C2;
#pragma unroll
    for (int r = 0; r < 16; ++r) p0[r] = fmaf(p0[r], C2, mnL);
#pragma unroll
    for (int r = 0; r < 16; ++r) p1[r] = fmaf(p1[r], C2, mnL);
#pragma unroll
    for (int r = 0; r < 16; ++r) p0[r] = __builtin_amdgcn_exp2f(p0[r]);
}
__device__ __forceinline__ void finishSM(f32x16& p0, f32x16& p1, float alpha, float& l_reg, bf16x8& pa0, bf16x8& pa1, bf16x8& pa2, bf16x8& pa3) {
#pragma unroll
    for (int r = 0; r < 16; ++r) p1[r] = __builtin_amdgcn_exp2f(p1[r]);
    float ps = 0;
#pragma unroll
    for (int r = 0; r < 16; ++r) ps += p0[r];
#pragma unroll
    for (int r = 0; r < 16; ++r) ps += p1[r];
    { auto rr = __builtin_amdgcn_permlane32_swap(__float_as_uint(ps), __float_as_uint(ps), false, false);
      ps = __uint_as_float(rr[0]) + __uint_as_float(rr[1]); }
    l_reg = l_reg * alpha + ps;
#define PK4(P, B_, OUT) do { unsigned a0 = cvt_pk_bf16(P[B_+0], P[B_+1]), a1 = cvt_pk_bf16(P[B_+2], P[B_+3]);                          \
        unsigned b0 = cvt_pk_bf16(P[B_+4], P[B_+5]), b1 = cvt_pk_bf16(P[B_+6], P[B_+7]);                                             \
        auto r0 = __builtin_amdgcn_permlane32_swap(a0, b0, false, false); auto r1 = __builtin_amdgcn_permlane32_swap(a1, b1, false, false); \
        u32x4 w = {r0[0], r1[0], r0[1], r1[1]}; OUT = *reinterpret_cast<bf16x8*>(&w); } while (0)
    PK4(p0, 0, pa0); PK4(p0, 8, pa1); PK4(p1, 0, pa2); PK4(p1, 8, pa3);
#undef PK4
}
template <int KB>
__device__ __forceinline__ void qkt(f32x16& p0, f32x16& p1, const char* K_lds, int r32, int hi, const bf16x8* qr, bool act) {
    if (!act) { const float NEG = -__builtin_inff();
#pragma unroll
        for (int r = 0; r < 16; ++r) { p0[r] = NEG; p1[r] = NEG; } return; }
    p0 = f32x16{}; p1 = f32x16{};
    const char* kb[4];
#pragma unroll
    for (int dd = 0; dd < 4; ++dd) kb[dd] = K_lds + KB * SHM_K + KSWZ(r32, (dd * 16 + hi * 8) * 2);
#pragma unroll
    for (int d0 = 0; d0 < 8; ++d0) { const char* a = kb[d0 & 3] + (d0 >> 2) * 128;
        bf16x8 b0 = *reinterpret_cast<const bf16x8*>(a);
        bf16x8 b1 = *reinterpret_cast<const bf16x8*>(a + 32 * 256);
        p0 = __builtin_amdgcn_mfma_f32_32x32x16_bf16(b0, qr[d0], p0, 0, 0, 0);
        p1 = __builtin_amdgcn_mfma_f32_32x32x16_bf16(b1, qr[d0], p1, 0, 0, 0); }
}
template <int VB>
__device__ __forceinline__ void pv_tile(f32x16* o, int vb0, bf16x8 pa0, bf16x8 pa1, bf16x8 pa2, bf16x8 pa3, bool act) {
    if (!act) return;
#define TRRD(dst, off) asm volatile("ds_read_b64_tr_b16 %0, %1 offset:%2" : "=&v"(dst) : "v"(vb0), "i"(off) : "memory")
#define PV_D0(d0) do { s16x4 l0, l1, l2, l3, h0, h1, h2, h3; constexpr int b_ = VB * SHM_V + v_rd_off(d0, 0, 0); \
        TRRD(l0, b_); TRRD(h0, b_ + 2048); TRRD(l1, b_ + 4096); TRRD(h1, b_ + 6144); TRRD(l2, b_ + 8192); TRRD(h2, b_ + 10240); TRRD(l3, b_ + 12288); TRRD(h3, b_ + 14336); \
        asm volatile("s_waitcnt lgkmcnt(0)" ::: "memory"); SBAR();   \
        o[d0] = __builtin_amdgcn_mfma_f32_32x32x16_bf16(pa0, (bf16x8){l0[0], l0[1], l0[2], l0[3], h0[0], h0[1], h0[2], h0[3]}, o[d0], 0, 0, 0);   \
        o[d0] = __builtin_amdgcn_mfma_f32_32x32x16_bf16(pa1, (bf16x8){l1[0], l1[1], l1[2], l1[3], h1[0], h1[1], h1[2], h1[3]}, o[d0], 0, 0, 0);   \
        o[d0] = __builtin_amdgcn_mfma_f32_32x32x16_bf16(pa2, (bf16x8){l2[0], l2[1], l2[2], l2[3], h2[0], h2[1], h2[2], h2[3]}, o[d0], 0, 0, 0);   \
        o[d0] = __builtin_amdgcn_mfma_f32_32x32x16_bf16(pa3, (bf16x8){l3[0], l3[1], l3[2], l3[3], h3[0], h3[1], h3[2], h3[3]}, o[d0], 0, 0, 0); } while (0)
    PV_D0(0); PV_D0(1); PV_D0(2); PV_D0(3);
#undef PV_D0
#undef TRRD
}
struct BlockRef { const bf16_t* Q; const bf16_t* K; bf16_t* O; float* LSE; int P0, bh, dsh;
    __device__ __forceinline__ int rs() const { return IN1_N << dsh; }
    __device__ __forceinline__ int os() const { return DM << dsh; }
    __device__ __forceinline__ int ls() const { return 8 << dsh; }
    __device__ __forceinline__ int skv() const { return SEQ >> dsh; }
    __device__ __forceinline__ const bf16_t* V() const { return K + 1024; } };
struct Seam { bf16x8 qr[8]; bf16x8 st_v0, st_v1, st_k0, st_k1; };
__device__ __forceinline__ int swa_jlo(int P0) { const int lowk = P0 - WIN + 1; return lowk > 0 ? lowk / KVBLK : 0; }
#define ROWP(p, k0, rs_, vo) ((const bf16_t*)((const char*)(p) + (size_t)(k0) * (size_t)(rs_) * 2 + (size_t)(vo)))
#define VMW() asm volatile("s_waitcnt vmcnt(0)" ::: "memory")
#define VMWN(n) asm volatile("s_waitcnt vmcnt(%0)" :: "i"(n) : "memory")
#define TIDL() int tid_l = tid; asm volatile("" : "+v"(tid_l)); const int sr = tid_l >> 4, sc = (tid_l & 15) * 8; (void)sr; (void)sc
#define SLOAD_H(Kp, Vp, k0, rs_) do { TIDL(); const unsigned vo0_ = (unsigned)(sr * (rs_) + sc) * 2u, vo1_ = vo0_ + (unsigned)(rs_) * 64u; \
                         S.st_v0 = load8(ROWP(Vp, k0, rs_, vo0_)); S.st_v1 = load8(ROWP(Vp, k0, rs_, vo1_));              \
                         S.st_k0 = load8(ROWP(Kp, k0, rs_, vo0_)); S.st_k1 = load8(ROWP(Kp, k0, rs_, vo1_)); } while (0)
#define SWRITE_HK(bf) do { TIDL(); const int kws = KSWZ(sr, sc * 2); *(bf16x8*)(K_lds + (bf) * SHM_K + kws) = S.st_k0; *(bf16x8*)(K_lds + (bf) * SHM_K + kws + 32 * 256) = S.st_k1; } while (0)
#define SWRITE_HV(bf) do { TIDL(); const int vst0 = v_st(sr, sc), vst1 = v_st(32 + sr, sc); *(bf16x8*)(V_lds + (bf) * SHM_V + vst0) = S.st_v0; *(bf16x8*)(V_lds + (bf) * SHM_V + vst1) = S.st_v1; } while (0)
#define SWRITE_H(bf) do { SWRITE_HV(bf); SWRITE_HK(bf); } while (0)
__device__ __forceinline__ void tb_load(const float* biast, int bh, int dsh, int tid, float& v0, float& v1) {
    const int d0 = tid - 384, d1 = tid + 512 - 384;
    v0 = (d0 >= 0 && d0 < WIN) ? biast[bh * 4096 + (d0 << dsh)] * (1.0f / SCALE) : 0.f;
    v1 = (d1 >= 0 && d1 < WIN) ? biast[bh * 4096 + (d1 << dsh)] * (1.0f / SCALE) : 0.f;
}
__device__ __forceinline__ void swa_prime(const BlockRef& cur, const float* biast, char* lds, Seam& S, int tid) {
    const int wid = __builtin_amdgcn_readfirstlane(tid >> 6), lane = tid & 63, r32 = lane & 31, hi = lane >> 5;
    char* K_lds = lds + 2 * SHM_V;
    const int kb0 = swa_jlo(cur.P0) * KVBLK;
    float t0, t1; tb_load(biast, cur.bh, cur.dsh, tid, t0, t1);
#pragma unroll
    for (int d0 = 0; d0 < 8; ++d0) S.qr[d0] = load8((const bf16_t*)((const char*)cur.Q + (size_t)((unsigned)((wid * QBLK + r32) * cur.rs() + hi * 8) * 2u)) + d0 * 16);
    SLOAD_H(cur.K, cur.V(), kb0, cur.rs()); VMW(); SWRITE_HK(0);
    float* tb = (float*)(lds + LDS_TB); tb[tid] = t0; tb[tid + 512] = t1;
    __syncthreads();
}
__device__ __forceinline__ void swa_block(const BlockRef& cur, const BlockRef& nxt, const float* biast, int slot, char* lds, Seam& S, int tid) {
    const int wid = __builtin_amdgcn_readfirstlane(tid >> 6), lane = tid & 63, r32 = lane & 31, hi = lane >> 5;
    const int j_lo = swa_jlo(cur.P0);
    int j_hi = (cur.P0 + QB - 1) / KVBLK + 1; if (j_hi > cur.skv() / KVBLK) j_hi = cur.skv() / KVBLK;
    const int NT = j_hi - j_lo;
    const int kbn = swa_jlo(nxt.P0) * KVBLK;
    const int qlo = cur.P0 + wid * QBLK, qm = qlo + r32 - 4 * hi;
    char* V_lds = lds; char* K_lds = lds + 2 * SHM_V;
    float* wsl = (float*)(lds + 2 * SHM_V + 2 * SHM_K) + wid * 64; float* li_l = wsl, * al_l = wsl + 32;
    const float* tbl0 = (const float*)(lds + LDS_TB + slot * 4096) + 325;
    float m_reg = -1e30f, l_reg = 0; f32x16 o[4] = {};
    const int vb0 = (int)(uintptr_t)V_lds + v_rd_base(lane);
    const bf16_t* Kh = cur.K; const bf16_t* Vh = cur.V(); const int rs = cur.rs();
#define RESC(a) do { if (__any((a) < 1.f)) { if (hi == 0) al_l[r32] = (a); asm volatile("s_waitcnt lgkmcnt(0)" ::: "memory");              \
                     _Pragma("unroll") for (int d_ = 0; d_ < 4; ++d_) _Pragma("unroll") for (int r = 0; r < 16; ++r) o[d_][r] *= al_l[crow(r, hi)]; } } while (0)
#define KBASE(t) ((j_lo + (t)) * KVBLK)
#define ACT(t) (KBASE(t) <= qlo + QBLK - 1 && KBASE(t) + KVBLK - 1 >= qlo - WIN + 1)
#define MASKT(P0_, P1_, t) do { const int kb_ = KBASE(t); if (ACT(t)) mask_bias_tile(P0_, P1_, qm - kb_, tbl0 + (qm - kb_)); } while (0)
    constexpr int NQL = 8;
#define SEAM_K0() do { VMWN(NQL); SWRITE_HK(0); SBAR(); } while (0)
    f32x16 pA0, pA1, pB0, pB1; float mnA, mnB, alA, alB; bf16x8 pa0, pa1, pa2, pa3;
    SWRITE_HV(0); SBAR();
    if (NT > 1) { SLOAD_H(Kh, Vh, KBASE(1), rs); }
    SBAR(); qkt<0>(pA0, pA1, K_lds, r32, hi, S.qr, ACT(0));
    MASKT(pA0, pA1, 0); partialSM(pA0, pA1, m_reg, mnA, alA);
    if (NT > 1) { VMW(); SWRITE_H(1); }
    __syncthreads();
#define HALF_STEP(PX0, PX1, mnX, alX, PY0, PY1, alY, t, KB, VB, SB) do {                                                      \
        SBAR(); qkt<KB>(PX0, PX1, K_lds, r32, hi, S.qr, ACT(t));                                             \
        finishSM(PY0, PY1, alY, l_reg, pa0, pa1, pa2, pa3); SBAR();                                                           \
        if ((t) + 1 < NT) { SLOAD_H(Kh, Vh, KBASE((t) + 1), rs); SBAR(); }                                               \
        pv_tile<VB>(o, vb0, pa0, pa1, pa2, pa3, ACT((t) - 1)); MASKT(PX0, PX1, (t)); partialSM(PX0, PX1, m_reg, mnX, alX);                                        \
        __syncthreads();                                                                                                      \
        if ((t) + 1 < NT) { VMW(); SWRITE_H(SB); }                                                                          \
        RESC(alX); __syncthreads(); } while (0)
    for (int t = 1; t + 1 < NT; t += 2) {
        HALF_STEP(pB0, pB1, mnB, alB, pA0, pA1, alA, t, 1, 0, 0);
        HALF_STEP(pA0, pA1, mnA, alA, pB0, pB1, alB, t + 1, 0, 1, 1);
    }
    const bool even = (NT & 1) == 0;
    if (even) { SBAR(); qkt<1>(pB0, pB1, K_lds, r32, hi, S.qr, ACT(NT - 1)); SBAR(); }
    SLOAD_H(nxt.K, nxt.V(), kbn, nxt.rs()); SBAR();
#pragma unroll
    for (int d0 = 0; d0 < 8; ++d0) S.qr[d0] = load8((const bf16_t*)((const char*)nxt.Q + (size_t)((unsigned)((wid * QBLK + r32) * nxt.rs() + hi * 8) * 2u)) + d0 * 16);
    SBAR();
    finishSM(pA0, pA1, alA, l_reg, pa0, pa1, pa2, pa3); SBAR();
    pv_tile<0>(o, vb0, pa0, pa1, pa2, pa3, ACT(even ? NT - 2 : NT - 1));
    if (even) { MASKT(pB0, pB1, NT - 1); partialSM(pB0, pB1, m_reg, mnB, alB); __syncthreads(); RESC(alB);
        finishSM(pB0, pB1, alB, l_reg, pa0, pa1, pa2, pa3); SBAR(); pv_tile<1>(o, vb0, pa0, pa1, pa2, pa3, ACT(NT - 1)); }
    SBAR(); SEAM_K0();
    float t0, t1; tb_load(biast, nxt.bh, nxt.dsh, tid, t0, t1);
    if (hi == 0) li_l[r32] = l_reg; asm volatile("s_waitcnt lgkmcnt(0)" ::: "memory");
    int r32e = r32, hie = hi; asm volatile("" : "+v"(r32e), "+v"(hie));
    if (hie == 0) cur.LSE[(size_t)(wid * QBLK + r32e) * cur.ls()] = m_reg * SCALE + __logf(l_reg);
    float rli[16];
#pragma unroll
    for (int r = 0; r < 16; ++r) rli[r] = __builtin_amdgcn_rcpf(li_l[crow(r, hie)]);
    const int os = cur.os();
    bf16_t* Ow = cur.O + (size_t)(wid * QBLK) * os;
#pragma unroll
    for (int r = 0; r < 16; ++r) { const unsigned oo = (unsigned)(crow(r, hie) * os + r32e) * 2u;
#pragma unroll
        for (int d0 = 0; d0 < 4; ++d0) { const float v = o[d0][r] * rli[r];
            const float vn = swz_xor<1>(v);
            if ((r32e & 1) == 0) *(unsigned*)((char*)Ow + oo + d0 * 64) = cvt_pk_bf16(v, vn); } }
    { float* tb = (float*)(lds + LDS_TB + (slot ^ 1) * 4096); tb[tid] = t0; tb[tid + 512] = t1; }
    __syncthreads();
#undef RESC
#undef KBASE
#undef ACT
#undef MASKT
#undef SEAM_K0
#undef HALF_STEP
}
#undef ROWP
#undef VMW
#undef VMWN
#undef SLOAD_H
#undef SWRITE_HK
#undef SWRITE_HV
#undef SWRITE_H
#undef TIDL
#undef KSWZ
#undef SBAR
}


namespace dsa {
constexpr int D = 64, NW = 8, QBLK = 32, KVBLK = 64, QB = NW * QBLK;
constexpr int SHM_V = KVBLK * D * 2, SHM_K = KVBLK * D * 2;
constexpr int LDS_TB = 2 * SHM_V + 2 * SHM_K + NW * 64 * 4;
constexpr int TB_PAD = 128;
constexpr float SCALE = 0.125f, THR = 8.f;
typedef float f32x16 __attribute__((ext_vector_type(16)));
typedef short s16x4 __attribute__((ext_vector_type(4)));
#define KSWZ(row, colB) ((row) * 128 + ((colB) ^ (((row) & 7) << 4)))
#define SBAR() __builtin_amdgcn_sched_barrier(0)
__device__ __forceinline__ int v_st(int k, int c) { const int kk = (k & ~0xC) | ((k & 4) << 1) | ((k & 8) >> 1); return ((kk >> 3) * 2 + (c >> 5)) * 512 + ((kk & 7) * 32 + (c & 31)) * 2; }
__device__ __forceinline__ int v_rd_base(int lane) { return ((lane & 3) << 3) | (((lane >> 2) & 3) << 6) | (((lane >> 4) & 1) << 5) | (((lane >> 5) & 1) << 8); }
__device__ __forceinline__ int crow(int r, int hi) { return (r & 3) + 8 * (r >> 2) + 4 * hi; }
__device__ __forceinline__ bf16x8 load8(const bf16_t* p) { return *reinterpret_cast<const bf16x8*>(p); }
__device__ __forceinline__ void mask_bias_tile(f32x16& p0, f32x16& p1, const float* tb, unsigned lo4, unsigned hi4) {
    const float NEG = -__builtin_inff();
#pragma unroll
    for (int r = 0; r < 16; ++r) {
        const int c = (r & 3) + 8 * (r >> 2);
        p0[r] = ((lo4 >> c) & 1u) ? p0[r] + tb[63 - c] : NEG;
        p1[r] = ((hi4 >> c) & 1u) ? p1[r] + tb[31 - c] : NEG;
    }
}
__device__ __forceinline__ void partialSM(f32x16& p0, f32x16& p1, float& m_reg, float& mn, float& alpha) {
    float pmax = p0[0];
#pragma unroll
    for (int r = 1; r < 16; ++r) pmax = fmaxf(pmax, p0[r]);
#pragma unroll
    for (int r = 0; r < 16; ++r) pmax = fmaxf(pmax, p1[r]);
    { auto rr = __builtin_amdgcn_permlane32_swap(__float_as_uint(pmax), __float_as_uint(pmax), false, false);
      pmax = fmaxf(__uint_as_float(rr[0]), __uint_as_float(rr[1])); }
    constexpr float C2 = 1.4426950408889634f * SCALE;
    if (__builtin_expect(__all((pmax - m_reg) * SCALE <= THR), 1)) { mn = m_reg; alpha = 1.f; }
    else { mn = fmaxf(m_reg, pmax); alpha = __builtin_amdgcn_exp2f((m_reg - mn) * C2); m_reg = mn; }
    const float mnL = -mn * C2;
#pragma unroll
    for (int r = 0; r < 16; ++r) p0[r] = fmaf(p0[r], C2, mnL);
#pragma unroll
    for (int r = 0; r < 16; ++r) p1[r] = fmaf(p1[r], C2, mnL);
#pragma unroll
    for (int r = 0; r < 16; ++r) p0[r] = __builtin_amdgcn_exp2f(p0[r]);
}
__device__ __forceinline__ void finishSM(f32x16& p0, f32x16& p1, float alpha, float& l_reg, bf16x8& pa0, bf16x8& pa1, bf16x8& pa2, bf16x8& pa3) {
#pragma unroll
    for (int r = 0; r < 16; ++r) p1[r] = __builtin_amdgcn_exp2f(p1[r]);
    float ps = 0;
#pragma unroll
    for (int r = 0; r < 16; ++r) ps += p0[r];
#pragma unroll
    for (int r = 0; r < 16; ++r) ps += p1[r];
    { auto rr = __builtin_amdgcn_permlane32_swap(__float_as_uint(ps), __float_as_uint(ps), false, false);
      ps = __uint_as_float(rr[0]) + __uint_as_float(rr[1]); }
    l_reg = l_reg * alpha + ps;
#define PK4(P, B_, OUT) do { unsigned a0 = cvt_pk_bf16(P[B_+0], P[B_+1]), a1 = cvt_pk_bf16(P[B_+2], P[B_+3]);                          \
        unsigned b0 = cvt_pk_bf16(P[B_+4], P[B_+5]), b1 = cvt_pk_bf16(P[B_+6], P[B_+7]);                                             \
        auto r0 = __builtin_amdgcn_permlane32_swap(a0, b0, false, false); auto r1 = __builtin_amdgcn_permlane32_swap(a1, b1, false, false); \
        u32x4 w = {r0[0], r1[0], r0[1], r1[1]}; OUT = *reinterpret_cast<bf16x8*>(&w); } while (0)
    PK4(p0, 0, pa0); PK4(p0, 8, pa1); PK4(p1, 0, pa2); PK4(p1, 8, pa3);
#undef PK4
}
template <int KB>
__device__ __forceinline__ void qkt(f32x16& p0, f32x16& p1, const char* K_lds, int r32, int hi, const bf16x8* qr, bool act) {
    if (!act) { const float NEG = -__builtin_inff();
#pragma unroll
        for (int r = 0; r < 16; ++r) { p0[r] = NEG; p1[r] = NEG; } return; }
    p0 = f32x16{}; p1 = f32x16{};
#pragma unroll
    for (int d0 = 0; d0 < 4; ++d0) { const char* a = K_lds + KB * SHM_K + KSWZ(r32, (d0 * 16 + hi * 8) * 2);
        bf16x8 b0 = *reinterpret_cast<const bf16x8*>(a);
        bf16x8 b1 = *reinterpret_cast<const bf16x8*>(a + 32 * 128);
        p0 = __builtin_amdgcn_mfma_f32_32x32x16_bf16(b0, qr[d0], p0, 0, 0, 0);
        p1 = __builtin_amdgcn_mfma_f32_32x32x16_bf16(b1, qr[d0], p1, 0, 0, 0); }
}
template <int VB>
__device__ __forceinline__ void pv_tile(f32x16* o, int vb0, bf16x8 pa0, bf16x8 pa1, bf16x8 pa2, bf16x8 pa3, bool act) {
    if (!act) return;
#define TRRD(dst, off) asm volatile("ds_read_b64_tr_b16 %0, %1 offset:%2" : "=&v"(dst) : "v"(vb0), "i"(off) : "memory")
#define PV_D0(d0) do { s16x4 l0, l1, l2, l3, h0, h1, h2, h3; constexpr int b_ = VB * SHM_V + (d0) * 512; \
        TRRD(l0, b_); TRRD(h0, b_ + 1024); TRRD(l1, b_ + 2048); TRRD(h1, b_ + 3072); TRRD(l2, b_ + 4096); TRRD(h2, b_ + 5120); TRRD(l3, b_ + 6144); TRRD(h3, b_ + 7168); \
        asm volatile("s_waitcnt lgkmcnt(0)" ::: "memory"); SBAR();   \
        o[d0] = __builtin_amdgcn_mfma_f32_32x32x16_bf16(pa0, (bf16x8){l0[0], l0[1], l0[2], l0[3], h0[0], h0[1], h0[2], h0[3]}, o[d0], 0, 0, 0);   \
        o[d0] = __builtin_amdgcn_mfma_f32_32x32x16_bf16(pa1, (bf16x8){l1[0], l1[1], l1[2], l1[3], h1[0], h1[1], h1[2], h1[3]}, o[d0], 0, 0, 0);   \
        o[d0] = __builtin_amdgcn_mfma_f32_32x32x16_bf16(pa2, (bf16x8){l2[0], l2[1], l2[2], l2[3], h2[0], h2[1], h2[2], h2[3]}, o[d0], 0, 0, 0);   \
        o[d0] = __builtin_amdgcn_mfma_f32_32x32x16_bf16(pa3, (bf16x8){l3[0], l3[1], l3[2], l3[3], h3[0], h3[1], h3[2], h3[3]}, o[d0], 0, 0, 0); } while (0)
    PV_D0(0); PV_D0(1);
#undef PV_D0
#undef TRRD
}
struct BlockRef { const bf16_t* Q; const bf16_t* K; const bf16_t* V; bf16_t* O; const u64* MW; int P0; };
struct Seam { bf16x8 qr[4]; bf16x8 st_v0, st_k0; u64 mw; };
#define VMW() asm volatile("s_waitcnt vmcnt(0)" ::: "memory")
#define VMWN(n) asm volatile("s_waitcnt vmcnt(%0)" :: "i"(n) : "memory")
#define TIDL() int tid_l = tid; asm volatile("" : "+v"(tid_l)); const int sr = tid_l >> 3, sc = (tid_l & 7) * 8; (void)sr; (void)sc
#define SLOAD_H(Kp, Vp, k0) do { TIDL(); const unsigned vo_ = (unsigned)((k0 + sr) * 512 + sc) * 2u; \
        S.st_v0 = load8((const bf16_t*)((const char*)(Vp) + vo_)); S.st_k0 = load8((const bf16_t*)((const char*)(Kp) + vo_)); } while (0)
#define SWRITE_HK(bf) do { TIDL(); *(bf16x8*)(K_lds + (bf) * SHM_K + KSWZ(sr, sc * 2)) = S.st_k0; } while (0)
#define SWRITE_HV(bf) do { TIDL(); *(bf16x8*)(V_lds + (bf) * SHM_V + v_st(sr, sc)) = S.st_v0; } while (0)
#define SWRITE_H(bf) do { SWRITE_HV(bf); SWRITE_HK(bf); } while (0)
#define MWLOAD(ref, tile) ((ref).MW[(size_t)(tile) * SEQ + wid * QBLK + r32])
__device__ __forceinline__ void dsa_prime(const BlockRef& cur, char* lds, Seam& S, int tid) {
    const int wid = __builtin_amdgcn_readfirstlane(tid >> 6), lane = tid & 63, r32 = lane & 31, hi = lane >> 5;
    char* K_lds = lds + 2 * SHM_V;
#pragma unroll
    for (int d0 = 0; d0 < 4; ++d0) S.qr[d0] = load8(cur.Q + (size_t)(wid * QBLK + r32) * 512 + d0 * 16 + hi * 8);
    S.mw = MWLOAD(cur, 0);
    SLOAD_H(cur.K, cur.V, 0); VMW(); SWRITE_HK(0);
    __syncthreads();
}
__device__ __forceinline__ void dsa_block(const BlockRef& cur, const BlockRef& nxt, char* lds, Seam& S, int tid) {
    const int wid = __builtin_amdgcn_readfirstlane(tid >> 6), lane = tid & 63, r32 = lane & 31, hi = lane >> 5;
    const int NT = (cur.P0 + QB - 1) / KVBLK + 1;
    const int qlo = cur.P0 + wid * QBLK, qm = qlo + r32 - 4 * hi;
    char* V_lds = lds; char* K_lds = lds + 2 * SHM_V;
    float* wsl = (float*)(lds + 2 * SHM_V + 2 * SHM_K) + wid * 64; float* li_l = wsl, * al_l = wsl + 32;
    const float* tbl0 = (const float*)(lds + LDS_TB) + (TB_PAD - 63);
    float m_reg = -1e30f, l_reg = 0; f32x16 o[2] = {};
    const int vb0 = (int)(uintptr_t)V_lds + v_rd_base(lane);
    const bf16_t* Kh = cur.K; const bf16_t* Vh = cur.V;
#define RESC(a) do { if (__any((a) < 1.f)) { if (hi == 0) al_l[r32] = (a); asm volatile("s_waitcnt lgkmcnt(0)" ::: "memory");              \
                     _Pragma("unroll") for (int d_ = 0; d_ < 2; ++d_) _Pragma("unroll") for (int r = 0; r < 16; ++r) o[d_][r] *= al_l[crow(r, hi)]; } } while (0)
#define KBASE(t) ((t) * KVBLK)
#define ACT(t) (KBASE(t) <= qlo + QBLK - 1)
#define MASKT(P0_, P1_, t, MWX) do { const int kb_ = KBASE(t); if (ACT(t)) mask_bias_tile(P0_, P1_, tbl0 + (qm - kb_), (unsigned)(MWX) >> (4 * hi), (unsigned)((MWX) >> 32) >> (4 * hi)); } while (0)
    constexpr int NQL = 5;
#define SEAM_K0() do { VMWN(NQL); SWRITE_HK(0); SBAR(); } while (0)
    f32x16 pA0, pA1, pB0, pB1; float mnA, mnB, alA, alB; bf16x8 pa0, pa1, pa2, pa3;
    u64 mwA = S.mw, mwB = 0;
    SWRITE_HV(0); SBAR();
    if (NT > 1) { SLOAD_H(Kh, Vh, KBASE(1)); mwB = MWLOAD(cur, 1); }
    SBAR(); qkt<0>(pA0, pA1, K_lds, r32, hi, S.qr, ACT(0));
    MASKT(pA0, pA1, 0, mwA); partialSM(pA0, pA1, m_reg, mnA, alA);
    if (NT > 1) { VMW(); SWRITE_H(1); }
    __syncthreads();
#define HALF_STEP(PX0, PX1, mnX, alX, PY0, PY1, alY, t, KB, VB, SB, MWX, MWY) do {                                                      \
        SBAR(); qkt<KB>(PX0, PX1, K_lds, r32, hi, S.qr, ACT(t));                                             \
        finishSM(PY0, PY1, alY, l_reg, pa0, pa1, pa2, pa3); SBAR();                                                           \
        if ((t) + 1 < NT) { SLOAD_H(Kh, Vh, KBASE((t) + 1)); MWY = MWLOAD(cur, (t) + 1); SBAR(); }                                               \
        pv_tile<VB>(o, vb0, pa0, pa1, pa2, pa3, ACT((t) - 1)); MASKT(PX0, PX1, (t), MWX); partialSM(PX0, PX1, m_reg, mnX, alX);                                        \
        __syncthreads();                                                                                                      \
        if ((t) + 1 < NT) { VMW(); SWRITE_H(SB); }                                                                          \
        RESC(alX); __syncthreads(); } while (0)
    for (int t = 1; t + 1 < NT; t += 2) {
        HALF_STEP(pB0, pB1, mnB, alB, pA0, pA1, alA, t, 1, 0, 0, mwB, mwA);
        HALF_STEP(pA0, pA1, mnA, alA, pB0, pB1, alB, t + 1, 0, 1, 1, mwA, mwB);
    }
    const bool even = (NT & 1) == 0;
    if (even) { SBAR(); qkt<1>(pB0, pB1, K_lds, r32, hi, S.qr, ACT(NT - 1)); SBAR(); }
    SLOAD_H(nxt.K, nxt.V, 0); SBAR();
#pragma unroll
    for (int d0 = 0; d0 < 4; ++d0) S.qr[d0] = load8(nxt.Q + (size_t)(wid * QBLK + r32) * 512 + d0 * 16 + hi * 8);
    S.mw = MWLOAD(nxt, 0);
    SBAR();
    finishSM(pA0, pA1, alA, l_reg, pa0, pa1, pa2, pa3); SBAR();
    pv_tile<0>(o, vb0, pa0, pa1, pa2, pa3, ACT(even ? NT - 2 : NT - 1));
    if (even) { MASKT(pB0, pB1, NT - 1, mwB); partialSM(pB0, pB1, m_reg, mnB, alB); __syncthreads(); RESC(alB);
        finishSM(pB0, pB1, alB, l_reg, pa0, pa1, pa2, pa3); SBAR(); pv_tile<1>(o, vb0, pa0, pa1, pa2, pa3, ACT(NT - 1)); }
    SBAR(); SEAM_K0();
    if (hi == 0) li_l[r32] = l_reg; asm volatile("s_waitcnt lgkmcnt(0)" ::: "memory");
    int r32e = r32, hie = hi; asm volatile("" : "+v"(r32e), "+v"(hie));
    float rli[16];
#pragma unroll
    for (int r = 0; r < 16; ++r) rli[r] = __builtin_amdgcn_rcpf(li_l[crow(r, hie)]);
    bf16_t* Ow = cur.O + (size_t)(wid * QBLK) * DM;
#pragma unroll
    for (int r = 0; r < 16; ++r) { const unsigned oo = (unsigned)(crow(r, hie) * DM + r32e) * 2u;
#pragma unroll
        for (int d0 = 0; d0 < 2; ++d0) { const float v = o[d0][r] * rli[r];
            const float vn = swz_xor<1>(v);
            if ((r32e & 1) == 0) *(unsigned*)((char*)Ow + oo + d0 * 64) = cvt_pk_bf16(v, vn); } }
    __syncthreads();
#undef RESC
#undef KBASE
#undef ACT
#undef MASKT
#undef SEAM_K0
#undef HALF_STEP
}
#undef VMW
#undef VMWN
#undef TIDL
#undef SLOAD_H
#undef SWRITE_HK
#undef SWRITE_HV
#undef SWRITE_H
#undef MWLOAD
#undef KSWZ
#undef SBAR
}

__device__ __forceinline__ swa::BlockRef dil_ref(int u, const bf16_t* H1p, bf16_t* OPp, float* LSEp) {
    const int x = u & 15, rest = u >> 4, g = rest % 3, bh = rest / 3, h = bh & 7, bl = bh >> 3;
    const int dsh = 2 * g, dil = 1 << dsh, r = x >> (4 - dsh), blk = x & ((16 >> dsh) - 1), P0 = blk * 256;
    const size_t row0 = (size_t)bl * SEQ + r, rowq = row0 + (size_t)dil * P0;
    swa::BlockRef R;
    R.K = H1p + row0 * IN1_N + g * 3072 + 1024 + h * 128; R.Q = H1p + rowq * IN1_N + g * 3072 + h * 128;
    R.O = OPp + ((size_t)g * CHUNK_T + rowq) * DM + h * 128; R.LSE = LSEp + ((size_t)g * CHUNK_T + rowq) * 8 + h;
    R.P0 = P0; R.bh = h; R.dsh = dsh;
    return R;
}

struct Args {
    const float* in[25]; float* out; unsigned char* ws; int ph_lo, ph_hi;
};
enum { I_X = 0, I_RELB, I_EWIN, I_CONVW, I_CONVB, I_CLNG, I_CLNB, I_EWOUT, I_ELN1G, I_ELN1B, I_FWG, I_FWU, I_FWD, I_ELN2G, I_ELN2B,
       I_OWIN, I_OWOUT, I_OLN1G, I_OLN1B, I_ROUTER, I_MWG, I_MWU, I_MWD, I_OLN2G, I_OLN2B };

__device__ __forceinline__ void transpose_item(const float* W, int ldw, int src_c0, int nvalid, int k0, bf16_t* WT, int K, int dst_row0, LAS float* scr, int lane) {
    (void)scr;
    const int kg = lane & 7, ng = lane >> 3;
    f32x4 v[8];
    const float* src = W + (size_t)(k0 + 8 * kg) * ldw + src_c0 + 4 * ng;
    const bool ok = 4 * ng < nvalid;
#pragma unroll
    for (int r = 0; r < 8; ++r) v[r] = ok ? *(const f32x4*)(src + (size_t)r * ldw) : (f32x4){0.f, 0.f, 0.f, 0.f};
#pragma unroll
    for (int c = 0; c < 4; ++c) { u32x4 o; o.x = cvt_pk_bf16(v[0][c], v[1][c]); o.y = cvt_pk_bf16(v[2][c], v[3][c]); o.z = cvt_pk_bf16(v[4][c], v[5][c]); o.w = cvt_pk_bf16(v[6][c], v[7][c]);
        *(u32x4*)(WT + (size_t)(dst_row0 + 4 * ng + c) * K + k0 + 8 * kg) = o; }
}
__device__ __forceinline__ void gu_item(const float* wg, const float* wu, int FF, int K, bf16_t* WT, int item, LAS float* scr, int lane) {
    const int nblk = 2 * FF / 32, kb = item / nblk, nb = item % nblk, tile = nb >> 3, sub = nb & 7;
    transpose_item(sub < 4 ? wg : wu, FF, tile * 128 + (sub & 3) * 32, 32, kb * 64, WT, K, nb * 32, scr, lane);
}
__device__ __forceinline__ void plain_item(const float* W, int K, int N, bf16_t* WT, int item, LAS float* scr, int lane) {
    const int nblk = N / 32, kb = item / nblk, nb = item % nblk;
    transpose_item(W, N, nb * 32, 32, kb * 64, WT, K, nb * 32, scr, lane);
}
__device__ __forceinline__ void in0_item(const float* W, bf16_t* WT, int item, LAS float* scr, int lane) {
    const int nblk = IN0_N / 32, kb = item / nblk, nb = item % nblk, tile = nb >> 3, sub = nb & 7;
    int src_c0, nvalid = 32;
    if (tile < 4) src_c0 = (sub < 4) ? tile * 128 + sub * 32 : 512 + tile * 128 + (sub - 4) * 32;
    else { src_c0 = nb * 32; nvalid = IN0_SRC - src_c0; nvalid = nvalid < 0 ? 0 : (nvalid > 32 ? 32 : nvalid); if (nvalid == 0) src_c0 = 0; }
    transpose_item(W, IN0_SRC, src_c0, nvalid, kb * 64, WT, DM, nb * 32, scr, lane);
}
__device__ __forceinline__ int rel_bucket(int n) {
    if (n < 16) return n;
    const float nf = (float)n;
    int large = 16 + (int)(logf(nf / 16.0f) / logf(128.0f) * 16.0f);
    return large < 31 ? large : 31;
}

__device__ __forceinline__ void ln_core(f32x4 (&v)[4], const float* g, const float* b, int lane) {
    float s = 0.f;
#pragma unroll
    for (int j = 0; j < 4; ++j) s += (v[j][0] + v[j][1]) + (v[j][2] + v[j][3]);
    const float mean = wave_sum(s) * (1.f / DM); float s2 = 0.f;
#pragma unroll
    for (int j = 0; j < 4; ++j) { v[j] = v[j] - mean; s2 += (v[j][0] * v[j][0] + v[j][1] * v[j][1]) + (v[j][2] * v[j][2] + v[j][3] * v[j][3]); }
    const float rstd = 1.f / sqrtf(wave_sum(s2) * (1.f / DM) + LN_EPS);
#pragma unroll
    for (int j = 0; j < 4; ++j) { const f32x4 gg = *(const f32x4*)(g + 4 * lane + 256 * j), bb = *(const f32x4*)(b + 4 * lane + 256 * j); v[j] = v[j] * rstd * gg + bb; }
}
__device__ __forceinline__ void store_row_bf16(bf16_t* orow, const f32x4 (&v)[4], int lane) {
#pragma unroll
    for (int j = 0; j < 4; ++j) { u32x2 w; w.x = cvt_pk_bf16(v[j][0], v[j][1]); w.y = cvt_pk_bf16(v[j][2], v[j][3]); *(u32x2*)(orow + 4 * lane + 256 * j) = w; }
}
__device__ __forceinline__ f32x4 ld_bf4(const bf16_t* p) { const u32x2 w = *(const u32x2*)p; return (f32x4){bf_lo(w.x), bf_hi(w.x), bf_lo(w.y), bf_hi(w.y)}; }

__device__ __forceinline__ int my_lane_asm() { int l; asm volatile("v_mbcnt_lo_u32_b32 %0, -1, 0\n\tv_mbcnt_hi_u32_b32 %0, -1, %0" : "=v"(l)); return l; }
__global__ void __launch_bounds__(NTHR, 2) fwd_kernel(Args args) {
    extern __shared__ __attribute__((aligned(16))) unsigned char lds_raw[];
    LAS unsigned char* lds = (LAS unsigned char*)lds_raw;
    const int G = gridDim.x, bid = blockIdx.x;
    const int NGW = G * NWAVES;
    volatile LAS unsigned* MISC = (volatile LAS unsigned*)(lds + LDS_MISC);
    const int wave_id = __builtin_amdgcn_readfirstlane((int)(threadIdx.x >> 6));
    {
        const int l0 = my_lane_asm();
        if (wave_id == 0 && l0 < 16) MISC[l0] = 0u;
        __syncthreads();
    }
#define MY_LANE() my_lane_asm()
#if ONE_LAUNCH
    (void)xcd_barrier_post((unsigned*)(args.ws + WS_CTL) + CW_BAR, MISC, wave_id == 0 && MY_LANE() == 0);
#define GRID_BAR() do { XcdBarrier _b; _b.bar = (unsigned*)(ws + WS_CTL) + CW_BAR; _b.x = xb_xcc_id(); _b.st = (volatile LAS unsigned*)(lds + LDS_MISC); xcd_barrier(_b, tid == 0); } while (0)
#else
#define GRID_BAR() do { } while (0)
#endif
    const int lo = args.ph_lo, hi = args.ph_hi;
#ifndef PH_MASK
#define PH_MASK 0xFFFFFFu
#endif
#define IN(k) ((((PH_MASK) >> (k)) & 1u) && lo <= (k) && (k) < hi)
#define BOTH(k) (IN(k) && IN((k) + 1))
#define PHASE_BEGIN int lane = MY_LANE(); asm volatile("" : "+v"(lane)); const int wave = wave_id; const int tid = wave * 64 + lane; const int gw = bid * NWAVES + wave; \
    size_t zoff_ = 0; asm volatile("" : "+s"(zoff_)); unsigned char* ws = args.ws + zoff_; float* outp = (float*)((unsigned char*)args.out + zoff_); unsigned* ctl = (unsigned*)(ws + WS_CTL); (void)lane; (void)wave; (void)gw; (void)ctl; (void)outp;
#define x_in (args.in[I_X])
#define WIN0 ((bf16_t*)(ws + WS_WIN0))
#define WOUT0 ((bf16_t*)(ws + WS_WOUT0))
#define WGU0 ((bf16_t*)(ws + WS_WGU0))
#define WD0 ((bf16_t*)(ws + WS_WD0))
#define WIN1 ((bf16_t*)(ws + WS_WIN1))
#define WOUT1 ((bf16_t*)(ws + WS_WOUT1))
#define MWGU ((bf16_t*)(ws + WS_MWGU))
#define MWD ((bf16_t*)(ws + WS_MWD))
#define BIAST ((float*)(ws + WS_BIAST))
#define XB ((bf16_t*)(ws + WS_XB))
#define Ub ((bf16_t*)(ws + WS_U))
#define Q0 ((bf16_t*)(ws + WS_Q0))
#define K0 ((bf16_t*)(ws + WS_Q0 + SEG0))
#define V0 ((bf16_t*)(ws + WS_Q0 + 2 * SEG0))
#define QI ((bf16_t*)(ws + WS_Q0 + 3 * SEG0))
#define KI ((bf16_t*)(ws + WS_KI))
#define WI ((float*)(ws + WS_WI))
#define MASK ((u64*)(ws + WS_MASK))
#define MIXIN ((bf16_t*)(ws + WS_MIXIN))
#define X1B ((bf16_t*)(ws + WS_X1B))
#define H0 ((bf16_t*)(ws + WS_H0))
#define X2B ((bf16_t*)(ws + WS_X2B))
#define H1 ((bf16_t*)(ws + WS_H1))
#define O1 ((bf16_t*)outp)
#define Y3 ((float*)(ws + WS_Y3))
#define X3B ((bf16_t*)(ws + WS_X3B))
#define YB ((bf16_t*)(ws + WS_YB))
#define MTOK ((int*)(ws + WS_MOE_TOK))
#define MGATE ((float*)(ws + WS_MOE_GATE))
#define GTAB ((const LAS int*)(lds + LDS_GTAB))

    if (IN(0)) { asm volatile("; PHASE_MARK 0"); PHASE_BEGIN
        LAS float* scr = (LAS float*)(lds + wave * 16384);
        constexpr int I_IN0 = 16 * (IN0_N / 32), I_OUT = 16 * 32, I_GU0 = 16 * (2 * FF0 / 32), I_D0 = (FF0 / 64) * 32, I_IN1 = 16 * (IN1_N / 32);
        constexpr int NIT = I_IN0 + I_OUT + I_GU0 + I_D0 + I_IN1 + I_OUT;
        for (int it = gw; it < NIT; it += NGW) {
            int r = it;
            if (r < I_IN0) { in0_item(args.in[I_EWIN], WIN0, r, scr, lane); continue; } r -= I_IN0;
            if (r < I_OUT) { plain_item(args.in[I_EWOUT], DM, DM, WOUT0, r, scr, lane); continue; } r -= I_OUT;
            if (r < I_GU0) { gu_item(args.in[I_FWG], args.in[I_FWU], FF0, DM, WGU0, r, scr, lane); continue; } r -= I_GU0;
            if (r < I_D0) { plain_item(args.in[I_FWD], FF0, DM, WD0, r, scr, lane); continue; } r -= I_D0;
            if (r < I_IN1) { plain_item(args.in[I_OWIN], DM, IN1_N, WIN1, r, scr, lane); continue; } r -= I_IN1;
            plain_item(args.in[I_OWOUT], DM, DM, WOUT1, r, scr, lane);
        }
        for (size_t i = (size_t)bid * NTHR + tid; i < (size_t)NTOK * DM / 8; i += (size_t)G * NTHR) {
            const f32x4 a = *(const f32x4*)(x_in + i * 8), b = *(const f32x4*)(x_in + i * 8 + 4);
            *(u32x4*)(XB + i * 8) = pg8::pack8(a, b);
        }
        for (int i = bid * NTHR + tid; i < 8 * 4096; i += G * NTHR) { const int h = i >> 12, d = i & 4095; BIAST[i] = args.in[I_RELB][rel_bucket(d) * 8 + h]; }
        if (BOTH(0)) GRID_BAR();
    }

    if (IN(1)) { asm volatile("; PHASE_MARK 1"); PHASE_BEGIN
        pg8::StaticOrder S; S.init(XB, NTOK, IN0_N, DM, G, bid);
        pg8::EpiIn0 E{Ub, Q0, KI, WI};
        pg8::gemm_phase<pg8::EpiIn0, pg8::StaticOrder, true, false>(tid, lds, WIN0, DM, S, E, GTAB);
        if (BOTH(1)) GRID_BAR();
    }

    if (IN(2)) { asm volatile("; PHASE_MARK 2"); PHASE_BEGIN
        {
            LAS bf16_t* ut = (LAS bf16_t*)lds;
            LAS float* yt = (LAS float*)(lds + 65536);
            const float* cw = args.in[I_CONVW]; const int c = tid;
            float w[31];
#pragma unroll
            for (int j = 0; j < 31; ++j) w[j] = cw[j * 512 + c];
            const float cb = args.in[I_CONVB][c];
            for (int tile = bid; tile < NTOK / 32; tile += G) {
                const int t0 = tile * 32, s0 = t0 & (SEQ - 1);
                for (int i = tid; i < 62 * 64; i += NTHR) { const int r = i >> 6, c8 = i & 63; const int sr = s0 - 30 + r;
                    u32x4 v = (u32x4){0u, 0u, 0u, 0u}; if (sr >= 0) v = *(const u32x4*)(Ub + (size_t)(t0 - 30 + r) * 512 + c8 * 8);
                    *(LAS u32x4*)(ut + r * 512 + c8 * 8) = v; }
                __syncthreads();
                for (int t = 0; t < 32; ++t) { float a = cb;
#pragma unroll
                    for (int j = 0; j < 31; ++j) a += w[j] * bf2f(ut[(t + j) * 512 + c]);
                    yt[t * 512 + c] = a; }
                __syncthreads();
                const float* lg = args.in[I_CLNG]; const float* lb = args.in[I_CLNB];
#pragma unroll
                for (int tt = 0; tt < 4; ++tt) { const int t = wave * 4 + tt;
                    f32x4 a = *(LAS f32x4*)(yt + t * 512 + lane * 8), b = *(LAS f32x4*)(yt + t * 512 + lane * 8 + 4);
                    float s = (a[0] + a[1]) + (a[2] + a[3]) + (b[0] + b[1]) + (b[2] + b[3]); const float mean = wave_sum(s) * (1.f / 512.f);
                    a = a - mean; b = b - mean; float s2 = a[0] * a[0] + a[1] * a[1] + a[2] * a[2] + a[3] * a[3] + b[0] * b[0] + b[1] * b[1] + b[2] * b[2] + b[3] * b[3];
                    const float rstd = 1.f / sqrtf(wave_sum(s2) * (1.f / 512.f) + LN_EPS);
                    const f32x4 g0 = *(const f32x4*)(lg + lane * 8), g1 = *(const f32x4*)(lg + lane * 8 + 4), b0 = *(const f32x4*)(lb + lane * 8), b1 = *(const f32x4*)(lb + lane * 8 + 4);
                    a = a * rstd * g0 + b0; b = b * rstd * g1 + b1;
#pragma unroll
                    for (int j = 0; j < 4; ++j) { a[j] = a[j] * sigmoidf_(a[j]); b[j] = b[j] * sigmoidf_(b[j]); }
                    *(u32x4*)(MIXIN + (size_t)(t0 + t) * DM + lane * 8) = pg8::pack8(a, b); }
                __syncthreads();
            }
        }
        {
            constexpr int CAP = 512;
            LAS unsigned char* kbuf = lds;
            LAS unsigned* hist = (LAS unsigned*)(lds + 65536);
            LAS unsigned* clist = hist;
            LAS unsigned* mtile = (LAS unsigned*)(lds + 131072);
            LAS unsigned* rinfo = (LAS unsigned*)(lds + 131072 + 8192);
            LAS unsigned* ccnt = rinfo + 64;
            LAS unsigned* flag = rinfo + 80;
            LAS unsigned* rsel = rinfo + 96;
            LAS unsigned* whist = (LAS unsigned*)lds + wave * 256;
            const int vcu = (G % 8 == 0) ? (bid % 8) * (G / 8) + bid / 8 : bid;
            const int g4 = lane >> 4, r16 = lane & 15;
            for (int it = 0; it < 8 && vcu < 256; ++it) {
                const int b = it, qt = (it & 1) ? 255 - vcu : vcu;
                const int q0 = qt * 16, tok0 = b * SEQ + q0, nwords = (q0 + 15) / 64 + 1, nch = (nwords + 3) >> 2, q = q0 + r16;
                if (q0 < 256) {
                    for (int i = tid; i < 16 * nwords; i += NTHR) { const int r = i & 15, W = i >> 4; const int d = q0 + r - 64 * W;
                        const u64 word = d >= 63 ? ~0ull : (d < 0 ? 0ull : ((2ull << d) - 1ull));
                        MASK[((size_t)b * 64 + W) * SEQ + q0 + r] = word; }
                    continue;
                }
                bf16x8 Qf[8][2]; float wq[8];
#pragma unroll
                for (int h = 0; h < 8; ++h)
#pragma unroll
                    for (int c2 = 0; c2 < 2; ++c2) Qf[h][c2] = *(const bf16x8*)(QI + (size_t)(tok0 + r16) * 512 + h * 64 + c2 * 32 + g4 * 8);
                { const f32x4 w0 = *(const f32x4*)(WI + (size_t)(tok0 + r16) * 8), w1 = *(const f32x4*)(WI + (size_t)(tok0 + r16) * 8 + 4);
                  wq[0] = w0[0]; wq[1] = w0[1]; wq[2] = w0[2]; wq[3] = w0[3]; wq[4] = w1[0]; wq[5] = w1[1]; wq[6] = w1[2]; wq[7] = w1[3]; }
                for (int i = tid; i < 16 * 64 * 2; i += NTHR) mtile[i] = 0u;
                if (tid < 16) ccnt[tid] = 0u;
                unsigned prefix = 0u; int shift = 21, shift_prev = 32, level = 0; bool collect = false;
#define KDMA(c_) do { _Pragma("unroll") for (int k_ = 0; k_ < 4; ++k_) { const int wc_ = wave * 4 + k_; const int kl_ = lane >> 3, cp_ = lane & 7; \
                    const bf16_t* src_ = KI + ((size_t)b * SEQ + (c_) * 256 + wc_ * 8 + kl_) * 64 + ((cp_ ^ kl_) * 8); \
                    __builtin_amdgcn_global_load_lds((const unsigned*)src_, (LAS unsigned*)(kbuf + ((c_) & 1) * 32768 + wc_ * 1024), 16, 0, 0); } } while (0)
                for (int pass = 0; pass < 4; ++pass) {
                    if (!collect) { for (int i = tid; i < 16 * 1024; i += NTHR) hist[i] = 0u; if (tid < 4) flag[tid] = 0u; }
                    const unsigned bmask = (level == 2) ? 1023u : 2047u;
                    KDMA(0);
                    asm volatile("s_waitcnt vmcnt(0)" ::: "memory"); __syncthreads();
                    for (int c = 0; c < nch; ++c) {
                        if (c + 1 < nch) KDMA(c + 1);
                        const int W = 4 * c + (wave >> 1);
                        if (W < nwords) {
                            unsigned bits = 0u;
#pragma unroll
                            for (int tu = 0; tu < 2; ++tu) {
                                const int u = 2 * (wave & 1) + tu;
                                const LAS unsigned char* kp = kbuf + (c & 1) * 32768 + ((wave >> 1) * 64 + u * 16 + r16) * 128;
                                const bf16x8 Ka = *(const LAS bf16x8*)(kp + ((g4 ^ (r16 & 7)) * 16));
                                const bf16x8 Kb = *(const LAS bf16x8*)(kp + (((4 + g4) ^ (r16 & 7)) * 16));
                                f32x4 sc = (f32x4){0.f, 0.f, 0.f, 0.f};
#pragma unroll
                                for (int h = 0; h < 8; ++h) {
                                    f32x4 t = __builtin_amdgcn_mfma_f32_16x16x32_bf16(Ka, Qf[h][0], (f32x4){0.f, 0.f, 0.f, 0.f}, 0, 0, 0);
                                    t = __builtin_amdgcn_mfma_f32_16x16x32_bf16(Kb, Qf[h][1], t, 0, 0, 0);
#pragma unroll
                                    for (int i = 0; i < 4; ++i) sc[i] += wq[h] * fmaxf(t[i], 0.f);
                                }
#pragma unroll
                                for (int i = 0; i < 4; ++i) {
                                    const int kidx = 64 * W + 16 * u + 4 * g4 + i; const unsigned uu = __float_as_uint(sc[i] + 0.0f);
                                    const unsigned key = (uu & 0x80000000u) ? ~uu : (uu | 0x80000000u);
                                    if (kidx <= q) {
                                        if (!collect) {
                                            if (level == 0 || (key >> shift_prev) == (prefix >> shift_prev)) { const unsigned bin = (key >> shift) & bmask;
                                                __hip_atomic_fetch_add((unsigned*)(hist + r16 * 1024 + (bin >> 1)), 1u << (16 * (bin & 1u)), __ATOMIC_RELAXED, __HIP_MEMORY_SCOPE_WORKGROUP); }
                                        } else {
                                            const unsigned kb_ = key >> shift, pb_ = prefix >> shift;
                                            if (kb_ > pb_) bits |= 1u << (16 * tu + 4 * g4 + i);
                                            else if (kb_ == pb_) { const unsigned pos = __hip_atomic_fetch_add((unsigned*)(ccnt + r16), 1u, __ATOMIC_RELAXED, __HIP_MEMORY_SCOPE_WORKGROUP);
                                                if (pos < (unsigned)CAP) { clist[(r16 * CAP + pos) * 2] = key; clist[(r16 * CAP + pos) * 2 + 1] = (unsigned)kidx; } }
                                        }
                                    }
                                }
                            }
                            if (collect) {
                                bits |= (unsigned)__builtin_amdgcn_ds_swizzle((int)bits, (16 << 10) | 0x1f);
                                { auto r0 = __builtin_amdgcn_permlane32_swap(bits, bits, false, false); bits = r0[0] | r0[1]; }
                                if (lane < 16) mtile[(lane * 64 + W) * 2 + (wave & 1)] = bits;
                            }
                        }
                        asm volatile("s_waitcnt vmcnt(0)" ::: "memory"); __syncthreads();
                    }
                    if (collect) break;
                    {
                        const int row = tid >> 5, seg = tid & 31; const LAS unsigned* hr = hist + row * 1024 + seg * 32;
                        unsigned tot = 0u;
                        for (int j = 0; j < 32; ++j) { const unsigned w = hr[j]; tot += (w & 0xffffu) + (w >> 16); }
                        unsigned inc = tot;
#pragma unroll
                        for (int o = 1; o < 32; o <<= 1) { const unsigned t = lane_get(inc, (lane & 32) | ((seg + o) & 31)); if (seg + o < 32) inc += t; }
                        const unsigned exc = inc - tot, kk = (level == 0) ? 256u : rinfo[row * 4 + 1], pfx = (level == 0) ? 0u : rinfo[row * 4 + 0];
                        if (exc < kk && inc >= kk) {
                            unsigned cum = exc, bin = 0u, kn = kk, cb = 0u; bool done = false;
                            for (int j = 31; j >= 0 && !done; --j) { const unsigned w = hr[j]; const unsigned chi = w >> 16, clo = w & 0xffffu;
                                if (cum + chi >= kk) { bin = seg * 64 + 2 * j + 1; kn = kk - cum; cb = chi; done = true; }
                                else { cum += chi; if (cum + clo >= kk) { bin = seg * 64 + 2 * j; kn = kk - cum; cb = clo; done = true; } else cum += clo; } }
                            rinfo[row * 4 + 0] = pfx | (bin << shift); rinfo[row * 4 + 1] = kn; rinfo[row * 4 + 2] = cb;
                            if (cb > (unsigned)CAP && level < 2) __hip_atomic_fetch_or((unsigned*)flag, 1u, __ATOMIC_RELAXED, __HIP_MEMORY_SCOPE_WORKGROUP);
                        }
                    }
                    __syncthreads();
                    prefix = rinfo[r16 * 4 + 0];
                    const unsigned more = flag[0];
                    __syncthreads();
                    if (more) { shift_prev = shift; ++level; shift = (level == 1) ? 10 : 0; } else collect = true;
                }
#undef KDMA
                for (int rr = 0; rr < 2; ++rr) {
                    const int row = wave * 2 + rr; unsigned cc = ccnt[row]; cc = cc > (unsigned)CAP ? (unsigned)CAP : cc; const int cn = (int)cc;
                    const LAS unsigned* cl = clist + row * CAP * 2;
                    unsigned pf = 0u; int kk = (int)rinfo[row * 4 + 1]; unsigned ties = 0u;
                    if (kk > cn) kk = cn;
                    if (kk > 0) {
                    for (int ps = 0; ps < 4; ++ps) {
                        const int sh = 24 - 8 * ps;
#pragma unroll
                        for (int j = 0; j < 4; ++j) whist[lane * 4 + j] = 0u;
                        WAVE_LDS_FENCE();
                        for (int i = lane; i < cn; i += 64) { const unsigned key = cl[i * 2];
                            const bool m = (ps == 0) || ((key >> (sh + 8)) == (pf >> (sh + 8)));
                            if (m) __hip_atomic_fetch_add((unsigned*)(whist + ((key >> sh) & 255u)), 1u, __ATOMIC_RELAXED, __HIP_MEMORY_SCOPE_WORKGROUP); }
                        WAVE_LDS_FENCE();
                        const unsigned c0 = whist[lane * 4 + 0], c1 = whist[lane * 4 + 1], c2 = whist[lane * 4 + 2], c3 = whist[lane * 4 + 3];
                        const unsigned sl = c0 + c1 + c2 + c3; unsigned inc = sl;
#pragma unroll
                        for (int o = 1; o < 64; o <<= 1) { const unsigned t = lane_get(inc, (lane + o) & 63); if (lane + o < 64) inc += t; }
                        const unsigned exc = inc - sl;
                        const bool found = (exc < (unsigned)kk) && (inc >= (unsigned)kk);
                        int bin = 0, kn = 0; unsigned cb = 0u;
                        { unsigned cum = exc;
                          if (cum + c3 >= (unsigned)kk) { bin = 3; kn = kk - (int)cum; cb = c3; } else { cum += c3;
                          if (cum + c2 >= (unsigned)kk) { bin = 2; kn = kk - (int)cum; cb = c2; } else { cum += c2;
                          if (cum + c1 >= (unsigned)kk) { bin = 1; kn = kk - (int)cum; cb = c1; } else { cum += c1; bin = 0; kn = kk - (int)cum; cb = c0; } } } }
                        const u64 fm = __ballot(found); const int src = fm ? (__ffsll((long long)fm) - 1) : 0;
                        bin = (int)lane_get((unsigned)(lane * 4 + bin), src); kk = (int)lane_get((unsigned)kn, src); ties = lane_get(cb, src);
                        pf |= ((unsigned)bin) << sh;
                        WAVE_LDS_FENCE();
                    }
                    unsigned cut = 0xFFFFFFFFu;
                    if (ties > (unsigned)kk) {
                        for (int i = lane; i < cn; i += 64) { if (cl[i * 2] == pf) { const unsigned myi = cl[i * 2 + 1]; int rank = 0;
                                for (int j = 0; j < cn; ++j) rank += (cl[j * 2] == pf && cl[j * 2 + 1] < myi) ? 1 : 0;
                                if (rank == kk - 1) rsel[row * 2 + 1] = myi; } }
                        WAVE_LDS_FENCE();
                        cut = rsel[row * 2 + 1];
                    }
                    for (int i = lane; i < cn; i += 64) { const unsigned key = cl[i * 2], kidx = cl[i * 2 + 1];
                        if (key > pf || (key == pf && kidx <= cut)) __hip_atomic_fetch_or((unsigned*)(mtile + (row * 64 + (kidx >> 6)) * 2 + ((kidx >> 5) & 1u)), 1u << (kidx & 31u), __ATOMIC_RELAXED, __HIP_MEMORY_SCOPE_WORKGROUP); }
                    }
                }
                __syncthreads();
                for (int i = tid; i < 16 * nwords; i += NTHR) { const int r = i & 15, W = i >> 4;
                    MASK[((size_t)b * 64 + W) * SEQ + q0 + r] = (u64)mtile[(r * 64 + W) * 2] | ((u64)mtile[(r * 64 + W) * 2 + 1] << 32); }
                __syncthreads();
            }
        }
        if (BOTH(2)) GRID_BAR();
    }

    if (IN(3)) { asm volatile("; PHASE_MARK 3"); PHASE_BEGIN
        const int vcu = (G % 8 == 0) ? (bid % 8) * (G / 8) + bid / 8 : bid;
        if (vcu < 256) {
            const int pp = vcu & 3, h = (vcu >> 2) & 7, b = vcu >> 5;
            { float* tb = (float*)(lds_raw + dsa::LDS_TB);
              for (int i = tid; i < dsa::TB_PAD + 4096; i += NTHR) tb[i] = (i >= dsa::TB_PAD) ? BIAST[h * 4096 + (i - dsa::TB_PAD)] * 8.0f : 0.f; }
            const bf16_t* Kp = K0 + (size_t)b * SEQ * 512 + h * 64; const bf16_t* Vp = V0 + (size_t)b * SEQ * 512 + h * 64;
#define DSA_REF(R, i_) do { const int qb_ = ((i_) == 0) ? pp : ((i_) == 1) ? 15 - pp : ((i_) == 2) ? pp + 4 : 11 - pp; const int P0_ = qb_ * 256; \
            R.Q = Q0 + ((size_t)b * SEQ + P0_) * 512 + h * 64; R.K = Kp; R.V = Vp; R.O = MIXIN + ((size_t)b * SEQ + P0_) * DM + 512 + h * 64; \
            R.MW = MASK + (size_t)b * 64 * SEQ + P0_; R.P0 = P0_; } while (0)
            dsa::Seam SS; dsa::BlockRef cur, nxt; DSA_REF(cur, 0);
            dsa::dsa_prime(cur, (char*)lds_raw, SS, tid);
            for (int i = 0; i < 4; ++i) {
                if (i < 3) { DSA_REF(nxt, i + 1); } else nxt = cur;
                dsa::dsa_block(cur, nxt, (char*)lds_raw, SS, tid);
                cur = nxt;
            }
#undef DSA_REF
        }
        if (BOTH(3)) GRID_BAR();
    }
    if (IN(4)) { asm volatile("; PHASE_MARK 4"); PHASE_BEGIN
        pg8::StaticOrder S; S.init(MIXIN, NTOK, DM, DM, G, bid);
        pg8::EpiRes<false> E{outp, x_in};
        pg8::gemm_phase<pg8::EpiRes<false>, pg8::StaticOrder, true, false>(tid, lds, WOUT0, DM, S, E, GTAB);
        if (BOTH(4)) GRID_BAR();
    }
    if (IN(5)) { asm volatile("; PHASE_MARK 5"); PHASE_BEGIN
        for (int m = gw; m < NTOK; m += NGW) { f32x4 v[4];
#pragma unroll
            for (int j = 0; j < 4; ++j) v[j] = *(const f32x4*)(outp + (size_t)m * DM + 4 * lane + 256 * j);
            ln_core(v, args.in[I_ELN1G], args.in[I_ELN1B], lane); store_row_bf16(X1B + (size_t)m * DM, v, lane); }
        if (BOTH(5)) GRID_BAR();
    }
    if (IN(6)) { asm volatile("; PHASE_MARK 6"); PHASE_BEGIN
        pg8::StaticOrder S; S.init(X1B, NTOK, 2 * FF0, DM, G, bid);
        pg8::EpiSwiglu<false> E{H0, FF0, (char*)outp, (char*)ws};
        pg8::gemm_phase<pg8::EpiSwiglu<false>, pg8::StaticOrder, true, false>(tid, lds, WGU0, DM, S, E, GTAB);
        if (BOTH(6)) GRID_BAR();
    }
    if (IN(7)) { asm volatile("; PHASE_MARK 7"); PHASE_BEGIN
        pg8::StaticOrder S; S.init(H0, NTOK, DM, FF0, G, bid);
        pg8::EpiRes<true> E{outp, X1B};
        pg8::gemm_phase<pg8::EpiRes<true>, pg8::StaticOrder, true, false>(tid, lds, WD0, FF0, S, E, GTAB);
        if (BOTH(7)) GRID_BAR();
    }
    if (IN(8)) { asm volatile("; PHASE_MARK 8"); PHASE_BEGIN
        for (int m = gw; m < NTOK; m += NGW) { f32x4 v[4];
#pragma unroll
            for (int j = 0; j < 4; ++j) v[j] = *(const f32x4*)(outp + (size_t)m * DM + 4 * lane + 256 * j);
            ln_core(v, args.in[I_ELN2G], args.in[I_ELN2B], lane); store_row_bf16(X2B + (size_t)m * DM, v, lane); }
        if (BOTH(8)) GRID_BAR();
    }
#define MERGE_CHUNK(chm) do { \
        const bf16_t* OPp = (const bf16_t*)(ws + WS_OP); const float* LSEp = (const float*)(ws + WS_LSE); \
        for (int tl = gw; tl < CHUNK_T; tl += NGW) { const int hh = lane >> 3; \
            const float l0 = LSEp[(size_t)tl * 8 + hh], l1 = LSEp[((size_t)CHUNK_T + tl) * 8 + hh], l2 = LSEp[((size_t)2 * CHUNK_T + tl) * 8 + hh]; \
            const float mm = fmaxf(l0, fmaxf(l1, l2)); float w0 = __expf(l0 - mm), w1 = __expf(l1 - mm), w2 = __expf(l2 - mm); const float inv = 1.f / (w0 + w1 + w2); w0 *= inv; w1 *= inv; w2 *= inv; \
            const bf16_t* p0 = OPp + (size_t)tl * DM + lane * 16; const bf16_t* p1 = p0 + (size_t)CHUNK_T * DM; const bf16_t* p2 = p1 + (size_t)CHUNK_T * DM; \
            _Pragma("unroll") for (int q = 0; q < 2; ++q) { const u32x4 a = *(const u32x4*)(p0 + q * 8), b = *(const u32x4*)(p1 + q * 8), c = *(const u32x4*)(p2 + q * 8); u32x4 o; \
                o.x = cvt_pk_bf16(w0 * bf_lo(a.x) + w1 * bf_lo(b.x) + w2 * bf_lo(c.x), w0 * bf_hi(a.x) + w1 * bf_hi(b.x) + w2 * bf_hi(c.x)); \
                o.y = cvt_pk_bf16(w0 * bf_lo(a.y) + w1 * bf_lo(b.y) + w2 * bf_lo(c.y), w0 * bf_hi(a.y) + w1 * bf_hi(b.y) + w2 * bf_hi(c.y)); \
                o.z = cvt_pk_bf16(w0 * bf_lo(a.z) + w1 * bf_lo(b.z) + w2 * bf_lo(c.z), w0 * bf_hi(a.z) + w1 * bf_hi(b.z) + w2 * bf_hi(c.z)); \
                o.w = cvt_pk_bf16(w0 * bf_lo(a.w) + w1 * bf_lo(b.w) + w2 * bf_lo(c.w), w0 * bf_hi(a.w) + w1 * bf_hi(b.w) + w2 * bf_hi(c.w)); \
                *(u32x4*)(O1 + ((size_t)(chm) * CHUNK_T + tl) * DM + lane * 16 + q * 8) = o; } } } while (0)
#pragma unroll
    for (int ch = 0; ch < 2; ++ch) {
        if (IN(9 + 2 * ch)) { asm volatile("; PHASE_MARK 9"); PHASE_BEGIN
            if (ch == 1) { MERGE_CHUNK(0); }
            pg8::StaticOrder S; S.init(X2B + (size_t)ch * CHUNK_T * DM, CHUNK_T, IN1_N, DM, G, bid);
            pg8::EpiQkv1 E{H1, IN1_N, 1.0f};
            pg8::gemm_phase<pg8::EpiQkv1, pg8::StaticOrder, true, false>(tid, lds, WIN1, DM, S, E, GTAB);
            if (BOTH(9 + 2 * ch)) GRID_BAR();
        }
        if (IN(10 + 2 * ch)) { asm volatile("; PHASE_MARK 10"); PHASE_BEGIN
            constexpr int NU = CHUNK_B * 8 * 3 * 16;
            const int vcu = (G % 8 == 0) ? (bid % 8) * (G / 8) + bid / 8 : bid;
            bf16_t* OPp = (bf16_t*)(ws + WS_OP); float* LSEp = (float*)(ws + WS_LSE);
            int L0 = vcu;
            if (L0 < NU) {
                swa::Seam SS; swa::BlockRef cur = dil_ref(L0, H1, OPp, LSEp);
                swa::swa_prime(cur, BIAST, (char*)lds_raw, SS, tid);
                int slot = 0;
                for (;;) {
                    const int Ln = L0 + G; const bool last = Ln >= NU;
                    const swa::BlockRef nxt = last ? cur : dil_ref(Ln, H1, OPp, LSEp);
                    swa::swa_block(cur, nxt, BIAST, slot, (char*)lds_raw, SS, tid);
                    if (last) break;
                    cur = nxt; L0 = Ln; slot ^= 1;
                }
            }
            if (BOTH(10 + 2 * ch)) GRID_BAR();
        }
    }
    if (IN(13)) { asm volatile("; PHASE_MARK 13"); PHASE_BEGIN
        MERGE_CHUNK(1);
        if (BOTH(13)) GRID_BAR();
    }
    if (IN(14)) { asm volatile("; PHASE_MARK 14"); PHASE_BEGIN
        pg8::StaticOrder S; S.init(O1, NTOK, DM, DM, G, bid);
        pg8::EpiRes<true> E{Y3, X2B};
        pg8::gemm_phase<pg8::EpiRes<true>, pg8::StaticOrder, true, false>(tid, lds, WOUT1, DM, S, E, GTAB);
        if (BOTH(14)) GRID_BAR();
    }
    if (IN(15)) { asm volatile("; PHASE_MARK 15"); PHASE_BEGIN
        const float* rt = args.in[I_ROUTER];
        LAS unsigned* lcnt = (LAS unsigned*)lds;
        LAS unsigned* lbase = lcnt + 8;
        LAS int* lrow = (LAS int*)(lds + 256);
        LAS float* lgate = (LAS float*)(lds + 256 + 16384);
        if (tid < 8) lcnt[tid] = 0u;
        __syncthreads();
        int nloc = 0;
        for (int m = gw; m < NTOK; m += NGW, ++nloc) { f32x4 v[4];
#pragma unroll
            for (int j = 0; j < 4; ++j) v[j] = *(const f32x4*)(Y3 + (size_t)m * DM + 4 * lane + 256 * j);
            ln_core(v, args.in[I_OLN1G], args.in[I_OLN1B], lane); store_row_bf16(X3B + (size_t)m * DM, v, lane);
            float lgt[8];
#pragma unroll
            for (int e = 0; e < 8; ++e) lgt[e] = 0.f;
#pragma unroll
            for (int j = 0; j < 4; ++j)
#pragma unroll
                for (int i = 0; i < 4; ++i) { const float* rr = rt + (size_t)(4 * lane + 256 * j + i) * 8; const f32x4 r0 = *(const f32x4*)rr, r1 = *(const f32x4*)(rr + 4); const float xv = v[j][i];
                    lgt[0] += xv * r0[0]; lgt[1] += xv * r0[1]; lgt[2] += xv * r0[2]; lgt[3] += xv * r0[3]; lgt[4] += xv * r1[0]; lgt[5] += xv * r1[1]; lgt[6] += xv * r1[2]; lgt[7] += xv * r1[3]; }
#pragma unroll
            for (int e = 0; e < 8; ++e) lgt[e] = wave_sum(lgt[e]);
            int e1 = 0; float v1 = lgt[0];
#pragma unroll
            for (int e = 1; e < 8; ++e) if (lgt[e] > v1) { v1 = lgt[e]; e1 = e; }
            int e2 = -1; float v2 = -INFINITY;
#pragma unroll
            for (int e = 0; e < 8; ++e) if (e != e1 && lgt[e] > v2) { v2 = lgt[e]; e2 = e; }
            const float g2 = 1.f / (1.f + __expf(v1 - v2)), g1 = 1.f - g2;
            if (lane == 0) { const int li = nloc * NWAVES + wave;
                const unsigned r1 = __hip_atomic_fetch_add((unsigned*)(lcnt + e1), 1u, __ATOMIC_RELAXED, __HIP_MEMORY_SCOPE_WORKGROUP), r2 = __hip_atomic_fetch_add((unsigned*)(lcnt + e2), 1u, __ATOMIC_RELAXED, __HIP_MEMORY_SCOPE_WORKGROUP);
                lrow[li * 4 + 0] = e1; lrow[li * 4 + 1] = (int)r1; lrow[li * 4 + 2] = e2; lrow[li * 4 + 3] = (int)r2; lgate[li * 2] = g1; lgate[li * 2 + 1] = g2; }
        }
        __syncthreads();
        if (tid < 8) lbase[tid] = atomicAdd(ctl + CW_MOECNT + tid, lcnt[tid]);
        __syncthreads();
        { const int nrows = (NTOK - bid * NWAVES + NGW - 1) / NGW;
          for (int li = tid; li < nrows * NWAVES; li += NTHR) { const int rnd = li / NWAVES, wv = li % NWAVES; const int m = (bid * NWAVES + wv) + rnd * NGW;
            if (m < NTOK) { const int e1 = lrow[li * 4 + 0], e2 = lrow[li * 4 + 2]; const unsigned p1 = lbase[e1] + (unsigned)lrow[li * 4 + 1], p2 = lbase[e2] + (unsigned)lrow[li * 4 + 3];
                if (p1 < (unsigned)NTOK) { MTOK[e1 * NTOK + p1] = m * 2; MGATE[e1 * NTOK + p1] = lgate[li * 2]; }
                if (p2 < (unsigned)NTOK) { MTOK[e2 * NTOK + p2] = m * 2 + 1; MGATE[e2 * NTOK + p2] = lgate[li * 2 + 1]; } } } }
        __syncthreads();
        {
            LAS float* scr = (LAS float*)(lds + wave * 16384);
            constexpr int I_GU = 16 * (2 * FFE / 32), I_D = (FFE / 64) * 32;
            for (int it = gw; it < NEXP * (I_GU + I_D); it += NGW) {
                const int e = it / (I_GU + I_D), r = it % (I_GU + I_D);
                if (r < I_GU) gu_item(args.in[I_MWG] + (size_t)e * DM * FFE, args.in[I_MWU] + (size_t)e * DM * FFE, FFE, DM, MWGU + (size_t)e * 2 * FFE * DM, r, scr, lane);
                else plain_item(args.in[I_MWD] + (size_t)e * FFE * DM, FFE, DM, MWD + (size_t)e * DM * FFE, r - I_GU, scr, lane);
            }
        }
        if (BOTH(15)) GRID_BAR();
    }
#pragma unroll
    for (int ch = 0; ch < 2; ++ch) {
        if (IN(16 + 2 * ch) || IN(17 + 2 * ch)) {
            LAS int* rt = (LAS int*)(lds + LDS_RT);
            int nM;
            { PHASE_BEGIN int ts[9]; int cn[8]; ts[0] = 0;
#pragma unroll
              for (int e = 0; e < 8; ++e) { int ce = __builtin_amdgcn_readfirstlane((int)ctl[CW_MOECNT + e]); ce = ce > NTOK ? NTOK : ce; cn[e] = ce; ts[e + 1] = ts[e] + (ce + 255) / 256; }
              const int t0 = ch * MOE_CH_TILES; int t1 = t0 + MOE_CH_TILES; if (t1 > ts[8]) t1 = ts[8]; nM = __builtin_amdgcn_readfirstlane(t1 > t0 ? t1 - t0 : 0);
              if (tid < nM) { const int g = t0 + tid; int e = 0;
#pragma unroll
                  for (int k = 1; k < 8; ++k) e += (g >= ts[k]) ? 1 : 0;
                  int ce = cn[0], tse = ts[0];
#pragma unroll
                  for (int k = 1; k < 8; ++k) { ce = (e == k) ? cn[k] : ce; tse = (e == k) ? ts[k] : tse; }
                  const int j = g - tse; int nv = ce - j * 256; nv = nv > 256 ? 256 : nv;
                  rt[tid * 4 + 0] = e; rt[tid * 4 + 1] = e * NTOK + j * 256; rt[tid * 4 + 2] = nv; rt[tid * 4 + 3] = 0; } }
            __syncthreads();
            if (IN(16 + 2 * ch)) { asm volatile("; PHASE_MARK 16"); PHASE_BEGIN
                pg8::MoeOrder S{G, bid, nM, 2 * FFE / 256, rt, (const char*)X3B, (char*)outp, (char*)ws, true};
                LAS int* gtab = (LAS int*)(lds + LDS_GTAB);
                { pg8::Unit u; for (int i = 0; i < 16 && S.next(i, u); ++i) { if (tid < 256) { const int lb = rt[u.pm * 4 + 1], nv = rt[u.pm * 4 + 2]; const int r = tid < nv ? tid : 0; gtab[i * 256 + tid] = MTOK[lb + r] >> 1; } } }
                __syncthreads();
                pg8::EpiSwiglu<true> E{H0, FFE, (char*)outp, (char*)ws};
                pg8::gemm_phase<pg8::EpiSwiglu<true>, pg8::MoeOrder, true, true>(tid, lds, MWGU, DM, S, E, gtab);
                if (BOTH(16 + 2 * ch)) GRID_BAR();
            }
            if (IN(17 + 2 * ch)) { asm volatile("; PHASE_MARK 17"); PHASE_BEGIN
                pg8::MoeOrder S{G, bid, nM, DM / 256, rt, (const char*)X3B, (char*)outp, (char*)ws, false};
                pg8::EpiMoeDown E{YB, MTOK, MGATE, rt};
                pg8::gemm_phase<pg8::EpiMoeDown, pg8::MoeOrder, true, false>(tid, lds, MWD, FFE, S, E, GTAB);
                if (BOTH(17 + 2 * ch)) GRID_BAR();
            }
        }
    }
    if (IN(20)) { asm volatile("; PHASE_MARK 20"); PHASE_BEGIN
        for (int m = gw; m < NTOK; m += NGW) { f32x4 v[4];
#pragma unroll
            for (int j = 0; j < 4; ++j) { const size_t o = (size_t)m * DM + 4 * lane + 256 * j; v[j] = ld_bf4(X3B + o) * ALPHA + ld_bf4(YB + o) + ld_bf4(YB + (size_t)NTOK * DM + o); }
            ln_core(v, args.in[I_OLN2G], args.in[I_OLN2B], lane);
#pragma unroll
            for (int j = 0; j < 4; ++j) *(f32x4*)(outp + (size_t)m * DM + 4 * lane + 256 * j) = v[j]; }
    }
#undef IN
#undef BOTH
}

constexpr int NPHASES = 21;
extern "C" void kernel_launch(void* const* d_in, const int* in_sizes, int n_in, void* d_out, int out_size, void* d_ws, size_t ws_size, hipStream_t stream) {
    static int grid = 0;
    if (grid == 0) {
        if (n_in != 25 || out_size != NTOK * DM || ws_size < WS_END) { fprintf(stderr, "kernel_launch: unexpected shapes (n_in %d out %d ws %zu)\n", n_in, out_size, ws_size); grid = -1; return; }
        int dev = 0, cus = 0;
        if (hipGetDevice(&dev) != hipSuccess || hipDeviceGetAttribute(&cus, hipDeviceAttributeMultiprocessorCount, dev) != hipSuccess) { grid = -1; return; }
        if (hipFuncSetAttribute((const void*)fwd_kernel, hipFuncAttributeMaxDynamicSharedMemorySize, LDS_BYTES) != hipSuccess) { fprintf(stderr, "kernel_launch: hipFuncSetAttribute failed\n"); grid = -1; return; }
        int per_cu = 0;
        if (hipOccupancyMaxActiveBlocksPerMultiprocessor(&per_cu, (const void*)fwd_kernel, NTHR, LDS_BYTES) != hipSuccess || per_cu < 1) { fprintf(stderr, "kernel_launch: occupancy query says %d\n", per_cu); }
        (void)hipGetLastError();
        grid = cus;
    }
    if (grid < 0) return;
    (void)hipMemsetAsync((char*)d_ws + WS_CTL, 0, CTL_ZERO_BYTES, stream);
    Args a{};
    for (int i = 0; i < 25; ++i) a.in[i] = (const float*)d_in[i];
    a.out = (float*)d_out; a.ws = (unsigned char*)d_ws;
#if ONE_LAUNCH
    a.ph_lo = 0; a.ph_hi = NPHASES;
    hipLaunchKernelGGL(fwd_kernel, dim3(grid), dim3(NTHR), LDS_BYTES, stream, a);
#else
    for (int ph = 0; ph < NPHASES; ++ph) { a.ph_lo = ph; a.ph_hi = ph + 1; for (int rep = 0; rep < (((DUP_MASK) >> ph) & 1u ? 2 : 1); ++rep) hipLaunchKernelGGL(fwd_kernel, dim3(grid), dim3(NTHR), LDS_BYTES, stream, a); }
#endif
}
```

```cpp
#include <hip/hip_runtime.h>
#include <cstdio>
#include <cstdint>

#ifndef ONE_LAUNCH
#define ONE_LAUNCH 1
#endif
#ifndef DUP_MASK
#define DUP_MASK 0u
#endif

#define LAS __attribute__((address_space(3)))
typedef unsigned short bf16_t;
typedef short bf16x8 __attribute__((ext_vector_type(8)));
typedef float f32x4 __attribute__((ext_vector_type(4)));
typedef float f32x2 __attribute__((ext_vector_type(2)));
typedef unsigned u32x4 __attribute__((ext_vector_type(4)));
typedef unsigned u32x2 __attribute__((ext_vector_type(2)));
typedef unsigned long long u64;

constexpr int NB = 8, SEQ = 4096, DM = 1024, NTOK = NB * SEQ;
constexpr int IN0_SRC = 3144, IN0_N = 3328;
constexpr int FF0 = 2816, FFE = 3584, NEXP = 8;
constexpr int IN1_N = 9216;
constexpr int CHUNK_B = 4, CHUNK_T = CHUNK_B * SEQ;
constexpr int MOE_CH_TILES = 128;
constexpr int HM_DOUT_TILES = 73;
constexpr float ALPHA = 1.4142135623730951f;
constexpr float LN_EPS = 1e-5f;
constexpr int NWAVES = 8, NTHR = 512;

constexpr size_t MiB = 1u << 20;
constexpr size_t WS_CTL = 0, CTL_ZERO_BYTES = 64 * 1024;
constexpr size_t WS_BIAST = 1 * MiB;
constexpr size_t WS_MOE_TOK = 2 * MiB;
constexpr size_t WS_MOE_GATE = 3 * MiB;
constexpr size_t WS_WIN0 = 4 * MiB;
constexpr size_t WS_WOUT0 = 11 * MiB;
constexpr size_t WS_WGU0 = 13 * MiB;
constexpr size_t WS_WD0 = 24 * MiB;
constexpr size_t WS_WIN1 = 30 * MiB;
constexpr size_t WS_WOUT1 = 48 * MiB;
constexpr size_t WS_XB = 50 * MiB;
constexpr size_t WS_U = 114 * MiB;
constexpr size_t WS_Q0 = 146 * MiB, SEG0 = 32 * MiB;
constexpr size_t WS_KI = 274 * MiB;
constexpr size_t WS_WI = 278 * MiB;
constexpr size_t WS_MASK = 280 * MiB;
constexpr size_t WS_MIXIN = 296 * MiB;
constexpr size_t WS_X1B = 50 * MiB;
constexpr size_t WS_H0 = 114 * MiB;
constexpr size_t WS_X2B = 448 * MiB;
constexpr size_t WS_H1 = 50 * MiB;
constexpr size_t WS_OP = 338 * MiB;
constexpr size_t WS_LSE = 434 * MiB;
constexpr size_t WS_Y3 = 216 * MiB;
constexpr size_t WS_X3B = 152 * MiB;
constexpr size_t WS_YB = 216 * MiB;
constexpr size_t WS_MWGU = 344 * MiB;
constexpr size_t WS_MWD = 456 * MiB;
constexpr size_t WS_HM = 4 * MiB;
constexpr size_t WS_END = 512 * MiB;
constexpr size_t HM_TILE_BYTES = (size_t)256 * FFE * 2;
constexpr int CW_MOECNT = 64;
constexpr int CW_BAR = 1024;

constexpr int LDS_GTAB = 131072;
constexpr int LDS_RT = 147456;
constexpr int LDS_MISC = 155648 + 2048;
constexpr int LDS_BYTES = 159744;

__device__ __forceinline__ unsigned cvt_pk_bf16(float lo, float hi) { unsigned r; asm volatile("v_cvt_pk_bf16_f32 %0, %1, %2" : "=v"(r) : "v"(lo), "v"(hi)); return r; }
__device__ __forceinline__ float bf_lo(unsigned w) { return __uint_as_float(w << 16); }
__device__ __forceinline__ float bf_hi(unsigned w) { return __uint_as_float(w & 0xffff0000u); }
__device__ __forceinline__ float bf2f(bf16_t b) { return __uint_as_float(((unsigned)b) << 16); }
template <int M> __device__ __forceinline__ float swz_xor(float v) {
    return __int_as_float(__builtin_amdgcn_ds_swizzle(__float_as_int(v), (M << 10) | 0x1f)); }
__device__ __forceinline__ float wave_sum(float v) {
    v += swz_xor<1>(v); v += swz_xor<2>(v); v += swz_xor<4>(v); v += swz_xor<8>(v); v += swz_xor<16>(v);
    auto rr = __builtin_amdgcn_permlane32_swap(__float_as_uint(v), __float_as_uint(v), false, false);
    return __uint_as_float(rr[0]) + __uint_as_float(rr[1]);
}
__device__ __forceinline__ float wave_max(float v) {
    v = fmaxf(v, swz_xor<1>(v)); v = fmaxf(v, swz_xor<2>(v)); v = fmaxf(v, swz_xor<4>(v)); v = fmaxf(v, swz_xor<8>(v)); v = fmaxf(v, swz_xor<16>(v));
    auto rr = __builtin_amdgcn_permlane32_swap(__float_as_uint(v), __float_as_uint(v), false, false);
    return fmaxf(__uint_as_float(rr[0]), __uint_as_float(rr[1]));
}
__device__ __forceinline__ unsigned lane_get(unsigned v, int src_lane) { return (unsigned)__builtin_amdgcn_ds_bpermute(src_lane << 2, (int)v); }
__device__ __forceinline__ float sigmoidf_(float x) { return __builtin_amdgcn_rcpf(1.0f + __expf(-x)); }
#define WAVE_LDS_FENCE() do { asm volatile("s_waitcnt lgkmcnt(0)" ::: "memory"); __builtin_amdgcn_wave_barrier(); } while (0)

#define XB_TMO      128
#define XB_XCNT(j)  (256  + 64 * (j))
#define XB_XSUB(j)  (1280 + 64 * (j))
#define XB_XGEN(j)  (2304 + 64 * (j))
#define XB_TOP      3328
#define XB_TOPGEN   3392
#define XCD_BAR_WORDS 3456
#define XB_SPIN_CAP (1u << 18)
__device__ __forceinline__ unsigned xb_ld(unsigned* p)              { return __hip_atomic_load(p, __ATOMIC_RELAXED, __HIP_MEMORY_SCOPE_AGENT); }
__device__ __forceinline__ unsigned xb_add(unsigned* p, unsigned v) { return __hip_atomic_fetch_add(p, v, __ATOMIC_RELAXED, __HIP_MEMORY_SCOPE_AGENT); }
__device__ __forceinline__ unsigned xb_xcc_id() { return (unsigned)__builtin_amdgcn_s_getreg((3 << 11) | 20) & 0xFu; }
#define XB_SPIN(cond, bar) do { unsigned _sp = 0; while (cond) { __builtin_amdgcn_s_sleep(1); \
    if ((++_sp & 255u) == 0u) { if (xb_ld(&(bar)[XB_TMO])) break; if (_sp > XB_SPIN_CAP) { atomicAdd(&(bar)[XB_TMO], 1u); break; } } } } while (0)
struct XcdBarrier { unsigned* bar; unsigned x; volatile LAS unsigned* st; };
__device__ __forceinline__ XcdBarrier xcd_barrier_post(unsigned* bar, volatile LAS unsigned* st, bool leader) {
    XcdBarrier b; b.bar = bar; b.x = xb_xcc_id(); b.st = st;
    if (leader) (void)xb_add(&bar[XB_XCNT(b.x)], 1u);
    return b;
}
__device__ __forceinline__ void xcd_barrier_complete(unsigned* bar, unsigned x, unsigned& nloc, unsigned& nx) {
    const unsigned G = gridDim.x * gridDim.y * gridDim.z;
    unsigned sum, cnt, mine, sp = 0u;
    for (;;) {
        sum = 0u; cnt = 0u; mine = 0u;
#pragma unroll
        for (unsigned j = 0; j < 16; ++j) { const unsigned c = xb_ld(&bar[XB_XCNT(j)]); sum += c; cnt += (c > 0u) ? 1u : 0u; mine = (j == x) ? c : mine; }
        if (sum == G) break;
        __builtin_amdgcn_s_sleep(1);
        if ((++sp & 255u) == 0u) { if (xb_ld(&bar[XB_TMO])) break; if (sp > XB_SPIN_CAP) { atomicAdd(&bar[XB_TMO], 1u); break; } }
    }
    nloc = mine > 0u ? mine : 1u; nx = cnt > 0u ? cnt : 1u;
}
__device__ __forceinline__ void xcd_barrier(const XcdBarrier& b, bool leader) {
    asm volatile("s_waitcnt vmcnt(0)" ::: "memory");
    __syncthreads();
    if (leader) {
        unsigned* bar = b.bar;
        __builtin_amdgcn_s_waitcnt(0);
        unsigned nloc = b.st[0], nx = b.st[1];
        if (nloc == 0u) { xcd_barrier_complete(bar, b.x, nloc, nx); b.st[0] = nloc; b.st[1] = nx; }
        const unsigned old = xb_add(&bar[XB_XSUB(b.x)], 1u);
        const unsigned gen = old / nloc;
        if (old + 1u == (gen + 1u) * nloc) {
            __builtin_amdgcn_fence(__ATOMIC_RELEASE, "agent");
            asm volatile("s_waitcnt vmcnt(0)" ::: "memory");
            const unsigned og = xb_add(&bar[XB_TOP], 1u);
            const unsigned tg = og / nx;
            if (og + 1u == (tg + 1u) * nx) xb_add(&bar[XB_TOPGEN], 1u);
            else XB_SPIN(xb_ld(&bar[XB_TOPGEN]) == tg, bar);
            __builtin_amdgcn_fence(__ATOMIC_ACQUIRE, "agent");
            xb_add(&bar[XB_XGEN(b.x)], 1u);
            asm volatile("s_waitcnt vmcnt(0)" ::: "memory");
        } else {
            XB_SPIN(xb_ld(&bar[XB_XGEN(b.x)]) == gen, bar);
            __builtin_amdgcn_fence(__ATOMIC_ACQUIRE, "agent");
            asm volatile("s_waitcnt vmcnt(0)" ::: "memory");
        }
    }
    __syncthreads();
}

namespace pg8 {
constexpr int BM = 256, BK = 64, HALF = 128, HTB = HALF * BK * 2, STAGE_BYTES = 8 * HTB, NXCD = 8, WGM = 8;
__host__ __device__ __forceinline__ int lds_byte(int r, int c) { const int st = (r >> 4) * 2 + (c >> 5), rr = r & 15, cc = c & 31, ob = rr * 64 + cc * 2; return st * 1024 + (ob ^ (((ob >> 9) & 1) << 5)); }
__host__ __device__ __forceinline__ void stage_rc(int b, int& R, int& C) { const int st = b / 1024, sb = b % 1024, swz = sb ^ (((sb >> 9) & 1) << 5); R = (st >> 1) * 16 + swz / 64; C = (st & 1) * 32 + (swz % 64) / 2; }
__host__ __device__ __forceinline__ int perm32(int rho) { const int n = rho >> 4, i = rho & 15; return 8 * (i >> 2) + 4 * n + (i & 3); }

struct Unit { int pm, pn; };

__device__ __forceinline__ void remap_unit(int wgid, int nM, int nN, int& pm, int& pn) {
    const int nwg = nM * nN;
    { const int q = nwg / NXCD, r = nwg % NXCD, xcd = wgid % NXCD, off = wgid / NXCD; wgid = (xcd < r ? xcd * (q + 1) : r * (q + 1) + (xcd - r) * q) + off; }
    const int nig = WGM * nN, gid = wgid / nig, fm = gid * WGM, gsz = (nM - fm) < WGM ? (nM - fm) : WGM;
    pm = fm + ((wgid % nig) % gsz); pn = (wgid % nig) / gsz;
}
struct StaticOrder {
    int nM, nN, nwg, G, c; const char* A; size_t tstepA;
    __device__ void init(const bf16_t* A_, int M, int N, int K, int G_, int c_) { nM = M / BM; nN = N / BM; nwg = nM * nN; G = G_; c = c_; A = (const char*)A_; tstepA = (size_t)BM * K * 2; }
    __device__ __forceinline__ bool next(int i, Unit& u) const {
        const long L = (long)i * G + c; if (L >= nwg) return false;
        remap_unit((int)L, nM, nN, u.pm, u.pn); return true;
    }
    __device__ __forceinline__ const char* a_ptr(const Unit& u) const { return A + (size_t)u.pm * tstepA; }
    __device__ __forceinline__ int b_tile(const Unit& u) const { return u.pn; }
};

#define PG8_LAS __attribute__((address_space(3)))
template <class Epi, class Sched, bool ALIGN_EPI, bool GATHER>
__device__ __forceinline__ void gemm_phase(const int tid, PG8_LAS unsigned char* lds, const bf16_t* Btp, const int K, const Sched& S, const Epi& E, const PG8_LAS int* gtab) {
    const int wid = __builtin_amdgcn_readfirstlane(tid >> 6), lane = tid & 63, wr = wid >> 2, wc = wid & 3, fr = lane & 15, fq = lane >> 4;
    const int nt = K / BK;
    unsigned voffA[2], voffB[2];
#pragma unroll
    for (int i = 0; i < 2; ++i) { int R, C; stage_rc(tid * 16 + i * 8192, R, C); const int Rb = Epi::PERM ? ((R & ~31) + perm32(R & 31)) : R;
        voffA[i] = (unsigned)(R * K + C) * 2u; voffB[i] = (unsigned)(Rb * K + C) * 2u; }
    const size_t kstep = (size_t)(BK * 2);
    const size_t hstep = (size_t)HALF * K * 2;
    const size_t tstep = 2 * hstep;
    const unsigned ldsw = (unsigned)wid * 1024u;
    const int aoff = lds_byte(wr * 64 + fr, fq * 8), boff = lds_byte(wc * 32 + fr, fq * 8);
#define PG8_SA(b, h) (((b) * 2 + (h)) * HTB)
#define PG8_SB(b, h) ((4 + (b) * 2 + (h)) * HTB)
#define PG8_STAGE(bufoff, gbase, voff) do { _Pragma("unroll") for (int _i = 0; _i < 2; ++_i) \
        __builtin_amdgcn_global_load_lds((const unsigned*)((const char*)(gbase) + (voff)[_i]), (PG8_LAS unsigned*)(lds + (bufoff) + ldsw + _i * 8192), 16, 0, 0); } while (0)
#define PG8_STAGE_AC(bufoff, kt, h) do { if constexpr (GATHER) { PG8_STAGE(bufoff, cA + (size_t)(kt) * kstep, gcur[h]); } else { PG8_STAGE(bufoff, cA + (size_t)(kt) * kstep + (h) * hstep, voffA); } } while (0)
#define PG8_STAGE_AN(bufoff, d, h) do { if constexpr (GATHER) { if (last) { unsigned _g[2]; _Pragma("unroll") for (int _i = 0; _i < 2; ++_i) { int _R, _C; stage_rc(tid * 16 + _i * 8192, _R, _C); _g[_i] = (unsigned)gtab[nslot * 256 + (h) * 128 + _R] * (unsigned)(K * 2) + (unsigned)(_C * 2); } \
            PG8_STAGE(bufoff, nA + (size_t)(d) * kstep, _g); } else { PG8_STAGE(bufoff, cA + (size_t)(t + 2 + (d)) * kstep, gcur[h]); } } \
        else { PG8_STAGE(bufoff, a2 + (size_t)(d) * kstep + (h) * hstep, voffA); } } while (0)
#define PG8_LDA(dst, b, h) do { _Pragma("unroll") for (int m = 0; m < 4; ++m) _Pragma("unroll") for (int k = 0; k < 2; ++k) dst[m][k] = *(const PG8_LAS bf16x8*)(lds + PG8_SA(b, h) + aoff + m * 2048 + k * 1024); } while (0)
#define PG8_LDB(dst, b, h) do { _Pragma("unroll") for (int n = 0; n < 2; ++n) _Pragma("unroll") for (int k = 0; k < 2; ++k) dst[n][k] = *(const PG8_LAS bf16x8*)(lds + PG8_SB(b, h) + boff + n * 2048 + k * 1024); } while (0)
#define PG8_MMA(ai, bj, At, Bt) do { __builtin_amdgcn_s_setprio(1); _Pragma("unroll") for (int m = 0; m < 4; ++m) _Pragma("unroll") for (int n = 0; n < 2; ++n) _Pragma("unroll") for (int k = 0; k < 2; ++k) \
        acc[ai][bj][m][n] = __builtin_amdgcn_mfma_f32_16x16x32_bf16(Bt[n][k], At[m][k], acc[ai][bj][m][n], 0, 0, 0); __builtin_amdgcn_s_setprio(0); } while (0)
#define PG8_WAIT_V(n) asm volatile("s_waitcnt vmcnt(" #n ")" ::: "memory")
#define PG8_WAIT_L(n) asm volatile("s_waitcnt lgkmcnt(" #n ")" ::: "memory")
#define PG8_BAR __builtin_amdgcn_s_barrier()
#define PG8_SCHED __builtin_amdgcn_sched_barrier(0)
#define PG8_LOADG(dst, slot_) do { _Pragma("unroll") for (int _i = 0; _i < 2; ++_i) { int _R, _C; stage_rc(tid * 16 + _i * 8192, _R, _C); _Pragma("unroll") for (int _h = 0; _h < 2; ++_h) \
        dst[_h][_i] = (unsigned)gtab[(slot_) * 256 + _h * 128 + _R] * (unsigned)(K * 2) + (unsigned)(_C * 2); } } while (0)
    Unit cur, nxt; int ui = 0;
    if (!S.next(0, cur)) return;
    f32x4 acc[2][2][4][2];
#pragma unroll
    for (int a = 0; a < 2; ++a)
#pragma unroll
        for (int b = 0; b < 2; ++b)
#pragma unroll
            for (int m = 0; m < 4; ++m)
#pragma unroll
                for (int n = 0; n < 2; ++n) acc[a][b][m][n] = (f32x4){0.f, 0.f, 0.f, 0.f};
    bf16x8 At[4][2], B0[2][2], B1[2][2];
    unsigned gcur[2][2] = {{0u, 0u}, {0u, 0u}};
    const char* cA = S.a_ptr(cur); const char* cB = (const char*)Btp + (size_t)S.b_tile(cur) * tstep;
    if constexpr (GATHER) { PG8_LOADG(gcur, 0); PG8_WAIT_L(0); }
    PG8_STAGE(PG8_SB(0, 0), cB, voffB); PG8_STAGE(PG8_SB(0, 1), cB + hstep, voffB); PG8_STAGE_AC(PG8_SA(0, 0), 0, 0); PG8_STAGE_AC(PG8_SA(0, 1), 0, 1);
    if (wr == 1) PG8_BAR;
    PG8_WAIT_V(2); PG8_BAR;
    PG8_STAGE(PG8_SB(1, 0), cB + kstep, voffB); PG8_STAGE_AC(PG8_SA(1, 0), 1, 0); PG8_STAGE(PG8_SB(1, 1), cB + hstep + kstep, voffB);
    PG8_WAIT_V(6); PG8_BAR;
    for (;;) {
        const bool has_next = S.next(ui + 1, nxt);
        const char* nA = has_next ? S.a_ptr(nxt) : cA; const char* nB = has_next ? (const char*)Btp + (size_t)S.b_tile(nxt) * tstep : cB;
        const int nslot = has_next ? ui + 1 : ui;
        for (int t = 0; t < nt; t += 2) {
            const bool last = (t == nt - 2);
            const char* a2 = last ? nA : cA + (size_t)(t + 2) * kstep; const char* b2 = last ? nB : cB + (size_t)(t + 2) * kstep;
            const char* b3 = b2 + kstep;
            (void)a2;
            PG8_LDB(B0, 0, 0); PG8_LDB(B1, 0, 1); PG8_SCHED; PG8_LDA(At, 0, 0); PG8_STAGE_AC(PG8_SA(1, 1), t + 1, 1);
            PG8_WAIT_V(8); PG8_WAIT_L(0); PG8_BAR; PG8_MMA(0, 0, At, B0); PG8_MMA(0, 1, At, B1); PG8_BAR; PG8_SCHED;
            PG8_LDA(At, 0, 1); PG8_STAGE(PG8_SB(0, 0), b2, voffB); PG8_STAGE(PG8_SB(0, 1), b2 + hstep, voffB); PG8_STAGE_AN(PG8_SA(0, 0), 0, 0);
            PG8_WAIT_V(8); PG8_WAIT_L(0); PG8_BAR; PG8_MMA(1, 0, At, B0); PG8_MMA(1, 1, At, B1); PG8_BAR; PG8_SCHED;
            PG8_LDB(B0, 1, 0); PG8_LDB(B1, 1, 1); PG8_SCHED; PG8_LDA(At, 1, 0); PG8_STAGE_AN(PG8_SA(0, 1), 0, 1);
            PG8_WAIT_V(8); PG8_WAIT_L(0); PG8_BAR; PG8_MMA(0, 0, At, B0); PG8_MMA(0, 1, At, B1); PG8_BAR; PG8_SCHED;
            PG8_LDA(At, 1, 1); PG8_STAGE(PG8_SB(1, 0), b3, voffB); PG8_STAGE(PG8_SB(1, 1), b3 + hstep, voffB); PG8_STAGE_AN(PG8_SA(1, 0), 1, 0);
            PG8_WAIT_V(8); PG8_WAIT_L(0); PG8_BAR; PG8_MMA(1, 0, At, B0); PG8_MMA(1, 1, At, B1); PG8_BAR; PG8_SCHED;
        }
        if constexpr (ALIGN_EPI) { if (wr == 0) PG8_BAR; }
        { int fr_e = fr, fq_e = fq; asm volatile("" : "+v"(fr_e), "+v"(fq_e)); E(acc, cur, wr, wc, fr_e, fq_e); }
        if (!has_next) break;
#pragma unroll
        for (int a = 0; a < 2; ++a)
#pragma unroll
            for (int b = 0; b < 2; ++b)
#pragma unroll
                for (int m = 0; m < 4; ++m)
#pragma unroll
                    for (int n = 0; n < 2; ++n) acc[a][b][m][n] = (f32x4){0.f, 0.f, 0.f, 0.f};
        cur = nxt; cA = nA; cB = nB; ++ui;
        if constexpr (GATHER) { PG8_LOADG(gcur, ui); }
        if constexpr (ALIGN_EPI) { if (wr == 1) PG8_BAR; }
    }
    PG8_WAIT_V(0);
    if constexpr (!ALIGN_EPI) { if (wr == 0) PG8_BAR; }
    PG8_BAR;
#undef PG8_SA
#undef PG8_SB
#undef PG8_STAGE
#undef PG8_STAGE_AC
#undef PG8_STAGE_AN
#undef PG8_LDA
#undef PG8_LDB
#undef PG8_MMA
#undef PG8_WAIT_V
#undef PG8_WAIT_L
#undef PG8_BAR
#undef PG8_SCHED
#undef PG8_LOADG
}

typedef f32x4 AccT[2][2][4][2];
__device__ __forceinline__ u32x4 pack8(const f32x4 v0, const f32x4 v1) { u32x4 w; w.x = cvt_pk_bf16(v0[0], v0[1]); w.y = cvt_pk_bf16(v0[2], v0[3]); w.z = cvt_pk_bf16(v1[0], v1[1]); w.w = cvt_pk_bf16(v1[2], v1[3]); return w; }

struct EpiIn0 {
    static constexpr bool PERM = true;
    bf16_t* U; bf16_t* Q; bf16_t* KI; float* WI;
    __device__ __forceinline__ void operator()(const AccT& acc, const Unit& u, int wr, int wc, int fr, int fq) const {
        const int row0 = u.pm * BM + wr * 64 + fr;
        if (u.pn < 4) {
            const int col0 = u.pn * 128 + wc * 32 + 8 * fq;
#pragma unroll
            for (int ai = 0; ai < 2; ++ai)
#pragma unroll
                for (int m = 0; m < 4; ++m) { f32x4 o0, o1;
#pragma unroll
                    for (int j = 0; j < 4; ++j) { o0[j] = acc[ai][0][m][0][j] * sigmoidf_(acc[ai][1][m][0][j]); o1[j] = acc[ai][0][m][1][j] * sigmoidf_(acc[ai][1][m][1][j]); }
                    *(u32x4*)(U + (size_t)(row0 + ai * HALF + m * 16) * 512 + col0) = pack8(o0, o1); }
        } else if (u.pn < 12) {
            const int t = (u.pn - 4) >> 1; bf16_t* base = Q + (size_t)t * (SEG0 / 2); const float sc = 1.0f;
            const int col0 = ((u.pn - 4) & 1) * 256 + wc * 32 + 8 * fq;
#pragma unroll
            for (int ai = 0; ai < 2; ++ai)
#pragma unroll
                for (int m = 0; m < 4; ++m)
#pragma unroll
                    for (int bj = 0; bj < 2; ++bj)
                        *(u32x4*)(base + (size_t)(row0 + ai * HALF + m * 16) * 512 + col0 + bj * HALF) = pack8(acc[ai][bj][m][0] * sc, acc[ai][bj][m][1] * sc);
        } else {
            if (wc < 2) {
#pragma unroll
                for (int ai = 0; ai < 2; ++ai)
#pragma unroll
                    for (int m = 0; m < 4; ++m) *(u32x4*)(KI + (size_t)(row0 + ai * HALF + m * 16) * 64 + wc * 32 + 8 * fq) = pack8(acc[ai][0][m][0], acc[ai][0][m][1]);
            } else if (wc == 2 && fq == 0) {
                const float sc = 0.04419417382415922f;
#pragma unroll
                for (int ai = 0; ai < 2; ++ai)
#pragma unroll
                    for (int m = 0; m < 4; ++m) { float* p = WI + (size_t)(row0 + ai * HALF + m * 16) * 8; *(f32x4*)p = acc[ai][0][m][0] * sc; *(f32x4*)(p + 4) = acc[ai][0][m][1] * sc; }
            }
        }
    }
};
struct EpiRes {
    static constexpr bool PERM = true;
    bf16_t* out; const bf16_t* resid;
    __device__ __forceinline__ void operator()(const AccT& acc, const Unit& u, int wr, int wc, int fr, int fq) const {
        const int row0 = u.pm * BM + wr * 64 + fr, col0 = u.pn * BM + wc * 32 + 8 * fq;
#pragma unroll
        for (int ai = 0; ai < 2; ++ai)
#pragma unroll
            for (int m = 0; m < 4; ++m) { const size_t off = (size_t)(row0 + ai * HALF + m * 16) * DM + col0;
#pragma unroll
                for (int bj = 0; bj < 2; ++bj) { const u32x4 w = *(const u32x4*)(resid + off + bj * HALF);
                    const f32x4 r0 = (f32x4){bf_lo(w.x), bf_hi(w.x), bf_lo(w.y), bf_hi(w.y)}, r1 = (f32x4){bf_lo(w.z), bf_hi(w.z), bf_lo(w.w), bf_hi(w.w)};
                    *(u32x4*)(out + off + bj * HALF) = pack8(r0 * ALPHA + acc[ai][bj][m][0], r1 * ALPHA + acc[ai][bj][m][1]); } }
    }
};
__device__ __forceinline__ char* hm_tile(char* dout, char* ws, int p) { return p < HM_DOUT_TILES ? dout + (size_t)p * HM_TILE_BYTES : ws + WS_HM + (size_t)(p - HM_DOUT_TILES) * HM_TILE_BYTES; }
template <bool TILE_LOCAL> struct EpiSwiglu {
    static constexpr bool PERM = true;
    bf16_t* H; int ldh; char* dout; char* ws;
    __device__ __forceinline__ void operator()(const AccT& acc, const Unit& u, int wr, int wc, int fr, int fq) const {
        bf16_t* base; if constexpr (TILE_LOCAL) base = (bf16_t*)hm_tile(dout, ws, u.pm); else base = H + (size_t)u.pm * BM * ldh;
        const int rl0 = wr * 64 + fr, col0 = u.pn * 128 + wc * 32 + 8 * fq;
#pragma unroll
        for (int ai = 0; ai < 2; ++ai)
#pragma unroll
            for (int m = 0; m < 4; ++m) { f32x4 o0, o1;
#pragma unroll
                for (int j = 0; j < 4; ++j) { const float g0 = acc[ai][0][m][0][j], g1 = acc[ai][0][m][1][j];
                    o0[j] = g0 * sigmoidf_(g0) * acc[ai][1][m][0][j]; o1[j] = g1 * sigmoidf_(g1) * acc[ai][1][m][1][j]; }
                *(u32x4*)(base + (size_t)(rl0 + ai * HALF + m * 16) * ldh + col0) = pack8(o0, o1); }
    }
};
struct EpiQkv1 {
    static constexpr bool PERM = true;
    bf16_t* O; int ldc; float qscale;
    __device__ __forceinline__ void operator()(const AccT& acc, const Unit& u, int wr, int wc, int fr, int fq) const {
        const int row0 = u.pm * BM + wr * 64 + fr, col0 = u.pn * BM + wc * 32 + 8 * fq; const float sc = ((u.pn % 12) < 4) ? qscale : 1.0f;
#pragma unroll
        for (int ai = 0; ai < 2; ++ai)
#pragma unroll
            for (int m = 0; m < 4; ++m)
#pragma unroll
                for (int bj = 0; bj < 2; ++bj)
                    *(u32x4*)(O + (size_t)(row0 + ai * HALF + m * 16) * ldc + col0 + bj * HALF) = pack8(acc[ai][bj][m][0] * sc, acc[ai][bj][m][1] * sc);
    }
};
struct EpiMoeDown {
    static constexpr bool PERM = true;
    bf16_t* YB; const int* tokk; const float* gate; const PG8_LAS int* rt;
    __device__ __forceinline__ void operator()(const AccT& acc, const Unit& u, int wr, int wc, int fr, int fq) const {
        const int lbase = rt[u.pm * 4 + 1], nvalid = rt[u.pm * 4 + 2];
        const int rl0 = wr * 64 + fr, col0 = u.pn * BM + wc * 32 + 8 * fq;
#pragma unroll
        for (int ai = 0; ai < 2; ++ai)
#pragma unroll
            for (int m = 0; m < 4; ++m) { const int rl = rl0 + ai * HALF + m * 16;
                if (rl < nvalid) { const int tk = tokk[lbase + rl]; const float g = gate[lbase + rl];
                    bf16_t* rowp = YB + ((size_t)(tk & 1) * NTOK + (size_t)(tk >> 1)) * DM + col0;
#pragma unroll
                    for (int bj = 0; bj < 2; ++bj) *(u32x4*)(rowp + bj * HALF) = pack8(acc[ai][bj][m][0] * g, acc[ai][bj][m][1] * g); } }
    }
};
struct MoeOrder {
    int G, c, nM, nN; const PG8_LAS int* rt; const char* xbase; char* dout; char* ws; bool up;
    __device__ __forceinline__ bool next(int i, Unit& u) const {
        const long L = (long)i * G + c; if (L >= (long)nM * nN) return false;
        remap_unit((int)L, nM, nN, u.pm, u.pn); return true;
    }
    __device__ __forceinline__ const char* a_ptr(const Unit& u) const { return up ? xbase : (const char*)hm_tile(dout, ws, u.pm); }
    __device__ __forceinline__ int b_tile(const Unit& u) const { return __builtin_amdgcn_readfirstlane(rt[u.pm * 4]) * nN + u.pn; }
};
}


namespace swa {
constexpr int D = 128, NW = 8, QBLK = 32, KVBLK = 64, QB = NW * QBLK, WIN = 129;
constexpr int SHM_V = KVBLK * D * 2, SHM_K = KVBLK * D * 2;
constexpr int LDS_TB = 2 * SHM_V + 2 * SHM_K + NW * 64 * 4;
constexpr float SCALE = 0.08838834764831845f, THR = 8.f;
typedef float f32x16 __attribute__((ext_vector_type(16)));
typedef short s16x4 __attribute__((ext_vector_type(4)));
#define KSWZ(row, colB) ((row) * 256 + ((colB) ^ (((row) & 7) << 4)))
#define SBAR() __builtin_amdgcn_sched_barrier(0)
__device__ __forceinline__ int v_st(int k, int c) { const int kk = (k & ~0xC) | ((k & 4) << 1) | ((k & 8) >> 1); return ((kk >> 3) * 4 + (c >> 5)) * 512 + ((kk & 7) * 32 + (c & 31)) * 2; }
__device__ __forceinline__ int v_rd_base(int lane) { return ((lane & 3) << 3) | (((lane >> 2) & 3) << 6) | (((lane >> 4) & 1) << 5) | (((lane >> 5) & 1) << 8); }
constexpr int v_rd_off(int d0, int ks, int half) { return d0 * 512 + ks * 4096 + half * 2048; }
__device__ __forceinline__ int crow(int r, int hi) { return (r & 3) + 8 * (r >> 2) + 4 * hi; }
__device__ __forceinline__ bf16x8 load8(const bf16_t* p) { return *reinterpret_cast<const bf16x8*>(p); }
__device__ __forceinline__ void mask_bias_tile(f32x16& p0, f32x16& p1, int dq, const float* tb) {
    const float NEG = -__builtin_inff();
#pragma unroll
    for (int r = 0; r < 16; ++r) {
        const int c = (r & 3) + 8 * (r >> 2);
        p0[r] = ((unsigned)(dq - c) < (unsigned)WIN) ? p0[r] + tb[59 - c] : NEG;
        p1[r] = ((unsigned)(dq - c - 32) < (unsigned)WIN) ? p1[r] + tb[27 - c] : NEG;
    }
}
__device__ __forceinline__ void partialSM(f32x16& p0, f32x16& p1, float& m_reg, float& mn, float& alpha) {
    float pmax = p0[0];
#pragma unroll
    for (int r = 1; r < 16; ++r) pmax = fmaxf(pmax, p0[r]);
#pragma unroll
    for (int r = 0; r < 16; ++r) pmax = fmaxf(pmax, p1[r]);
    { auto rr = __builtin_amdgcn_permlane32_swap(__float_as_uint(pmax), __float_as_uint(pmax), false, false);
      pmax = fmaxf(__uint_as_float(rr[0]), __uint_as_float(rr[1])); }
    constexpr float C2 = 1.4426950408889634f * SCALE;
    if (__builtin_expect(__all((pmax - m_reg) * SCALE <= THR), 1)) { mn = m_reg; alpha = 1.f; }
    else { mn = fmaxf(m_reg, pmax); alpha = __builtin_amdgcn_exp2f((m_reg - mn) * C2); m_reg = mn; }
    const float mnL = -mn * C2;
#pragma unroll
    for (int r = 0; r < 16; ++r) p0[r] = fmaf(p0[r], C2, mnL);
#pragma unroll
    for (int r = 0; r < 16; ++r) p1[r] = fmaf(p1[r], C2, mnL);
#pragma unroll
    for (int r = 0; r < 16; ++r) p0[r] = __builtin_amdgcn_exp2f(p0[r]);
}
__device__ __forceinline__ void finishSM(f32x16& p0, f32x16& p1, float alpha, float& l_reg, bf16x8& pa0, bf16x8& pa1, bf16x8& pa2, bf16x8& pa3) {
#pragma unroll
    for (int r = 0; r < 16; ++r) p1[r] = __builtin_amdgcn_exp2f(p1[r]);
    float ps = 0;
#pragma unroll
    for (int r = 0; r < 16; ++r) ps += p0[r];
#pragma unroll
    for (int r = 0; r < 16; ++r) ps += p1[r];
    { auto rr = __builtin_amdgcn_permlane32_swap(__float_as_uint(ps), __float_as_uint(ps), false, false);
      ps = __uint_as_float(rr[0]) + __uint_as_float(rr[1]); }
    l_reg = l_reg * alpha + ps;
#define PK4(P, B_, OUT) do { unsigned a0 = cvt_pk_bf16(P[B_+0], P[B_+1]), a1 = cvt_pk_bf16(P[B_+2], P[B_+3]);                          \
        unsigned b0 = cvt_pk_bf16(P[B_+4], P[B_+5]), b1 = cvt_pk_bf16(P[B_+6], P[B_+7]);                                             \
        auto r0 = __builtin_amdgcn_permlane32_swap(a0, b0, false, false); auto r1 = __builtin_amdgcn_permlane32_swap(a1, b1, false, false); \
        u32x4 w = {r0[0], r1[0], r0[1], r1[1]}; OUT = *reinterpret_cast<bf16x8*>(&w); } while (0)
    PK4(p0, 0, pa0); PK4(p0, 8, pa1); PK4(p1, 0, pa2); PK4(p1, 8, pa3);
#undef PK4
}
template <int KB>
__device__ __forceinline__ void qkt(f32x16& p0, f32x16& p1, const char* K_lds, int r32, int hi, const bf16x8* qr, bool act) {
    if (!act) { const float NEG = -__builtin_inff();
#pragma unroll
        for (int r = 0; r < 16; ++r) { p0[r] = NEG; p1[r] = NEG; } return; }
    p0 = f32x16{}; p1 = f32x16{};
    const char* kb[4];
#pragma unroll
    for (int dd = 0; dd < 4; ++dd) kb[dd] = K_lds + KB * SHM_K + KSWZ(r32, (dd * 16 + hi * 8) * 2);
#pragma unroll
    for (int d0 = 0; d0 < 8; ++d0) { const char* a = kb[d0 & 3] + (d0 >> 2) * 128;
        bf16x8 b0 = *reinterpret_cast<const bf16x8*>(a);
        bf16x8 b1 = *reinterpret_cast<const bf16x8*>(a + 32 * 256);
        p0 = __builtin_amdgcn_mfma_f32_32x32x16_bf16(b0, qr[d0], p0, 0, 0, 0);
        p1 = __builtin_amdgcn_mfma_f32_32x32x16_bf16(b1, qr[d0], p1, 0, 0, 0); }
}
template <int VB>
__device__ __forceinline__ void pv_tile(f32x16* o, int vb0, bf16x8 pa0, bf16x8 pa1, bf16x8 pa2, bf16x8 pa3, bool act) {
    if (!act) return;
#define TRRD(dst, off) asm volatile("ds_read_b64_tr_b16 %0, %1 offset:%2" : "=&v"(dst) : "v"(vb0), "i"(off) : "memory")
#define PV_D0(d0) do { s16x4 l0, l1, l2, l3, h0, h1, h2, h3; constexpr int b_ = VB * SHM_V + v_rd_off(d0, 0, 0); \
        TRRD(l0, b_); TRRD(h0, b_ + 2048); TRRD(l1, b_ + 4096); TRRD(h1, b_ + 6144); TRRD(l2, b_ + 8192); TRRD(h2, b_ + 10240); TRRD(l3, b_ + 12288); TRRD(h3, b_ + 14336); \
        asm volatile("s_waitcnt lgkmcnt(0)" ::: "memory"); SBAR();   \
        o[d0] = __builtin_amdgcn_mfma_f32_32x32x16_bf16(pa0, (bf16x8){l0[0], l0[1], l0[2], l0[3], h0[0], h0[1], h0[2], h0[3]}, o[d0], 0, 0, 0);   \
        o[d0] = __builtin_amdgcn_mfma_f32_32x32x16_bf16(pa1, (bf16x8){l1[0], l1[1], l1[2], l1[3], h1[0], h1[1], h1[2], h1[3]}, o[d0], 0, 0, 0);   \
        o[d0] = __builtin_amdgcn_mfma_f32_32x32x16_bf16(pa2, (bf16x8){l2[0], l2[1], l2[2], l2[3], h2[0], h2[1], h2[2], h2[3]}, o[d0], 0, 0, 0);   \
        o[d0] = __builtin_amdgcn_mfma_f32_32x32x16_bf16(pa3, (bf16x8){l3[0], l3[1], l3[2], l3[3], h3[0], h3[1], h3[2], h3[3]}, o[d0], 0, 0, 0); } while (0)
    PV_D0(0); PV_D0(1); PV_D0(2); PV_D0(3);
#undef PV_D0
#undef TRRD
}
struct BlockRef { const bf16_t* Q; const bf16_t* K; bf16_t* O; float* LSE; int P0, bh, dsh;
    __device__ __forceinline__ int rs() const { return IN1_N << dsh; }
    __device__ __forceinline__ int os() const { return DM << dsh; }
    __device__ __forceinline__ int ls() const { return 8 << dsh; }
    __device__ __forceinline__ int skv() const { return SEQ >> dsh; }
    __device__ __forceinline__ const bf16_t* V() const { return K + 1024; } };
struct Seam { bf16x8 qr[8]; bf16x8 st_v0, st_v1, st_k0, st_k1; };
__device__ __forceinline__ int swa_jlo(int P0) { const int lowk = P0 - WIN + 1; return lowk > 0 ? lowk / KVBLK : 0; }
#define ROWP(p, k0, rs_, vo) ((const bf16_t*)((const char*)(p) + (size_t)(k0) * (size_t)(rs_) * 2 + (size_t)(vo)))
#define VMW() asm volatile("s_waitcnt vmcnt(0)" ::: "memory")
#define VMWN(n) asm volatile("s_waitcnt vmcnt(%0)" :: "i"(n) : "memory")
#define TIDL() int tid_l = tid; asm volatile("" : "+v"(tid_l)); const int sr = tid_l >> 4, sc = (tid_l & 15) * 8; (void)sr; (void)sc
#define SLOAD_H(Kp, Vp, k0, rs_) do { TIDL(); const unsigned vo0_ = (unsigned)(sr * (rs_) + sc) * 2u, vo1_ = vo0_ + (unsigned)(rs_) * 64u; \
                         S.st_v0 = load8(ROWP(Vp, k0, rs_, vo0_)); S.st_v1 = load8(ROWP(Vp, k0, rs_, vo1_));              \
                         S.st_k0 = load8(ROWP(Kp, k0, rs_, vo0_)); S.st_k1 = load8(ROWP(Kp, k0, rs_, vo1_)); } while (0)
#define SWRITE_HK(bf) do { TIDL(); const int kws = KSWZ(sr, sc * 2); *(bf16x8*)(K_lds + (bf) * SHM_K + kws) = S.st_k0; *(bf16x8*)(K_lds + (bf) * SHM_K + kws + 32 * 256) = S.st_k1; } while (0)
#define SWRITE_HV(bf) do { TIDL(); const int vst0 = v_st(sr, sc), vst1 = v_st(32 + sr, sc); *(bf16x8*)(V_lds + (bf) * SHM_V + vst0) = S.st_v0; *(bf16x8*)(V_lds + (bf) * SHM_V + vst1) = S.st_v1; } while (0)
#define SWRITE_H(bf) do { SWRITE_HV(bf); SWRITE_HK(bf); } while (0)
__device__ __forceinline__ void tb_load(const float* biast, int bh, int dsh, int tid, float& v0, float& v1) {
    const int d0 = tid - 384, d1 = tid + 512 - 384;
    v0 = (d0 >= 0 && d0 < WIN) ? biast[bh * 4096 + (d0 << dsh)] * (1.0f / SCALE) : 0.f;
    v1 = (d1 >= 0 && d1 < WIN) ? biast[bh * 4096 + (d1 << dsh)] * (1.0f / SCALE) : 0.f;
}
__device__ __forceinline__ void swa_prime(const BlockRef& cur, const float* biast, char* lds, Seam& S, int tid) {
    const int wid = __builtin_amdgcn_readfirstlane(tid >> 6), lane = tid & 63, r32 = lane & 31, hi = lane >> 5;
    char* K_lds = lds + 2 * SHM_V;
    const int kb0 = swa_jlo(cur.P0) * KVBLK;
    float t0, t1; tb_load(biast, cur.bh, cur.dsh, tid, t0, t1);
#pragma unroll
    for (int d0 = 0; d0 < 8; ++d0) S.qr[d0] = load8((const bf16_t*)((const char*)cur.Q + (size_t)((unsigned)((wid * QBLK + r32) * cur.rs() + hi * 8) * 2u)) + d0 * 16);
    SLOAD_H(cur.K, cur.V(), kb0, cur.rs()); VMW(); SWRITE_HK(0);
    float* tb = (float*)(lds + LDS_TB); tb[tid] = t0; tb[tid + 512] = t1;
    __syncthreads();
}
__device__ __forceinline__ void swa_block(const BlockRef& cur, const BlockRef& nxt, const float* biast, int slot, char* lds, Seam& S, int tid) {
    const int wid = __builtin_amdgcn_readfirstlane(tid >> 6), lane = tid & 63, r32 = lane & 31, hi = lane >> 5;
    const int j_lo = swa_jlo(cur.P0);
    int j_hi = (cur.P0 + QB - 1) / KVBLK + 1; if (j_hi > cur.skv() / KVBLK) j_hi = cur.skv() / KVBLK;
    const int NT = j_hi - j_lo;
    const int kbn = swa_jlo(nxt.P0) * KVBLK;
    const int qlo = cur.P0 + wid * QBLK, qm = qlo + r32 - 4 * hi;
    char* V_lds = lds; char* K_lds = lds + 2 * SHM_V;
    float* wsl = (float*)(lds + 2 * SHM_V + 2 * SHM_K) + wid * 64; float* li_l = wsl, * al_l = wsl + 32;
    const float* tbl0 = (const float*)(lds + LDS_TB + slot * 4096) + 325;
    float m_reg = -1e30f, l_reg = 0; f32x16 o[4] = {};
    const int vb0 = (int)(uintptr_t)V_lds + v_rd_base(lane);
    const bf16_t* Kh = cur.K; const bf16_t* Vh = cur.V(); const int rs = cur.rs();
#define RESC(a) do { if (__any((a) < 1.f)) { if (hi == 0) al_l[r32] = (a); asm volatile("s_waitcnt lgkmcnt(0)" ::: "memory");              \
                     _Pragma("unroll") for (int d_ = 0; d_ < 4; ++d_) _Pragma("unroll") for (int r = 0; r < 16; ++r) o[d_][r] *= al_l[crow(r, hi)]; } } while (0)
#define KBASE(t) ((j_lo + (t)) * KVBLK)
#define ACT(t) (KBASE(t) <= qlo + QBLK - 1 && KBASE(t) + KVBLK - 1 >= qlo - WIN + 1)
#define MASKT(P0_, P1_, t) do { const int kb_ = KBASE(t); if (ACT(t)) mask_bias_tile(P0_, P1_, qm - kb_, tbl0 + (qm - kb_)); } while (0)
    constexpr int NQL = 8;
#define SEAM_K0() do { VMWN(NQL); SWRITE_HK(0); SBAR(); } while (0)
    f32x16 pA0, pA1, pB0, pB1; float mnA, mnB, alA, alB; bf16x8 pa0, pa1, pa2, pa3;
    SWRITE_HV(0); SBAR();
    if (NT > 1) { SLOAD_H(Kh, Vh, KBASE(1), rs); }
    SBAR(); qkt<0>(pA0, pA1, K_lds, r32, hi, S.qr, ACT(0));
    MASKT(pA0, pA1, 0); partialSM(pA0, pA1, m_reg, mnA, alA);
    if (NT > 1) { VMW(); SWRITE_H(1); }
    __syncthreads();
#define HALF_STEP(PX0, PX1, mnX, alX, PY0, PY1, alY, t, KB, VB, SB) do {                                                      \
        SBAR(); qkt<KB>(PX0, PX1, K_lds, r32, hi, S.qr, ACT(t));                                             \
        finishSM(PY0, PY1, alY, l_reg, pa0, pa1, pa2, pa3); SBAR();                                                           \
        if ((t) + 1 < NT) { SLOAD_H(Kh, Vh, KBASE((t) + 1), rs); SBAR(); }                                               \
        pv_tile<VB>(o, vb0, pa0, pa1, pa2, pa3, ACT((t) - 1)); MASKT(PX0, PX1, (t)); partialSM(PX0, PX1, m_reg, mnX, alX);                                        \
        __syncthreads();                                                                                                      \
        if ((t) + 1 < NT) { VMW(); SWRITE_H(SB); }                                                                          \
        RESC(alX); __syncthreads(); } while (0)
    for (int t = 1; t + 1 < NT; t += 2) {
        HALF_STEP(pB0, pB1, mnB, alB, pA0, pA1, alA, t, 1, 0, 0);
        HALF_STEP(pA0, pA1, mnA, alA, pB0, pB1, alB, t + 1, 0, 1, 1);
    }
    const bool even = (NT & 1) == 0;
    if (even) { SBAR(); qkt<1>(pB0, pB1, K_lds, r32, hi, S.qr, ACT(NT - 1)); SBAR(); }
    SLOAD_H(nxt.K, nxt.V(), kbn, nxt.rs()); SBAR();
#pragma unroll
    for (int d0 = 0; d0 < 8; ++d0) S.qr[d0] = load8((const bf16_t*)((const char*)nxt.Q + (size_t)((unsigned)((wid * QBLK + r32) * nxt.rs() + hi * 8) * 2u)) + d0 * 16);
    SBAR();
    finishSM(pA0, pA1, alA, l_reg, pa0, pa1, pa2, pa3); SBAR();
    pv_tile<0>(o, vb0, pa0, pa1, pa2, pa3, ACT(even ? NT - 2 : NT - 1));
    if (even) { MASKT(pB0, pB1, NT - 1); partialSM(pB0, pB1, m_reg, mnB, alB); __syncthreads(); RESC(alB);
        finishSM(pB0, pB1, alB, l_reg, pa0, pa1, pa2, pa3); SBAR(); pv_tile<1>(o, vb0, pa0, pa1, pa2, pa3, ACT(NT - 1)); }
    SBAR(); SEAM_K0();
    float t0, t1; tb_load(biast, nxt.bh, nxt.dsh, tid, t0, t1);
    if (hi == 0) li_l[r32] = l_reg; asm volatile("s_waitcnt lgkmcnt(0)" ::: "memory");
    int r32e = r32, hie = hi; asm volatile("" : "+v"(r32e), "+v"(hie));
    if (hie == 0) cur.LSE[(size_t)(wid * QBLK + r32e) * cur.ls()] = m_reg * SCALE + __logf(l_reg);
    float rli[16];
#pragma unroll
    for (int r = 0; r < 16; ++r) rli[r] = __builtin_amdgcn_rcpf(li_l[crow(r, hie)]);
    const int os = cur.os();
    bf16_t* Ow = cur.O + (size_t)(wid * QBLK) * os;
#pragma unroll
    for (int r = 0; r < 16; ++r) { const unsigned oo = (unsigned)(crow(r, hie) * os + r32e) * 2u;
#pragma unroll
        for (int d0 = 0; d0 < 4; ++d0) { const float v = o[d0][r] * rli[r];
            const float vn = swz_xor<1>(v);
            if ((r32e & 1) == 0) *(unsigned*)((char*)Ow + oo + d0 * 64) = cvt_pk_bf16(v, vn); } }
    { float* tb = (float*)(lds + LDS_TB + (slot ^ 1) * 4096); tb[tid] = t0; tb[tid + 512] = t1; }
    __syncthreads();
#undef RESC
#undef KBASE
#undef ACT
#undef MASKT
#undef SEAM_K0
#undef HALF_STEP
}
#undef ROWP
#undef VMW
#undef VMWN
#undef SLOAD_H
#undef SWRITE_HK
#undef SWRITE_HV
#undef SWRITE_H
#undef TIDL
#undef KSWZ
#undef SBAR
}


namespace dsa {
constexpr int D = 64, NW = 8, QBLK = 32, KVBLK = 64, QB = NW * QBLK;
constexpr int SHM_V = KVBLK * D * 2, SHM_K = KVBLK * D * 2;
constexpr int LDS_TB = 2 * SHM_V + 2 * SHM_K + NW * 64 * 4;
constexpr int TB_PAD = 128;
constexpr float SCALE = 0.125f, THR = 8.f;
typedef float f32x16 __attribute__((ext_vector_type(16)));
typedef short s16x4 __attribute__((ext_vector_type(4)));
#define KSWZ(row, colB) ((row) * 128 + ((colB) ^ (((row) & 7) << 4)))
#define SBAR() __builtin_amdgcn_sched_barrier(0)
__device__ __forceinline__ int v_st(int k, int c) { const int kk = (k & ~0xC) | ((k & 4) << 1) | ((k & 8) >> 1); return ((kk >> 3) * 2 + (c >> 5)) * 512 + ((kk & 7) * 32 + (c & 31)) * 2; }
__device__ __forceinline__ int v_rd_base(int lane) { return ((lane & 3) << 3) | (((lane >> 2) & 3) << 6) | (((lane >> 4) & 1) << 5) | (((lane >> 5) & 1) << 8); }
__device__ __forceinline__ int crow(int r, int hi) { return (r & 3) + 8 * (r >> 2) + 4 * hi; }
__device__ __forceinline__ bf16x8 load8(const bf16_t* p) { return *reinterpret_cast<const bf16x8*>(p); }
__device__ __forceinline__ void mask_bias_tile(f32x16& p0, f32x16& p1, const float* tb, unsigned lo4, unsigned hi4) {
    const float NEG = -__builtin_inff();
#pragma unroll
    for (int r = 0; r < 16; ++r) {
        const int c = (r & 3) + 8 * (r >> 2);
        p0[r] = ((lo4 >> c) & 1u) ? p0[r] + tb[63 - c] : NEG;
        p1[r] = ((hi4 >> c) & 1u) ? p1[r] + tb[31 - c] : NEG;
    }
}
__device__ __forceinline__ void partialSM(f32x16& p0, f32x16& p1, float& m_reg, float& mn, float& alpha) {
    float pmax = p0[0];
#pragma unroll
    for (int r = 1; r < 16; ++r) pmax = fmaxf(pmax, p0[r]);
#pragma unroll
    for (int r = 0; r < 16; ++r) pmax = fmaxf(pmax, p1[r]);
    { auto rr = __builtin_amdgcn_permlane32_swap(__float_as_uint(pmax), __float_as_uint(pmax), false, false);
      pmax = fmaxf(__uint_as_float(rr[0]), __uint_as_float(rr[1])); }
    constexpr float C2 = 1.4426950408889634f * SCALE;
    if (__builtin_expect(__all((pmax - m_reg) * SCALE <= THR), 1)) { mn = m_reg; alpha = 1.f; }
    else { mn = fmaxf(m_reg, pmax); alpha = __builtin_amdgcn_exp2f((m_reg - mn) * C2); m_reg = mn; }
    const float mnL = -mn * C2;
#pragma unroll
    for (int r = 0; r < 16; ++r) p0[r] = fmaf(p0[r], C2, mnL);
#pragma unroll
    for (int r = 0; r < 16; ++r) p1[r] = fmaf(p1[r], C2, mnL);
#pragma unroll
    for (int r = 0; r < 16; ++r) p0[r] = __builtin_amdgcn_exp2f(p0[r]);
}
__device__ __forceinline__ void finishSM(f32x16& p0, f32x16& p1, float alpha, float& l_reg, bf16x8& pa0, bf16x8& pa1, bf16x8& pa2, bf16x8& pa3) {
#pragma unroll
    for (int r = 0; r < 16; ++r) p1[r] = __builtin_amdgcn_exp2f(p1[r]);
    float ps = 0;
#pragma unroll
    for (int r = 0; r < 16; ++r) ps += p0[r];
#pragma unroll
    for (int r = 0; r < 16; ++r) ps += p1[r];
    { auto rr = __builtin_amdgcn_permlane32_swap(__float_as_uint(ps), __float_as_uint(ps), false, false);
      ps = __uint_as_float(rr[0]) + __uint_as_float(rr[1]); }
    l_reg = l_reg * alpha + ps;
#define PK4(P, B_, OUT) do { unsigned a0 = cvt_pk_bf16(P[B_+0], P[B_+1]), a1 = cvt_pk_bf16(P[B_+2], P[B_+3]);                          \
        unsigned b0 = cvt_pk_bf16(P[B_+4], P[B_+5]), b1 = cvt_pk_bf16(P[B_+6], P[B_+7]);                                             \
        auto r0 = __builtin_amdgcn_permlane32_swap(a0, b0, false, false); auto r1 = __builtin_amdgcn_permlane32_swap(a1, b1, false, false); \
        u32x4 w = {r0[0], r1[0], r0[1], r1[1]}; OUT = *reinterpret_cast<bf16x8*>(&w); } while (0)
    PK4(p0, 0, pa0); PK4(p0, 8, pa1); PK4(p1, 0, pa2); PK4(p1, 8, pa3);
#undef PK4
}
template <int KB>
__device__ __forceinline__ void qkt(f32x16& p0, f32x16& p1, const char* K_lds, int r32, int hi, const bf16x8* qr, bool act) {
    if (!act) { const float NEG = -__builtin_inff();
#pragma unroll
        for (int r = 0; r < 16; ++r) { p0[r] = NEG; p1[r] = NEG; } return; }
    p0 = f32x16{}; p1 = f32x16{};
#pragma unroll
    for (int d0 = 0; d0 < 4; ++d0) { const char* a = K_lds + KB * SHM_K + KSWZ(r32, (d0 * 16 + hi * 8) * 2);
        bf16x8 b0 = *reinterpret_cast<const bf16x8*>(a);
        bf16x8 b1 = *reinterpret_cast<const bf16x8*>(a + 32 * 128);
        p0 = __builtin_amdgcn_mfma_f32_32x32x16_bf16(b0, qr[d0], p0, 0, 0, 0);
        p1 = __builtin_amdgcn_mfma_f32_32x32x16_bf16(b1, qr[d0], p1, 0, 0, 0); }
}
template <int VB>
__device__ __forceinline__ void pv_tile(f32x16* o, int vb0, bf16x8 pa0, bf16x8 pa1, bf16x8 pa2, bf16x8 pa3, bool act) {
    if (!act) return;
#define TRRD(dst, off) asm volatile("ds_read_b64_tr_b16 %0, %1 offset:%2" : "=&v"(dst) : "v"(vb0), "i"(off) : "memory")
#define PV_D0(d0) do { s16x4 l0, l1, l2, l3, h0, h1, h2, h3; constexpr int b_ = VB * SHM_V + (d0) * 512; \
        TRRD(l0, b_); TRRD(h0, b_ + 1024); TRRD(l1, b_ + 2048); TRRD(h1, b_ + 3072); TRRD(l2, b_ + 4096); TRRD(h2, b_ + 5120); TRRD(l3, b_ + 6144); TRRD(h3, b_ + 7168); \
        asm volatile("s_waitcnt lgkmcnt(0)" ::: "memory"); SBAR();   \
        o[d0] = __builtin_amdgcn_mfma_f32_32x32x16_bf16(pa0, (bf16x8){l0[0], l0[1], l0[2], l0[3], h0[0], h0[1], h0[2], h0[3]}, o[d0], 0, 0, 0);   \
        o[d0] = __builtin_amdgcn_mfma_f32_32x32x16_bf16(pa1, (bf16x8){l1[0], l1[1], l1[2], l1[3], h1[0], h1[1], h1[2], h1[3]}, o[d0], 0, 0, 0);   \
        o[d0] = __builtin_amdgcn_mfma_f32_32x32x16_bf16(pa2, (bf16x8){l2[0], l2[1], l2[2], l2[3], h2[0], h2[1], h2[2], h2[3]}, o[d0], 0, 0, 0);   \
        o[d0] = __builtin_amdgcn_mfma_f32_32x32x16_bf16(pa3, (bf16x8){l3[0], l3[1], l3[2], l3[3], h3[0], h3[1], h3[2], h3[3]}, o[d0], 0, 0, 0); } while (0)
    PV_D0(0); PV_D0(1);
#undef PV_D0
#undef TRRD
}
struct BlockRef { const bf16_t* Q; const bf16_t* K; const bf16_t* V; bf16_t* O; const u64* MW; int P0; };
struct Seam { bf16x8 qr[4]; bf16x8 st_v0, st_k0; u64 mw; };
#define VMW() asm volatile("s_waitcnt vmcnt(0)" ::: "memory")
#define VMWN(n) asm volatile("s_waitcnt vmcnt(%0)" :: "i"(n) : "memory")
#define TIDL() int tid_l = tid; asm volatile("" : "+v"(tid_l)); const int sr = tid_l >> 3, sc = (tid_l & 7) * 8; (void)sr; (void)sc
#define SLOAD_H(Kp, Vp, k0) do { TIDL(); const unsigned vo_ = (unsigned)((k0 + sr) * 512 + sc) * 2u; \
        S.st_v0 = load8((const bf16_t*)((const char*)(Vp) + vo_)); S.st_k0 = load8((const bf16_t*)((const char*)(Kp) + vo_)); } while (0)
#define SWRITE_HK(bf) do { TIDL(); *(bf16x8*)(K_lds + (bf) * SHM_K + KSWZ(sr, sc * 2)) = S.st_k0; } while (0)
#define SWRITE_HV(bf) do { TIDL(); *(bf16x8*)(V_lds + (bf) * SHM_V + v_st(sr, sc)) = S.st_v0; } while (0)
#define SWRITE_H(bf) do { SWRITE_HV(bf); SWRITE_HK(bf); } while (0)
#define MWLOAD(ref, tile) ((ref).MW[(size_t)(tile) * SEQ + wid * QBLK + r32])
__device__ __forceinline__ void dsa_prime(const BlockRef& cur, char* lds, Seam& S, int tid) {
    const int wid = __builtin_amdgcn_readfirstlane(tid >> 6), lane = tid & 63, r32 = lane & 31, hi = lane >> 5;
    char* K_lds = lds + 2 * SHM_V;
#pragma unroll
    for (int d0 = 0; d0 < 4; ++d0) S.qr[d0] = load8(cur.Q + (size_t)(wid * QBLK + r32) * 512 + d0 * 16 + hi * 8);
    S.mw = MWLOAD(cur, 0);
    SLOAD_H(cur.K, cur.V, 0); VMW(); SWRITE_HK(0);
    __syncthreads();
}
__device__ __forceinline__ void dsa_block(const BlockRef& cur, const BlockRef& nxt, char* lds, Seam& S, int tid) {
    const int wid = __builtin_amdgcn_readfirstlane(tid >> 6), lane = tid & 63, r32 = lane & 31, hi = lane >> 5;
    const int NT = (cur.P0 + QB - 1) / KVBLK + 1;
    const int qlo = cur.P0 + wid * QBLK, qm = qlo + r32 - 4 * hi;
    char* V_lds = lds; char* K_lds = lds + 2 * SHM_V;
    float* wsl = (float*)(lds + 2 * SHM_V + 2 * SHM_K) + wid * 64; float* li_l = wsl, * al_l = wsl + 32;
    const float* tbl0 = (const float*)(lds + LDS_TB) + (TB_PAD - 63);
    float m_reg = -1e30f, l_reg = 0; f32x16 o[2] = {};
    const int vb0 = (int)(uintptr_t)V_lds + v_rd_base(lane);
    const bf16_t* Kh = cur.K; const bf16_t* Vh = cur.V;
#define RESC(a) do { if (__any((a) < 1.f)) { if (hi == 0) al_l[r32] = (a); asm volatile("s_waitcnt lgkmcnt(0)" ::: "memory");              \
                     _Pragma("unroll") for (int d_ = 0; d_ < 2; ++d_) _Pragma("unroll") for (int r = 0; r < 16; ++r) o[d_][r] *= al_l[crow(r, hi)]; } } while (0)
#define KBASE(t) ((t) * KVBLK)
#define ACT(t) (KBASE(t) <= qlo + QBLK - 1)
#define MASKT(P0_, P1_, t, MWX) do { const int kb_ = KBASE(t); if (ACT(t)) mask_bias_tile(P0_, P1_, tbl0 + (qm - kb_), (unsigned)(MWX) >> (4 * hi), (unsigned)((MWX) >> 32) >> (4 * hi)); } while (0)
    constexpr int NQL = 5;
#define SEAM_K0() do { VMWN(NQL); SWRITE_HK(0); SBAR(); } while (0)
    f32x16 pA0, pA1, pB0, pB1; float mnA, mnB, alA, alB; bf16x8 pa0, pa1, pa2, pa3;
    u64 mwA = S.mw, mwB = 0;
    SWRITE_HV(0); SBAR();
    if (NT > 1) { SLOAD_H(Kh, Vh, KBASE(1)); mwB = MWLOAD(cur, 1); }
    SBAR(); qkt<0>(pA0, pA1, K_lds, r32, hi, S.qr, ACT(0));
    MASKT(pA0, pA1, 0, mwA); partialSM(pA0, pA1, m_reg, mnA, alA);
    if (NT > 1) { VMW(); SWRITE_H(1); }
    __syncthreads();
#define HALF_STEP(PX0, PX1, mnX, alX, PY0, PY1, alY, t, KB, VB, SB, MWX, MWY) do {                                                      \
        SBAR(); qkt<KB>(PX0, PX1, K_lds, r32, hi, S.qr, ACT(t));                                             \
        finishSM(PY0, PY1, alY, l_reg, pa0, pa1, pa2, pa3); SBAR();                                                           \
        if ((t) + 1 < NT) { SLOAD_H(Kh, Vh, KBASE((t) + 1)); MWY = MWLOAD(cur, (t) + 1); SBAR(); }                                               \
        pv_tile<VB>(o, vb0, pa0, pa1, pa2, pa3, ACT((t) - 1)); MASKT(PX0, PX1, (t), MWX); partialSM(PX0, PX1, m_reg, mnX, alX);                                        \
        __syncthreads();                                                                                                      \
        if ((t) + 1 < NT) { VMW(); SWRITE_H(SB); }                                                                          \
        RESC(alX); __syncthreads(); } while (0)
    for (int t = 1; t + 1 < NT; t += 2) {
        HALF_STEP(pB0, pB1, mnB, alB, pA0, pA1, alA, t, 1, 0, 0, mwB, mwA);
        HALF_STEP(pA0, pA1, mnA, alA, pB0, pB1, alB, t + 1, 0, 1, 1, mwA, mwB);
    }
    const bool even = (NT & 1) == 0;
    if (even) { SBAR(); qkt<1>(pB0, pB1, K_lds, r32, hi, S.qr, ACT(NT - 1)); SBAR(); }
    SLOAD_H(nxt.K, nxt.V, 0); SBAR();
#pragma unroll
    for (int d0 = 0; d0 < 4; ++d0) S.qr[d0] = load8(nxt.Q + (size_t)(wid * QBLK + r32) * 512 + d0 * 16 + hi * 8);
    S.mw = MWLOAD(nxt, 0);
    SBAR();
    finishSM(pA0, pA1, alA, l_reg, pa0, pa1, pa2, pa3); SBAR();
    pv_tile<0>(o, vb0, pa0, pa1, pa2, pa3, ACT(even ? NT - 2 : NT - 1));
    if (even) { MASKT(pB0, pB1, NT - 1, mwB); partialSM(pB0, pB1, m_reg, mnB, alB); __syncthreads(); RESC(alB);
        finishSM(pB0, pB1, alB, l_reg, pa0, pa1, pa2, pa3); SBAR(); pv_tile<1>(o, vb0, pa0, pa1, pa2, pa3, ACT(NT - 1)); }
    SBAR(); SEAM_K0();
    if (hi == 0) li_l[r32] = l_reg; asm volatile("s_waitcnt lgkmcnt(0)" ::: "memory");
    int r32e = r32, hie = hi; asm volatile("" : "+v"(r32e), "+v"(hie));
    float rli[16];
#pragma unroll
    for (int r = 0; r < 16; ++r) rli[r] = __builtin_amdgcn_rcpf(li_l[crow(r, hie)]);
    bf16_t* Ow = cur.O + (size_t)(wid * QBLK) * DM;
#pragma unroll
    for (int r = 0; r < 16; ++r) { const unsigned oo = (unsigned)(crow(r, hie) * DM + r32e) * 2u;
#pragma unroll
        for (int d0 = 0; d0 < 2; ++d0) { const float v = o[d0][r] * rli[r];
            const float vn = swz_xor<1>(v);
            if ((r32e & 1) == 0) *(unsigned*)((char*)Ow + oo + d0 * 64) = cvt_pk_bf16(v, vn); } }
    __syncthreads();
#undef RESC
#undef KBASE
#undef ACT
#undef MASKT
#undef SEAM_K0
#undef HALF_STEP
}
#undef VMW
#undef VMWN
#undef TIDL
#undef SLOAD_H
#undef SWRITE_HK
#undef SWRITE_HV
#undef SWRITE_H
#undef MWLOAD
#undef KSWZ
#undef SBAR
}

__device__ __forceinline__ swa::BlockRef dil_ref(int u, const bf16_t* H1p, bf16_t* OPp, float* LSEp) {
    const int x = u & 15, rest = u >> 4, g = rest % 3, bh = rest / 3, h = bh & 7, bl = bh >> 3;
    const int dsh = 2 * g, dil = 1 << dsh, r = x >> (4 - dsh), blk = x & ((16 >> dsh) - 1), P0 = blk * 256;
    const size_t row0 = (size_t)bl * SEQ + r, rowq = row0 + (size_t)dil * P0;
    swa::BlockRef R;
    R.K = H1p + row0 * IN1_N + g * 3072 + 1024 + h * 128; R.Q = H1p + rowq * IN1_N + g * 3072 + h * 128;
    R.O = OPp + ((size_t)g * CHUNK_T + rowq) * DM + h * 128; R.LSE = LSEp + ((size_t)g * CHUNK_T + rowq) * 8 + h;
    R.P0 = P0; R.bh = h; R.dsh = dsh;
    return R;
}

struct Args {
    const float* in[25]; float* out; unsigned char* ws; int ph_lo, ph_hi;
};
enum { I_X = 0, I_RELB, I_EWIN, I_CONVW, I_CONVB, I_CLNG, I_CLNB, I_EWOUT, I_ELN1G, I_ELN1B, I_FWG, I_FWU, I_FWD, I_ELN2G, I_ELN2B,
       I_OWIN, I_OWOUT, I_OLN1G, I_OLN1B, I_ROUTER, I_MWG, I_MWU, I_MWD, I_OLN2G, I_OLN2B };

__device__ __forceinline__ void transpose_item(const float* W, int ldw, int src_c0, int nvalid, int k0, bf16_t* WT, int K, int dst_row0, LAS float* scr, int lane) {
    (void)scr;
    const int kg = lane & 7, ng = lane >> 3;
    f32x4 v[8];
    const float* src = W + (size_t)(k0 + 8 * kg) * ldw + src_c0 + 4 * ng;
    const bool ok = 4 * ng < nvalid;
#pragma unroll
    for (int r = 0; r < 8; ++r) v[r] = ok ? *(const f32x4*)(src + (size_t)r * ldw) : (f32x4){0.f, 0.f, 0.f, 0.f};
#pragma unroll
    for (int c = 0; c < 4; ++c) { u32x4 o; o.x = cvt_pk_bf16(v[0][c], v[1][c]); o.y = cvt_pk_bf16(v[2][c], v[3][c]); o.z = cvt_pk_bf16(v[4][c], v[5][c]); o.w = cvt_pk_bf16(v[6][c], v[7][c]);
        *(u32x4*)(WT + (size_t)(dst_row0 + 4 * ng + c) * K + k0 + 8 * kg) = o; }
}
__device__ __forceinline__ void gu_item(const float* wg, const float* wu, int FF, int K, bf16_t* WT, int item, LAS float* scr, int lane) {
    const int nblk = 2 * FF / 32, kb = item / nblk, nb = item % nblk, tile = nb >> 3, sub = nb & 7;
    transpose_item(sub < 4 ? wg : wu, FF, tile * 128 + (sub & 3) * 32, 32, kb * 64, WT, K, nb * 32, scr, lane);
}
__device__ __forceinline__ void plain_item(const float* W, int K, int N, bf16_t* WT, int item, LAS float* scr, int lane) {
    const int nblk = N / 32, kb = item / nblk, nb = item % nblk;
    transpose_item(W, N, nb * 32, 32, kb * 64, WT, K, nb * 32, scr, lane);
}
__device__ __forceinline__ void in0_item(const float* W, bf16_t* WT, int item, LAS float* scr, int lane) {
    const int nblk = IN0_N / 32, kb = item / nblk, nb = item % nblk, tile = nb >> 3, sub = nb & 7;
    int src_c0, nvalid = 32;
    if (tile < 4) src_c0 = (sub < 4) ? tile * 128 + sub * 32 : 512 + tile * 128 + (sub - 4) * 32;
    else { src_c0 = nb * 32; nvalid = IN0_SRC - src_c0; nvalid = nvalid < 0 ? 0 : (nvalid > 32 ? 32 : nvalid); if (nvalid == 0) src_c0 = 0; }
    transpose_item(W, IN0_SRC, src_c0, nvalid, kb * 64, WT, DM, nb * 32, scr, lane);
}
__device__ __forceinline__ int rel_bucket(int n) {
    if (n < 16) return n;
    const float nf = (float)n;
    int large = 16 + (int)(logf(nf / 16.0f) / logf(128.0f) * 16.0f);
    return large < 31 ? large : 31;
}

__device__ __forceinline__ void ln_core(f32x4 (&v)[4], const float* g, const float* b, int lane) {
    float s = 0.f;
#pragma unroll
    for (int j = 0; j < 4; ++j) s += (v[j][0] + v[j][1]) + (v[j][2] + v[j][3]);
    const float mean = wave_sum(s) * (1.f / DM); float s2 = 0.f;
#pragma unroll
    for (int j = 0; j < 4; ++j) { v[j] = v[j] - mean; s2 += (v[j][0] * v[j][0] + v[j][1] * v[j][1]) + (v[j][2] * v[j][2] + v[j][3] * v[j][3]); }
    const float rstd = 1.f / sqrtf(wave_sum(s2) * (1.f / DM) + LN_EPS);
#pragma unroll
    for (int j = 0; j < 4; ++j) { const f32x4 gg = *(const f32x4*)(g + 4 * lane + 256 * j), bb = *(const f32x4*)(b + 4 * lane + 256 * j); v[j] = v[j] * rstd * gg + bb; }
}
__device__ __forceinline__ void store_row_bf16(bf16_t* orow, const f32x4 (&v)[4], int lane) {
#pragma unroll
    for (int j = 0; j < 4; ++j) { u32x2 w; w.x = cvt_pk_bf16(v[j][0], v[j][1]); w.y = cvt_pk_bf16(v[j][2], v[j][3]); *(u32x2*)(orow + 4 * lane + 256 * j) = w; }
}
__device__ __forceinline__ f32x4 ld_bf4(const bf16_t* p) { const u32x2 w = *(const u32x2*)p; return (f32x4){bf_lo(w.x), bf_hi(w.x), bf_lo(w.y), bf_hi(w.y)}; }

__device__ __forceinline__ int my_lane_asm() { int l; asm volatile("v_mbcnt_lo_u32_b32 %0, -1, 0\n\tv_mbcnt_hi_u32_b32 %0, -1, %0" : "=v"(l)); return l; }
__global__ void __launch_bounds__(NTHR, 2) fwd_kernel(Args args) {
    extern __shared__ __attribute__((aligned(16))) unsigned char lds_raw[];
    LAS unsigned char* lds = (LAS unsigned char*)lds_raw;
    const int G = gridDim.x, bid = blockIdx.x;
    const int NGW = G * NWAVES;
    volatile LAS unsigned* MISC = (volatile LAS unsigned*)(lds + LDS_MISC);
    const int wave_id = __builtin_amdgcn_readfirstlane((int)(threadIdx.x >> 6));
    {
        const int l0 = my_lane_asm();
        if (wave_id == 0 && l0 < 16) MISC[l0] = 0u;
        __syncthreads();
    }
#define MY_LANE() my_lane_asm()
#if ONE_LAUNCH
    (void)xcd_barrier_post((unsigned*)(args.ws + WS_CTL) + CW_BAR, MISC, wave_id == 0 && MY_LANE() == 0);
#define GRID_BAR() do { XcdBarrier _b; _b.bar = (unsigned*)(ws + WS_CTL) + CW_BAR; _b.x = xb_xcc_id(); _b.st = (volatile LAS unsigned*)(lds + LDS_MISC); xcd_barrier(_b, tid == 0); } while (0)
#else
#define GRID_BAR() do { } while (0)
#endif
    const int lo = args.ph_lo, hi = args.ph_hi;
#ifndef PH_MASK
#define PH_MASK 0xFFFFFFu
#endif
#define IN(k) ((((PH_MASK) >> (k)) & 1u) && lo <= (k) && (k) < hi)
#define BOTH(k) (IN(k) && IN((k) + 1))
#define PHASE_BEGIN int lane = MY_LANE(); asm volatile("" : "+v"(lane)); const int wave = wave_id; const int tid = wave * 64 + lane; const int gw = bid * NWAVES + wave; \
    size_t zoff_ = 0; asm volatile("" : "+s"(zoff_)); unsigned char* ws = args.ws + zoff_; float* outp = (float*)((unsigned char*)args.out + zoff_); unsigned* ctl = (unsigned*)(ws + WS_CTL); (void)lane; (void)wave; (void)gw; (void)ctl; (void)outp;
#define x_in (args.in[I_X])
#define WIN0 ((bf16_t*)(ws + WS_WIN0))
#define WOUT0 ((bf16_t*)(ws + WS_WOUT0))
#define WGU0 ((bf16_t*)(ws + WS_WGU0))
#define WD0 ((bf16_t*)(ws + WS_WD0))
#define WIN1 ((bf16_t*)(ws + WS_WIN1))
#define WOUT1 ((bf16_t*)(ws + WS_WOUT1))
#define MWGU ((bf16_t*)(ws + WS_MWGU))
#define MWD ((bf16_t*)(ws + WS_MWD))
#define BIAST ((float*)(ws + WS_BIAST))
#define XB ((bf16_t*)(ws + WS_XB))
#define Ub ((bf16_t*)(ws + WS_U))
#define Q0 ((bf16_t*)(ws + WS_Q0))
#define K0 ((bf16_t*)(ws + WS_Q0 + SEG0))
#define V0 ((bf16_t*)(ws + WS_Q0 + 2 * SEG0))
#define QI ((bf16_t*)(ws + WS_Q0 + 3 * SEG0))
#define KI ((bf16_t*)(ws + WS_KI))
#define WI ((float*)(ws + WS_WI))
#define MASK ((u64*)(ws + WS_MASK))
#define MIXIN ((bf16_t*)(ws + WS_MIXIN))
#define X1B ((bf16_t*)(ws + WS_X1B))
#define H0 ((bf16_t*)(ws + WS_H0))
#define X2B ((bf16_t*)(ws + WS_X2B))
#define H1 ((bf16_t*)(ws + WS_H1))
#define O1 ((bf16_t*)outp)
#define Y3 ((float*)(ws + WS_Y3))
#define X3B ((bf16_t*)(ws + WS_X3B))
#define YB ((bf16_t*)(ws + WS_YB))
#define MTOK ((int*)(ws + WS_MOE_TOK))
#define MGATE ((float*)(ws + WS_MOE_GATE))
#define GTAB ((const LAS int*)(lds + LDS_GTAB))

    if (IN(0)) { asm volatile("; PHASE_MARK 0"); PHASE_BEGIN
        LAS float* scr = (LAS float*)(lds + wave * 16384);
        constexpr int I_IN0 = 16 * (IN0_N / 32), I_OUT = 16 * 32, I_GU0 = 16 * (2 * FF0 / 32), I_D0 = (FF0 / 64) * 32, I_IN1 = 16 * (IN1_N / 32);
        constexpr int NIT = I_IN0 + I_OUT + I_GU0 + I_D0 + I_IN1 + I_OUT;
        for (int it = gw; it < NIT; it += NGW) {
            int r = it;
            if (r < I_IN0) { in0_item(args.in[I_EWIN], WIN0, r, scr, lane); continue; } r -= I_IN0;
            if (r < I_OUT) { plain_item(args.in[I_EWOUT], DM, DM, WOUT0, r, scr, lane); continue; } r -= I_OUT;
            if (r < I_GU0) { gu_item(args.in[I_FWG], args.in[I_FWU], FF0, DM, WGU0, r, scr, lane); continue; } r -= I_GU0;
            if (r < I_D0) { plain_item(args.in[I_FWD], FF0, DM, WD0, r, scr, lane); continue; } r -= I_D0;
            if (r < I_IN1) { plain_item(args.in[I_OWIN], DM, IN1_N, WIN1, r, scr, lane); continue; } r -= I_IN1;
            plain_item(args.in[I_OWOUT], DM, DM, WOUT1, r, scr, lane);
        }
        for (size_t i = (size_t)bid * NTHR + tid; i < (size_t)NTOK * DM / 8; i += (size_t)G * NTHR) {
            const f32x4 a = *(const f32x4*)(x_in + i * 8), b = *(const f32x4*)(x_in + i * 8 + 4);
            *(u32x4*)(XB + i * 8) = pg8::pack8(a, b);
        }
        for (int i = bid * NTHR + tid; i < 8 * 4096; i += G * NTHR) { const int h = i >> 12, d = i & 4095; BIAST[i] = args.in[I_RELB][rel_bucket(d) * 8 + h]; }
        if (BOTH(0)) GRID_BAR();
    }

    if (IN(1)) { asm volatile("; PHASE_MARK 1"); PHASE_BEGIN
        pg8::StaticOrder S; S.init(XB, NTOK, IN0_N, DM, G, bid);
        pg8::EpiIn0 E{Ub, Q0, KI, WI};
        pg8::gemm_phase<pg8::EpiIn0, pg8::StaticOrder, true, false>(tid, lds, WIN0, DM, S, E, GTAB);
        if (BOTH(1)) GRID_BAR();
    }

    if (IN(2)) { asm volatile("; PHASE_MARK 2"); PHASE_BEGIN
        {
            LAS bf16_t* ut = (LAS bf16_t*)lds;
            LAS float* yt = (LAS float*)(lds + 65536);
            const float* cw = args.in[I_CONVW]; const int c = tid;
            float w[31];
#pragma unroll
            for (int j = 0; j < 31; ++j) w[j] = cw[j * 512 + c];
            const float cb = args.in[I_CONVB][c];
            for (int tile = bid; tile < NTOK / 32; tile += G) {
                const int t0 = tile * 32, s0 = t0 & (SEQ - 1);
                for (int i = tid; i < 62 * 64; i += NTHR) { const int r = i >> 6, c8 = i & 63; const int sr = s0 - 30 + r;
                    u32x4 v = (u32x4){0u, 0u, 0u, 0u}; if (sr >= 0) v = *(const u32x4*)(Ub + (size_t)(t0 - 30 + r) * 512 + c8 * 8);
                    *(LAS u32x4*)(ut + r * 512 + c8 * 8) = v; }
                __syncthreads();
                for (int t = 0; t < 32; ++t) { float a = cb;
#pragma unroll
                    for (int j = 0; j < 31; ++j) a += w[j] * bf2f(ut[(t + j) * 512 + c]);
                    yt[t * 512 + c] = a; }
                __syncthreads();
                const float* lg = args.in[I_CLNG]; const float* lb = args.in[I_CLNB];
#pragma unroll
                for (int tt = 0; tt < 4; ++tt) { const int t = wave * 4 + tt;
                    f32x4 a = *(LAS f32x4*)(yt + t * 512 + lane * 8), b = *(LAS f32x4*)(yt + t * 512 + lane * 8 + 4);
                    float s = (a[0] + a[1]) + (a[2] + a[3]) + (b[0] + b[1]) + (b[2] + b[3]); const float mean = wave_sum(s) * (1.f / 512.f);
                    a = a - mean; b = b - mean; float s2 = a[0] * a[0] + a[1] * a[1] + a[2] * a[2] + a[3] * a[3] + b[0] * b[0] + b[1] * b[1] + b[2] * b[2] + b[3] * b[3];
                    const float rstd = 1.f / sqrtf(wave_sum(s2) * (1.f / 512.f) + LN_EPS);
                    const f32x4 g0 = *(const f32x4*)(lg + lane * 8), g1 = *(const f32x4*)(lg + lane * 8 + 4), b0 = *(const f32x4*)(lb + lane * 8), b1 = *(const f32x4*)(lb + lane * 8 + 4);
                    a = a * rstd * g0 + b0; b = b * rstd * g1 + b1;
#pragma unroll
                    for (int j = 0; j < 4; ++j) { a[j] = a[j] * sigmoidf_(a[j]); b[j] = b[j] * sigmoidf_(b[j]); }
                    *(u32x4*)(MIXIN + (size_t)(t0 + t) * DM + lane * 8) = pg8::pack8(a, b); }
                __syncthreads();
            }
        }
        {
            constexpr int CAP = 512;
            LAS unsigned* hist = (LAS unsigned*)lds;
            LAS unsigned* clist = hist;
            LAS unsigned* mtile = (LAS unsigned*)(lds + 65536);
            LAS unsigned* rinfo = (LAS unsigned*)(lds + 65536 + 8192);
            LAS unsigned* ccnt = rinfo + 64;
            LAS unsigned* flag = rinfo + 80;
            LAS unsigned* rsel = rinfo + 96;
            LAS unsigned* whist = (LAS unsigned*)(lds + 65536 + 8192 + 1024) + wave * 256;
            const int vcu = (G % 8 == 0) ? (bid % 8) * (G / 8) + bid / 8 : bid;
            const int g4 = lane >> 4, r16 = lane & 15;
            for (int it = 0; it < 8 && vcu < 256; ++it) {
                const int b = it, qt = (it & 1) ? 255 - vcu : vcu;
                const int q0 = qt * 16, tok0 = b * SEQ + q0, nwords = (q0 + 15) / 64 + 1, q = q0 + r16;
                if (q0 < 256) {
                    for (int i = tid; i < 16 * nwords; i += NTHR) { const int r = i & 15, W = i >> 4; const int d = q0 + r - 64 * W;
                        const u64 word = d >= 63 ? ~0ull : (d < 0 ? 0ull : ((2ull << d) - 1ull));
                        MASK[((size_t)b * 64 + W) * SEQ + q0 + r] = word; }
                    continue;
                }
                bf16x8 Qf[8][2]; float wq[8];
#pragma unroll
                for (int h = 0; h < 8; ++h)
#pragma unroll
                    for (int c2 = 0; c2 < 2; ++c2) Qf[h][c2] = *(const bf16x8*)(QI + (size_t)(tok0 + r16) * 512 + h * 64 + c2 * 32 + g4 * 8);
                { const f32x4 w0 = *(const f32x4*)(WI + (size_t)(tok0 + r16) * 8), w1 = *(const f32x4*)(WI + (size_t)(tok0 + r16) * 8 + 4);
                  wq[0] = w0[0]; wq[1] = w0[1]; wq[2] = w0[2]; wq[3] = w0[3]; wq[4] = w1[0]; wq[5] = w1[1]; wq[6] = w1[2]; wq[7] = w1[3]; }
                for (int i = tid; i < 16 * 64 * 2; i += NTHR) mtile[i] = 0u;
                if (tid < 16) ccnt[tid] = 0u;
                unsigned prefix = 0u; int shift = 21, shift_prev = 32, level = 0; bool collect = false;
#define KLOAD(dst, st_) do { const int W_ = wave + 8 * ((st_) >> 1), hf_ = (st_) & 1; _Pragma("unroll") for (int u_ = 0; u_ < 2; ++u_) _Pragma("unroll") for (int c2_ = 0; c2_ < 2; ++c2_) \
                    dst[u_][c2_] = *(const bf16x8*)(KI + ((size_t)b * SEQ + 64 * W_ + 32 * hf_ + 16 * u_ + r16) * 64 + c2_ * 32 + g4 * 8); } while (0)
                const int nmine = (nwords > wave) ? ((nwords - wave + 7) >> 3) : 0;
                for (int pass = 0; pass < 4; ++pass) {
                    if (!collect) { for (int i = tid; i < 16 * 1024; i += NTHR) hist[i] = 0u; if (tid < 4) flag[tid] = 0u; }
                    const unsigned bmask = (level == 2) ? 1023u : 2047u;
                    __syncthreads();
                    bf16x8 Kc[2][2], Kn[2][2];
                    if (nmine > 0) KLOAD(Kc, 0);
                    for (int st = 0; st < 2 * nmine; ++st) {
                        const int W = wave + 8 * (st >> 1), hf = st & 1;
                        if (st + 1 < 2 * nmine) KLOAD(Kn, st + 1);
                        unsigned braw = 0u;
#pragma unroll
                        for (int tu = 0; tu < 2; ++tu) {
                            f32x4 sc = (f32x4){0.f, 0.f, 0.f, 0.f};
#pragma unroll
                            for (int h = 0; h < 8; ++h) {
                                f32x4 t = __builtin_amdgcn_mfma_f32_16x16x32_bf16(Kc[tu][0], Qf[h][0], (f32x4){0.f, 0.f, 0.f, 0.f}, 0, 0, 0);
                                t = __builtin_amdgcn_mfma_f32_16x16x32_bf16(Kc[tu][1], Qf[h][1], t, 0, 0, 0);
#pragma unroll
                                for (int i = 0; i < 4; ++i) sc[i] += wq[h] * fmaxf(t[i], 0.f);
                            }
#pragma unroll
                            for (int i = 0; i < 4; ++i) {
                                const int kidx = 64 * W + 32 * hf + 16 * tu + 4 * g4 + i; const unsigned uu = __float_as_uint(sc[i] + 0.0f);
                                const unsigned key = (uu & 0x80000000u) ? ~uu : (uu | 0x80000000u);
                                if (kidx <= q) {
                                    if (!collect) {
                                        if (level == 0 || (key >> shift_prev) == (prefix >> shift_prev)) { const unsigned bin = (key >> shift) & bmask;
                                            __hip_atomic_fetch_add((unsigned*)(hist + r16 * 1024 + (bin >> 1)), 1u << (16 * (bin & 1u)), __ATOMIC_RELAXED, __HIP_MEMORY_SCOPE_WORKGROUP); }
                                    } else {
                                        const unsigned kb_ = key >> shift, pb_ = prefix >> shift;
                                        if (kb_ > pb_) braw |= 1u << (16 * tu + i);
                                        else if (kb_ == pb_) { const unsigned pos = __hip_atomic_fetch_add((unsigned*)(ccnt + r16), 1u, __ATOMIC_RELAXED, __HIP_MEMORY_SCOPE_WORKGROUP);
                                            if (pos < (unsigned)CAP) { clist[(r16 * CAP + pos) * 2] = key; clist[(r16 * CAP + pos) * 2 + 1] = (unsigned)kidx; } }
                                    }
                                }
                            }
                        }
                        if (collect) {
                            unsigned bits = braw << (4 * g4);
                            bits |= (unsigned)__builtin_amdgcn_ds_swizzle((int)bits, (16 << 10) | 0x1f);
                            { auto r0 = __builtin_amdgcn_permlane32_swap(bits, bits, false, false); bits = r0[0] | r0[1]; }
                            if (lane < 16) mtile[(lane * 64 + W) * 2 + hf] = bits;
                        }
#pragma unroll
                        for (int u = 0; u < 2; ++u) { Kc[u][0] = Kn[u][0]; Kc[u][1] = Kn[u][1]; }
                    }
                    __syncthreads();
                    if (collect) break;
                    {
                        const int row = tid >> 5, seg = tid & 31; const LAS unsigned* hr = hist + row * 1024 + seg * 32;
                        unsigned tot = 0u;
                        for (int j = 0; j < 32; ++j) { const unsigned w = hr[j]; tot += (w & 0xffffu) + (w >> 16); }
                        unsigned inc = tot;
#pragma unroll
                        for (int o = 1; o < 32; o <<= 1) { const unsigned t = lane_get(inc, (lane & 32) | ((seg + o) & 31)); if (seg + o < 32) inc += t; }
                        const unsigned exc = inc - tot, kk = (level == 0) ? 256u : rinfo[row * 4 + 1], pfx = (level == 0) ? 0u : rinfo[row * 4 + 0];
                        if (exc < kk && inc >= kk) {
                            unsigned cum = exc, bin = 0u, kn = kk, cb = 0u; bool done = false;
                            for (int j = 31; j >= 0 && !done; --j) { const unsigned w = hr[j]; const unsigned chi = w >> 16, clo = w & 0xffffu;
                                if (cum + chi >= kk) { bin = seg * 64 + 2 * j + 1; kn = kk - cum; cb = chi; done = true; }
                                else { cum += chi; if (cum + clo >= kk) { bin = seg * 64 + 2 * j; kn = kk - cum; cb = clo; done = true; } else cum += clo; } }
                            rinfo[row * 4 + 0] = pfx | (bin << shift); rinfo[row * 4 + 1] = kn; rinfo[row * 4 + 2] = cb;
                            if (cb > (unsigned)CAP && level < 2) __hip_atomic_fetch_or((unsigned*)flag, 1u, __ATOMIC_RELAXED, __HIP_MEMORY_SCOPE_WORKGROUP);
                        }
                    }
                    __syncthreads();
                    prefix = rinfo[r16 * 4 + 0];
                    const unsigned more = flag[0];
                    __syncthreads();
                    if (more) { shift_prev = shift; ++level; shift = (level == 1) ? 10 : 0; } else collect = true;
                }
#undef KLOAD
                for (int rr = 0; rr < 2; ++rr) {
                    const int row = wave * 2 + rr; unsigned cc = ccnt[row]; cc = cc > (unsigned)CAP ? (unsigned)CAP : cc; const int cn = (int)cc;
                    const LAS unsigned* cl = clist + row * CAP * 2;
                    unsigned pf = 0u; int kk = (int)rinfo[row * 4 + 1]; unsigned ties = 0u;
                    if (kk > cn) kk = cn;
                    if (kk > 0) {
                    for (int ps = 0; ps < 4; ++ps) {
                        const int sh = 24 - 8 * ps;
#pragma unroll
                        for (int j = 0; j < 4; ++j) whist[lane * 4 + j] = 0u;
                        WAVE_LDS_FENCE();
                        for (int i = lane; i < cn; i += 64) { const unsigned key = cl[i * 2];
                            const bool m = (ps == 0) || ((key >> (sh + 8)) == (pf >> (sh + 8)));
                            if (m) __hip_atomic_fetch_add((unsigned*)(whist + ((key >> sh) & 255u)), 1u, __ATOMIC_RELAXED, __HIP_MEMORY_SCOPE_WORKGROUP); }
                        WAVE_LDS_FENCE();
                        const unsigned c0 = whist[lane * 4 + 0], c1 = whist[lane * 4 + 1], c2 = whist[lane * 4 + 2], c3 = whist[lane * 4 + 3];
                        const unsigned sl = c0 + c1 + c2 + c3; unsigned inc = sl;
#pragma unroll
                        for (int o = 1; o < 64; o <<= 1) { const unsigned t = lane_get(inc, (lane + o) & 63); if (lane + o < 64) inc += t; }
                        const unsigned exc = inc - sl;
                        const bool found = (exc < (unsigned)kk) && (inc >= (unsigned)kk);
                        int bin = 0, kn = 0; unsigned cb = 0u;
                        { unsigned cum = exc;
                          if (cum + c3 >= (unsigned)kk) { bin = 3; kn = kk - (int)cum; cb = c3; } else { cum += c3;
                          if (cum + c2 >= (unsigned)kk) { bin = 2; kn = kk - (int)cum; cb = c2; } else { cum += c2;
                          if (cum + c1 >= (unsigned)kk) { bin = 1; kn = kk - (int)cum; cb = c1; } else { cum += c1; bin = 0; kn = kk - (int)cum; cb = c0; } } } }
                        const u64 fm = __ballot(found); const int src = fm ? (__ffsll((long long)fm) - 1) : 0;
                        bin = (int)lane_get((unsigned)(lane * 4 + bin), src); kk = (int)lane_get((unsigned)kn, src); ties = lane_get(cb, src);
                        pf |= ((unsigned)bin) << sh;
                        WAVE_LDS_FENCE();
                    }
                    unsigned cut = 0xFFFFFFFFu;
                    if (ties > (unsigned)kk) {
                        for (int i = lane; i < cn; i += 64) { if (cl[i * 2] == pf) { const unsigned myi = cl[i * 2 + 1]; int rank = 0;
                                for (int j = 0; j < cn; ++j) rank += (cl[j * 2] == pf && cl[j * 2 + 1] < myi) ? 1 : 0;
                                if (rank == kk - 1) rsel[row * 2 + 1] = myi; } }
                        WAVE_LDS_FENCE();
                        cut = rsel[row * 2 + 1];
                    }
                    for (int i = lane; i < cn; i += 64) { const unsigned key = cl[i * 2], kidx = cl[i * 2 + 1];
                        if (key > pf || (key == pf && kidx <= cut)) __hip_atomic_fetch_or((unsigned*)(mtile + (row * 64 + (kidx >> 6)) * 2 + ((kidx >> 5) & 1u)), 1u << (kidx & 31u), __ATOMIC_RELAXED, __HIP_MEMORY_SCOPE_WORKGROUP); }
                    }
                }
                __syncthreads();
                for (int i = tid; i < 16 * nwords; i += NTHR) { const int r = i & 15, W = i >> 4;
                    MASK[((size_t)b * 64 + W) * SEQ + q0 + r] = (u64)mtile[(r * 64 + W) * 2] | ((u64)mtile[(r * 64 + W) * 2 + 1] << 32); }
                __syncthreads();
            }
        }
        if (BOTH(2)) GRID_BAR();
    }

    if (IN(3)) { asm volatile("; PHASE_MARK 3"); PHASE_BEGIN
        const int vcu = (G % 8 == 0) ? (bid % 8) * (G / 8) + bid / 8 : bid;
        if (vcu < 256) {
            const int pp = vcu & 3, h = (vcu >> 2) & 7, b = vcu >> 5;
            { float* tb = (float*)(lds_raw + dsa::LDS_TB);
              for (int i = tid; i < dsa::TB_PAD + 4096; i += NTHR) tb[i] = (i >= dsa::TB_PAD) ? BIAST[h * 4096 + (i - dsa::TB_PAD)] * 8.0f : 0.f; }
            const bf16_t* Kp = K0 + (size_t)b * SEQ * 512 + h * 64; const bf16_t* Vp = V0 + (size_t)b * SEQ * 512 + h * 64;
#define DSA_REF(R, i_) do { const int qb_ = ((i_) == 0) ? pp : ((i_) == 1) ? 15 - pp : ((i_) == 2) ? pp + 4 : 11 - pp; const int P0_ = qb_ * 256; \
            R.Q = Q0 + ((size_t)b * SEQ + P0_) * 512 + h * 64; R.K = Kp; R.V = Vp; R.O = MIXIN + ((size_t)b * SEQ + P0_) * DM + 512 + h * 64; \
            R.MW = MASK + (size_t)b * 64 * SEQ + P0_; R.P0 = P0_; } while (0)
            dsa::Seam SS; dsa::BlockRef cur, nxt; DSA_REF(cur, 0);
            dsa::dsa_prime(cur, (char*)lds_raw, SS, tid);
            for (int i = 0; i < 4; ++i) {
                if (i < 3) { DSA_REF(nxt, i + 1); } else nxt = cur;
                dsa::dsa_block(cur, nxt, (char*)lds_raw, SS, tid);
                cur = nxt;
            }
#undef DSA_REF
        }
        if (BOTH(3)) GRID_BAR();
    }
    if (IN(4)) { asm volatile("; PHASE_MARK 4"); PHASE_BEGIN
        pg8::StaticOrder S; S.init(MIXIN, NTOK, DM, DM, G, bid);
        pg8::EpiRes E{(bf16_t*)outp, XB};
        pg8::gemm_phase<pg8::EpiRes, pg8::StaticOrder, true, false>(tid, lds, WOUT0, DM, S, E, GTAB);
        if (BOTH(4)) GRID_BAR();
    }
    if (IN(5)) { asm volatile("; PHASE_MARK 5"); PHASE_BEGIN
        for (int m = gw; m < NTOK; m += NGW) { f32x4 v[4];
#pragma unroll
            for (int j = 0; j < 4; ++j) v[j] = ld_bf4((const bf16_t*)outp + (size_t)m * DM + 4 * lane + 256 * j);
            ln_core(v, args.in[I_ELN1G], args.in[I_ELN1B], lane); store_row_bf16(X1B + (size_t)m * DM, v, lane); }
        if (BOTH(5)) GRID_BAR();
    }
    if (IN(6)) { asm volatile("; PHASE_MARK 6"); PHASE_BEGIN
        pg8::StaticOrder S; S.init(X1B, NTOK, 2 * FF0, DM, G, bid);
        pg8::EpiSwiglu<false> E{H0, FF0, (char*)outp, (char*)ws};
        pg8::gemm_phase<pg8::EpiSwiglu<false>, pg8::StaticOrder, true, false>(tid, lds, WGU0, DM, S, E, GTAB);
        if (BOTH(6)) GRID_BAR();
    }
    if (IN(7)) { asm volatile("; PHASE_MARK 7"); PHASE_BEGIN
        pg8::StaticOrder S; S.init(H0, NTOK, DM, FF0, G, bid);
        pg8::EpiRes E{(bf16_t*)outp, X1B};
        pg8::gemm_phase<pg8::EpiRes, pg8::StaticOrder, true, false>(tid, lds, WD0, FF0, S, E, GTAB);
        if (BOTH(7)) GRID_BAR();
    }
    if (IN(8)) { asm volatile("; PHASE_MARK 8"); PHASE_BEGIN
        for (int m = gw; m < NTOK; m += NGW) { f32x4 v[4];
#pragma unroll
            for (int j = 0; j < 4; ++j) v[j] = ld_bf4((const bf16_t*)outp + (size_t)m * DM + 4 * lane + 256 * j);
            ln_core(v, args.in[I_ELN2G], args.in[I_ELN2B], lane); store_row_bf16(X2B + (size_t)m * DM, v, lane); }
        if (BOTH(8)) GRID_BAR();
    }
#define MERGE_CHUNK(chm) do { \
        const bf16_t* OPp = (const bf16_t*)(ws + WS_OP); const float* LSEp = (const float*)(ws + WS_LSE); \
        for (int tl = gw; tl < CHUNK_T; tl += NGW) { const int hh = lane >> 3; \
            const float l0 = LSEp[(size_t)tl * 8 + hh], l1 = LSEp[((size_t)CHUNK_T + tl) * 8 + hh], l2 = LSEp[((size_t)2 * CHUNK_T + tl) * 8 + hh]; \
            const float mm = fmaxf(l0, fmaxf(l1, l2)); float w0 = __expf(l0 - mm), w1 = __expf(l1 - mm), w2 = __expf(l2 - mm); const float inv = 1.f / (w0 + w1 + w2); w0 *= inv; w1 *= inv; w2 *= inv; \
            const bf16_t* p0 = OPp + (size_t)tl * DM + lane * 16; const bf16_t* p1 = p0 + (size_t)CHUNK_T * DM; const bf16_t* p2 = p1 + (size_t)CHUNK_T * DM; \
            _Pragma("unroll") for (int q = 0; q < 2; ++q) { const u32x4 a = *(const u32x4*)(p0 + q * 8), b = *(const u32x4*)(p1 + q * 8), c = *(const u32x4*)(p2 + q * 8); u32x4 o; \
                o.x = cvt_pk_bf16(w0 * bf_lo(a.x) + w1 * bf_lo(b.x) + w2 * bf_lo(c.x), w0 * bf_hi(a.x) + w1 * bf_hi(b.x) + w2 * bf_hi(c.x)); \
                o.y = cvt_pk_bf16(w0 * bf_lo(a.y) + w1 * bf_lo(b.y) + w2 * bf_lo(c.y), w0 * bf_hi(a.y) + w1 * bf_hi(b.y) + w2 * bf_hi(c.y)); \
                o.z = cvt_pk_bf16(w0 * bf_lo(a.z) + w1 * bf_lo(b.z) + w2 * bf_lo(c.z), w0 * bf_hi(a.z) + w1 * bf_hi(b.z) + w2 * bf_hi(c.z)); \
                o.w = cvt_pk_bf16(w0 * bf_lo(a.w) + w1 * bf_lo(b.w) + w2 * bf_lo(c.w), w0 * bf_hi(a.w) + w1 * bf_hi(b.w) + w2 * bf_hi(c.w)); \
                *(u32x4*)(O1 + ((size_t)(chm) * CHUNK_T + tl) * DM + lane * 16 + q * 8) = o; } } } while (0)
#pragma unroll
    for (int ch = 0; ch < 2; ++ch) {
        if (IN(9 + 2 * ch)) { asm volatile("; PHASE_MARK 9"); PHASE_BEGIN
            if (ch == 1) { MERGE_CHUNK(0); }
            pg8::StaticOrder S; S.init(X2B + (size_t)ch * CHUNK_T * DM, CHUNK_T, IN1_N, DM, G, bid);
            pg8::EpiQkv1 E{H1, IN1_N, 1.0f};
            pg8::gemm_phase<pg8::EpiQkv1, pg8::StaticOrder, true, false>(tid, lds, WIN1, DM, S, E, GTAB);
            if (BOTH(9 + 2 * ch)) GRID_BAR();
        }
        if (IN(10 + 2 * ch)) { asm volatile("; PHASE_MARK 10"); PHASE_BEGIN
            constexpr int NU = CHUNK_B * 8 * 3 * 16;
            const int vcu = (G % 8 == 0) ? (bid % 8) * (G / 8) + bid / 8 : bid;
            bf16_t* OPp = (bf16_t*)(ws + WS_OP); float* LSEp = (float*)(ws + WS_LSE);
            int L0 = vcu;
            if (L0 < NU) {
                swa::Seam SS; swa::BlockRef cur = dil_ref(L0, H1, OPp, LSEp);
                swa::swa_prime(cur, BIAST, (char*)lds_raw, SS, tid);
                int slot = 0;
                for (;;) {
                    const int Ln = L0 + G; const bool last = Ln >= NU;
                    const swa::BlockRef nxt = last ? cur : dil_ref(Ln, H1, OPp, LSEp);
                    swa::swa_block(cur, nxt, BIAST, slot, (char*)lds_raw, SS, tid);
                    if (last) break;
                    cur = nxt; L0 = Ln; slot ^= 1;
                }
            }
            if (BOTH(10 + 2 * ch)) GRID_BAR();
        }
    }
    if (IN(13)) { asm volatile("; PHASE_MARK 13"); PHASE_BEGIN
        MERGE_CHUNK(1);
        if (BOTH(13)) GRID_BAR();
    }
    if (IN(14)) { asm volatile("; PHASE_MARK 14"); PHASE_BEGIN
        pg8::StaticOrder S; S.init(O1, NTOK, DM, DM, G, bid);
        pg8::EpiRes E{(bf16_t*)Y3, X2B};
        pg8::gemm_phase<pg8::EpiRes, pg8::StaticOrder, true, false>(tid, lds, WOUT1, DM, S, E, GTAB);
        if (BOTH(14)) GRID_BAR();
    }
    if (IN(15)) { asm volatile("; PHASE_MARK 15"); PHASE_BEGIN
        const float* rt = args.in[I_ROUTER];
        LAS unsigned* lcnt = (LAS unsigned*)lds;
        LAS unsigned* lbase = lcnt + 8;
        LAS int* lrow = (LAS int*)(lds + 256);
        LAS float* lgate = (LAS float*)(lds + 256 + 16384);
        if (tid < 8) lcnt[tid] = 0u;
        __syncthreads();
        int nloc = 0;
        for (int m = gw; m < NTOK; m += NGW, ++nloc) { f32x4 v[4];
#pragma unroll
            for (int j = 0; j < 4; ++j) v[j] = ld_bf4((const bf16_t*)Y3 + (size_t)m * DM + 4 * lane + 256 * j);
            ln_core(v, args.in[I_OLN1G], args.in[I_OLN1B], lane); store_row_bf16(X3B + (size_t)m * DM, v, lane);
            float lgt[8];
#pragma unroll
            for (int e = 0; e < 8; ++e) lgt[e] = 0.f;
#pragma unroll
            for (int j = 0; j < 4; ++j)
#pragma unroll
                for (int i = 0; i < 4; ++i) { const float* rr = rt + (size_t)(4 * lane + 256 * j + i) * 8; const f32x4 r0 = *(const f32x4*)rr, r1 = *(const f32x4*)(rr + 4); const float xv = v[j][i];
                    lgt[0] += xv * r0[0]; lgt[1] += xv * r0[1]; lgt[2] += xv * r0[2]; lgt[3] += xv * r0[3]; lgt[4] += xv * r1[0]; lgt[5] += xv * r1[1]; lgt[6] += xv * r1[2]; lgt[7] += xv * r1[3]; }
#pragma unroll
            for (int e = 0; e < 8; ++e) lgt[e] = wave_sum(lgt[e]);
            int e1 = 0; float v1 = lgt[0];
#pragma unroll
            for (int e = 1; e < 8; ++e) if (lgt[e] > v1) { v1 = lgt[e]; e1 = e; }
            int e2 = -1; float v2 = -INFINITY;
#pragma unroll
            for (int e = 0; e < 8; ++e) if (e != e1 && lgt[e] > v2) { v2 = lgt[e]; e2 = e; }
            const float g2 = 1.f / (1.f + __expf(v1 - v2)), g1 = 1.f - g2;
            if (lane == 0) { const int li = nloc * NWAVES + wave;
                const unsigned r1 = __hip_atomic_fetch_add((unsigned*)(lcnt + e1), 1u, __ATOMIC_RELAXED, __HIP_MEMORY_SCOPE_WORKGROUP), r2 = __hip_atomic_fetch_add((unsigned*)(lcnt + e2), 1u, __ATOMIC_RELAXED, __HIP_MEMORY_SCOPE_WORKGROUP);
                lrow[li * 4 + 0] = e1; lrow[li * 4 + 1] = (int)r1; lrow[li * 4 + 2] = e2; lrow[li * 4 + 3] = (int)r2; lgate[li * 2] = g1; lgate[li * 2 + 1] = g2; }
        }
        __syncthreads();
        if (tid < 8) lbase[tid] = atomicAdd(ctl + CW_MOECNT + tid, lcnt[tid]);
        __syncthreads();
        { const int nrows = (NTOK - bid * NWAVES + NGW - 1) / NGW;
          for (int li = tid; li < nrows * NWAVES; li += NTHR) { const int rnd = li / NWAVES, wv = li % NWAVES; const int m = (bid * NWAVES + wv) + rnd * NGW;
            if (m < NTOK) { const int e1 = lrow[li * 4 + 0], e2 = lrow[li * 4 + 2]; const unsigned p1 = lbase[e1] + (unsigned)lrow[li * 4 + 1], p2 = lbase[e2] + (unsigned)lrow[li * 4 + 3];
                if (p1 < (unsigned)NTOK) { MTOK[e1 * NTOK + p1] = m * 2; MGATE[e1 * NTOK + p1] = lgate[li * 2]; }
                if (p2 < (unsigned)NTOK) { MTOK[e2 * NTOK + p2] = m * 2 + 1; MGATE[e2 * NTOK + p2] = lgate[li * 2 + 1]; } } } }
        __syncthreads();
        {
            LAS float* scr = (LAS float*)(lds + wave * 16384);
            constexpr int I_GU = 16 * (2 * FFE / 32), I_D = (FFE / 64) * 32;
            for (int it = gw; it < NEXP * (I_GU + I_D); it += NGW) {
                const int e = it / (I_GU + I_D), r = it % (I_GU + I_D);
                if (r < I_GU) gu_item(args.in[I_MWG] + (size_t)e * DM * FFE, args.in[I_MWU] + (size_t)e * DM * FFE, FFE, DM, MWGU + (size_t)e * 2 * FFE * DM, r, scr, lane);
                else plain_item(args.in[I_MWD] + (size_t)e * FFE * DM, FFE, DM, MWD + (size_t)e * DM * FFE, r - I_GU, scr, lane);
            }
        }
        if (BOTH(15)) GRID_BAR();
    }
#pragma unroll
    for (int ch = 0; ch < 2; ++ch) {
        if (IN(16 + 2 * ch) || IN(17 + 2 * ch)) {
            LAS int* rt = (LAS int*)(lds + LDS_RT);
            int nM;
            { PHASE_BEGIN int ts[9]; int cn[8]; ts[0] = 0;
#pragma unroll
              for (int e = 0; e < 8; ++e) { int ce = __builtin_amdgcn_readfirstlane((int)ctl[CW_MOECNT + e]); ce = ce > NTOK ? NTOK : ce; cn[e] = ce; ts[e + 1] = ts[e] + (ce + 255) / 256; }
              const int t0 = ch * MOE_CH_TILES; int t1 = (ch == 0) ? MOE_CH_TILES : ts[8]; if (t1 > ts[8]) t1 = ts[8]; if (t1 > t0 + 136) t1 = t0 + 136; nM = __builtin_amdgcn_readfirstlane(t1 > t0 ? t1 - t0 : 0);
              if (tid < nM) { const int g = t0 + tid; int e = 0;
#pragma unroll
                  for (int k = 1; k < 8; ++k) e += (g >= ts[k]) ? 1 : 0;
                  int ce = cn[0], tse = ts[0];
#pragma unroll
                  for (int k = 1; k < 8; ++k) { ce = (e == k) ? cn[k] : ce; tse = (e == k) ? ts[k] : tse; }
                  const int j = g - tse; int nv = ce - j * 256; nv = nv > 256 ? 256 : nv;
                  rt[tid * 4 + 0] = e; rt[tid * 4 + 1] = e * NTOK + j * 256; rt[tid * 4 + 2] = nv; rt[tid * 4 + 3] = 0; } }
            __syncthreads();
            if (IN(16 + 2 * ch)) { asm volatile("; PHASE_MARK 16"); PHASE_BEGIN
                pg8::MoeOrder S{G, bid, nM, 2 * FFE / 256, rt, (const char*)X3B, (char*)outp, (char*)ws, true};
                LAS int* gtab = (LAS int*)(lds + LDS_GTAB);
                { pg8::Unit u; for (int i = 0; i < 16 && S.next(i, u); ++i) { if (tid < 256) { const int lb = rt[u.pm * 4 + 1], nv = rt[u.pm * 4 + 2]; const int r = tid < nv ? tid : 0; gtab[i * 256 + tid] = MTOK[lb + r] >> 1; } } }
                __syncthreads();
                pg8::EpiSwiglu<true> E{H0, FFE, (char*)outp, (char*)ws};
                pg8::gemm_phase<pg8::EpiSwiglu<true>, pg8::MoeOrder, true, true>(tid, lds, MWGU, DM, S, E, gtab);
                if (BOTH(16 + 2 * ch)) GRID_BAR();
            }
            if (IN(17 + 2 * ch)) { asm volatile("; PHASE_MARK 17"); PHASE_BEGIN
                pg8::MoeOrder S{G, bid, nM, DM / 256, rt, (const char*)X3B, (char*)outp, (char*)ws, false};
                pg8::EpiMoeDown E{YB, MTOK, MGATE, rt};
                pg8::gemm_phase<pg8::EpiMoeDown, pg8::MoeOrder, true, false>(tid, lds, MWD, FFE, S, E, GTAB);
                if (BOTH(17 + 2 * ch)) GRID_BAR();
            }
        }
    }
    if (IN(20)) { asm volatile("; PHASE_MARK 20"); PHASE_BEGIN
        for (int m = gw; m < NTOK; m += NGW) { f32x4 v[4];
#pragma unroll
            for (int j = 0; j < 4; ++j) { const size_t o = (size_t)m * DM + 4 * lane + 256 * j; v[j] = ld_bf4(X3B + o) * ALPHA + ld_bf4(YB + o) + ld_bf4(YB + (size_t)NTOK * DM + o); }
            ln_core(v, args.in[I_OLN2G], args.in[I_OLN2B], lane);
#pragma unroll
            for (int j = 0; j < 4; ++j) *(f32x4*)(outp + (size_t)m * DM + 4 * lane + 256 * j) = v[j]; }
    }
#undef IN
#undef BOTH
}

constexpr int NPHASES = 21;
extern "C" void kernel_launch(void* const* d_in, const int* in_sizes, int n_in, void* d_out, int out_size, void* d_ws, size_t ws_size, hipStream_t stream) {
    static int grid = 0;
    if (grid == 0) {
        if (n_in != 25 || out_size != NTOK * DM || ws_size < WS_END) { fprintf(stderr, "kernel_launch: unexpected shapes (n_in %d out %d ws %zu)\n", n_in, out_size, ws_size); grid = -1; return; }
        int dev = 0, cus = 0;
        if (hipGetDevice(&dev) != hipSuccess || hipDeviceGetAttribute(&cus, hipDeviceAttributeMultiprocessorCount, dev) != hipSuccess) { grid = -1; return; }
        if (hipFuncSetAttribute((const void*)fwd_kernel, hipFuncAttributeMaxDynamicSharedMemorySize, LDS_BYTES) != hipSuccess) { fprintf(stderr, "kernel_launch: hipFuncSetAttribute failed\n"); grid = -1; return; }
        int per_cu = 0;
        if (hipOccupancyMaxActiveBlocksPerMultiprocessor(&per_cu, (const void*)fwd_kernel, NTHR, LDS_BYTES) != hipSuccess || per_cu < 1) { fprintf(stderr, "kernel_launch: occupancy query says %d\n", per_cu); }
        (void)hipGetLastError();
        grid = cus;
    }
    if (grid < 0) return;
    (void)hipMemsetAsync((char*)d_ws + WS_CTL, 0, CTL_ZERO_BYTES, stream);
    Args a{};
    for (int i = 0; i < 25; ++i) a.in[i] = (const float*)d_in[i];
    a.out = (float*)d_out; a.ws = (unsigned char*)d_ws;
#if ONE_LAUNCH
    a.ph_lo = 0; a.ph_hi = NPHASES;
    hipLaunchKernelGGL(fwd_kernel, dim3(grid), dim3(NTHR), LDS_BYTES, stream, a);
#else
    for (int ph = 0; ph < NPHASES; ++ph) { a.ph_lo = ph; a.ph_hi = ph + 1; for (int rep = 0; rep < (((DUP_MASK) >> ph) & 1u ? 2 : 1); ++rep) hipLaunchKernelGGL(fwd_kernel, dim3(grid), dim3(NTHR), LDS_BYTES, stream, a); }
#endif
}
```

```cpp
#include <hip/hip_runtime.h>
#include <cstdio>
#include <cstdint>

#ifndef ONE_LAUNCH
#define ONE_LAUNCH 1
#endif
#ifndef DUP_MASK
#define DUP_MASK 0u
#endif

#define LAS __attribute__((address_space(3)))
typedef unsigned short bf16_t;
typedef short bf16x8 __attribute__((ext_vector_type(8)));
typedef float f32x4 __attribute__((ext_vector_type(4)));
typedef float f32x2 __attribute__((ext_vector_type(2)));
typedef unsigned u32x4 __attribute__((ext_vector_type(4)));
typedef unsigned u32x2 __attribute__((ext_vector_type(2)));
typedef unsigned long long u64;

constexpr int NB = 8, SEQ = 4096, DM = 1024, NTOK = NB * SEQ;
constexpr int IN0_SRC = 3144, IN0_N = 3328;
constexpr int FF0 = 2816, FFE = 3584, NEXP = 8;
constexpr int IN1_N = 9216;
constexpr int CHUNK_B = 4, CHUNK_T = CHUNK_B * SEQ;
constexpr int MOE_CH_TILES = 128;
constexpr int HM_DOUT_TILES = 73;
constexpr float ALPHA = 1.4142135623730951f;
constexpr float LN_EPS = 1e-5f;
constexpr int NWAVES = 8, NTHR = 512;

constexpr size_t MiB = 1u << 20;
constexpr size_t WS_CTL = 0, CTL_ZERO_BYTES = 64 * 1024;
constexpr size_t WS_BIAST = 1 * MiB;
constexpr size_t WS_MOE_TOK = 2 * MiB;
constexpr size_t WS_MOE_GATE = 3 * MiB;
constexpr size_t WS_WIN0 = 4 * MiB;
constexpr size_t WS_WOUT0 = 11 * MiB;
constexpr size_t WS_WGU0 = 13 * MiB;
constexpr size_t WS_WD0 = 24 * MiB;
constexpr size_t WS_WIN1 = 30 * MiB;
constexpr size_t WS_WOUT1 = 48 * MiB;
constexpr size_t WS_XB = 50 * MiB;
constexpr size_t WS_U = 114 * MiB;
constexpr size_t WS_Q0 = 146 * MiB, SEG0 = 32 * MiB;
constexpr size_t WS_KI = 274 * MiB;
constexpr size_t WS_WI = 278 * MiB;
constexpr size_t WS_MASK = 280 * MiB;
constexpr size_t WS_MIXIN = 296 * MiB;
constexpr size_t WS_X1B = 50 * MiB;
constexpr size_t WS_H0 = 114 * MiB;
constexpr size_t WS_X2B = 448 * MiB;
constexpr size_t WS_H1 = 50 * MiB;
constexpr size_t WS_OP = 338 * MiB;
constexpr size_t WS_LSE = 434 * MiB;
constexpr size_t WS_Y3 = 216 * MiB;
constexpr size_t WS_X3B = 152 * MiB;
constexpr size_t WS_YB = 216 * MiB;
constexpr size_t WS_MWGU = 344 * MiB;
constexpr size_t WS_MWD = 456 * MiB;
constexpr size_t WS_HM = 4 * MiB;
constexpr size_t WS_END = 512 * MiB;
constexpr size_t HM_TILE_BYTES = (size_t)256 * FFE * 2;
constexpr int CW_MOECNT = 64;
constexpr int CW_BAR = 1024;

constexpr int LDS_GTAB = 131072;
constexpr int LDS_RT = 147456;
constexpr int LDS_MISC = 155648 + 2048;
constexpr int LDS_BYTES = 159744;

__device__ __forceinline__ unsigned cvt_pk_bf16(float lo, float hi) { unsigned r; asm volatile("v_cvt_pk_bf16_f32 %0, %1, %2" : "=v"(r) : "v"(lo), "v"(hi)); return r; }
__device__ __forceinline__ float bf_lo(unsigned w) { return __uint_as_float(w << 16); }
__device__ __forceinline__ float bf_hi(unsigned w) { return __uint_as_float(w & 0xffff0000u); }
__device__ __forceinline__ float bf2f(bf16_t b) { return __uint_as_float(((unsigned)b) << 16); }
template <int M> __device__ __forceinline__ float swz_xor(float v) {
    return __int_as_float(__builtin_amdgcn_ds_swizzle(__float_as_int(v), (M << 10) | 0x1f)); }
__device__ __forceinline__ float wave_sum(float v) {
    v += swz_xor<1>(v); v += swz_xor<2>(v); v += swz_xor<4>(v); v += swz_xor<8>(v); v += swz_xor<16>(v);
    auto rr = __builtin_amdgcn_permlane32_swap(__float_as_uint(v), __float_as_uint(v), false, false);
    return __uint_as_float(rr[0]) + __uint_as_float(rr[1]);
}
__device__ __forceinline__ float wave_max(float v) {
    v = fmaxf(v, swz_xor<1>(v)); v = fmaxf(v, swz_xor<2>(v)); v = fmaxf(v, swz_xor<4>(v)); v = fmaxf(v, swz_xor<8>(v)); v = fmaxf(v, swz_xor<16>(v));
    auto rr = __builtin_amdgcn_permlane32_swap(__float_as_uint(v), __float_as_uint(v), false, false);
    return fmaxf(__uint_as_float(rr[0]), __uint_as_float(rr[1]));
}
__device__ __forceinline__ unsigned lane_get(unsigned v, int src_lane) { return (unsigned)__builtin_amdgcn_ds_bpermute(src_lane << 2, (int)v); }
__device__ __forceinline__ float sigmoidf_(float x) { return __builtin_amdgcn_rcpf(1.0f + __expf(-x)); }
#define WAVE_LDS_FENCE() do { asm volatile("s_waitcnt lgkmcnt(0)" ::: "memory"); __builtin_amdgcn_wave_barrier(); } while (0)

#define XB_TMO      128
#define XB_XCNT(j)  (256  + 64 * (j))
#define XB_XSUB(j)  (1280 + 64 * (j))
#define XB_XGEN(j)  (2304 + 64 * (j))
#define XB_TOP      3328
#define XB_TOPGEN   3392
#define XCD_BAR_WORDS 3456
#define XB_SPIN_CAP (1u << 18)
__device__ __forceinline__ unsigned xb_ld(unsigned* p)              { return __hip_atomic_load(p, __ATOMIC_RELAXED, __HIP_MEMORY_SCOPE_AGENT); }
__device__ __forceinline__ unsigned xb_add(unsigned* p, unsigned v) { return __hip_atomic_fetch_add(p, v, __ATOMIC_RELAXED, __HIP_MEMORY_SCOPE_AGENT); }
__device__ __forceinline__ unsigned xb_xcc_id() { return (unsigned)__builtin_amdgcn_s_getreg((3 << 11) | 20) & 0xFu; }
#define XB_SPIN(cond, bar) do { unsigned _sp = 0; while (cond) { __builtin_amdgcn_s_sleep(1); \
    if ((++_sp & 255u) == 0u) { if (xb_ld(&(bar)[XB_TMO])) break; if (_sp > XB_SPIN_CAP) { atomicAdd(&(bar)[XB_TMO], 1u); break; } } } } while (0)
struct XcdBarrier { unsigned* bar; unsigned x; volatile LAS unsigned* st; };
__device__ __forceinline__ XcdBarrier xcd_barrier_post(unsigned* bar, volatile LAS unsigned* st, bool leader) {
    XcdBarrier b; b.bar = bar; b.x = xb_xcc_id(); b.st = st;
    if (leader) (void)xb_add(&bar[XB_XCNT(b.x)], 1u);
    return b;
}
__device__ __forceinline__ void xcd_barrier_complete(unsigned* bar, unsigned x, unsigned& nloc, unsigned& nx) {
    const unsigned G = gridDim.x * gridDim.y * gridDim.z;
    unsigned sum, cnt, mine, sp = 0u;
    for (;;) {
        sum = 0u; cnt = 0u; mine = 0u;
#pragma unroll
        for (unsigned j = 0; j < 16; ++j) { const unsigned c = xb_ld(&bar[XB_XCNT(j)]); sum += c; cnt += (c > 0u) ? 1u : 0u; mine = (j == x) ? c : mine; }
        if (sum == G) break;
        __builtin_amdgcn_s_sleep(1);
        if ((++sp & 255u) == 0u) { if (xb_ld(&bar[XB_TMO])) break; if (sp > XB_SPIN_CAP) { atomicAdd(&bar[XB_TMO], 1u); break; } }
    }
    nloc = mine > 0u ? mine : 1u; nx = cnt > 0u ? cnt : 1u;
}
__device__ __forceinline__ void xcd_barrier(const XcdBarrier& b, bool leader) {
    asm volatile("s_waitcnt vmcnt(0)" ::: "memory");
    __syncthreads();
    if (leader) {
        unsigned* bar = b.bar;
        __builtin_amdgcn_s_waitcnt(0);
        unsigned nloc = b.st[0], nx = b.st[1];
        if (nloc == 0u) { xcd_barrier_complete(bar, b.x, nloc, nx); b.st[0] = nloc; b.st[1] = nx; }
        const unsigned old = xb_add(&bar[XB_XSUB(b.x)], 1u);
        const unsigned gen = old / nloc;
        if (old + 1u == (gen + 1u) * nloc) {
            __builtin_amdgcn_fence(__ATOMIC_RELEASE, "agent");
            asm volatile("s_waitcnt vmcnt(0)" ::: "memory");
            const unsigned og = xb_add(&bar[XB_TOP], 1u);
            const unsigned tg = og / nx;
            if (og + 1u == (tg + 1u) * nx) xb_add(&bar[XB_TOPGEN], 1u);
            else XB_SPIN(xb_ld(&bar[XB_TOPGEN]) == tg, bar);
            __builtin_amdgcn_fence(__ATOMIC_ACQUIRE, "agent");
            xb_add(&bar[XB_XGEN(b.x)], 1u);
            asm volatile("s_waitcnt vmcnt(0)" ::: "memory");
        } else {
            XB_SPIN(xb_ld(&bar[XB_XGEN(b.x)]) == gen, bar);
            __builtin_amdgcn_fence(__ATOMIC_ACQUIRE, "agent");
            asm volatile("s_waitcnt vmcnt(0)" ::: "memory");
        }
    }
    __syncthreads();
}

namespace pg8 {
constexpr int BM = 256, BK = 64, HALF = 128, HTB = HALF * BK * 2, STAGE_BYTES = 8 * HTB, NXCD = 8, WGM = 8;
__host__ __device__ __forceinline__ int lds_byte(int r, int c) { const int st = (r >> 4) * 2 + (c >> 5), rr = r & 15, cc = c & 31, ob = rr * 64 + cc * 2; return st * 1024 + (ob ^ (((ob >> 9) & 1) << 5)); }
__host__ __device__ __forceinline__ void stage_rc(int b, int& R, int& C) { const int st = b / 1024, sb = b % 1024, swz = sb ^ (((sb >> 9) & 1) << 5); R = (st >> 1) * 16 + swz / 64; C = (st & 1) * 32 + (swz % 64) / 2; }
__host__ __device__ __forceinline__ int perm32(int rho) { const int n = rho >> 4, i = rho & 15; return 8 * (i >> 2) + 4 * n + (i & 3); }

struct Unit { int pm, pn; };

__device__ __forceinline__ void remap_unit(int wgid, int nM, int nN, int& pm, int& pn) {
    const int nwg = nM * nN;
    { const int q = nwg / NXCD, r = nwg % NXCD, xcd = wgid % NXCD, off = wgid / NXCD; wgid = (xcd < r ? xcd * (q + 1) : r * (q + 1) + (xcd - r) * q) + off; }
    const int nig = WGM * nN, gid = wgid / nig, fm = gid * WGM, gsz = (nM - fm) < WGM ? (nM - fm) : WGM;
    pm = fm + ((wgid % nig) % gsz); pn = (wgid % nig) / gsz;
}
struct StaticOrder {
    int nM, nN, nwg, G, c; const char* A; size_t tstepA;
    __device__ void init(const bf16_t* A_, int M, int N, int K, int G_, int c_) { nM = M / BM; nN = N / BM; nwg = nM * nN; G = G_; c = c_; A = (const char*)A_; tstepA = (size_t)BM * K * 2; }
    __device__ __forceinline__ bool next(int i, Unit& u) const {
        const long L = (long)i * G + c; if (L >= nwg) return false;
        remap_unit((int)L, nM, nN, u.pm, u.pn); return true;
    }
    __device__ __forceinline__ const char* a_ptr(const Unit& u) const { return A + (size_t)u.pm * tstepA; }
    __device__ __forceinline__ int b_tile(const Unit& u) const { return u.pn; }
};

#define PG8_LAS __attribute__((address_space(3)))
template <class Epi, class Sched, bool ALIGN_EPI, bool GATHER>
__device__ __forceinline__ void gemm_phase(const int tid, PG8_LAS unsigned char* lds, const bf16_t* Btp, const int K, const Sched& S, const Epi& E, const PG8_LAS int* gtab) {
    const int wid = __builtin_amdgcn_readfirstlane(tid >> 6), lane = tid & 63, wr = wid >> 2, wc = wid & 3, fr = lane & 15, fq = lane >> 4;
    const int nt = K / BK;
    unsigned voffA[2], voffB[2];
#pragma unroll
    for (int i = 0; i < 2; ++i) { int R, C; stage_rc(tid * 16 + i * 8192, R, C); const int Rb = Epi::PERM ? ((R & ~31) + perm32(R & 31)) : R;
        voffA[i] = (unsigned)(R * K + C) * 2u; voffB[i] = (unsigned)(Rb * K + C) * 2u; }
    const size_t kstep = (size_t)(BK * 2);
    const size_t hstep = (size_t)HALF * K * 2;
    const size_t tstep = 2 * hstep;
    const unsigned ldsw = (unsigned)wid * 1024u;
    const int aoff = lds_byte(wr * 64 + fr, fq * 8), boff = lds_byte(wc * 32 + fr, fq * 8);
#define PG8_SA(b, h) (((b) * 2 + (h)) * HTB)
#define PG8_SB(b, h) ((4 + (b) * 2 + (h)) * HTB)
#define PG8_STAGE(bufoff, gbase, voff) do { _Pragma("unroll") for (int _i = 0; _i < 2; ++_i) \
        __builtin_amdgcn_global_load_lds((const unsigned*)((const char*)(gbase) + (voff)[_i]), (PG8_LAS unsigned*)(lds + (bufoff) + ldsw + _i * 8192), 16, 0, 0); } while (0)
#define PG8_STAGE_AC(bufoff, kt, h) do { if constexpr (GATHER) { PG8_STAGE(bufoff, cA + (size_t)(kt) * kstep, gcur[h]); } else { PG8_STAGE(bufoff, cA + (size_t)(kt) * kstep + (h) * hstep, voffA); } } while (0)
#define PG8_STAGE_AN(bufoff, d, h) do { if constexpr (GATHER) { if (last) { unsigned _g[2]; _Pragma("unroll") for (int _i = 0; _i < 2; ++_i) { int _R, _C; stage_rc(tid * 16 + _i * 8192, _R, _C); _g[_i] = (unsigned)gtab[nslot * 256 + (h) * 128 + _R] * (unsigned)(K * 2) + (unsigned)(_C * 2); } \
            PG8_STAGE(bufoff, nA + (size_t)(d) * kstep, _g); } else { PG8_STAGE(bufoff, cA + (size_t)(t + 2 + (d)) * kstep, gcur[h]); } } \
        else { PG8_STAGE(bufoff, a2 + (size_t)(d) * kstep + (h) * hstep, voffA); } } while (0)
#define PG8_LDA(dst, b, h) do { _Pragma("unroll") for (int m = 0; m < 4; ++m) _Pragma("unroll") for (int k = 0; k < 2; ++k) dst[m][k] = *(const PG8_LAS bf16x8*)(lds + PG8_SA(b, h) + aoff + m * 2048 + k * 1024); } while (0)
#define PG8_LDB(dst, b, h) do { _Pragma("unroll") for (int n = 0; n < 2; ++n) _Pragma("unroll") for (int k = 0; k < 2; ++k) dst[n][k] = *(const PG8_LAS bf16x8*)(lds + PG8_SB(b, h) + boff + n * 2048 + k * 1024); } while (0)
#define PG8_MMA(ai, bj, At, Bt) do { __builtin_amdgcn_s_setprio(1); _Pragma("unroll") for (int m = 0; m < 4; ++m) _Pragma("unroll") for (int n = 0; n < 2; ++n) _Pragma("unroll") for (int k = 0; k < 2; ++k) \
        acc[ai][bj][m][n] = __builtin_amdgcn_mfma_f32_16x16x32_bf16(Bt[n][k], At[m][k], acc[ai][bj][m][n], 0, 0, 0); __builtin_amdgcn_s_setprio(0); } while (0)
#define PG8_WAIT_V(n) asm volatile("s_waitcnt vmcnt(" #n ")" ::: "memory")
#define PG8_WAIT_L(n) asm volatile("s_waitcnt lgkmcnt(" #n ")" ::: "memory")
#define PG8_BAR __builtin_amdgcn_s_barrier()
#define PG8_SCHED __builtin_amdgcn_sched_barrier(0)
#define PG8_LOADG(dst, slot_) do { _Pragma("unroll") for (int _i = 0; _i < 2; ++_i) { int _R, _C; stage_rc(tid * 16 + _i * 8192, _R, _C); _Pragma("unroll") for (int _h = 0; _h < 2; ++_h) \
        dst[_h][_i] = (unsigned)gtab[(slot_) * 256 + _h * 128 + _R] * (unsigned)(K * 2) + (unsigned)(_C * 2); } } while (0)
    Unit cur, nxt; int ui = 0;
    if (!S.next(0, cur)) return;
    f32x4 acc[2][2][4][2];
#pragma unroll
    for (int a = 0; a < 2; ++a)
#pragma unroll
        for (int b = 0; b < 2; ++b)
#pragma unroll
            for (int m = 0; m < 4; ++m)
#pragma unroll
                for (int n = 0; n < 2; ++n) acc[a][b][m][n] = (f32x4){0.f, 0.f, 0.f, 0.f};
    bf16x8 At[4][2], B0[2][2], B1[2][2];
    unsigned gcur[2][2] = {{0u, 0u}, {0u, 0u}};
    const char* cA = S.a_ptr(cur); const char* cB = (const char*)Btp + (size_t)S.b_tile(cur) * tstep;
    if constexpr (GATHER) { PG8_LOADG(gcur, 0); PG8_WAIT_L(0); }
    PG8_STAGE(PG8_SB(0, 0), cB, voffB); PG8_STAGE(PG8_SB(0, 1), cB + hstep, voffB); PG8_STAGE_AC(PG8_SA(0, 0), 0, 0); PG8_STAGE_AC(PG8_SA(0, 1), 0, 1);
    if (wr == 1) PG8_BAR;
    PG8_WAIT_V(2); PG8_BAR;
    PG8_STAGE(PG8_SB(1, 0), cB + kstep, voffB); PG8_STAGE_AC(PG8_SA(1, 0), 1, 0); PG8_STAGE(PG8_SB(1, 1), cB + hstep + kstep, voffB);
    PG8_WAIT_V(6); PG8_BAR;
    for (;;) {
        const bool has_next = S.next(ui + 1, nxt);
        const char* nA = has_next ? S.a_ptr(nxt) : cA; const char* nB = has_next ? (const char*)Btp + (size_t)S.b_tile(nxt) * tstep : cB;
        const int nslot = has_next ? ui + 1 : ui;
        for (int t = 0; t < nt; t += 2) {
            const bool last = (t == nt - 2);
            const char* a2 = last ? nA : cA + (size_t)(t + 2) * kstep; const char* b2 = last ? nB : cB + (size_t)(t + 2) * kstep;
            const char* b3 = b2 + kstep;
            (void)a2;
            PG8_LDB(B0, 0, 0); PG8_LDB(B1, 0, 1); PG8_SCHED; PG8_LDA(At, 0, 0); PG8_STAGE_AC(PG8_SA(1, 1), t + 1, 1);
            PG8_WAIT_V(8); PG8_WAIT_L(0); PG8_BAR; PG8_MMA(0, 0, At, B0); PG8_MMA(0, 1, At, B1); PG8_BAR; PG8_SCHED;
            PG8_LDA(At, 0, 1); PG8_STAGE(PG8_SB(0, 0), b2, voffB); PG8_STAGE(PG8_SB(0, 1), b2 + hstep, voffB); PG8_STAGE_AN(PG8_SA(0, 0), 0, 0);
            PG8_WAIT_V(8); PG8_WAIT_L(0); PG8_BAR; PG8_MMA(1, 0, At, B0); PG8_MMA(1, 1, At, B1); PG8_BAR; PG8_SCHED;
            PG8_LDB(B0, 1, 0); PG8_LDB(B1, 1, 1); PG8_SCHED; PG8_LDA(At, 1, 0); PG8_STAGE_AN(PG8_SA(0, 1), 0, 1);
            PG8_WAIT_V(8); PG8_WAIT_L(0); PG8_BAR; PG8_MMA(0, 0, At, B0); PG8_MMA(0, 1, At, B1); PG8_BAR; PG8_SCHED;
            PG8_LDA(At, 1, 1); PG8_STAGE(PG8_SB(1, 0), b3, voffB); PG8_STAGE(PG8_SB(1, 1), b3 + hstep, voffB); PG8_STAGE_AN(PG8_SA(1, 0), 1, 0);
            PG8_WAIT_V(8); PG8_WAIT_L(0); PG8_BAR; PG8_MMA(1, 0, At, B0); PG8_MMA(1, 1, At, B1); PG8_BAR; PG8_SCHED;
        }
        if constexpr (ALIGN_EPI) { if (wr == 0) PG8_BAR; }
        { int fr_e = fr, fq_e = fq; asm volatile("" : "+v"(fr_e), "+v"(fq_e)); E(acc, cur, wr, wc, fr_e, fq_e); }
        if (!has_next) break;
#pragma unroll
        for (int a = 0; a < 2; ++a)
#pragma unroll
            for (int b = 0; b < 2; ++b)
#pragma unroll
                for (int m = 0; m < 4; ++m)
#pragma unroll
                    for (int n = 0; n < 2; ++n) acc[a][b][m][n] = (f32x4){0.f, 0.f, 0.f, 0.f};
        cur = nxt; cA = nA; cB = nB; ++ui;
        if constexpr (GATHER) { PG8_LOADG(gcur, ui); }
        if constexpr (ALIGN_EPI) { if (wr == 1) PG8_BAR; }
    }
    PG8_WAIT_V(0);
    if constexpr (!ALIGN_EPI) { if (wr == 0) PG8_BAR; }
    PG8_BAR;
#undef PG8_SA
#undef PG8_SB
#undef PG8_STAGE
#undef PG8_STAGE_AC
#undef PG8_STAGE_AN
#undef PG8_LDA
#undef PG8_LDB
#undef PG8_MMA
#undef PG8_WAIT_V
#undef PG8_WAIT_L
#undef PG8_BAR
#undef PG8_SCHED
#undef PG8_LOADG
}

typedef f32x4 AccT[2][2][4][2];
__device__ __forceinline__ u32x4 pack8(const f32x4 v0, const f32x4 v1) { u32x4 w; w.x = cvt_pk_bf16(v0[0], v0[1]); w.y = cvt_pk_bf16(v0[2], v0[3]); w.z = cvt_pk_bf16(v1[0], v1[1]); w.w = cvt_pk_bf16(v1[2], v1[3]); return w; }

struct EpiIn0 {
    static constexpr bool PERM = true;
    bf16_t* U; bf16_t* Q; bf16_t* KI; float* WI;
    __device__ __forceinline__ void operator()(const AccT& acc, const Unit& u, int wr, int wc, int fr, int fq) const {
        const int row0 = u.pm * BM + wr * 64 + fr;
        if (u.pn < 4) {
            const int col0 = u.pn * 128 + wc * 32 + 8 * fq;
#pragma unroll
            for (int ai = 0; ai < 2; ++ai)
#pragma unroll
                for (int m = 0; m < 4; ++m) { f32x4 o0, o1;
#pragma unroll
                    for (int j = 0; j < 4; ++j) { o0[j] = acc[ai][0][m][0][j] * sigmoidf_(acc[ai][1][m][0][j]); o1[j] = acc[ai][0][m][1][j] * sigmoidf_(acc[ai][1][m][1][j]); }
                    *(u32x4*)(U + (size_t)(row0 + ai * HALF + m * 16) * 512 + col0) = pack8(o0, o1); }
        } else if (u.pn < 12) {
            const int t = (u.pn - 4) >> 1; bf16_t* base = Q + (size_t)t * (SEG0 / 2); const float sc = 1.0f;
            const int col0 = ((u.pn - 4) & 1) * 256 + wc * 32 + 8 * fq;
#pragma unroll
            for (int ai = 0; ai < 2; ++ai)
#pragma unroll
                for (int m = 0; m < 4; ++m)
#pragma unroll
                    for (int bj = 0; bj < 2; ++bj)
                        *(u32x4*)(base + (size_t)(row0 + ai * HALF + m * 16) * 512 + col0 + bj * HALF) = pack8(acc[ai][bj][m][0] * sc, acc[ai][bj][m][1] * sc);
        } else {
            if (wc < 2) {
#pragma unroll
                for (int ai = 0; ai < 2; ++ai)
#pragma unroll
                    for (int m = 0; m < 4; ++m) *(u32x4*)(KI + (size_t)(row0 + ai * HALF + m * 16) * 64 + wc * 32 + 8 * fq) = pack8(acc[ai][0][m][0], acc[ai][0][m][1]);
            } else if (wc == 2 && fq == 0) {
                const float sc = 0.04419417382415922f;
#pragma unroll
                for (int ai = 0; ai < 2; ++ai)
#pragma unroll
                    for (int m = 0; m < 4; ++m) { float* p = WI + (size_t)(row0 + ai * HALF + m * 16) * 8; *(f32x4*)p = acc[ai][0][m][0] * sc; *(f32x4*)(p + 4) = acc[ai][0][m][1] * sc; }
            }
        }
    }
};
struct EpiRes {
    static constexpr bool PERM = true;
    bf16_t* out; const bf16_t* resid;
    __device__ __forceinline__ void operator()(const AccT& acc, const Unit& u, int wr, int wc, int fr, int fq) const {
        const int row0 = u.pm * BM + wr * 64 + fr, col0 = u.pn * BM + wc * 32 + 8 * fq;
#pragma unroll
        for (int ai = 0; ai < 2; ++ai)
#pragma unroll
            for (int m = 0; m < 4; ++m) { const size_t off = (size_t)(row0 + ai * HALF + m * 16) * DM + col0;
#pragma unroll
                for (int bj = 0; bj < 2; ++bj) { const u32x4 w = *(const u32x4*)(resid + off + bj * HALF);
                    const f32x4 r0 = (f32x4){bf_lo(w.x), bf_hi(w.x), bf_lo(w.y), bf_hi(w.y)}, r1 = (f32x4){bf_lo(w.z), bf_hi(w.z), bf_lo(w.w), bf_hi(w.w)};
                    *(u32x4*)(out + off + bj * HALF) = pack8(r0 * ALPHA + acc[ai][bj][m][0], r1 * ALPHA + acc[ai][bj][m][1]); } }
    }
};
__device__ __forceinline__ char* hm_tile(char* dout, char* ws, int p) { return p < HM_DOUT_TILES ? dout + (size_t)p * HM_TILE_BYTES : ws + WS_HM + (size_t)(p - HM_DOUT_TILES) * HM_TILE_BYTES; }
template <bool TILE_LOCAL> struct EpiSwiglu {
    static constexpr bool PERM = true;
    bf16_t* H; int ldh; char* dout; char* ws;
    __device__ __forceinline__ void operator()(const AccT& acc, const Unit& u, int wr, int wc, int fr, int fq) const {
        bf16_t* base; if constexpr (TILE_LOCAL) base = (bf16_t*)hm_tile(dout, ws, u.pm); else base = H + (size_t)u.pm * BM * ldh;
        const int rl0 = wr * 64 + fr, col0 = u.pn * 128 + wc * 32 + 8 * fq;
#pragma unroll
        for (int ai = 0; ai < 2; ++ai)
#pragma unroll
            for (int m = 0; m < 4; ++m) { f32x4 o0, o1;
#pragma unroll
                for (int j = 0; j < 4; ++j) { const float g0 = acc[ai][0][m][0][j], g1 = acc[ai][0][m][1][j];
                    o0[j] = g0 * sigmoidf_(g0) * acc[ai][1][m][0][j]; o1[j] = g1 * sigmoidf_(g1) * acc[ai][1][m][1][j]; }
                *(u32x4*)(base + (size_t)(rl0 + ai * HALF + m * 16) * ldh + col0) = pack8(o0, o1); }
    }
};
struct EpiQkv1 {
    static constexpr bool PERM = true;
    bf16_t* O; int ldc; float qscale;
    __device__ __forceinline__ void operator()(const AccT& acc, const Unit& u, int wr, int wc, int fr, int fq) const {
        const int row0 = u.pm * BM + wr * 64 + fr, col0 = u.pn * BM + wc * 32 + 8 * fq; const float sc = ((u.pn % 12) < 4) ? qscale : 1.0f;
#pragma unroll
        for (int ai = 0; ai < 2; ++ai)
#pragma unroll
            for (int m = 0; m < 4; ++m)
#pragma unroll
                for (int bj = 0; bj < 2; ++bj)
                    *(u32x4*)(O + (size_t)(row0 + ai * HALF + m * 16) * ldc + col0 + bj * HALF) = pack8(acc[ai][bj][m][0] * sc, acc[ai][bj][m][1] * sc);
    }
};
struct EpiMoeDown {
    static constexpr bool PERM = true;
    bf16_t* YB; const int* tokk; const float* gate; const PG8_LAS int* rt;
    __device__ __forceinline__ void operator()(const AccT& acc, const Unit& u, int wr, int wc, int fr, int fq) const {
        const int lbase = rt[u.pm * 4 + 1], nvalid = rt[u.pm * 4 + 2];
        const int rl0 = wr * 64 + fr, col0 = u.pn * BM + wc * 32 + 8 * fq;
#pragma unroll
        for (int ai = 0; ai < 2; ++ai)
#pragma unroll
            for (int m = 0; m < 4; ++m) { const int rl = rl0 + ai * HALF + m * 16;
                if (rl < nvalid) { const int tk = tokk[lbase + rl]; const float g = gate[lbase + rl];
                    bf16_t* rowp = YB + ((size_t)(tk & 1) * NTOK + (size_t)(tk >> 1)) * DM + col0;
#pragma unroll
                    for (int bj = 0; bj < 2; ++bj) *(u32x4*)(rowp + bj * HALF) = pack8(acc[ai][bj][m][0] * g, acc[ai][bj][m][1] * g); } }
    }
};
struct MoeOrder {
    int G, c, nM, nN; const PG8_LAS int* rt; const char* xbase; char* dout; char* ws; bool up;
    __device__ __forceinline__ bool next(int i, Unit& u) const {
        const long L = (long)i * G + c; if (L >= (long)nM * nN) return false;
        remap_unit((int)L, nM, nN, u.pm, u.pn); return true;
    }
    __device__ __forceinline__ const char* a_ptr(const Unit& u) const { return up ? xbase : (const char*)hm_tile(dout, ws, u.pm); }
    __device__ __forceinline__ int b_tile(const Unit& u) const { return __builtin_amdgcn_readfirstlane(rt[u.pm * 4]) * nN + u.pn; }
};
}


namespace swa {
constexpr int D = 128, NW = 8, QBLK = 32, KVBLK = 64, QB = NW * QBLK, WIN = 129;
constexpr int SHM_V = KVBLK * D * 2, SHM_K = KVBLK * D * 2;
constexpr int LDS_TB = 2 * SHM_V + 2 * SHM_K + NW * 64 * 4;
constexpr float SCALE = 0.08838834764831845f, THR = 8.f;
typedef float f32x16 __attribute__((ext_vector_type(16)));
typedef short s16x4 __attribute__((ext_vector_type(4)));
#define KSWZ(row, colB) ((row) * 256 + ((colB) ^ (((row) & 7) << 4)))
#define SBAR() __builtin_amdgcn_sched_barrier(0)
__device__ __forceinline__ int v_st(int k, int c) { const int kk = (k & ~0xC) | ((k & 4) << 1) | ((k & 8) >> 1); return ((kk >> 3) * 4 + (c >> 5)) * 512 + ((kk & 7) * 32 + (c & 31)) * 2; }
__device__ __forceinline__ int v_rd_base(int lane) { return ((lane & 3) << 3) | (((lane >> 2) & 3) << 6) | (((lane >> 4) & 1) << 5) | (((lane >> 5) & 1) << 8); }
constexpr int v_rd_off(int d0, int ks, int half) { return d0 * 512 + ks * 4096 + half * 2048; }
__device__ __forceinline__ int crow(int r, int hi) { return (r & 3) + 8 * (r >> 2) + 4 * hi; }
__device__ __forceinline__ bf16x8 load8(const bf16_t* p) { return *reinterpret_cast<const bf16x8*>(p); }
__device__ __forceinline__ void mask_bias_tile(f32x16& p0, f32x16& p1, int dq, const float* tb) {
    const float NEG = -__builtin_inff();
    float b0[16], b1[16];
#pragma unroll
    for (int r = 0; r < 16; ++r) { const int c = (r & 3) + 8 * (r >> 2); b0[r] = tb[59 - c]; b1[r] = tb[27 - c]; }
#pragma unroll
    for (int r = 0; r < 16; ++r) {
        const int c = (r & 3) + 8 * (r >> 2);
        const float a0 = p0[r] + b0[r], a1 = p1[r] + b1[r];
        p0[r] = ((unsigned)(dq - c) < (unsigned)WIN) ? a0 : NEG;
        p1[r] = ((unsigned)(dq - c - 32) < (unsigned)WIN) ? a1 : NEG;
    }
}
__device__ __forceinline__ void partialSM(f32x16& p0, f32x16& p1, float& m_reg, float& mn, float& alpha) {
    float pmax = p0[0];
#pragma unroll
    for (int r = 1; r < 16; ++r) pmax = fmaxf(pmax, p0[r]);
#pragma unroll
    for (int r = 0; r < 16; ++r) pmax = fmaxf(pmax, p1[r]);
    { auto rr = __builtin_amdgcn_permlane32_swap(__float_as_uint(pmax), __float_as_uint(pmax), false, false);
      pmax = fmaxf(__uint_as_float(rr[0]), __uint_as_float(rr[1])); }
    constexpr float C2 = 1.4426950408889634f * SCALE;
    if (__builtin_expect(__all((pmax - m_reg) * SCALE <= THR), 1)) { mn = m_reg; alpha = 1.f; }
    else { mn = fmaxf(m_reg, pmax); alpha = __builtin_amdgcn_exp2f((m_reg - mn) * C2); m_reg = mn; }
    const float mnL = -mn * C2;
#pragma unroll
    for (int r = 0; r < 16; ++r) p0[r] = fmaf(p0[r], C2, mnL);
#pragma unroll
    for (int r = 0; r < 16; ++r) p1[r] = fmaf(p1[r], C2, mnL);
#pragma unroll
    for (int r = 0; r < 16; ++r) p0[r] = __builtin_amdgcn_exp2f(p0[r]);
}
__device__ __forceinline__ void finishSM(f32x16& p0, f32x16& p1, float alpha, float& l_reg, bf16x8& pa0, bf16x8& pa1, bf16x8& pa2, bf16x8& pa3) {
#pragma unroll
    for (int r = 0; r < 16; ++r) p1[r] = __builtin_amdgcn_exp2f(p1[r]);
    float ps = 0;
#pragma unroll
    for (int r = 0; r < 16; ++r) ps += p0[r];
#pragma unroll
    for (int r = 0; r < 16; ++r) ps += p1[r];
    { auto rr = __builtin_amdgcn_permlane32_swap(__float_as_uint(ps), __float_as_uint(ps), false, false);
      ps = __uint_as_float(rr[0]) + __uint_as_float(rr[1]); }
    l_reg = l_reg * alpha + ps;
#define PK4(P, B_, OUT) do { unsigned a0 = cvt_pk_bf16(P[B_+0], P[B_+1]), a1 = cvt_pk_bf16(P[B_+2], P[B_+3]);                          \
        unsigned b0 = cvt_pk_bf16(P[B_+4], P[B_+5]), b1 = cvt_pk_bf16(P[B_+6], P[B_+7]);                                             \
        auto r0 = __builtin_amdgcn_permlane32_swap(a0, b0, false, false); auto r1 = __builtin_amdgcn_permlane32_swap(a1, b1, false, false); \
        u32x4 w = {r0[0], r1[0], r0[1], r1[1]}; OUT = *reinterpret_cast<bf16x8*>(&w); } while (0)
    PK4(p0, 0, pa0); PK4(p0, 8, pa1); PK4(p1, 0, pa2); PK4(p1, 8, pa3);
#undef PK4
}
template <int KB>
__device__ __forceinline__ void qkt(f32x16& p0, f32x16& p1, const char* K_lds, int r32, int hi, const bf16x8* qr, bool act) {
    if (!act) { const float NEG = -__builtin_inff();
#pragma unroll
        for (int r = 0; r < 16; ++r) { p0[r] = NEG; p1[r] = NEG; } return; }
    p0 = f32x16{}; p1 = f32x16{};
    const char* kb[4];
#pragma unroll
    for (int dd = 0; dd < 4; ++dd) kb[dd] = K_lds + KB * SHM_K + KSWZ(r32, (dd * 16 + hi * 8) * 2);
#pragma unroll
    for (int d0 = 0; d0 < 8; ++d0) { const char* a = kb[d0 & 3] + (d0 >> 2) * 128;
        bf16x8 b0 = *reinterpret_cast<const bf16x8*>(a);
        bf16x8 b1 = *reinterpret_cast<const bf16x8*>(a + 32 * 256);
        p0 = __builtin_amdgcn_mfma_f32_32x32x16_bf16(b0, qr[d0], p0, 0, 0, 0);
        p1 = __builtin_amdgcn_mfma_f32_32x32x16_bf16(b1, qr[d0], p1, 0, 0, 0); }
}
template <int VB>
__device__ __forceinline__ void pv_tile(f32x16* o, int vb0, bf16x8 pa0, bf16x8 pa1, bf16x8 pa2, bf16x8 pa3, bool act) {
    if (!act) return;
#define TRRD(dst, off) asm volatile("ds_read_b64_tr_b16 %0, %1 offset:%2" : "=&v"(dst) : "v"(vb0), "i"(off) : "memory")
#define PV_D0(d0) do { s16x4 l0, l1, l2, l3, h0, h1, h2, h3; constexpr int b_ = VB * SHM_V + v_rd_off(d0, 0, 0); \
        TRRD(l0, b_); TRRD(h0, b_ + 2048); TRRD(l1, b_ + 4096); TRRD(h1, b_ + 6144); TRRD(l2, b_ + 8192); TRRD(h2, b_ + 10240); TRRD(l3, b_ + 12288); TRRD(h3, b_ + 14336); \
        asm volatile("s_waitcnt lgkmcnt(0)" ::: "memory"); SBAR();   \
        o[d0] = __builtin_amdgcn_mfma_f32_32x32x16_bf16(pa0, (bf16x8){l0[0], l0[1], l0[2], l0[3], h0[0], h0[1], h0[2], h0[3]}, o[d0], 0, 0, 0);   \
        o[d0] = __builtin_amdgcn_mfma_f32_32x32x16_bf16(pa1, (bf16x8){l1[0], l1[1], l1[2], l1[3], h1[0], h1[1], h1[2], h1[3]}, o[d0], 0, 0, 0);   \
        o[d0] = __builtin_amdgcn_mfma_f32_32x32x16_bf16(pa2, (bf16x8){l2[0], l2[1], l2[2], l2[3], h2[0], h2[1], h2[2], h2[3]}, o[d0], 0, 0, 0);   \
        o[d0] = __builtin_amdgcn_mfma_f32_32x32x16_bf16(pa3, (bf16x8){l3[0], l3[1], l3[2], l3[3], h3[0], h3[1], h3[2], h3[3]}, o[d0], 0, 0, 0); } while (0)
    PV_D0(0); PV_D0(1); PV_D0(2); PV_D0(3);
#undef PV_D0
#undef TRRD
}
struct BlockRef { const bf16_t* Q; const bf16_t* K; bf16_t* O; float* LSE; int P0, bh, dsh;
    __device__ __forceinline__ int rs() const { return IN1_N << dsh; }
    __device__ __forceinline__ int os() const { return DM << dsh; }
    __device__ __forceinline__ int ls() const { return 8 << dsh; }
    __device__ __forceinline__ int skv() const { return SEQ >> dsh; }
    __device__ __forceinline__ const bf16_t* V() const { return K + 1024; } };
struct Seam { bf16x8 qr[8]; bf16x8 st_v0, st_v1, st_k0, st_k1; };
__device__ __forceinline__ int swa_jlo(int P0) { const int lowk = P0 - WIN + 1; return lowk > 0 ? lowk / KVBLK : 0; }
#define ROWP(p, k0, rs_, vo) ((const bf16_t*)((const char*)(p) + (size_t)(k0) * (size_t)(rs_) * 2 + (size_t)(vo)))
#define VMW() asm volatile("s_waitcnt vmcnt(0)" ::: "memory")
#define VMWN(n) asm volatile("s_waitcnt vmcnt(%0)" :: "i"(n) : "memory")
#define TIDL() int tid_l = tid; asm volatile("" : "+v"(tid_l)); const int sr = tid_l >> 4, sc = (tid_l & 15) * 8; (void)sr; (void)sc
#define SLOAD_H(Kp, Vp, k0, rs_) do { TIDL(); const unsigned vo0_ = (unsigned)(sr * (rs_) + sc) * 2u, vo1_ = vo0_ + (unsigned)(rs_) * 64u; \
                         S.st_v0 = load8(ROWP(Vp, k0, rs_, vo0_)); S.st_v1 = load8(ROWP(Vp, k0, rs_, vo1_));              \
                         S.st_k0 = load8(ROWP(Kp, k0, rs_, vo0_)); S.st_k1 = load8(ROWP(Kp, k0, rs_, vo1_)); } while (0)
#define SWRITE_HK(bf) do { TIDL(); const int kws = KSWZ(sr, sc * 2); *(bf16x8*)(K_lds + (bf) * SHM_K + kws) = S.st_k0; *(bf16x8*)(K_lds + (bf) * SHM_K + kws + 32 * 256) = S.st_k1; } while (0)
#define SWRITE_HV(bf) do { TIDL(); const int vst0 = v_st(sr, sc), vst1 = v_st(32 + sr, sc); *(bf16x8*)(V_lds + (bf) * SHM_V + vst0) = S.st_v0; *(bf16x8*)(V_lds + (bf) * SHM_V + vst1) = S.st_v1; } while (0)
#define SWRITE_H(bf) do { SWRITE_HV(bf); SWRITE_HK(bf); } while (0)
__device__ __forceinline__ void tb_load(const float* biast, int bh, int dsh, int tid, float& v0, float& v1) {
    const int d0 = tid - 384, d1 = tid + 512 - 384;
    v0 = (d0 >= 0 && d0 < WIN) ? biast[bh * 4096 + (d0 << dsh)] * (1.0f / SCALE) : 0.f;
    v1 = (d1 >= 0 && d1 < WIN) ? biast[bh * 4096 + (d1 << dsh)] * (1.0f / SCALE) : 0.f;
}
__device__ __forceinline__ void swa_prime(const BlockRef& cur, const float* biast, char* lds, Seam& S, int tid) {
    const int wid = __builtin_amdgcn_readfirstlane(tid >> 6), lane = tid & 63, r32 = lane & 31, hi = lane >> 5;
    char* K_lds = lds + 2 * SHM_V;
    const int kb0 = swa_jlo(cur.P0) * KVBLK;
    float t0, t1; tb_load(biast, cur.bh, cur.dsh, tid, t0, t1);
#pragma unroll
    for (int d0 = 0; d0 < 8; ++d0) S.qr[d0] = load8((const bf16_t*)((const char*)cur.Q + (size_t)((unsigned)((wid * QBLK + r32) * cur.rs() + hi * 8) * 2u)) + d0 * 16);
    SLOAD_H(cur.K, cur.V(), kb0, cur.rs()); VMW(); SWRITE_HK(0);
    float* tb = (float*)(lds + LDS_TB); tb[tid] = t0; tb[tid + 512] = t1;
    __syncthreads();
}
__device__ __forceinline__ void swa_block(const BlockRef& cur, const BlockRef& nxt, const float* biast, int slot, char* lds, Seam& S, int tid) {
    const int wid = __builtin_amdgcn_readfirstlane(tid >> 6), lane = tid & 63, r32 = lane & 31, hi = lane >> 5;
    const int j_lo = swa_jlo(cur.P0);
    int j_hi = (cur.P0 + QB - 1) / KVBLK + 1; if (j_hi > cur.skv() / KVBLK) j_hi = cur.skv() / KVBLK;
    const int NT = j_hi - j_lo;
    const int kbn = swa_jlo(nxt.P0) * KVBLK;
    const int qlo = cur.P0 + wid * QBLK, qm = qlo + r32 - 4 * hi;
    char* V_lds = lds; char* K_lds = lds + 2 * SHM_V;
    float* wsl = (float*)(lds + 2 * SHM_V + 2 * SHM_K) + wid * 64; float* li_l = wsl, * al_l = wsl + 32;
    const float* tbl0 = (const float*)(lds + LDS_TB + slot * 4096) + 325;
    float m_reg = -1e30f, l_reg = 0; f32x16 o[4] = {};
    const int vb0 = (int)(uintptr_t)V_lds + v_rd_base(lane);
    const bf16_t* Kh = cur.K; const bf16_t* Vh = cur.V(); const int rs = cur.rs();
#define RESC(a) do { if (__any((a) < 1.f)) { if (hi == 0) al_l[r32] = (a); asm volatile("s_waitcnt lgkmcnt(0)" ::: "memory");              \
                     _Pragma("unroll") for (int d_ = 0; d_ < 4; ++d_) _Pragma("unroll") for (int r = 0; r < 16; ++r) o[d_][r] *= al_l[crow(r, hi)]; } } while (0)
#define KBASE(t) ((j_lo + (t)) * KVBLK)
#define ACT(t) (KBASE(t) <= qlo + QBLK - 1 && KBASE(t) + KVBLK - 1 >= qlo - WIN + 1)
#define MASKT(P0_, P1_, t) do { const int kb_ = KBASE(t); if (ACT(t)) mask_bias_tile(P0_, P1_, qm - kb_, tbl0 + (qm - kb_)); } while (0)
    constexpr int NQL = 8;
#define SEAM_K0() do { VMWN(NQL); SWRITE_HK(0); SBAR(); } while (0)
    f32x16 pA0, pA1, pB0, pB1; float mnA, mnB, alA, alB; bf16x8 pa0, pa1, pa2, pa3;
    SWRITE_HV(0); SBAR();
    if (NT > 1) { SLOAD_H(Kh, Vh, KBASE(1), rs); }
    SBAR(); qkt<0>(pA0, pA1, K_lds, r32, hi, S.qr, ACT(0));
    MASKT(pA0, pA1, 0); partialSM(pA0, pA1, m_reg, mnA, alA);
    if (NT > 1) { VMW(); SWRITE_H(1); }
    __syncthreads();
#define HALF_STEP(PX0, PX1, mnX, alX, PY0, PY1, alY, t, KB, VB, SB) do {                                                      \
        SBAR(); qkt<KB>(PX0, PX1, K_lds, r32, hi, S.qr, ACT(t));                                             \
        finishSM(PY0, PY1, alY, l_reg, pa0, pa1, pa2, pa3); SBAR();                                                           \
        if ((t) + 1 < NT) { SLOAD_H(Kh, Vh, KBASE((t) + 1), rs); SBAR(); }                                               \
        pv_tile<VB>(o, vb0, pa0, pa1, pa2, pa3, ACT((t) - 1)); MASKT(PX0, PX1, (t)); partialSM(PX0, PX1, m_reg, mnX, alX);                                        \
        __syncthreads();                                                                                                      \
        if ((t) + 1 < NT) { VMW(); SWRITE_H(SB); }                                                                          \
        RESC(alX); __syncthreads(); } while (0)
    for (int t = 1; t + 1 < NT; t += 2) {
        HALF_STEP(pB0, pB1, mnB, alB, pA0, pA1, alA, t, 1, 0, 0);
        HALF_STEP(pA0, pA1, mnA, alA, pB0, pB1, alB, t + 1, 0, 1, 1);
    }
    const bool even = (NT & 1) == 0;
    if (even) { SBAR(); qkt<1>(pB0, pB1, K_lds, r32, hi, S.qr, ACT(NT - 1)); SBAR(); }
    SLOAD_H(nxt.K, nxt.V(), kbn, nxt.rs()); SBAR();
#pragma unroll
    for (int d0 = 0; d0 < 8; ++d0) S.qr[d0] = load8((const bf16_t*)((const char*)nxt.Q + (size_t)((unsigned)((wid * QBLK + r32) * nxt.rs() + hi * 8) * 2u)) + d0 * 16);
    SBAR();
    finishSM(pA0, pA1, alA, l_reg, pa0, pa1, pa2, pa3); SBAR();
    pv_tile<0>(o, vb0, pa0, pa1, pa2, pa3, ACT(even ? NT - 2 : NT - 1));
    if (even) { MASKT(pB0, pB1, NT - 1); partialSM(pB0, pB1, m_reg, mnB, alB); __syncthreads(); RESC(alB);
        finishSM(pB0, pB1, alB, l_reg, pa0, pa1, pa2, pa3); SBAR(); pv_tile<1>(o, vb0, pa0, pa1, pa2, pa3, ACT(NT - 1)); }
    SBAR(); SEAM_K0();
    float t0, t1; tb_load(biast, nxt.bh, nxt.dsh, tid, t0, t1);
    if (hi == 0) li_l[r32] = l_reg; asm volatile("s_waitcnt lgkmcnt(0)" ::: "memory");
    int r32e = r32, hie = hi; asm volatile("" : "+v"(r32e), "+v"(hie));
    if (hie == 0) cur.LSE[(size_t)(wid * QBLK + r32e) * cur.ls()] = m_reg * SCALE + __logf(l_reg);
    float rli[16];
#pragma unroll
    for (int r = 0; r < 16; ++r) rli[r] = __builtin_amdgcn_rcpf(li_l[crow(r, hie)]);
    const int os = cur.os();
    bf16_t* Ow = cur.O + (size_t)(wid * QBLK) * os;
#pragma unroll
    for (int r = 0; r < 16; ++r) { const unsigned oo = (unsigned)(crow(r, hie) * os + r32e) * 2u;
#pragma unroll
        for (int d0 = 0; d0 < 4; ++d0) { const float v = o[d0][r] * rli[r];
            const float vn = swz_xor<1>(v);
            if ((r32e & 1) == 0) *(unsigned*)((char*)Ow + oo + d0 * 64) = cvt_pk_bf16(v, vn); } }
    { float* tb = (float*)(lds + LDS_TB + (slot ^ 1) * 4096); tb[tid] = t0; tb[tid + 512] = t1; }
    __syncthreads();
#undef RESC
#undef KBASE
#undef ACT
#undef MASKT
#undef SEAM_K0
#undef HALF_STEP
}
#undef ROWP
#undef VMW
#undef VMWN
#undef SLOAD_H
#undef SWRITE_HK
#undef SWRITE_HV
#undef SWRITE_H
#undef TIDL
#undef KSWZ
#undef SBAR
}


namespace dsa {
constexpr int D = 64, NW = 8, QBLK = 32, KVBLK = 64, QB = NW * QBLK;
constexpr int SHM_V = KVBLK * D * 2, SHM_K = KVBLK * D * 2;
constexpr int LDS_TB = 2 * SHM_V + 2 * SHM_K + NW * 64 * 4;
constexpr int TB_PAD = 128;
constexpr float SCALE = 0.125f, THR = 8.f;
typedef float f32x16 __attribute__((ext_vector_type(16)));
typedef short s16x4 __attribute__((ext_vector_type(4)));
#define KSWZ(row, colB) ((row) * 128 + ((colB) ^ (((row) & 7) << 4)))
#define SBAR() __builtin_amdgcn_sched_barrier(0)
__device__ __forceinline__ int v_st(int k, int c) { const int kk = (k & ~0xC) | ((k & 4) << 1) | ((k & 8) >> 1); return ((kk >> 3) * 2 + (c >> 5)) * 512 + ((kk & 7) * 32 + (c & 31)) * 2; }
__device__ __forceinline__ int v_rd_base(int lane) { return ((lane & 3) << 3) | (((lane >> 2) & 3) << 6) | (((lane >> 4) & 1) << 5) | (((lane >> 5) & 1) << 8); }
__device__ __forceinline__ int crow(int r, int hi) { return (r & 3) + 8 * (r >> 2) + 4 * hi; }
__device__ __forceinline__ bf16x8 load8(const bf16_t* p) { return *reinterpret_cast<const bf16x8*>(p); }
__device__ __forceinline__ void mask_bias_tile(f32x16& p0, f32x16& p1, const float* tb, unsigned lo4, unsigned hi4) {
    const float NEG = -__builtin_inff();
    float b0[16], b1[16];
#pragma unroll
    for (int r = 0; r < 16; ++r) { const int c = (r & 3) + 8 * (r >> 2); b0[r] = tb[63 - c]; b1[r] = tb[31 - c]; }
#pragma unroll
    for (int r = 0; r < 16; ++r) {
        const int c = (r & 3) + 8 * (r >> 2);
        const float a0 = p0[r] + b0[r], a1 = p1[r] + b1[r];
        p0[r] = ((lo4 >> c) & 1u) ? a0 : NEG;
        p1[r] = ((hi4 >> c) & 1u) ? a1 : NEG;
    }
}
__device__ __forceinline__ void partialSM(f32x16& p0, f32x16& p1, float& m_reg, float& mn, float& alpha) {
    float pmax = p0[0];
#pragma unroll
    for (int r = 1; r < 16; ++r) pmax = fmaxf(pmax, p0[r]);
#pragma unroll
    for (int r = 0; r < 16; ++r) pmax = fmaxf(pmax, p1[r]);
    { auto rr = __builtin_amdgcn_permlane32_swap(__float_as_uint(pmax), __float_as_uint(pmax), false, false);
      pmax = fmaxf(__uint_as_float(rr[0]), __uint_as_float(rr[1])); }
    constexpr float C2 = 1.4426950408889634f * SCALE;
    if (__builtin_expect(__all((pmax - m_reg) * SCALE <= THR), 1)) { mn = m_reg; alpha = 1.f; }
    else { mn = fmaxf(m_reg, pmax); alpha = __builtin_amdgcn_exp2f((m_reg - mn) * C2); m_reg = mn; }
    const float mnL = -mn * C2;
#pragma unroll
    for (int r = 0; r < 16; ++r) p0[r] = fmaf(p0[r], C2, mnL);
#pragma unroll
    for (int r = 0; r < 16; ++r) p1[r] = fmaf(p1[r], C2, mnL);
#pragma unroll
    for (int r = 0; r < 16; ++r) p0[r] = __builtin_amdgcn_exp2f(p0[r]);
}
__device__ __forceinline__ void finishSM(f32x16& p0, f32x16& p1, float alpha, float& l_reg, bf16x8& pa0, bf16x8& pa1, bf16x8& pa2, bf16x8& pa3) {
#pragma unroll
    for (int r = 0; r < 16; ++r) p1[r] = __builtin_amdgcn_exp2f(p1[r]);
    float ps = 0;
#pragma unroll
    for (int r = 0; r < 16; ++r) ps += p0[r];
#pragma unroll
    for (int r = 0; r < 16; ++r) ps += p1[r];
    { auto rr = __builtin_amdgcn_permlane32_swap(__float_as_uint(ps), __float_as_uint(ps), false, false);
      ps = __uint_as_float(rr[0]) + __uint_as_float(rr[1]); }
    l_reg = l_reg * alpha + ps;
#define PK4(P, B_, OUT) do { unsigned a0 = cvt_pk_bf16(P[B_+0], P[B_+1]), a1 = cvt_pk_bf16(P[B_+2], P[B_+3]);                          \
        unsigned b0 = cvt_pk_bf16(P[B_+4], P[B_+5]), b1 = cvt_pk_bf16(P[B_+6], P[B_+7]);                                             \
        auto r0 = __builtin_amdgcn_permlane32_swap(a0, b0, false, false); auto r1 = __builtin_amdgcn_permlane32_swap(a1, b1, false, false); \
        u32x4 w = {r0[0], r1[0], r0[1], r1[1]}; OUT = *reinterpret_cast<bf16x8*>(&w); } while (0)
    PK4(p0, 0, pa0); PK4(p0, 8, pa1); PK4(p1, 0, pa2); PK4(p1, 8, pa3);
#undef PK4
}
template <int KB>
__device__ __forceinline__ void qkt(f32x16& p0, f32x16& p1, const char* K_lds, int r32, int hi, const bf16x8* qr, bool act) {
    if (!act) { const float NEG = -__builtin_inff();
#pragma unroll
        for (int r = 0; r < 16; ++r) { p0[r] = NEG; p1[r] = NEG; } return; }
    p0 = f32x16{}; p1 = f32x16{};
#pragma unroll
    for (int d0 = 0; d0 < 4; ++d0) { const char* a = K_lds + KB * SHM_K + KSWZ(r32, (d0 * 16 + hi * 8) * 2);
        bf16x8 b0 = *reinterpret_cast<const bf16x8*>(a);
        bf16x8 b1 = *reinterpret_cast<const bf16x8*>(a + 32 * 128);
        p0 = __builtin_amdgcn_mfma_f32_32x32x16_bf16(b0, qr[d0], p0, 0, 0, 0);
        p1 = __builtin_amdgcn_mfma_f32_32x32x16_bf16(b1, qr[d0], p1, 0, 0, 0); }
}
template <int VB>
__device__ __forceinline__ void pv_tile(f32x16* o, int vb0, bf16x8 pa0, bf16x8 pa1, bf16x8 pa2, bf16x8 pa3, bool act) {
    if (!act) return;
#define TRRD(dst, off) asm volatile("ds_read_b64_tr_b16 %0, %1 offset:%2" : "=&v"(dst) : "v"(vb0), "i"(off) : "memory")
#define PV_D0(d0) do { s16x4 l0, l1, l2, l3, h0, h1, h2, h3; constexpr int b_ = VB * SHM_V + (d0) * 512; \
        TRRD(l0, b_); TRRD(h0, b_ + 1024); TRRD(l1, b_ + 2048); TRRD(h1, b_ + 3072); TRRD(l2, b_ + 4096); TRRD(h2, b_ + 5120); TRRD(l3, b_ + 6144); TRRD(h3, b_ + 7168); \
        asm volatile("s_waitcnt lgkmcnt(0)" ::: "memory"); SBAR();   \
        o[d0] = __builtin_amdgcn_mfma_f32_32x32x16_bf16(pa0, (bf16x8){l0[0], l0[1], l0[2], l0[3], h0[0], h0[1], h0[2], h0[3]}, o[d0], 0, 0, 0);   \
        o[d0] = __builtin_amdgcn_mfma_f32_32x32x16_bf16(pa1, (bf16x8){l1[0], l1[1], l1[2], l1[3], h1[0], h1[1], h1[2], h1[3]}, o[d0], 0, 0, 0);   \
        o[d0] = __builtin_amdgcn_mfma_f32_32x32x16_bf16(pa2, (bf16x8){l2[0], l2[1], l2[2], l2[3], h2[0], h2[1], h2[2], h2[3]}, o[d0], 0, 0, 0);   \
        o[d0] = __builtin_amdgcn_mfma_f32_32x32x16_bf16(pa3, (bf16x8){l3[0], l3[1], l3[2], l3[3], h3[0], h3[1], h3[2], h3[3]}, o[d0], 0, 0, 0); } while (0)
    PV_D0(0); PV_D0(1);
#undef PV_D0
#undef TRRD
}
struct BlockRef { const bf16_t* Q; const bf16_t* K; const bf16_t* V; bf16_t* O; const u64* MW; int P0; };
struct Seam { bf16x8 qr[4]; bf16x8 st_v0, st_k0; u64 mw; };
#define VMW() asm volatile("s_waitcnt vmcnt(0)" ::: "memory")
#define VMWN(n) asm volatile("s_waitcnt vmcnt(%0)" :: "i"(n) : "memory")
#define TIDL() int tid_l = tid; asm volatile("" : "+v"(tid_l)); const int sr = tid_l >> 3, sc = (tid_l & 7) * 8; (void)sr; (void)sc
#define SLOAD_H(Kp, Vp, k0) do { TIDL(); const unsigned vo_ = (unsigned)((k0 + sr) * 512 + sc) * 2u; \
        S.st_v0 = load8((const bf16_t*)((const char*)(Vp) + vo_)); S.st_k0 = load8((const bf16_t*)((const char*)(Kp) + vo_)); } while (0)
#define SWRITE_HK(bf) do { TIDL(); *(bf16x8*)(K_lds + (bf) * SHM_K + KSWZ(sr, sc * 2)) = S.st_k0; } while (0)
#define SWRITE_HV(bf) do { TIDL(); *(bf16x8*)(V_lds + (bf) * SHM_V + v_st(sr, sc)) = S.st_v0; } while (0)
#define SWRITE_H(bf) do { SWRITE_HV(bf); SWRITE_HK(bf); } while (0)
#define MWLOAD(ref, tile) ((ref).MW[(size_t)(tile) * SEQ + wid * QBLK + r32])
__device__ __forceinline__ void dsa_prime(const BlockRef& cur, char* lds, Seam& S, int tid) {
    const int wid = __builtin_amdgcn_readfirstlane(tid >> 6), lane = tid & 63, r32 = lane & 31, hi = lane >> 5;
    char* K_lds = lds + 2 * SHM_V;
#pragma unroll
    for (int d0 = 0; d0 < 4; ++d0) S.qr[d0] = load8(cur.Q + (size_t)(wid * QBLK + r32) * 512 + d0 * 16 + hi * 8);
    S.mw = MWLOAD(cur, 0);
    SLOAD_H(cur.K, cur.V, 0); VMW(); SWRITE_HK(0);
    __syncthreads();
}
__device__ __forceinline__ void dsa_block(const BlockRef& cur, const BlockRef& nxt, char* lds, Seam& S, int tid) {
    const int wid = __builtin_amdgcn_readfirstlane(tid >> 6), lane = tid & 63, r32 = lane & 31, hi = lane >> 5;
    const int NT = (cur.P0 + QB - 1) / KVBLK + 1;
    const int qlo = cur.P0 + wid * QBLK, qm = qlo + r32 - 4 * hi;
    char* V_lds = lds; char* K_lds = lds + 2 * SHM_V;
    float* wsl = (float*)(lds + 2 * SHM_V + 2 * SHM_K) + wid * 64; float* li_l = wsl, * al_l = wsl + 32;
    const float* tbl0 = (const float*)(lds + LDS_TB) + (TB_PAD - 63);
    float m_reg = -1e30f, l_reg = 0; f32x16 o[2] = {};
    const int vb0 = (int)(uintptr_t)V_lds + v_rd_base(lane);
    const bf16_t* Kh = cur.K; const bf16_t* Vh = cur.V;
#define RESC(a) do { if (__any((a) < 1.f)) { if (hi == 0) al_l[r32] = (a); asm volatile("s_waitcnt lgkmcnt(0)" ::: "memory");              \
                     _Pragma("unroll") for (int d_ = 0; d_ < 2; ++d_) _Pragma("unroll") for (int r = 0; r < 16; ++r) o[d_][r] *= al_l[crow(r, hi)]; } } while (0)
#define KBASE(t) ((t) * KVBLK)
#define ACT(t) (KBASE(t) <= qlo + QBLK - 1)
#define MASKT(P0_, P1_, t, MWX) do { const int kb_ = KBASE(t); if (ACT(t)) mask_bias_tile(P0_, P1_, tbl0 + (qm - kb_), (unsigned)(MWX) >> (4 * hi), (unsigned)((MWX) >> 32) >> (4 * hi)); } while (0)
    constexpr int NQL = 5;
#define SEAM_K0() do { VMWN(NQL); SWRITE_HK(0); SBAR(); } while (0)
    f32x16 pA0, pA1, pB0, pB1; float mnA, mnB, alA, alB; bf16x8 pa0, pa1, pa2, pa3;
    u64 mwA = S.mw, mwB = 0;
    SWRITE_HV(0); SBAR();
    if (NT > 1) { SLOAD_H(Kh, Vh, KBASE(1)); mwB = MWLOAD(cur, 1); }
    SBAR(); qkt<0>(pA0, pA1, K_lds, r32, hi, S.qr, ACT(0));
    MASKT(pA0, pA1, 0, mwA); partialSM(pA0, pA1, m_reg, mnA, alA);
    if (NT > 1) { VMW(); SWRITE_H(1); }
    __syncthreads();
#define HALF_STEP(PX0, PX1, mnX, alX, PY0, PY1, alY, t, KB, VB, SB, MWX, MWY) do {                                                      \
        SBAR(); qkt<KB>(PX0, PX1, K_lds, r32, hi, S.qr, ACT(t));                                             \
        finishSM(PY0, PY1, alY, l_reg, pa0, pa1, pa2, pa3); SBAR();                                                           \
        if ((t) + 1 < NT) { SLOAD_H(Kh, Vh, KBASE((t) + 1)); MWY = MWLOAD(cur, (t) + 1); SBAR(); }                                               \
        pv_tile<VB>(o, vb0, pa0, pa1, pa2, pa3, ACT((t) - 1)); MASKT(PX0, PX1, (t), MWX); partialSM(PX0, PX1, m_reg, mnX, alX);                                        \
        __syncthreads();                                                                                                      \
        if ((t) + 1 < NT) { VMW(); SWRITE_H(SB); }                                                                          \
        RESC(alX); __syncthreads(); } while (0)
    for (int t = 1; t + 1 < NT; t += 2) {
        HALF_STEP(pB0, pB1, mnB, alB, pA0, pA1, alA, t, 1, 0, 0, mwB, mwA);
        HALF_STEP(pA0, pA1, mnA, alA, pB0, pB1, alB, t + 1, 0, 1, 1, mwA, mwB);
    }
    const bool even = (NT & 1) == 0;
    if (even) { SBAR(); qkt<1>(pB0, pB1, K_lds, r32, hi, S.qr, ACT(NT - 1)); SBAR(); }
    SLOAD_H(nxt.K, nxt.V, 0); SBAR();
#pragma unroll
    for (int d0 = 0; d0 < 4; ++d0) S.qr[d0] = load8(nxt.Q + (size_t)(wid * QBLK + r32) * 512 + d0 * 16 + hi * 8);
    S.mw = MWLOAD(nxt, 0);
    SBAR();
    finishSM(pA0, pA1, alA, l_reg, pa0, pa1, pa2, pa3); SBAR();
    pv_tile<0>(o, vb0, pa0, pa1, pa2, pa3, ACT(even ? NT - 2 : NT - 1));
    if (even) { MASKT(pB0, pB1, NT - 1, mwB); partialSM(pB0, pB1, m_reg, mnB, alB); __syncthreads(); RESC(alB);
        finishSM(pB0, pB1, alB, l_reg, pa0, pa1, pa2, pa3); SBAR(); pv_tile<1>(o, vb0, pa0, pa1, pa2, pa3, ACT(NT - 1)); }
    SBAR(); SEAM_K0();
    if (hi == 0) li_l[r32] = l_reg; asm volatile("s_waitcnt lgkmcnt(0)" ::: "memory");
    int r32e = r32, hie = hi; asm volatile("" : "+v"(r32e), "+v"(hie));
    float rli[16];
#pragma unroll
    for (int r = 0; r < 16; ++r) rli[r] = __builtin_amdgcn_rcpf(li_l[crow(r, hie)]);
    bf16_t* Ow = cur.O + (size_t)(wid * QBLK) * DM;
#pragma unroll
    for (int r = 0; r < 16; ++r) { const unsigned oo = (unsigned)(crow(r, hie) * DM + r32e) * 2u;
#pragma unroll
        for (int d0 = 0; d0 < 2; ++d0) { const float v = o[d0][r] * rli[r];
            const float vn = swz_xor<1>(v);
            if ((r32e & 1) == 0) *(unsigned*)((char*)Ow + oo + d0 * 64) = cvt_pk_bf16(v, vn); } }
    __syncthreads();
#undef RESC
#undef KBASE
#undef ACT
#undef MASKT
#undef SEAM_K0
#undef HALF_STEP
}
#undef VMW
#undef VMWN
#undef TIDL
#undef SLOAD_H
#undef SWRITE_HK
#undef SWRITE_HV
#undef SWRITE_H
#undef MWLOAD
#undef KSWZ
#undef SBAR
}

__device__ __forceinline__ swa::BlockRef dil_ref(int u, const bf16_t* H1p, bf16_t* OPp, float* LSEp) {
    const int x = u & 15, rest = u >> 4, g = rest % 3, bh = rest / 3, h = bh & 7, bl = bh >> 3;
    const int dsh = 2 * g, dil = 1 << dsh, r = x >> (4 - dsh), blk = x & ((16 >> dsh) - 1), P0 = blk * 256;
    const size_t row0 = (size_t)bl * SEQ + r, rowq = row0 + (size_t)dil * P0;
    swa::BlockRef R;
    R.K = H1p + row0 * IN1_N + g * 3072 + 1024 + h * 128; R.Q = H1p + rowq * IN1_N + g * 3072 + h * 128;
    R.O = OPp + ((size_t)g * CHUNK_T + rowq) * DM + h * 128; R.LSE = LSEp + ((size_t)g * CHUNK_T + rowq) * 8 + h;
    R.P0 = P0; R.bh = h; R.dsh = dsh;
    return R;
}

struct Args {
    const float* in[25]; float* out; unsigned char* ws; int ph_lo, ph_hi;
};
enum { I_X = 0, I_RELB, I_EWIN, I_CONVW, I_CONVB, I_CLNG, I_CLNB, I_EWOUT, I_ELN1G, I_ELN1B, I_FWG, I_FWU, I_FWD, I_ELN2G, I_ELN2B,
       I_OWIN, I_OWOUT, I_OLN1G, I_OLN1B, I_ROUTER, I_MWG, I_MWU, I_MWD, I_OLN2G, I_OLN2B };

__device__ __forceinline__ void transpose_item(const float* W, int ldw, int src_c0, int nvalid, int k0, bf16_t* WT, int K, int dst_row0, LAS float* scr, int lane) {
    (void)scr;
    const int kg = lane & 7, ng = lane >> 3;
    f32x4 v[8];
    const float* src = W + (size_t)(k0 + 8 * kg) * ldw + src_c0 + 4 * ng;
    const bool ok = 4 * ng < nvalid;
#pragma unroll
    for (int r = 0; r < 8; ++r) v[r] = ok ? *(const f32x4*)(src + (size_t)r * ldw) : (f32x4){0.f, 0.f, 0.f, 0.f};
#pragma unroll
    for (int c = 0; c < 4; ++c) { u32x4 o; o.x = cvt_pk_bf16(v[0][c], v[1][c]); o.y = cvt_pk_bf16(v[2][c], v[3][c]); o.z = cvt_pk_bf16(v[4][c], v[5][c]); o.w = cvt_pk_bf16(v[6][c], v[7][c]);
        *(u32x4*)(WT + (size_t)(dst_row0 + 4 * ng + c) * K + k0 + 8 * kg) = o; }
}
__device__ __forceinline__ void gu_item(const float* wg, const float* wu, int FF, int K, bf16_t* WT, int item, LAS float* scr, int lane) {
    const int nblk = 2 * FF / 32, kb = item / nblk, nb = item % nblk, tile = nb >> 3, sub = nb & 7;
    transpose_item(sub < 4 ? wg : wu, FF, tile * 128 + (sub & 3) * 32, 32, kb * 64, WT, K, nb * 32, scr, lane);
}
__device__ __forceinline__ void plain_item(const float* W, int K, int N, bf16_t* WT, int item, LAS float* scr, int lane) {
    const int nblk = N / 32, kb = item / nblk, nb = item % nblk;
    transpose_item(W, N, nb * 32, 32, kb * 64, WT, K, nb * 32, scr, lane);
}
__device__ __forceinline__ void in0_item(const float* W, bf16_t* WT, int item, LAS float* scr, int lane) {
    const int nblk = IN0_N / 32, kb = item / nblk, nb = item % nblk, tile = nb >> 3, sub = nb & 7;
    int src_c0, nvalid = 32;
    if (tile < 4) src_c0 = (sub < 4) ? tile * 128 + sub * 32 : 512 + tile * 128 + (sub - 4) * 32;
    else { src_c0 = nb * 32; nvalid = IN0_SRC - src_c0; nvalid = nvalid < 0 ? 0 : (nvalid > 32 ? 32 : nvalid); if (nvalid == 0) src_c0 = 0; }
    transpose_item(W, IN0_SRC, src_c0, nvalid, kb * 64, WT, DM, nb * 32, scr, lane);
}
__device__ __forceinline__ int rel_bucket(int n) {
    if (n < 16) return n;
    const float nf = (float)n;
    int large = 16 + (int)(logf(nf / 16.0f) / logf(128.0f) * 16.0f);
    return large < 31 ? large : 31;
}

__device__ __forceinline__ void ln_core(f32x4 (&v)[4], const float* g, const float* b, int lane) {
    float s = 0.f;
#pragma unroll
    for (int j = 0; j < 4; ++j) s += (v[j][0] + v[j][1]) + (v[j][2] + v[j][3]);
    const float mean = wave_sum(s) * (1.f / DM); float s2 = 0.f;
#pragma unroll
    for (int j = 0; j < 4; ++j) { v[j] = v[j] - mean; s2 += (v[j][0] * v[j][0] + v[j][1] * v[j][1]) + (v[j][2] * v[j][2] + v[j][3] * v[j][3]); }
    const float rstd = 1.f / sqrtf(wave_sum(s2) * (1.f / DM) + LN_EPS);
#pragma unroll
    for (int j = 0; j < 4; ++j) { const f32x4 gg = *(const f32x4*)(g + 4 * lane + 256 * j), bb = *(const f32x4*)(b + 4 * lane + 256 * j); v[j] = v[j] * rstd * gg + bb; }
}
__device__ __forceinline__ void store_row_bf16(bf16_t* orow, const f32x4 (&v)[4], int lane) {
#pragma unroll
    for (int j = 0; j < 4; ++j) { u32x2 w; w.x = cvt_pk_bf16(v[j][0], v[j][1]); w.y = cvt_pk_bf16(v[j][2], v[j][3]); *(u32x2*)(orow + 4 * lane + 256 * j) = w; }
}
__device__ __forceinline__ f32x4 ld_bf4(const bf16_t* p) { const u32x2 w = *(const u32x2*)p; return (f32x4){bf_lo(w.x), bf_hi(w.x), bf_lo(w.y), bf_hi(w.y)}; }

__device__ __forceinline__ int my_lane_asm() { int l; asm volatile("v_mbcnt_lo_u32_b32 %0, -1, 0\n\tv_mbcnt_hi_u32_b32 %0, -1, %0" : "=v"(l)); return l; }
__global__ void __launch_bounds__(NTHR, 2) fwd_kernel(Args args) {
    extern __shared__ __attribute__((aligned(16))) unsigned char lds_raw[];
    LAS unsigned char* lds = (LAS unsigned char*)lds_raw;
    const int G = gridDim.x, bid = blockIdx.x;
    const int NGW = G * NWAVES;
    volatile LAS unsigned* MISC = (volatile LAS unsigned*)(lds + LDS_MISC);
    const int wave_id = __builtin_amdgcn_readfirstlane((int)(threadIdx.x >> 6));
    {
        const int l0 = my_lane_asm();
        if (wave_id == 0 && l0 < 16) MISC[l0] = 0u;
        __syncthreads();
    }
#define MY_LANE() my_lane_asm()
#if ONE_LAUNCH
    (void)xcd_barrier_post((unsigned*)(args.ws + WS_CTL) + CW_BAR, MISC, wave_id == 0 && MY_LANE() == 0);
#define GRID_BAR() do { XcdBarrier _b; _b.bar = (unsigned*)(ws + WS_CTL) + CW_BAR; _b.x = xb_xcc_id(); _b.st = (volatile LAS unsigned*)(lds + LDS_MISC); xcd_barrier(_b, tid == 0); } while (0)
#else
#define GRID_BAR() do { } while (0)
#endif
    const int lo = args.ph_lo, hi = args.ph_hi;
#ifndef PH_MASK
#define PH_MASK 0xFFFFFFu
#endif
#define IN(k) ((((PH_MASK) >> (k)) & 1u) && lo <= (k) && (k) < hi)
#define BOTH(k) (IN(k) && IN((k) + 1))
#define PHASE_BEGIN int lane = MY_LANE(); asm volatile("" : "+v"(lane)); const int wave = wave_id; const int tid = wave * 64 + lane; const int gw = bid * NWAVES + wave; \
    size_t zoff_ = 0; asm volatile("" : "+s"(zoff_)); unsigned char* ws = args.ws + zoff_; float* outp = (float*)((unsigned char*)args.out + zoff_); unsigned* ctl = (unsigned*)(ws + WS_CTL); (void)lane; (void)wave; (void)gw; (void)ctl; (void)outp;
#define x_in (args.in[I_X])
#define WIN0 ((bf16_t*)(ws + WS_WIN0))
#define WOUT0 ((bf16_t*)(ws + WS_WOUT0))
#define WGU0 ((bf16_t*)(ws + WS_WGU0))
#define WD0 ((bf16_t*)(ws + WS_WD0))
#define WIN1 ((bf16_t*)(ws + WS_WIN1))
#define WOUT1 ((bf16_t*)(ws + WS_WOUT1))
#define MWGU ((bf16_t*)(ws + WS_MWGU))
#define MWD ((bf16_t*)(ws + WS_MWD))
#define BIAST ((float*)(ws + WS_BIAST))
#define XB ((bf16_t*)(ws + WS_XB))
#define Ub ((bf16_t*)(ws + WS_U))
#define Q0 ((bf16_t*)(ws + WS_Q0))
#define K0 ((bf16_t*)(ws + WS_Q0 + SEG0))
#define V0 ((bf16_t*)(ws + WS_Q0 + 2 * SEG0))
#define QI ((bf16_t*)(ws + WS_Q0 + 3 * SEG0))
#define KI ((bf16_t*)(ws + WS_KI))
#define WI ((float*)(ws + WS_WI))
#define MASK ((u64*)(ws + WS_MASK))
#define MIXIN ((bf16_t*)(ws + WS_MIXIN))
#define X1B ((bf16_t*)(ws + WS_X1B))
#define H0 ((bf16_t*)(ws + WS_H0))
#define X2B ((bf16_t*)(ws + WS_X2B))
#define H1 ((bf16_t*)(ws + WS_H1))
#define O1 ((bf16_t*)outp)
#define Y3 ((float*)(ws + WS_Y3))
#define X3B ((bf16_t*)(ws + WS_X3B))
#define YB ((bf16_t*)(ws + WS_YB))
#define MTOK ((int*)(ws + WS_MOE_TOK))
#define MGATE ((float*)(ws + WS_MOE_GATE))
#define GTAB ((const LAS int*)(lds + LDS_GTAB))

    if (IN(0)) { asm volatile("; PHASE_MARK 0"); PHASE_BEGIN
        LAS float* scr = (LAS float*)(lds + wave * 16384);
        constexpr int I_IN0 = 16 * (IN0_N / 32), I_OUT = 16 * 32, I_GU0 = 16 * (2 * FF0 / 32), I_D0 = (FF0 / 64) * 32, I_IN1 = 16 * (IN1_N / 32);
        constexpr int NIT = I_IN0 + I_OUT + I_GU0 + I_D0 + I_IN1 + I_OUT;
        for (int it = gw; it < NIT; it += NGW) {
            int r = it;
            if (r < I_IN0) { in0_item(args.in[I_EWIN], WIN0, r, scr, lane); continue; } r -= I_IN0;
            if (r < I_OUT) { plain_item(args.in[I_EWOUT], DM, DM, WOUT0, r, scr, lane); continue; } r -= I_OUT;
            if (r < I_GU0) { gu_item(args.in[I_FWG], args.in[I_FWU], FF0, DM, WGU0, r, scr, lane); continue; } r -= I_GU0;
            if (r < I_D0) { plain_item(args.in[I_FWD], FF0, DM, WD0, r, scr, lane); continue; } r -= I_D0;
            if (r < I_IN1) { plain_item(args.in[I_OWIN], DM, IN1_N, WIN1, r, scr, lane); continue; } r -= I_IN1;
            plain_item(args.in[I_OWOUT], DM, DM, WOUT1, r, scr, lane);
        }
        for (size_t i = (size_t)bid * NTHR + tid; i < (size_t)NTOK * DM / 8; i += (size_t)G * NTHR) {
            const f32x4 a = *(const f32x4*)(x_in + i * 8), b = *(const f32x4*)(x_in + i * 8 + 4);
            *(u32x4*)(XB + i * 8) = pg8::pack8(a, b);
        }
        for (int i = bid * NTHR + tid; i < 8 * 4096; i += G * NTHR) { const int h = i >> 12, d = i & 4095; BIAST[i] = args.in[I_RELB][rel_bucket(d) * 8 + h]; }
        if (BOTH(0)) GRID_BAR();
    }

    if (IN(1)) { asm volatile("; PHASE_MARK 1"); PHASE_BEGIN
        pg8::StaticOrder S; S.init(XB, NTOK, IN0_N, DM, G, bid);
        pg8::EpiIn0 E{Ub, Q0, KI, WI};
        pg8::gemm_phase<pg8::EpiIn0, pg8::StaticOrder, true, false>(tid, lds, WIN0, DM, S, E, GTAB);
        if (BOTH(1)) GRID_BAR();
    }

    if (IN(2)) { asm volatile("; PHASE_MARK 2"); PHASE_BEGIN
        {
            LAS bf16_t* ut = (LAS bf16_t*)lds;
            LAS float* yt = (LAS float*)(lds + 65536);
            const float* cw = args.in[I_CONVW]; const int c = tid;
            float w[31];
#pragma unroll
            for (int j = 0; j < 31; ++j) w[j] = cw[j * 512 + c];
            const float cb = args.in[I_CONVB][c];
            for (int tile = bid; tile < NTOK / 32; tile += G) {
                const int t0 = tile * 32, s0 = t0 & (SEQ - 1);
                for (int i = tid; i < 62 * 64; i += NTHR) { const int r = i >> 6, c8 = i & 63; const int sr = s0 - 30 + r;
                    u32x4 v = (u32x4){0u, 0u, 0u, 0u}; if (sr >= 0) v = *(const u32x4*)(Ub + (size_t)(t0 - 30 + r) * 512 + c8 * 8);
                    *(LAS u32x4*)(ut + r * 512 + c8 * 8) = v; }
                __syncthreads();
                for (int t = 0; t < 32; ++t) { float a = cb;
#pragma unroll
                    for (int j = 0; j < 31; ++j) a += w[j] * bf2f(ut[(t + j) * 512 + c]);
                    yt[t * 512 + c] = a; }
                __syncthreads();
                const float* lg = args.in[I_CLNG]; const float* lb = args.in[I_CLNB];
#pragma unroll
                for (int tt = 0; tt < 4; ++tt) { const int t = wave * 4 + tt;
                    f32x4 a = *(LAS f32x4*)(yt + t * 512 + lane * 8), b = *(LAS f32x4*)(yt + t * 512 + lane * 8 + 4);
                    float s = (a[0] + a[1]) + (a[2] + a[3]) + (b[0] + b[1]) + (b[2] + b[3]); const float mean = wave_sum(s) * (1.f / 512.f);
                    a = a - mean; b = b - mean; float s2 = a[0] * a[0] + a[1] * a[1] + a[2] * a[2] + a[3] * a[3] + b[0] * b[0] + b[1] * b[1] + b[2] * b[2] + b[3] * b[3];
                    const float rstd = 1.f / sqrtf(wave_sum(s2) * (1.f / 512.f) + LN_EPS);
                    const f32x4 g0 = *(const f32x4*)(lg + lane * 8), g1 = *(const f32x4*)(lg + lane * 8 + 4), b0 = *(const f32x4*)(lb + lane * 8), b1 = *(const f32x4*)(lb + lane * 8 + 4);
                    a = a * rstd * g0 + b0; b = b * rstd * g1 + b1;
#pragma unroll
                    for (int j = 0; j < 4; ++j) { a[j] = a[j] * sigmoidf_(a[j]); b[j] = b[j] * sigmoidf_(b[j]); }
                    *(u32x4*)(MIXIN + (size_t)(t0 + t) * DM + lane * 8) = pg8::pack8(a, b); }
                __syncthreads();
            }
        }
        {
            constexpr int CAP = 512, HROW = 2052;
            LAS unsigned* hist = (LAS unsigned*)lds;
            LAS unsigned* clist = hist;
            LAS unsigned* mtile = (LAS unsigned*)(lds + 16 * HROW * 4);
            LAS unsigned* rinfo = mtile + 2048;
            LAS unsigned* ccnt = rinfo + 64;
            LAS unsigned* flag = rinfo + 80;
            LAS unsigned* rsel = rinfo + 96;
            LAS unsigned* whist = rinfo + 256 + wave * 256;
            const int vcu = (G % 8 == 0) ? (bid % 8) * (G / 8) + bid / 8 : bid;
            const int lane_p = lane;
            for (int it = 0; it < 8 && vcu < 256; ++it) {
                int lane = lane_p; asm volatile("" : "+v"(lane));
                const int tid = wave * 64 + lane, g4 = lane >> 4, r16 = lane & 15;
                const int b = it, qt = (it & 1) ? 255 - vcu : vcu;
                const int q0 = qt * 16, tok0 = b * SEQ + q0, nwords = (q0 + 15) / 64 + 1, q = q0 + r16;
                if (q0 < 256) {
                    for (int i = tid; i < 16 * nwords; i += NTHR) { const int r = i & 15, W = i >> 4; const int d = q0 + r - 64 * W;
                        const u64 word = d >= 63 ? ~0ull : (d < 0 ? 0ull : ((2ull << d) - 1ull));
                        MASK[((size_t)b * 64 + W) * SEQ + q0 + r] = word; }
                    continue;
                }
                for (int i = tid; i < 16 * 64 * 2; i += NTHR) mtile[i] = 0u;
                if (tid < 16) ccnt[tid] = 0u;
                unsigned prefix = 0u; int shift = 21, shift_prev = 32, level = 0; bool collect = false;
#define KLOAD(dst, c_) do { const int W_ = wave + 8 * (c_); _Pragma("unroll") for (int u_ = 0; u_ < 4; ++u_) _Pragma("unroll") for (int c2_ = 0; c2_ < 2; ++c2_) \
                    dst[u_][c2_] = *(const bf16x8*)(KI + ((size_t)b * SEQ + 64 * W_ + 16 * u_ + r16) * 64 + c2_ * 32 + g4 * 8); } while (0)
#define STEP_LOOP(MODE) do { \
                    bf16x8 Qf[8][2]; float wq[8];                   \
                    _Pragma("unroll") for (int h = 0; h < 8; ++h) _Pragma("unroll") for (int c2 = 0; c2 < 2; ++c2) Qf[h][c2] = *(const bf16x8*)(QI + (size_t)(tok0 + r16) * 512 + h * 64 + c2 * 32 + g4 * 8); \
                    { const f32x4 w0 = *(const f32x4*)(WI + (size_t)(tok0 + r16) * 8), w1 = *(const f32x4*)(WI + (size_t)(tok0 + r16) * 8 + 4); \
                      wq[0] = w0[0]; wq[1] = w0[1]; wq[2] = w0[2]; wq[3] = w0[3]; wq[4] = w1[0]; wq[5] = w1[1]; wq[6] = w1[2]; wq[7] = w1[3]; } \
                    bf16x8 Kc[4][2], Kn[4][2]; \
                    if (nmine > 0) KLOAD(Kc, 0); \
                    for (int c = 0; c < nmine; ++c) { \
                        const int W = wave + 8 * c; \
                        if (c + 1 < nmine) KLOAD(Kn, c + 1); \
                        unsigned braw0 = 0u, braw1 = 0u; \
                        _Pragma("unroll") for (int u = 0; u < 4; ++u) { \
                            float scv[4] = {0.f, 0.f, 0.f, 0.f}; \
                            _Pragma("unroll") for (int h = 0; h < 8; ++h) { \
                                f32x4 t = __builtin_amdgcn_mfma_f32_16x16x32_bf16(Kc[u][0], Qf[h][0], (f32x4){0.f, 0.f, 0.f, 0.f}, 0, 0, 0); \
                                t = __builtin_amdgcn_mfma_f32_16x16x32_bf16(Kc[u][1], Qf[h][1], t, 0, 0, 0); \
                                _Pragma("unroll") for (int i = 0; i < 4; ++i) { const int ti = __float_as_int(t[i]); scv[i] += wq[h] * __int_as_float(ti > 0 ? ti : 0); } \
                            } \
                            const int dq = q - (64 * W + 16 * u + 4 * g4);            \
                            unsigned key[4]; \
                            _Pragma("unroll") for (int i = 0; i < 4; ++i) { const unsigned uu = __float_as_uint(scv[i] + 0.0f); key[i] = uu ^ ((unsigned)((int)uu >> 31) | 0x80000000u); } \
                            if (!collect) {                                    \
                                _Pragma("unroll") for (int i = 0; i < 4; ++i) { const bool m_ = (dq >= i) && (((key[i] ^ prefix) & pmask) == 0u); const unsigned a_ = m_ ? (((key[i] >> shift) & bmask) << 2) : (2050u << 2); \
                                    asm volatile("ds_add_u32 %0, %1" :: "v"(hrow + a_), "v"(1u) : "memory"); } \
                            } else { \
                                _Pragma("unroll") for (int i = 0; i < 4; ++i) { const bool valid = dq >= i; const unsigned kb_ = key[i] >> shift, pb_ = prefix >> shift; \
                                    const unsigned bit_ = (valid && kb_ > pb_) ? (1u << (16 * (u & 1) + i)) : 0u; if (u < 2) braw0 |= bit_; else braw1 |= bit_; \
                                    if (valid && kb_ == pb_) { const unsigned pos = __hip_atomic_fetch_add((unsigned*)(ccnt + r16), 1u, __ATOMIC_RELAXED, __HIP_MEMORY_SCOPE_WORKGROUP); \
                                        if (pos < (unsigned)CAP) { clist[(r16 * CAP + pos) * 2] = key[i]; clist[(r16 * CAP + pos) * 2 + 1] = (unsigned)(64 * W + 16 * u + 4 * g4 + i); } } } \
                            } \
                        } \
                        if (collect) { \
                            unsigned b0 = braw0 << (4 * g4), b1 = braw1 << (4 * g4); \
                            b0 |= (unsigned)__builtin_amdgcn_ds_swizzle((int)b0, (16 << 10) | 0x1f); b1 |= (unsigned)__builtin_amdgcn_ds_swizzle((int)b1, (16 << 10) | 0x1f); \
                            { auto r0 = __builtin_amdgcn_permlane32_swap(b0, b0, false, false); b0 = r0[0] | r0[1]; auto r1 = __builtin_amdgcn_permlane32_swap(b1, b1, false, false); b1 = r1[0] | r1[1]; } \
                            if (lane < 16) { mtile[(lane * 64 + W) * 2] = b0; mtile[(lane * 64 + W) * 2 + 1] = b1; } \
                        } \
                        _Pragma("unroll") for (int u = 0; u < 4; ++u) { Kc[u][0] = Kn[u][0]; Kc[u][1] = Kn[u][1]; } \
                    } } while (0)
                const int nmine = (nwords > wave) ? ((nwords - wave + 7) >> 3) : 0;
                const int lane_q = lane;
                for (int pass = 0; pass < 4; ++pass) {
                    int lane = lane_q; asm volatile("" : "+v"(lane));
                    const int tid = wave * 64 + lane, g4 = lane >> 4, r16 = lane & 15, q = q0 + r16;
                    const unsigned hrow = (unsigned)(uintptr_t)(hist + r16 * HROW);
                    if (!collect) { for (int i = tid; i < 16 * HROW; i += NTHR) hist[i] = 0u; if (tid < 4) flag[tid] = 0u; }
                    const unsigned bmask = (level == 2) ? 1023u : 2047u, pmask = (level == 0) ? 0u : (level == 1) ? 0xFFE00000u : 0xFFFFFC00u;
                    __syncthreads();
                    STEP_LOOP(0);
                    __syncthreads();
                    if (collect) break;
                    {
                        const int row = tid >> 5, seg = tid & 31; const LAS unsigned* hr = hist + row * HROW + seg * 64;
                        unsigned tot = 0u;
#pragma unroll 8
                        for (int j = 0; j < 64; ++j) tot += hr[j];
                        unsigned inc = tot;
#pragma unroll
                        for (int o = 1; o < 32; o <<= 1) { const unsigned t = lane_get(inc, (lane & 32) | ((seg + o) & 31)); if (seg + o < 32) inc += t; }
                        const unsigned exc = inc - tot, kk = (level == 0) ? 256u : rinfo[row * 4 + 1], pfx = (level == 0) ? 0u : rinfo[row * 4 + 0];
                        if (exc < kk && inc >= kk) {
                            unsigned cum = exc, bin = 0u, kn = kk, cb = 0u; bool done = false;
#pragma unroll 1
                            for (int j = 63; j >= 0 && !done; --j) { const unsigned cj = hr[j];
                                if (cum + cj >= kk) { bin = seg * 64 + j; kn = kk - cum; cb = cj; done = true; } else cum += cj; }
                            rinfo[row * 4 + 0] = pfx | (bin << shift); rinfo[row * 4 + 1] = kn; rinfo[row * 4 + 2] = cb;
                            if (cb > (unsigned)CAP && level < 2) __hip_atomic_fetch_or((unsigned*)flag, 1u, __ATOMIC_RELAXED, __HIP_MEMORY_SCOPE_WORKGROUP);
                        }
                    }
                    __syncthreads();
                    prefix = rinfo[r16 * 4 + 0];
                    const unsigned more = flag[0];
                    __syncthreads();
                    if (more) { shift_prev = shift; ++level; shift = (level == 1) ? 10 : 0; } else collect = true;
                }
#undef STEP_LOOP
#undef KLOAD
                for (int rr = 0; rr < 2; ++rr) {
                    int lane = lane_q; asm volatile("" : "+v"(lane));
                    const int row = wave * 2 + rr; unsigned cc = ccnt[row]; cc = cc > (unsigned)CAP ? (unsigned)CAP : cc; const int cn = (int)cc;
                    const LAS unsigned* cl = clist + row * CAP * 2;
                    unsigned pf = 0u; int kk = (int)rinfo[row * 4 + 1]; unsigned ties = 0u;
                    if (kk > cn) kk = cn;
                    if (kk > 0) {
                    for (int ps = 0; ps < 4; ++ps) {
                        const int sh = 24 - 8 * ps;
#pragma unroll
                        for (int j = 0; j < 4; ++j) whist[lane * 4 + j] = 0u;
                        WAVE_LDS_FENCE();
                        for (int i = lane; i < cn; i += 64) { const unsigned key = cl[i * 2];
                            const bool m = (ps == 0) || ((key >> (sh + 8)) == (pf >> (sh + 8)));
                            if (m) __hip_atomic_fetch_add((unsigned*)(whist + ((key >> sh) & 255u)), 1u, __ATOMIC_RELAXED, __HIP_MEMORY_SCOPE_WORKGROUP); }
                        WAVE_LDS_FENCE();
                        const unsigned c0 = whist[lane * 4 + 0], c1 = whist[lane * 4 + 1], c2 = whist[lane * 4 + 2], c3 = whist[lane * 4 + 3];
                        const unsigned sl = c0 + c1 + c2 + c3; unsigned inc = sl;
#pragma unroll
                        for (int o = 1; o < 64; o <<= 1) { const unsigned t = lane_get(inc, (lane + o) & 63); if (lane + o < 64) inc += t; }
                        const unsigned exc = inc - sl;
                        const bool found = (exc < (unsigned)kk) && (inc >= (unsigned)kk);
                        int bin = 0, kn = 0; unsigned cb = 0u;
                        { unsigned cum = exc;
                          if (cum + c3 >= (unsigned)kk) { bin = 3; kn = kk - (int)cum; cb = c3; } else { cum += c3;
                          if (cum + c2 >= (unsigned)kk) { bin = 2; kn = kk - (int)cum; cb = c2; } else { cum += c2;
                          if (cum + c1 >= (unsigned)kk) { bin = 1; kn = kk - (int)cum; cb = c1; } else { cum += c1; bin = 0; kn = kk - (int)cum; cb = c0; } } } }
                        const u64 fm = __ballot(found); const int src = fm ? (__ffsll((long long)fm) - 1) : 0;
                        bin = (int)lane_get((unsigned)(lane * 4 + bin), src); kk = (int)lane_get((unsigned)kn, src); ties = lane_get(cb, src);
                        pf |= ((unsigned)bin) << sh;
                        WAVE_LDS_FENCE();
                    }
                    unsigned cut = 0xFFFFFFFFu;
                    if (ties > (unsigned)kk) {
                        for (int i = lane; i < cn; i += 64) { if (cl[i * 2] == pf) { const unsigned myi = cl[i * 2 + 1]; int rank = 0;
                                for (int j = 0; j < cn; ++j) rank += (cl[j * 2] == pf && cl[j * 2 + 1] < myi) ? 1 : 0;
                                if (rank == kk - 1) rsel[row * 2 + 1] = myi; } }
                        WAVE_LDS_FENCE();
                        cut = rsel[row * 2 + 1];
                    }
                    for (int i = lane; i < cn; i += 64) { const unsigned key = cl[i * 2], kidx = cl[i * 2 + 1];
                        if (key > pf || (key == pf && kidx <= cut)) __hip_atomic_fetch_or((unsigned*)(mtile + (row * 64 + (kidx >> 6)) * 2 + ((kidx >> 5) & 1u)), 1u << (kidx & 31u), __ATOMIC_RELAXED, __HIP_MEMORY_SCOPE_WORKGROUP); }
                    }
                }
                __syncthreads();
                for (int i = tid; i < 16 * nwords; i += NTHR) { const int r = i & 15, W = i >> 4;
                    MASK[((size_t)b * 64 + W) * SEQ + q0 + r] = (u64)mtile[(r * 64 + W) * 2] | ((u64)mtile[(r * 64 + W) * 2 + 1] << 32); }
                __syncthreads();
            }
        }
        if (BOTH(2)) GRID_BAR();
    }

    if (IN(3)) { asm volatile("; PHASE_MARK 3"); PHASE_BEGIN
        const int vcu = (G % 8 == 0) ? (bid % 8) * (G / 8) + bid / 8 : bid;
        if (vcu < 256) {
            const int pp = vcu & 3, h = (vcu >> 2) & 7, b = vcu >> 5;
            { float* tb = (float*)(lds_raw + dsa::LDS_TB);
              for (int i = tid; i < dsa::TB_PAD + 4096; i += NTHR) tb[i] = (i >= dsa::TB_PAD) ? BIAST[h * 4096 + (i - dsa::TB_PAD)] * 8.0f : 0.f; }
            const bf16_t* Kp = K0 + (size_t)b * SEQ * 512 + h * 64; const bf16_t* Vp = V0 + (size_t)b * SEQ * 512 + h * 64;
#define DSA_REF(R, i_) do { const int qb_ = ((i_) == 0) ? pp : ((i_) == 1) ? 15 - pp : ((i_) == 2) ? pp + 4 : 11 - pp; const int P0_ = qb_ * 256; \
            R.Q = Q0 + ((size_t)b * SEQ + P0_) * 512 + h * 64; R.K = Kp; R.V = Vp; R.O = MIXIN + ((size_t)b * SEQ + P0_) * DM + 512 + h * 64; \
            R.MW = MASK + (size_t)b * 64 * SEQ + P0_; R.P0 = P0_; } while (0)
            dsa::Seam SS; dsa::BlockRef cur, nxt; DSA_REF(cur, 0);
            dsa::dsa_prime(cur, (char*)lds_raw, SS, tid);
            for (int i = 0; i < 4; ++i) {
                if (i < 3) { DSA_REF(nxt, i + 1); } else nxt = cur;
                dsa::dsa_block(cur, nxt, (char*)lds_raw, SS, tid);
                cur = nxt;
            }
#undef DSA_REF
        }
        if (BOTH(3)) GRID_BAR();
    }
    if (IN(4)) { asm volatile("; PHASE_MARK 4"); PHASE_BEGIN
        pg8::StaticOrder S; S.init(MIXIN, NTOK, DM, DM, G, bid);
        pg8::EpiRes E{(bf16_t*)outp, XB};
        pg8::gemm_phase<pg8::EpiRes, pg8::StaticOrder, true, false>(tid, lds, WOUT0, DM, S, E, GTAB);
        if (BOTH(4)) GRID_BAR();
    }
    if (IN(5)) { asm volatile("; PHASE_MARK 5"); PHASE_BEGIN
        for (int m = gw; m < NTOK; m += NGW) { f32x4 v[4];
#pragma unroll
            for (int j = 0; j < 4; ++j) v[j] = ld_bf4((const bf16_t*)outp + (size_t)m * DM + 4 * lane + 256 * j);
            ln_core(v, args.in[I_ELN1G], args.in[I_ELN1B], lane); store_row_bf16(X1B + (size_t)m * DM, v, lane); }
        if (BOTH(5)) GRID_BAR();
    }
    if (IN(6)) { asm volatile("; PHASE_MARK 6"); PHASE_BEGIN
        pg8::StaticOrder S; S.init(X1B, NTOK, 2 * FF0, DM, G, bid);
        pg8::EpiSwiglu<false> E{H0, FF0, (char*)outp, (char*)ws};
        pg8::gemm_phase<pg8::EpiSwiglu<false>, pg8::StaticOrder, true, false>(tid, lds, WGU0, DM, S, E, GTAB);
        if (BOTH(6)) GRID_BAR();
    }
    if (IN(7)) { asm volatile("; PHASE_MARK 7"); PHASE_BEGIN
        pg8::StaticOrder S; S.init(H0, NTOK, DM, FF0, G, bid);
        pg8::EpiRes E{(bf16_t*)outp, X1B};
        pg8::gemm_phase<pg8::EpiRes, pg8::StaticOrder, true, false>(tid, lds, WD0, FF0, S, E, GTAB);
        if (BOTH(7)) GRID_BAR();
    }
    if (IN(8)) { asm volatile("; PHASE_MARK 8"); PHASE_BEGIN
        for (int m = gw; m < NTOK; m += NGW) { f32x4 v[4];
#pragma unroll
            for (int j = 0; j < 4; ++j) v[j] = ld_bf4((const bf16_t*)outp + (size_t)m * DM + 4 * lane + 256 * j);
            ln_core(v, args.in[I_ELN2G], args.in[I_ELN2B], lane); store_row_bf16(X2B + (size_t)m * DM, v, lane); }
        if (BOTH(8)) GRID_BAR();
    }
#define MERGE_CHUNK(chm) do { \
        const bf16_t* OPp = (const bf16_t*)(ws + WS_OP); const float* LSEp = (const float*)(ws + WS_LSE); \
        for (int tl = gw; tl < CHUNK_T; tl += NGW) { const int hh = lane >> 3; \
            const float l0 = LSEp[(size_t)tl * 8 + hh], l1 = LSEp[((size_t)CHUNK_T + tl) * 8 + hh], l2 = LSEp[((size_t)2 * CHUNK_T + tl) * 8 + hh]; \
            const float mm = fmaxf(l0, fmaxf(l1, l2)); float w0 = __expf(l0 - mm), w1 = __expf(l1 - mm), w2 = __expf(l2 - mm); const float inv = 1.f / (w0 + w1 + w2); w0 *= inv; w1 *= inv; w2 *= inv; \
            const bf16_t* p0 = OPp + (size_t)tl * DM + lane * 16; const bf16_t* p1 = p0 + (size_t)CHUNK_T * DM; const bf16_t* p2 = p1 + (size_t)CHUNK_T * DM; \
            _Pragma("unroll") for (int q = 0; q < 2; ++q) { const u32x4 a = *(const u32x4*)(p0 + q * 8), b = *(const u32x4*)(p1 + q * 8), c = *(const u32x4*)(p2 + q * 8); u32x4 o; \
                o.x = cvt_pk_bf16(w0 * bf_lo(a.x) + w1 * bf_lo(b.x) + w2 * bf_lo(c.x), w0 * bf_hi(a.x) + w1 * bf_hi(b.x) + w2 * bf_hi(c.x)); \
                o.y = cvt_pk_bf16(w0 * bf_lo(a.y) + w1 * bf_lo(b.y) + w2 * bf_lo(c.y), w0 * bf_hi(a.y) + w1 * bf_hi(b.y) + w2 * bf_hi(c.y)); \
                o.z = cvt_pk_bf16(w0 * bf_lo(a.z) + w1 * bf_lo(b.z) + w2 * bf_lo(c.z), w0 * bf_hi(a.z) + w1 * bf_hi(b.z) + w2 * bf_hi(c.z)); \
                o.w = cvt_pk_bf16(w0 * bf_lo(a.w) + w1 * bf_lo(b.w) + w2 * bf_lo(c.w), w0 * bf_hi(a.w) + w1 * bf_hi(b.w) + w2 * bf_hi(c.w)); \
                *(u32x4*)(O1 + ((size_t)(chm) * CHUNK_T + tl) * DM + lane * 16 + q * 8) = o; } } } while (0)
#pragma unroll
    for (int ch = 0; ch < 2; ++ch) {
        if (IN(9 + 2 * ch)) { asm volatile("; PHASE_MARK 9"); PHASE_BEGIN
            if (ch == 1) { MERGE_CHUNK(0); }
            pg8::StaticOrder S; S.init(X2B + (size_t)ch * CHUNK_T * DM, CHUNK_T, IN1_N, DM, G, bid);
            pg8::EpiQkv1 E{H1, IN1_N, 1.0f};
            pg8::gemm_phase<pg8::EpiQkv1, pg8::StaticOrder, true, false>(tid, lds, WIN1, DM, S, E, GTAB);
            if (BOTH(9 + 2 * ch)) GRID_BAR();
        }
        if (IN(10 + 2 * ch)) { asm volatile("; PHASE_MARK 10"); PHASE_BEGIN
            constexpr int NU = CHUNK_B * 8 * 3 * 16;
            const int vcu = (G % 8 == 0) ? (bid % 8) * (G / 8) + bid / 8 : bid;
            bf16_t* OPp = (bf16_t*)(ws + WS_OP); float* LSEp = (float*)(ws + WS_LSE);
            int L0 = vcu;
            if (L0 < NU) {
                swa::Seam SS; swa::BlockRef cur = dil_ref(L0, H1, OPp, LSEp);
                swa::swa_prime(cur, BIAST, (char*)lds_raw, SS, tid);
                int slot = 0;
                for (;;) {
                    const int Ln = L0 + G; const bool last = Ln >= NU;
                    const swa::BlockRef nxt = last ? cur : dil_ref(Ln, H1, OPp, LSEp);
                    swa::swa_block(cur, nxt, BIAST, slot, (char*)lds_raw, SS, tid);
                    if (last) break;
                    cur = nxt; L0 = Ln; slot ^= 1;
                }
            }
            if (BOTH(10 + 2 * ch)) GRID_BAR();
        }
    }
    if (IN(13)) { asm volatile("; PHASE_MARK 13"); PHASE_BEGIN
        MERGE_CHUNK(1);
        if (BOTH(13)) GRID_BAR();
    }
    if (IN(14)) { asm volatile("; PHASE_MARK 14"); PHASE_BEGIN
        pg8::StaticOrder S; S.init(O1, NTOK, DM, DM, G, bid);
        pg8::EpiRes E{(bf16_t*)Y3, X2B};
        pg8::gemm_phase<pg8::EpiRes, pg8::StaticOrder, true, false>(tid, lds, WOUT1, DM, S, E, GTAB);
        if (BOTH(14)) GRID_BAR();
    }
    if (IN(15)) { asm volatile("; PHASE_MARK 15"); PHASE_BEGIN
        const float* rt = args.in[I_ROUTER];
        LAS unsigned* lcnt = (LAS unsigned*)lds;
        LAS unsigned* lbase = lcnt + 8;
        LAS int* lrow = (LAS int*)(lds + 256);
        LAS float* lgate = (LAS float*)(lds + 256 + 16384);
        if (tid < 8) lcnt[tid] = 0u;
        __syncthreads();
        int nloc = 0;
        for (int m = gw; m < NTOK; m += NGW, ++nloc) { f32x4 v[4];
#pragma unroll
            for (int j = 0; j < 4; ++j) v[j] = ld_bf4((const bf16_t*)Y3 + (size_t)m * DM + 4 * lane + 256 * j);
            ln_core(v, args.in[I_OLN1G], args.in[I_OLN1B], lane); store_row_bf16(X3B + (size_t)m * DM, v, lane);
            float lgt[8];
#pragma unroll
            for (int e = 0; e < 8; ++e) lgt[e] = 0.f;
#pragma unroll
            for (int j = 0; j < 4; ++j)
#pragma unroll
                for (int i = 0; i < 4; ++i) { const float* rr = rt + (size_t)(4 * lane + 256 * j + i) * 8; const f32x4 r0 = *(const f32x4*)rr, r1 = *(const f32x4*)(rr + 4); const float xv = v[j][i];
                    lgt[0] += xv * r0[0]; lgt[1] += xv * r0[1]; lgt[2] += xv * r0[2]; lgt[3] += xv * r0[3]; lgt[4] += xv * r1[0]; lgt[5] += xv * r1[1]; lgt[6] += xv * r1[2]; lgt[7] += xv * r1[3]; }
#pragma unroll
            for (int e = 0; e < 8; ++e) lgt[e] = wave_sum(lgt[e]);
            int e1 = 0; float v1 = lgt[0];
#pragma unroll
            for (int e = 1; e < 8; ++e) if (lgt[e] > v1) { v1 = lgt[e]; e1 = e; }
            int e2 = -1; float v2 = -INFINITY;
#pragma unroll
            for (int e = 0; e < 8; ++e) if (e != e1 && lgt[e] > v2) { v2 = lgt[e]; e2 = e; }
            const float g2 = 1.f / (1.f + __expf(v1 - v2)), g1 = 1.f - g2;
            if (lane == 0) { const int li = nloc * NWAVES + wave;
                const unsigned r1 = __hip_atomic_fetch_add((unsigned*)(lcnt + e1), 1u, __ATOMIC_RELAXED, __HIP_MEMORY_SCOPE_WORKGROUP), r2 = __hip_atomic_fetch_add((unsigned*)(lcnt + e2), 1u, __ATOMIC_RELAXED, __HIP_MEMORY_SCOPE_WORKGROUP);
                lrow[li * 4 + 0] = e1; lrow[li * 4 + 1] = (int)r1; lrow[li * 4 + 2] = e2; lrow[li * 4 + 3] = (int)r2; lgate[li * 2] = g1; lgate[li * 2 + 1] = g2; }
        }
        __syncthreads();
        if (tid < 8) lbase[tid] = atomicAdd(ctl + CW_MOECNT + tid, lcnt[tid]);
        __syncthreads();
        { const int nrows = (NTOK - bid * NWAVES + NGW - 1) / NGW;
          for (int li = tid; li < nrows * NWAVES; li += NTHR) { const int rnd = li / NWAVES, wv = li % NWAVES; const int m = (bid * NWAVES + wv) + rnd * NGW;
            if (m < NTOK) { const int e1 = lrow[li * 4 + 0], e2 = lrow[li * 4 + 2]; const unsigned p1 = lbase[e1] + (unsigned)lrow[li * 4 + 1], p2 = lbase[e2] + (unsigned)lrow[li * 4 + 3];
                if (p1 < (unsigned)NTOK) { MTOK[e1 * NTOK + p1] = m * 2; MGATE[e1 * NTOK + p1] = lgate[li * 2]; }
                if (p2 < (unsigned)NTOK) { MTOK[e2 * NTOK + p2] = m * 2 + 1; MGATE[e2 * NTOK + p2] = lgate[li * 2 + 1]; } } } }
        __syncthreads();
        {
            LAS float* scr = (LAS float*)(lds + wave * 16384);
            constexpr int I_GU = 16 * (2 * FFE / 32), I_D = (FFE / 64) * 32;
            for (int it = gw; it < NEXP * (I_GU + I_D); it += NGW) {
                const int e = it / (I_GU + I_D), r = it % (I_GU + I_D);
                if (r < I_GU) gu_item(args.in[I_MWG] + (size_t)e * DM * FFE, args.in[I_MWU] + (size_t)e * DM * FFE, FFE, DM, MWGU + (size_t)e * 2 * FFE * DM, r, scr, lane);
                else plain_item(args.in[I_MWD] + (size_t)e * FFE * DM, FFE, DM, MWD + (size_t)e * DM * FFE, r - I_GU, scr, lane);
            }
        }
        if (BOTH(15)) GRID_BAR();
    }
#pragma unroll
    for (int ch = 0; ch < 2; ++ch) {
        if (IN(16 + 2 * ch) || IN(17 + 2 * ch)) {
            LAS int* rt = (LAS int*)(lds + LDS_RT);
            int nM;
            { PHASE_BEGIN int ts[9]; int cn[8]; ts[0] = 0;
#pragma unroll
              for (int e = 0; e < 8; ++e) { int ce = __builtin_amdgcn_readfirstlane((int)ctl[CW_MOECNT + e]); ce = ce > NTOK ? NTOK : ce; cn[e] = ce; ts[e + 1] = ts[e] + (ce + 255) / 256; }
              const int t0 = ch * MOE_CH_TILES; int t1 = (ch == 0) ? MOE_CH_TILES : ts[8]; if (t1 > ts[8]) t1 = ts[8]; if (t1 > t0 + 136) t1 = t0 + 136; nM = __builtin_amdgcn_readfirstlane(t1 > t0 ? t1 - t0 : 0);
              if (tid < nM) { const int g = t0 + tid; int e = 0;
#pragma unroll
                  for (int k = 1; k < 8; ++k) e += (g >= ts[k]) ? 1 : 0;
                  int ce = cn[0], tse = ts[0];
#pragma unroll
                  for (int k = 1; k < 8; ++k) { ce = (e == k) ? cn[k] : ce; tse = (e == k) ? ts[k] : tse; }
                  const int j = g - tse; int nv = ce - j * 256; nv = nv > 256 ? 256 : nv;
                  rt[tid * 4 + 0] = e; rt[tid * 4 + 1] = e * NTOK + j * 256; rt[tid * 4 + 2] = nv; rt[tid * 4 + 3] = 0; } }
            __syncthreads();
            if (IN(16 + 2 * ch)) { asm volatile("; PHASE_MARK 16"); PHASE_BEGIN
                pg8::MoeOrder S{G, bid, nM, 2 * FFE / 256, rt, (const char*)X3B, (char*)outp, (char*)ws, true};
                LAS int* gtab = (LAS int*)(lds + LDS_GTAB);
                { pg8::Unit u; for (int i = 0; i < 16 && S.next(i, u); ++i) { if (tid < 256) { const int lb = rt[u.pm * 4 + 1], nv = rt[u.pm * 4 + 2]; const int r = tid < nv ? tid : 0; gtab[i * 256 + tid] = MTOK[lb + r] >> 1; } } }
                __syncthreads();
                pg8::EpiSwiglu<true> E{H0, FFE, (char*)outp, (char*)ws};
                pg8::gemm_phase<pg8::EpiSwiglu<true>, pg8::MoeOrder, true, true>(tid, lds, MWGU, DM, S, E, gtab);
                if (BOTH(16 + 2 * ch)) GRID_BAR();
            }
            if (IN(17 + 2 * ch)) { asm volatile("; PHASE_MARK 17"); PHASE_BEGIN
                pg8::MoeOrder S{G, bid, nM, DM / 256, rt, (const char*)X3B, (char*)outp, (char*)ws, false};
                pg8::EpiMoeDown E{YB, MTOK, MGATE, rt};
                pg8::gemm_phase<pg8::EpiMoeDown, pg8::MoeOrder, true, false>(tid, lds, MWD, FFE, S, E, GTAB);
                if (BOTH(17 + 2 * ch)) GRID_BAR();
            }
        }
    }
    if (IN(20)) { asm volatile("; PHASE_MARK 20"); PHASE_BEGIN
        for (int m = gw; m < NTOK; m += NGW) { f32x4 v[4];
#pragma unroll
            for (int j = 0; j < 4; ++j) { const size_t o = (size_t)m * DM + 4 * lane + 256 * j; v[j] = ld_bf4(X3B + o) * ALPHA + ld_bf4(YB + o) + ld_bf4(YB + (size_t)NTOK * DM + o); }
            ln_core(v, args.in[I_OLN2G], args.in[I_OLN2B], lane);
#pragma unroll
            for (int j = 0; j < 4; ++j) *(f32x4*)(outp + (size_t)m * DM + 4 * lane + 256 * j) = v[j]; }
    }
#undef IN
#undef BOTH
}

constexpr int NPHASES = 21;
extern "C" void kernel_launch(void* const* d_in, const int* in_sizes, int n_in, void* d_out, int out_size, void* d_ws, size_t ws_size, hipStream_t stream) {
    static int grid = 0;
    if (grid == 0) {
        if (n_in != 25 || out_size != NTOK * DM || ws_size < WS_END) { fprintf(stderr, "kernel_launch: unexpected shapes (n_in %d out %d ws %zu)\n", n_in, out_size, ws_size); grid = -1; return; }
        int dev = 0, cus = 0;
        if (hipGetDevice(&dev) != hipSuccess || hipDeviceGetAttribute(&cus, hipDeviceAttributeMultiprocessorCount, dev) != hipSuccess) { grid = -1; return; }
        if (hipFuncSetAttribute((const void*)fwd_kernel, hipFuncAttributeMaxDynamicSharedMemorySize, LDS_BYTES) != hipSuccess) { fprintf(stderr, "kernel_launch: hipFuncSetAttribute failed\n"); grid = -1; return; }
        int per_cu = 0;
        if (hipOccupancyMaxActiveBlocksPerMultiprocessor(&per_cu, (const void*)fwd_kernel, NTHR, LDS_BYTES) != hipSuccess || per_cu < 1) { fprintf(stderr, "kernel_launch: occupancy query says %d\n", per_cu); }
        (void)hipGetLastError();
        grid = cus;
    }
    if (grid < 0) return;
    (void)hipMemsetAsync((char*)d_ws + WS_CTL, 0, CTL_ZERO_BYTES, stream);
    Args a{};
    for (int i = 0; i < 25; ++i) a.in[i] = (const float*)d_in[i];
    a.out = (float*)d_out; a.ws = (unsigned char*)d_ws;
#if ONE_LAUNCH
    a.ph_lo = 0; a.ph_hi = NPHASES;
    hipLaunchKernelGGL(fwd_kernel, dim3(grid), dim3(NTHR), LDS_BYTES, stream, a);
#else
    for (int ph = 0; ph < NPHASES; ++ph) { a.ph_lo = ph; a.ph_hi = ph + 1; for (int rep = 0; rep < (((DUP_MASK) >> ph) & 1u ? 2 : 1); ++rep) hipLaunchKernelGGL(fwd_kernel, dim3(grid), dim3(NTHR), LDS_BYTES, stream, a); }
#endif
}
```

```cpp
#include <hip/hip_runtime.h>
#include <cstdio>
#include <cstdint>

#ifndef ONE_LAUNCH
#define ONE_LAUNCH 1
#endif
#ifndef DUP_MASK
#define DUP_MASK 0u
#endif

#define LAS __attribute__((address_space(3)))
typedef unsigned short bf16_t;
typedef short bf16x8 __attribute__((ext_vector_type(8)));
typedef float f32x4 __attribute__((ext_vector_type(4)));
typedef float f32x2 __attribute__((ext_vector_type(2)));
typedef unsigned u32x4 __attribute__((ext_vector_type(4)));
typedef unsigned u32x2 __attribute__((ext_vector_type(2)));
typedef unsigned long long u64;

constexpr int NB = 8, SEQ = 4096, DM = 1024, NTOK = NB * SEQ;
constexpr int IN0_SRC = 3144, IN0_N = 3328;
constexpr int FF0 = 2816, FFE = 3584, NEXP = 8;
constexpr int IN1_N = 9216;
constexpr int CHUNK_B = 4, CHUNK_T = CHUNK_B * SEQ;
constexpr int MOE_CH_TILES = 128;
constexpr int HM_DOUT_TILES = 73;
constexpr float ALPHA = 1.4142135623730951f;
constexpr float LN_EPS = 1e-5f;
constexpr int NWAVES = 8, NTHR = 512;

constexpr size_t MiB = 1u << 20;
constexpr size_t WS_CTL = 0, CTL_ZERO_BYTES = 64 * 1024;
constexpr size_t WS_BIAST = 1 * MiB;
constexpr size_t WS_MOE_TOK = 2 * MiB;
constexpr size_t WS_MOE_GATE = 3 * MiB;
constexpr size_t WS_WIN0 = 4 * MiB;
constexpr size_t WS_WOUT0 = 11 * MiB;
constexpr size_t WS_WGU0 = 13 * MiB;
constexpr size_t WS_WD0 = 24 * MiB;
constexpr size_t WS_WIN1 = 30 * MiB;
constexpr size_t WS_WOUT1 = 48 * MiB;
constexpr size_t WS_XB = 50 * MiB;
constexpr size_t WS_U = 114 * MiB;
constexpr size_t WS_Q0 = 146 * MiB, SEG0 = 32 * MiB;
constexpr size_t WS_KI = 274 * MiB;
constexpr size_t WS_WI = 278 * MiB;
constexpr size_t WS_MASK = 280 * MiB;
constexpr size_t WS_MIXIN = 296 * MiB;
constexpr size_t WS_KS = 384 * MiB;
constexpr size_t WS_X1B = 50 * MiB;
constexpr size_t WS_H0 = 114 * MiB;
constexpr size_t WS_X2B = 448 * MiB;
constexpr size_t WS_H1 = 50 * MiB;
constexpr size_t WS_OP = 338 * MiB;
constexpr size_t WS_LSE = 434 * MiB;
constexpr size_t WS_Y3 = 216 * MiB;
constexpr size_t WS_X3B = 152 * MiB;
constexpr size_t WS_YB = 216 * MiB;
constexpr size_t WS_MWGU = 344 * MiB;
constexpr size_t WS_MWD = 456 * MiB;
constexpr size_t WS_HM = 4 * MiB;
constexpr size_t WS_END = 512 * MiB;
constexpr size_t HM_TILE_BYTES = (size_t)256 * FFE * 2;
constexpr int CW_MOECNT = 64;
constexpr int CW_BAR = 1024;

constexpr int LDS_GTAB = 131072;
constexpr int LDS_RT = 147456;
constexpr int LDS_MISC = 155648 + 2048;
constexpr int LDS_BYTES = 159744;

__device__ __forceinline__ unsigned cvt_pk_bf16(float lo, float hi) { unsigned r; asm volatile("v_cvt_pk_bf16_f32 %0, %1, %2" : "=v"(r) : "v"(lo), "v"(hi)); return r; }
__device__ __forceinline__ float bf_lo(unsigned w) { return __uint_as_float(w << 16); }
__device__ __forceinline__ float bf_hi(unsigned w) { return __uint_as_float(w & 0xffff0000u); }
__device__ __forceinline__ float bf2f(bf16_t b) { return __uint_as_float(((unsigned)b) << 16); }
template <int M> __device__ __forceinline__ float swz_xor(float v) {
    return __int_as_float(__builtin_amdgcn_ds_swizzle(__float_as_int(v), (M << 10) | 0x1f)); }
__device__ __forceinline__ float wave_sum(float v) {
    v += swz_xor<1>(v); v += swz_xor<2>(v); v += swz_xor<4>(v); v += swz_xor<8>(v); v += swz_xor<16>(v);
    auto rr = __builtin_amdgcn_permlane32_swap(__float_as_uint(v), __float_as_uint(v), false, false);
    return __uint_as_float(rr[0]) + __uint_as_float(rr[1]);
}
__device__ __forceinline__ float wave_max(float v) {
    v = fmaxf(v, swz_xor<1>(v)); v = fmaxf(v, swz_xor<2>(v)); v = fmaxf(v, swz_xor<4>(v)); v = fmaxf(v, swz_xor<8>(v)); v = fmaxf(v, swz_xor<16>(v));
    auto rr = __builtin_amdgcn_permlane32_swap(__float_as_uint(v), __float_as_uint(v), false, false);
    return fmaxf(__uint_as_float(rr[0]), __uint_as_float(rr[1]));
}
__device__ __forceinline__ unsigned lane_get(unsigned v, int src_lane) { return (unsigned)__builtin_amdgcn_ds_bpermute(src_lane << 2, (int)v); }
__device__ __forceinline__ float sigmoidf_(float x) { return __builtin_amdgcn_rcpf(1.0f + __expf(-x)); }
#define WAVE_LDS_FENCE() do { asm volatile("s_waitcnt lgkmcnt(0)" ::: "memory"); __builtin_amdgcn_wave_barrier(); } while (0)

#define XB_TMO      128
#define XB_XCNT(j)  (256  + 64 * (j))
#define XB_XSUB(j)  (1280 + 64 * (j))
#define XB_XGEN(j)  (2304 + 64 * (j))
#define XB_TOP      3328
#define XB_TOPGEN   3392
#define XCD_BAR_WORDS 3456
#define XB_SPIN_CAP (1u << 18)
__device__ __forceinline__ unsigned xb_ld(unsigned* p)              { return __hip_atomic_load(p, __ATOMIC_RELAXED, __HIP_MEMORY_SCOPE_AGENT); }
__device__ __forceinline__ unsigned xb_add(unsigned* p, unsigned v) { return __hip_atomic_fetch_add(p, v, __ATOMIC_RELAXED, __HIP_MEMORY_SCOPE_AGENT); }
__device__ __forceinline__ unsigned xb_xcc_id() { return (unsigned)__builtin_amdgcn_s_getreg((3 << 11) | 20) & 0xFu; }
#define XB_SPIN(cond, bar) do { unsigned _sp = 0; while (cond) { __builtin_amdgcn_s_sleep(1); \
    if ((++_sp & 255u) == 0u) { if (xb_ld(&(bar)[XB_TMO])) break; if (_sp > XB_SPIN_CAP) { atomicAdd(&(bar)[XB_TMO], 1u); break; } } } } while (0)
struct XcdBarrier { unsigned* bar; unsigned x; volatile LAS unsigned* st; };
__device__ __forceinline__ XcdBarrier xcd_barrier_post(unsigned* bar, volatile LAS unsigned* st, bool leader) {
    XcdBarrier b; b.bar = bar; b.x = xb_xcc_id(); b.st = st;
    if (leader) (void)xb_add(&bar[XB_XCNT(b.x)], 1u);
    return b;
}
__device__ __forceinline__ void xcd_barrier_complete(unsigned* bar, unsigned x, unsigned& nloc, unsigned& nx) {
    const unsigned G = gridDim.x * gridDim.y * gridDim.z;
    unsigned sum, cnt, mine, sp = 0u;
    for (;;) {
        sum = 0u; cnt = 0u; mine = 0u;
#pragma unroll
        for (unsigned j = 0; j < 16; ++j) { const unsigned c = xb_ld(&bar[XB_XCNT(j)]); sum += c; cnt += (c > 0u) ? 1u : 0u; mine = (j == x) ? c : mine; }
        if (sum == G) break;
        __builtin_amdgcn_s_sleep(1);
        if ((++sp & 255u) == 0u) { if (xb_ld(&bar[XB_TMO])) break; if (sp > XB_SPIN_CAP) { atomicAdd(&bar[XB_TMO], 1u); break; } }
    }
    nloc = mine > 0u ? mine : 1u; nx = cnt > 0u ? cnt : 1u;
}
__device__ __forceinline__ void xcd_barrier(const XcdBarrier& b, bool leader) {
    asm volatile("s_waitcnt vmcnt(0)" ::: "memory");
    __syncthreads();
    if (leader) {
        unsigned* bar = b.bar;
        __builtin_amdgcn_s_waitcnt(0);
        unsigned nloc = b.st[0], nx = b.st[1];
        if (nloc == 0u) { xcd_barrier_complete(bar, b.x, nloc, nx); b.st[0] = nloc; b.st[1] = nx; }
        const unsigned old = xb_add(&bar[XB_XSUB(b.x)], 1u);
        const unsigned gen = old / nloc;
        if (old + 1u == (gen + 1u) * nloc) {
            __builtin_amdgcn_fence(__ATOMIC_RELEASE, "agent");
            asm volatile("s_waitcnt vmcnt(0)" ::: "memory");
            const unsigned og = xb_add(&bar[XB_TOP], 1u);
            const unsigned tg = og / nx;
            if (og + 1u == (tg + 1u) * nx) xb_add(&bar[XB_TOPGEN], 1u);
            else XB_SPIN(xb_ld(&bar[XB_TOPGEN]) == tg, bar);
            __builtin_amdgcn_fence(__ATOMIC_ACQUIRE, "agent");
            xb_add(&bar[XB_XGEN(b.x)], 1u);
            asm volatile("s_waitcnt vmcnt(0)" ::: "memory");
        } else {
            XB_SPIN(xb_ld(&bar[XB_XGEN(b.x)]) == gen, bar);
            __builtin_amdgcn_fence(__ATOMIC_ACQUIRE, "agent");
            asm volatile("s_waitcnt vmcnt(0)" ::: "memory");
        }
    }
    __syncthreads();
}

namespace pg8 {
constexpr int BM = 256, BK = 64, HALF = 128, HTB = HALF * BK * 2, STAGE_BYTES = 8 * HTB, NXCD = 8, WGM = 8;
__host__ __device__ __forceinline__ int lds_byte(int r, int c) { const int st = (r >> 4) * 2 + (c >> 5), rr = r & 15, cc = c & 31, ob = rr * 64 + cc * 2; return st * 1024 + (ob ^ (((ob >> 9) & 1) << 5)); }
__host__ __device__ __forceinline__ void stage_rc(int b, int& R, int& C) { const int st = b / 1024, sb = b % 1024, swz = sb ^ (((sb >> 9) & 1) << 5); R = (st >> 1) * 16 + swz / 64; C = (st & 1) * 32 + (swz % 64) / 2; }
__host__ __device__ __forceinline__ int perm32(int rho) { const int n = rho >> 4, i = rho & 15; return 8 * (i >> 2) + 4 * n + (i & 3); }

struct Unit { int pm, pn; };

__device__ __forceinline__ void remap_unit(int wgid, int nM, int nN, int& pm, int& pn) {
    const int nwg = nM * nN;
    { const int q = nwg / NXCD, r = nwg % NXCD, xcd = wgid % NXCD, off = wgid / NXCD; wgid = (xcd < r ? xcd * (q + 1) : r * (q + 1) + (xcd - r) * q) + off; }
    const int nig = WGM * nN, gid = wgid / nig, fm = gid * WGM, gsz = (nM - fm) < WGM ? (nM - fm) : WGM;
    pm = fm + ((wgid % nig) % gsz); pn = (wgid % nig) / gsz;
}
struct StaticOrder {
    int nM, nN, nwg, G, c; const char* A; size_t tstepA;
    __device__ void init(const bf16_t* A_, int M, int N, int K, int G_, int c_) { nM = M / BM; nN = N / BM; nwg = nM * nN; G = G_; c = c_; A = (const char*)A_; tstepA = (size_t)BM * K * 2; }
    __device__ __forceinline__ bool next(int i, Unit& u) const {
        const long L = (long)i * G + c; if (L >= nwg) return false;
        remap_unit((int)L, nM, nN, u.pm, u.pn); return true;
    }
    __device__ __forceinline__ const char* a_ptr(const Unit& u) const { return A + (size_t)u.pm * tstepA; }
    __device__ __forceinline__ int b_tile(const Unit& u) const { return u.pn; }
};

#define PG8_LAS __attribute__((address_space(3)))
template <class Epi, class Sched, bool ALIGN_EPI, bool GATHER>
__device__ __forceinline__ void gemm_phase(const int tid, PG8_LAS unsigned char* lds, const bf16_t* Btp, const int K, const Sched& S, const Epi& E, const PG8_LAS int* gtab) {
    const int wid = __builtin_amdgcn_readfirstlane(tid >> 6), lane = tid & 63, wr = wid >> 2, wc = wid & 3, fr = lane & 15, fq = lane >> 4;
    const int nt = K / BK;
    unsigned voffA[2], voffB[2];
#pragma unroll
    for (int i = 0; i < 2; ++i) { int R, C; stage_rc(tid * 16 + i * 8192, R, C); const int Rb = Epi::PERM ? ((R & ~31) + perm32(R & 31)) : R;
        voffA[i] = (unsigned)(R * K + C) * 2u; voffB[i] = (unsigned)(Rb * K + C) * 2u; }
    const size_t kstep = (size_t)(BK * 2);
    const size_t hstep = (size_t)HALF * K * 2;
    const size_t tstep = 2 * hstep;
    const unsigned ldsw = (unsigned)wid * 1024u;
    const int aoff = lds_byte(wr * 64 + fr, fq * 8), boff = lds_byte(wc * 32 + fr, fq * 8);
#define PG8_SA(b, h) (((b) * 2 + (h)) * HTB)
#define PG8_SB(b, h) ((4 + (b) * 2 + (h)) * HTB)
#define PG8_STAGE(bufoff, gbase, voff) do { _Pragma("unroll") for (int _i = 0; _i < 2; ++_i) \
        __builtin_amdgcn_global_load_lds((const unsigned*)((const char*)(gbase) + (voff)[_i]), (PG8_LAS unsigned*)(lds + (bufoff) + ldsw + _i * 8192), 16, 0, 0); } while (0)
#define PG8_STAGE_AC(bufoff, kt, h) do { if constexpr (GATHER) { PG8_STAGE(bufoff, cA + (size_t)(kt) * kstep, gcur[h]); } else { PG8_STAGE(bufoff, cA + (size_t)(kt) * kstep + (h) * hstep, voffA); } } while (0)
#define PG8_STAGE_AN(bufoff, d, h) do { if constexpr (GATHER) { if (last) { unsigned _g[2]; _Pragma("unroll") for (int _i = 0; _i < 2; ++_i) { int _R, _C; stage_rc(tid * 16 + _i * 8192, _R, _C); _g[_i] = (unsigned)gtab[nslot * 256 + (h) * 128 + _R] * (unsigned)(K * 2) + (unsigned)(_C * 2); } \
            PG8_STAGE(bufoff, nA + (size_t)(d) * kstep, _g); } else { PG8_STAGE(bufoff, cA + (size_t)(t + 2 + (d)) * kstep, gcur[h]); } } \
        else { PG8_STAGE(bufoff, a2 + (size_t)(d) * kstep + (h) * hstep, voffA); } } while (0)
#define PG8_LDA(dst, b, h) do { _Pragma("unroll") for (int m = 0; m < 4; ++m) _Pragma("unroll") for (int k = 0; k < 2; ++k) dst[m][k] = *(const PG8_LAS bf16x8*)(lds + PG8_SA(b, h) + aoff + m * 2048 + k * 1024); } while (0)
#define PG8_LDB(dst, b, h) do { _Pragma("unroll") for (int n = 0; n < 2; ++n) _Pragma("unroll") for (int k = 0; k < 2; ++k) dst[n][k] = *(const PG8_LAS bf16x8*)(lds + PG8_SB(b, h) + boff + n * 2048 + k * 1024); } while (0)
#define PG8_MMA(ai, bj, At, Bt) do { __builtin_amdgcn_s_setprio(1); _Pragma("unroll") for (int m = 0; m < 4; ++m) _Pragma("unroll") for (int n = 0; n < 2; ++n) _Pragma("unroll") for (int k = 0; k < 2; ++k) \
        acc[ai][bj][m][n] = __builtin_amdgcn_mfma_f32_16x16x32_bf16(Bt[n][k], At[m][k], acc[ai][bj][m][n], 0, 0, 0); __builtin_amdgcn_s_setprio(0); } while (0)
#define PG8_WAIT_V(n) asm volatile("s_waitcnt vmcnt(" #n ")" ::: "memory")
#define PG8_WAIT_L(n) asm volatile("s_waitcnt lgkmcnt(" #n ")" ::: "memory")
#define PG8_BAR __builtin_amdgcn_s_barrier()
#define PG8_SCHED __builtin_amdgcn_sched_barrier(0)
#define PG8_LOADG(dst, slot_) do { _Pragma("unroll") for (int _i = 0; _i < 2; ++_i) { int _R, _C; stage_rc(tid * 16 + _i * 8192, _R, _C); _Pragma("unroll") for (int _h = 0; _h < 2; ++_h) \
        dst[_h][_i] = (unsigned)gtab[(slot_) * 256 + _h * 128 + _R] * (unsigned)(K * 2) + (unsigned)(_C * 2); } } while (0)
    Unit cur, nxt; int ui = 0;
    if (!S.next(0, cur)) return;
    f32x4 acc[2][2][4][2];
#pragma unroll
    for (int a = 0; a < 2; ++a)
#pragma unroll
        for (int b = 0; b < 2; ++b)
#pragma unroll
            for (int m = 0; m < 4; ++m)
#pragma unroll
                for (int n = 0; n < 2; ++n) acc[a][b][m][n] = (f32x4){0.f, 0.f, 0.f, 0.f};
    bf16x8 At[4][2], B0[2][2], B1[2][2];
    unsigned gcur[2][2] = {{0u, 0u}, {0u, 0u}};
    const char* cA = S.a_ptr(cur); const char* cB = (const char*)Btp + (size_t)S.b_tile(cur) * tstep;
    if constexpr (GATHER) { PG8_LOADG(gcur, 0); PG8_WAIT_L(0); }
    PG8_STAGE(PG8_SB(0, 0), cB, voffB); PG8_STAGE(PG8_SB(0, 1), cB + hstep, voffB); PG8_STAGE_AC(PG8_SA(0, 0), 0, 0); PG8_STAGE_AC(PG8_SA(0, 1), 0, 1);
    if (wr == 1) PG8_BAR;
    PG8_WAIT_V(2); PG8_BAR;
    PG8_STAGE(PG8_SB(1, 0), cB + kstep, voffB); PG8_STAGE_AC(PG8_SA(1, 0), 1, 0); PG8_STAGE(PG8_SB(1, 1), cB + hstep + kstep, voffB);
    PG8_WAIT_V(6); PG8_BAR;
    for (;;) {
        const bool has_next = S.next(ui + 1, nxt);
        const char* nA = has_next ? S.a_ptr(nxt) : cA; const char* nB = has_next ? (const char*)Btp + (size_t)S.b_tile(nxt) * tstep : cB;
        const int nslot = has_next ? ui + 1 : ui;
        for (int t = 0; t < nt; t += 2) {
            const bool last = (t == nt - 2);
            const char* a2 = last ? nA : cA + (size_t)(t + 2) * kstep; const char* b2 = last ? nB : cB + (size_t)(t + 2) * kstep;
            const char* b3 = b2 + kstep;
            (void)a2;
            PG8_LDB(B0, 0, 0); PG8_LDB(B1, 0, 1); PG8_SCHED; PG8_LDA(At, 0, 0); PG8_STAGE_AC(PG8_SA(1, 1), t + 1, 1);
            PG8_WAIT_V(8); PG8_WAIT_L(0); PG8_BAR; PG8_MMA(0, 0, At, B0); PG8_MMA(0, 1, At, B1); PG8_BAR; PG8_SCHED;
            PG8_LDA(At, 0, 1); PG8_STAGE(PG8_SB(0, 0), b2, voffB); PG8_STAGE(PG8_SB(0, 1), b2 + hstep, voffB); PG8_STAGE_AN(PG8_SA(0, 0), 0, 0);
            PG8_WAIT_V(8); PG8_WAIT_L(0); PG8_BAR; PG8_MMA(1, 0, At, B0); PG8_MMA(1, 1, At, B1); PG8_BAR; PG8_SCHED;
            PG8_LDB(B0, 1, 0); PG8_LDB(B1, 1, 1); PG8_SCHED; PG8_LDA(At, 1, 0); PG8_STAGE_AN(PG8_SA(0, 1), 0, 1);
            PG8_WAIT_V(8); PG8_WAIT_L(0); PG8_BAR; PG8_MMA(0, 0, At, B0); PG8_MMA(0, 1, At, B1); PG8_BAR; PG8_SCHED;
            PG8_LDA(At, 1, 1); PG8_STAGE(PG8_SB(1, 0), b3, voffB); PG8_STAGE(PG8_SB(1, 1), b3 + hstep, voffB); PG8_STAGE_AN(PG8_SA(1, 0), 1, 0);
            PG8_WAIT_V(8); PG8_WAIT_L(0); PG8_BAR; PG8_MMA(1, 0, At, B0); PG8_MMA(1, 1, At, B1); PG8_BAR; PG8_SCHED;
        }
        if constexpr (ALIGN_EPI) { if (wr == 0) PG8_BAR; }
        { int fr_e = fr, fq_e = fq; asm volatile("" : "+v"(fr_e), "+v"(fq_e)); E(acc, cur, wr, wc, fr_e, fq_e); }
        if (!has_next) break;
#pragma unroll
        for (int a = 0; a < 2; ++a)
#pragma unroll
            for (int b = 0; b < 2; ++b)
#pragma unroll
                for (int m = 0; m < 4; ++m)
#pragma unroll
                    for (int n = 0; n < 2; ++n) acc[a][b][m][n] = (f32x4){0.f, 0.f, 0.f, 0.f};
        cur = nxt; cA = nA; cB = nB; ++ui;
        if constexpr (GATHER) { PG8_LOADG(gcur, ui); }
        if constexpr (ALIGN_EPI) { if (wr == 1) PG8_BAR; }
    }
    PG8_WAIT_V(0);
    if constexpr (!ALIGN_EPI) { if (wr == 0) PG8_BAR; }
    PG8_BAR;
#undef PG8_SA
#undef PG8_SB
#undef PG8_STAGE
#undef PG8_STAGE_AC
#undef PG8_STAGE_AN
#undef PG8_LDA
#undef PG8_LDB
#undef PG8_MMA
#undef PG8_WAIT_V
#undef PG8_WAIT_L
#undef PG8_BAR
#undef PG8_SCHED
#undef PG8_LOADG
}

typedef f32x4 AccT[2][2][4][2];
__device__ __forceinline__ u32x4 pack8(const f32x4 v0, const f32x4 v1) { u32x4 w; w.x = cvt_pk_bf16(v0[0], v0[1]); w.y = cvt_pk_bf16(v0[2], v0[3]); w.z = cvt_pk_bf16(v1[0], v1[1]); w.w = cvt_pk_bf16(v1[2], v1[3]); return w; }

struct EpiIn0 {
    static constexpr bool PERM = true;
    bf16_t* U; bf16_t* Q; bf16_t* KI; float* WI;
    __device__ __forceinline__ void operator()(const AccT& acc, const Unit& u, int wr, int wc, int fr, int fq) const {
        const int row0 = u.pm * BM + wr * 64 + fr;
        if (u.pn < 4) {
            const int col0 = u.pn * 128 + wc * 32 + 8 * fq;
#pragma unroll
            for (int ai = 0; ai < 2; ++ai)
#pragma unroll
                for (int m = 0; m < 4; ++m) { f32x4 o0, o1;
#pragma unroll
                    for (int j = 0; j < 4; ++j) { o0[j] = acc[ai][0][m][0][j] * sigmoidf_(acc[ai][1][m][0][j]); o1[j] = acc[ai][0][m][1][j] * sigmoidf_(acc[ai][1][m][1][j]); }
                    *(u32x4*)(U + (size_t)(row0 + ai * HALF + m * 16) * 512 + col0) = pack8(o0, o1); }
        } else if (u.pn < 12) {
            const int t = (u.pn - 4) >> 1; bf16_t* base = Q + (size_t)t * (SEG0 / 2); const float sc = 1.0f;
            const int col0 = ((u.pn - 4) & 1) * 256 + wc * 32 + 8 * fq;
#pragma unroll
            for (int ai = 0; ai < 2; ++ai)
#pragma unroll
                for (int m = 0; m < 4; ++m)
#pragma unroll
                    for (int bj = 0; bj < 2; ++bj)
                        *(u32x4*)(base + (size_t)(row0 + ai * HALF + m * 16) * 512 + col0 + bj * HALF) = pack8(acc[ai][bj][m][0] * sc, acc[ai][bj][m][1] * sc);
        } else {
            if (wc < 2) {
#pragma unroll
                for (int ai = 0; ai < 2; ++ai)
#pragma unroll
                    for (int m = 0; m < 4; ++m) *(u32x4*)(KI + (size_t)(row0 + ai * HALF + m * 16) * 64 + wc * 32 + 8 * fq) = pack8(acc[ai][0][m][0], acc[ai][0][m][1]);
            } else if (wc == 2 && fq == 0) {
                const float sc = 0.04419417382415922f;
#pragma unroll
                for (int ai = 0; ai < 2; ++ai)
#pragma unroll
                    for (int m = 0; m < 4; ++m) { float* p = WI + (size_t)(row0 + ai * HALF + m * 16) * 8; *(f32x4*)p = acc[ai][0][m][0] * sc; *(f32x4*)(p + 4) = acc[ai][0][m][1] * sc; }
            }
        }
    }
};
struct EpiRes {
    static constexpr bool PERM = true;
    bf16_t* out; const bf16_t* resid;
    __device__ __forceinline__ void operator()(const AccT& acc, const Unit& u, int wr, int wc, int fr, int fq) const {
        const int row0 = u.pm * BM + wr * 64 + fr, col0 = u.pn * BM + wc * 32 + 8 * fq;
#pragma unroll
        for (int ai = 0; ai < 2; ++ai)
#pragma unroll
            for (int m = 0; m < 4; ++m) { const size_t off = (size_t)(row0 + ai * HALF + m * 16) * DM + col0;
#pragma unroll
                for (int bj = 0; bj < 2; ++bj) { const u32x4 w = *(const u32x4*)(resid + off + bj * HALF);
                    const f32x4 r0 = (f32x4){bf_lo(w.x), bf_hi(w.x), bf_lo(w.y), bf_hi(w.y)}, r1 = (f32x4){bf_lo(w.z), bf_hi(w.z), bf_lo(w.w), bf_hi(w.w)};
                    *(u32x4*)(out + off + bj * HALF) = pack8(r0 * ALPHA + acc[ai][bj][m][0], r1 * ALPHA + acc[ai][bj][m][1]); } }
    }
};
__device__ __forceinline__ char* hm_tile(char* dout, char* ws, int p) { return p < HM_DOUT_TILES ? dout + (size_t)p * HM_TILE_BYTES : ws + WS_HM + (size_t)(p - HM_DOUT_TILES) * HM_TILE_BYTES; }
template <bool TILE_LOCAL> struct EpiSwiglu {
    static constexpr bool PERM = true;
    bf16_t* H; int ldh; char* dout; char* ws;
    __device__ __forceinline__ void operator()(const AccT& acc, const Unit& u, int wr, int wc, int fr, int fq) const {
        bf16_t* base; if constexpr (TILE_LOCAL) base = (bf16_t*)hm_tile(dout, ws, u.pm); else base = H + (size_t)u.pm * BM * ldh;
        const int rl0 = wr * 64 + fr, col0 = u.pn * 128 + wc * 32 + 8 * fq;
#pragma unroll
        for (int ai = 0; ai < 2; ++ai)
#pragma unroll
            for (int m = 0; m < 4; ++m) { f32x4 o0, o1;
#pragma unroll
                for (int j = 0; j < 4; ++j) { const float g0 = acc[ai][0][m][0][j], g1 = acc[ai][0][m][1][j];
                    o0[j] = g0 * sigmoidf_(g0) * acc[ai][1][m][0][j]; o1[j] = g1 * sigmoidf_(g1) * acc[ai][1][m][1][j]; }
                *(u32x4*)(base + (size_t)(rl0 + ai * HALF + m * 16) * ldh + col0) = pack8(o0, o1); }
    }
};
struct EpiQkv1 {
    static constexpr bool PERM = true;
    bf16_t* O; int ldc; float qscale;
    __device__ __forceinline__ void operator()(const AccT& acc, const Unit& u, int wr, int wc, int fr, int fq) const {
        const int row0 = u.pm * BM + wr * 64 + fr, col0 = u.pn * BM + wc * 32 + 8 * fq; const float sc = ((u.pn % 12) < 4) ? qscale : 1.0f;
#pragma unroll
        for (int ai = 0; ai < 2; ++ai)
#pragma unroll
            for (int m = 0; m < 4; ++m)
#pragma unroll
                for (int bj = 0; bj < 2; ++bj)
                    *(u32x4*)(O + (size_t)(row0 + ai * HALF + m * 16) * ldc + col0 + bj * HALF) = pack8(acc[ai][bj][m][0] * sc, acc[ai][bj][m][1] * sc);
    }
};
struct EpiMoeDown {
    static constexpr bool PERM = true;
    bf16_t* YB; const int* tokk; const float* gate; const PG8_LAS int* rt;
    __device__ __forceinline__ void operator()(const AccT& acc, const Unit& u, int wr, int wc, int fr, int fq) const {
        const int lbase = rt[u.pm * 4 + 1], nvalid = rt[u.pm * 4 + 2];
        const int rl0 = wr * 64 + fr, col0 = u.pn * BM + wc * 32 + 8 * fq;
#pragma unroll
        for (int ai = 0; ai < 2; ++ai)
#pragma unroll
            for (int m = 0; m < 4; ++m) { const int rl = rl0 + ai * HALF + m * 16;
                if (rl < nvalid) { const int tk = tokk[lbase + rl]; const float g = gate[lbase + rl];
                    bf16_t* rowp = YB + ((size_t)(tk & 1) * NTOK + (size_t)(tk >> 1)) * DM + col0;
#pragma unroll
                    for (int bj = 0; bj < 2; ++bj) *(u32x4*)(rowp + bj * HALF) = pack8(acc[ai][bj][m][0] * g, acc[ai][bj][m][1] * g); } }
    }
};
struct MoeOrder {
    int G, c, nM, nN; const PG8_LAS int* rt; const char* xbase; char* dout; char* ws; bool up;
    __device__ __forceinline__ bool next(int i, Unit& u) const {
        const long L = (long)i * G + c; if (L >= (long)nM * nN) return false;
        remap_unit((int)L, nM, nN, u.pm, u.pn); return true;
    }
    __device__ __forceinline__ const char* a_ptr(const Unit& u) const { return up ? xbase : (const char*)hm_tile(dout, ws, u.pm); }
    __device__ __forceinline__ int b_tile(const Unit& u) const { return __builtin_amdgcn_readfirstlane(rt[u.pm * 4]) * nN + u.pn; }
};
}


namespace swa {
constexpr int D = 128, NW = 8, QBLK = 32, KVBLK = 64, QB = NW * QBLK, WIN = 129;
constexpr int SHM_V = KVBLK * D * 2, SHM_K = KVBLK * D * 2;
constexpr int LDS_TB = 2 * SHM_V + 2 * SHM_K + NW * 64 * 4;
constexpr float SCALE = 0.08838834764831845f, THR = 8.f;
typedef float f32x16 __attribute__((ext_vector_type(16)));
typedef short s16x4 __attribute__((ext_vector_type(4)));
#define KSWZ(row, colB) ((row) * 256 + ((colB) ^ (((row) & 7) << 4)))
#define SBAR() __builtin_amdgcn_sched_barrier(0)
__device__ __forceinline__ int v_st(int k, int c) { const int kk = (k & ~0xC) | ((k & 4) << 1) | ((k & 8) >> 1); return ((kk >> 3) * 4 + (c >> 5)) * 512 + ((kk & 7) * 32 + (c & 31)) * 2; }
__device__ __forceinline__ int v_rd_base(int lane) { return ((lane & 3) << 3) | (((lane >> 2) & 3) << 6) | (((lane >> 4) & 1) << 5) | (((lane >> 5) & 1) << 8); }
constexpr int v_rd_off(int d0, int ks, int half) { return d0 * 512 + ks * 4096 + half * 2048; }
__device__ __forceinline__ int crow(int r, int hi) { return (r & 3) + 8 * (r >> 2) + 4 * hi; }
__device__ __forceinline__ bf16x8 load8(const bf16_t* p) { return *reinterpret_cast<const bf16x8*>(p); }
__device__ __forceinline__ void mask_bias_tile(f32x16& p0, f32x16& p1, int dq, const float* tb) {
    const float NEG = -__builtin_inff();
    float b0[16], b1[16];
#pragma unroll
    for (int r = 0; r < 16; ++r) { const int c = (r & 3) + 8 * (r >> 2); b0[r] = tb[59 - c]; b1[r] = tb[27 - c]; }
#pragma unroll
    for (int r = 0; r < 16; ++r) {
        const int c = (r & 3) + 8 * (r >> 2);
        const float a0 = p0[r] + b0[r], a1 = p1[r] + b1[r];
        p0[r] = ((unsigned)(dq - c) < (unsigned)WIN) ? a0 : NEG;
        p1[r] = ((unsigned)(dq - c - 32) < (unsigned)WIN) ? a1 : NEG;
    }
}
__device__ __forceinline__ void partialSM(f32x16& p0, f32x16& p1, float& m_reg, float& mn, float& alpha) {
    float pmax = p0[0];
#pragma unroll
    for (int r = 1; r < 16; ++r) pmax = fmaxf(pmax, p0[r]);
#pragma unroll
    for (int r = 0; r < 16; ++r) pmax = fmaxf(pmax, p1[r]);
    { auto rr = __builtin_amdgcn_permlane32_swap(__float_as_uint(pmax), __float_as_uint(pmax), false, false);
      pmax = fmaxf(__uint_as_float(rr[0]), __uint_as_float(rr[1])); }
    constexpr float C2 = 1.4426950408889634f * SCALE;
    if (__builtin_expect(__all((pmax - m_reg) * SCALE <= THR), 1)) { mn = m_reg; alpha = 1.f; }
    else { mn = fmaxf(m_reg, pmax); alpha = __builtin_amdgcn_exp2f((m_reg - mn) * C2); m_reg = mn; }
    const float mnL = -mn * C2;
#pragma unroll
    for (int r = 0; r < 16; ++r) p0[r] = fmaf(p0[r], C2, mnL);
#pragma unroll
    for (int r = 0; r < 16; ++r) p1[r] = fmaf(p1[r], C2, mnL);
#pragma unroll
    for (int r = 0; r < 16; ++r) p0[r] = __builtin_amdgcn_exp2f(p0[r]);
}
__device__ __forceinline__ void finishSM(f32x16& p0, f32x16& p1, float alpha, float& l_reg, bf16x8& pa0, bf16x8& pa1, bf16x8& pa2, bf16x8& pa3) {
#pragma unroll
    for (int r = 0; r < 16; ++r) p1[r] = __builtin_amdgcn_exp2f(p1[r]);
    float ps = 0;
#pragma unroll
    for (int r = 0; r < 16; ++r) ps += p0[r];
#pragma unroll
    for (int r = 0; r < 16; ++r) ps += p1[r];
    { auto rr = __builtin_amdgcn_permlane32_swap(__float_as_uint(ps), __float_as_uint(ps), false, false);
      ps = __uint_as_float(rr[0]) + __uint_as_float(rr[1]); }
    l_reg = l_reg * alpha + ps;
#define PK4(P, B_, OUT) do { unsigned a0 = cvt_pk_bf16(P[B_+0], P[B_+1]), a1 = cvt_pk_bf16(P[B_+2], P[B_+3]);                          \
        unsigned b0 = cvt_pk_bf16(P[B_+4], P[B_+5]), b1 = cvt_pk_bf16(P[B_+6], P[B_+7]);                                             \
        auto r0 = __builtin_amdgcn_permlane32_swap(a0, b0, false, false); auto r1 = __builtin_amdgcn_permlane32_swap(a1, b1, false, false); \
        u32x4 w = {r0[0], r1[0], r0[1], r1[1]}; OUT = *reinterpret_cast<bf16x8*>(&w); } while (0)
    PK4(p0, 0, pa0); PK4(p0, 8, pa1); PK4(p1, 0, pa2); PK4(p1, 8, pa3);
#undef PK4
}
template <int KB>
__device__ __forceinline__ void qkt(f32x16& p0, f32x16& p1, const char* K_lds, int r32, int hi, const bf16x8* qr, bool act) {
    if (!act) { const float NEG = -__builtin_inff();
#pragma unroll
        for (int r = 0; r < 16; ++r) { p0[r] = NEG; p1[r] = NEG; } return; }
    p0 = f32x16{}; p1 = f32x16{};
    const char* kb[4];
#pragma unroll
    for (int dd = 0; dd < 4; ++dd) kb[dd] = K_lds + KB * SHM_K + KSWZ(r32, (dd * 16 + hi * 8) * 2);
#pragma unroll
    for (int d0 = 0; d0 < 8; ++d0) { const char* a = kb[d0 & 3] + (d0 >> 2) * 128;
        bf16x8 b0 = *reinterpret_cast<const bf16x8*>(a);
        bf16x8 b1 = *reinterpret_cast<const bf16x8*>(a + 32 * 256);
        p0 = __builtin_amdgcn_mfma_f32_32x32x16_bf16(b0, qr[d0], p0, 0, 0, 0);
        p1 = __builtin_amdgcn_mfma_f32_32x32x16_bf16(b1, qr[d0], p1, 0, 0, 0); }
}
template <int VB>
__device__ __forceinline__ void pv_tile(f32x16* o, int vb0, bf16x8 pa0, bf16x8 pa1, bf16x8 pa2, bf16x8 pa3, bool act) {
    if (!act) return;
#define TRRD(dst, off) asm volatile("ds_read_b64_tr_b16 %0, %1 offset:%2" : "=&v"(dst) : "v"(vb0), "i"(off) : "memory")
#define PV_D0(d0) do { s16x4 l0, l1, l2, l3, h0, h1, h2, h3; constexpr int b_ = VB * SHM_V + v_rd_off(d0, 0, 0); \
        TRRD(l0, b_); TRRD(h0, b_ + 2048); TRRD(l1, b_ + 4096); TRRD(h1, b_ + 6144); TRRD(l2, b_ + 8192); TRRD(h2, b_ + 10240); TRRD(l3, b_ + 12288); TRRD(h3, b_ + 14336); \
        asm volatile("s_waitcnt lgkmcnt(0)" ::: "memory"); SBAR();   \
        o[d0] = __builtin_amdgcn_mfma_f32_32x32x16_bf16(pa0, (bf16x8){l0[0], l0[1], l0[2], l0[3], h0[0], h0[1], h0[2], h0[3]}, o[d0], 0, 0, 0);   \
        o[d0] = __builtin_amdgcn_mfma_f32_32x32x16_bf16(pa1, (bf16x8){l1[0], l1[1], l1[2], l1[3], h1[0], h1[1], h1[2], h1[3]}, o[d0], 0, 0, 0);   \
        o[d0] = __builtin_amdgcn_mfma_f32_32x32x16_bf16(pa2, (bf16x8){l2[0], l2[1], l2[2], l2[3], h2[0], h2[1], h2[2], h2[3]}, o[d0], 0, 0, 0);   \
        o[d0] = __builtin_amdgcn_mfma_f32_32x32x16_bf16(pa3, (bf16x8){l3[0], l3[1], l3[2], l3[3], h3[0], h3[1], h3[2], h3[3]}, o[d0], 0, 0, 0); } while (0)
    PV_D0(0); PV_D0(1); PV_D0(2); PV_D0(3);
#undef PV_D0
#undef TRRD
}
struct BlockRef { const bf16_t* Q; const bf16_t* K; bf16_t* O; float* LSE; int P0, bh, dsh;
    __device__ __forceinline__ int rs() const { return IN1_N << dsh; }
    __device__ __forceinline__ int os() const { return DM << dsh; }
    __device__ __forceinline__ int ls() const { return 8 << dsh; }
    __device__ __forceinline__ int skv() const { return SEQ >> dsh; }
    __device__ __forceinline__ const bf16_t* V() const { return K + 1024; } };
struct Seam { bf16x8 qr[8]; bf16x8 st_v0, st_v1, st_k0, st_k1; };
__device__ __forceinline__ int swa_jlo(int P0) { const int lowk = P0 - WIN + 1; return lowk > 0 ? lowk / KVBLK : 0; }
#define ROWP(p, k0, rs_, vo) ((const bf16_t*)((const char*)(p) + (size_t)(k0) * (size_t)(rs_) * 2 + (size_t)(vo)))
#define VMW() asm volatile("s_waitcnt vmcnt(0)" ::: "memory")
#define VMWN(n) asm volatile("s_waitcnt vmcnt(%0)" :: "i"(n) : "memory")
#define TIDL() int tid_l = tid; asm volatile("" : "+v"(tid_l)); const int sr = tid_l >> 4, sc = (tid_l & 15) * 8; (void)sr; (void)sc
#define SLOAD_H(Kp, Vp, k0, rs_) do { TIDL(); const unsigned vo0_ = (unsigned)(sr * (rs_) + sc) * 2u, vo1_ = vo0_ + (unsigned)(rs_) * 64u; \
                         S.st_v0 = load8(ROWP(Vp, k0, rs_, vo0_)); S.st_v1 = load8(ROWP(Vp, k0, rs_, vo1_));              \
                         S.st_k0 = load8(ROWP(Kp, k0, rs_, vo0_)); S.st_k1 = load8(ROWP(Kp, k0, rs_, vo1_)); } while (0)
#define SWRITE_HK(bf) do { TIDL(); const int kws = KSWZ(sr, sc * 2); *(bf16x8*)(K_lds + (bf) * SHM_K + kws) = S.st_k0; *(bf16x8*)(K_lds + (bf) * SHM_K + kws + 32 * 256) = S.st_k1; } while (0)
#define SWRITE_HV(bf) do { TIDL(); const int vst0 = v_st(sr, sc), vst1 = v_st(32 + sr, sc); *(bf16x8*)(V_lds + (bf) * SHM_V + vst0) = S.st_v0; *(bf16x8*)(V_lds + (bf) * SHM_V + vst1) = S.st_v1; } while (0)
#define SWRITE_H(bf) do { SWRITE_HV(bf); SWRITE_HK(bf); } while (0)
__device__ __forceinline__ void tb_load(const float* biast, int bh, int dsh, int tid, float& v0, float& v1) {
    const int d0 = tid - 384, d1 = tid + 512 - 384;
    v0 = (d0 >= 0 && d0 < WIN) ? biast[bh * 4096 + (d0 << dsh)] * (1.0f / SCALE) : 0.f;
    v1 = (d1 >= 0 && d1 < WIN) ? biast[bh * 4096 + (d1 << dsh)] * (1.0f / SCALE) : 0.f;
}
__device__ __forceinline__ void swa_prime(const BlockRef& cur, const float* biast, char* lds, Seam& S, int tid) {
    const int wid = __builtin_amdgcn_readfirstlane(tid >> 6), lane = tid & 63, r32 = lane & 31, hi = lane >> 5;
    char* K_lds = lds + 2 * SHM_V;
    const int kb0 = swa_jlo(cur.P0) * KVBLK;
    float t0, t1; tb_load(biast, cur.bh, cur.dsh, tid, t0, t1);
#pragma unroll
    for (int d0 = 0; d0 < 8; ++d0) S.qr[d0] = load8((const bf16_t*)((const char*)cur.Q + (size_t)((unsigned)((wid * QBLK + r32) * cur.rs() + hi * 8) * 2u)) + d0 * 16);
    SLOAD_H(cur.K, cur.V(), kb0, cur.rs()); VMW(); SWRITE_HK(0);
    float* tb = (float*)(lds + LDS_TB); tb[tid] = t0; tb[tid + 512] = t1;
    __syncthreads();
}
__device__ __forceinline__ void swa_block(const BlockRef& cur, const BlockRef& nxt, const float* biast, int slot, char* lds, Seam& S, int tid) {
    const int wid = __builtin_amdgcn_readfirstlane(tid >> 6), lane = tid & 63, r32 = lane & 31, hi = lane >> 5;
    const int j_lo = swa_jlo(cur.P0);
    int j_hi = (cur.P0 + QB - 1) / KVBLK + 1; if (j_hi > cur.skv() / KVBLK) j_hi = cur.skv() / KVBLK;
    const int NT = j_hi - j_lo;
    const int kbn = swa_jlo(nxt.P0) * KVBLK;
    const int qlo = cur.P0 + wid * QBLK, qm = qlo + r32 - 4 * hi;
    char* V_lds = lds; char* K_lds = lds + 2 * SHM_V;
    float* wsl = (float*)(lds + 2 * SHM_V + 2 * SHM_K) + wid * 64; float* li_l = wsl, * al_l = wsl + 32;
    const float* tbl0 = (const float*)(lds + LDS_TB + slot * 4096) + 325;
    float m_reg = -1e30f, l_reg = 0; f32x16 o[4] = {};
    const int vb0 = (int)(uintptr_t)V_lds + v_rd_base(lane);
    const bf16_t* Kh = cur.K; const bf16_t* Vh = cur.V(); const int rs = cur.rs();
#define RESC(a) do { if (__any((a) < 1.f)) { if (hi == 0) al_l[r32] = (a); asm volatile("s_waitcnt lgkmcnt(0)" ::: "memory");              \
                     _Pragma("unroll") for (int d_ = 0; d_ < 4; ++d_) _Pragma("unroll") for (int r = 0; r < 16; ++r) o[d_][r] *= al_l[crow(r, hi)]; } } while (0)
#define KBASE(t) ((j_lo + (t)) * KVBLK)
#define ACT(t) (KBASE(t) <= qlo + QBLK - 1 && KBASE(t) + KVBLK - 1 >= qlo - WIN + 1)
#define MASKT(P0_, P1_, t) do { const int kb_ = KBASE(t); if (ACT(t)) mask_bias_tile(P0_, P1_, qm - kb_, tbl0 + (qm - kb_)); } while (0)
    constexpr int NQL = 8;
#define SEAM_K0() do { VMWN(NQL); SWRITE_HK(0); SBAR(); } while (0)
    f32x16 pA0, pA1, pB0, pB1; float mnA, mnB, alA, alB; bf16x8 pa0, pa1, pa2, pa3;
    SWRITE_HV(0); SBAR();
    if (NT > 1) { SLOAD_H(Kh, Vh, KBASE(1), rs); }
    SBAR(); qkt<0>(pA0, pA1, K_lds, r32, hi, S.qr, ACT(0));
    MASKT(pA0, pA1, 0); partialSM(pA0, pA1, m_reg, mnA, alA);
    if (NT > 1) { VMW(); SWRITE_H(1); }
    __syncthreads();
#define HALF_STEP(PX0, PX1, mnX, alX, PY0, PY1, alY, t, KB, VB, SB) do {                                                      \
        SBAR(); qkt<KB>(PX0, PX1, K_lds, r32, hi, S.qr, ACT(t));                                             \
        finishSM(PY0, PY1, alY, l_reg, pa0, pa1, pa2, pa3); SBAR();                                                           \
        if ((t) + 1 < NT) { SLOAD_H(Kh, Vh, KBASE((t) + 1), rs); SBAR(); }                                               \
        pv_tile<VB>(o, vb0, pa0, pa1, pa2, pa3, ACT((t) - 1)); MASKT(PX0, PX1, (t)); partialSM(PX0, PX1, m_reg, mnX, alX);                                        \
        __syncthreads();                                                                                                      \
        if ((t) + 1 < NT) { VMW(); SWRITE_H(SB); }                                                                          \
        RESC(alX); __syncthreads(); } while (0)
    for (int t = 1; t + 1 < NT; t += 2) {
        HALF_STEP(pB0, pB1, mnB, alB, pA0, pA1, alA, t, 1, 0, 0);
        HALF_STEP(pA0, pA1, mnA, alA, pB0, pB1, alB, t + 1, 0, 1, 1);
    }
    const bool even = (NT & 1) == 0;
    if (even) { SBAR(); qkt<1>(pB0, pB1, K_lds, r32, hi, S.qr, ACT(NT - 1)); SBAR(); }
    SLOAD_H(nxt.K, nxt.V(), kbn, nxt.rs()); SBAR();
#pragma unroll
    for (int d0 = 0; d0 < 8; ++d0) S.qr[d0] = load8((const bf16_t*)((const char*)nxt.Q + (size_t)((unsigned)((wid * QBLK + r32) * nxt.rs() + hi * 8) * 2u)) + d0 * 16);
    SBAR();
    finishSM(pA0, pA1, alA, l_reg, pa0, pa1, pa2, pa3); SBAR();
    pv_tile<0>(o, vb0, pa0, pa1, pa2, pa3, ACT(even ? NT - 2 : NT - 1));
    if (even) { MASKT(pB0, pB1, NT - 1); partialSM(pB0, pB1, m_reg, mnB, alB); __syncthreads(); RESC(alB);
        finishSM(pB0, pB1, alB, l_reg, pa0, pa1, pa2, pa3); SBAR(); pv_tile<1>(o, vb0, pa0, pa1, pa2, pa3, ACT(NT - 1)); }
    SBAR(); SEAM_K0();
    float t0, t1; tb_load(biast, nxt.bh, nxt.dsh, tid, t0, t1);
    if (hi == 0) li_l[r32] = l_reg; asm volatile("s_waitcnt lgkmcnt(0)" ::: "memory");
    int r32e = r32, hie = hi; asm volatile("" : "+v"(r32e), "+v"(hie));
    if (hie == 0) cur.LSE[(size_t)(wid * QBLK + r32e) * cur.ls()] = m_reg * SCALE + __logf(l_reg);
    float rli[16];
#pragma unroll
    for (int r = 0; r < 16; ++r) rli[r] = __builtin_amdgcn_rcpf(li_l[crow(r, hie)]);
    const int os = cur.os();
    bf16_t* Ow = cur.O + (size_t)(wid * QBLK) * os;
#pragma unroll
    for (int r = 0; r < 16; ++r) { const unsigned oo = (unsigned)(crow(r, hie) * os + r32e) * 2u;
#pragma unroll
        for (int d0 = 0; d0 < 4; ++d0) { const float v = o[d0][r] * rli[r];
            const float vn = swz_xor<1>(v);
            if ((r32e & 1) == 0) *(unsigned*)((char*)Ow + oo + d0 * 64) = cvt_pk_bf16(v, vn); } }
    { float* tb = (float*)(lds + LDS_TB + (slot ^ 1) * 4096); tb[tid] = t0; tb[tid + 512] = t1; }
    __syncthreads();
#undef RESC
#undef KBASE
#undef ACT
#undef MASKT
#undef SEAM_K0
#undef HALF_STEP
}
#undef ROWP
#undef VMW
#undef VMWN
#undef SLOAD_H
#undef SWRITE_HK
#undef SWRITE_HV
#undef SWRITE_H
#undef TIDL
#undef KSWZ
#undef SBAR
}


namespace dsa {
constexpr int D = 64, NW = 8, QBLK = 32, KVBLK = 64, QB = NW * QBLK;
constexpr int SHM_V = KVBLK * D * 2, SHM_K = KVBLK * D * 2;
constexpr int LDS_TB = 2 * SHM_V + 2 * SHM_K + NW * 64 * 4;
constexpr int TB_PAD = 128;
constexpr float SCALE = 0.125f, THR = 8.f;
typedef float f32x16 __attribute__((ext_vector_type(16)));
typedef short s16x4 __attribute__((ext_vector_type(4)));
#define KSWZ(row, colB) ((row) * 128 + ((colB) ^ (((row) & 7) << 4)))
#define SBAR() __builtin_amdgcn_sched_barrier(0)
__device__ __forceinline__ int v_st(int k, int c) { const int kk = (k & ~0xC) | ((k & 4) << 1) | ((k & 8) >> 1); return ((kk >> 3) * 2 + (c >> 5)) * 512 + ((kk & 7) * 32 + (c & 31)) * 2; }
__device__ __forceinline__ int v_rd_base(int lane) { return ((lane & 3) << 3) | (((lane >> 2) & 3) << 6) | (((lane >> 4) & 1) << 5) | (((lane >> 5) & 1) << 8); }
__device__ __forceinline__ int crow(int r, int hi) { return (r & 3) + 8 * (r >> 2) + 4 * hi; }
__device__ __forceinline__ bf16x8 load8(const bf16_t* p) { return *reinterpret_cast<const bf16x8*>(p); }
__device__ __forceinline__ void mask_bias_tile(f32x16& p0, f32x16& p1, const float* tb, unsigned lo4, unsigned hi4) {
    const float NEG = -__builtin_inff();
    float b0[16], b1[16];
#pragma unroll
    for (int r = 0; r < 16; ++r) { const int c = (r & 3) + 8 * (r >> 2); b0[r] = tb[63 - c]; b1[r] = tb[31 - c]; }
#pragma unroll
    for (int r = 0; r < 16; ++r) {
        const int c = (r & 3) + 8 * (r >> 2);
        const float a0 = p0[r] + b0[r], a1 = p1[r] + b1[r];
        p0[r] = ((lo4 >> c) & 1u) ? a0 : NEG;
        p1[r] = ((hi4 >> c) & 1u) ? a1 : NEG;
    }
}
__device__ __forceinline__ void partialSM(f32x16& p0, f32x16& p1, float& m_reg, float& mn, float& alpha) {
    float pmax = p0[0];
#pragma unroll
    for (int r = 1; r < 16; ++r) pmax = fmaxf(pmax, p0[r]);
#pragma unroll
    for (int r = 0; r < 16; ++r) pmax = fmaxf(pmax, p1[r]);
    { auto rr = __builtin_amdgcn_permlane32_swap(__float_as_uint(pmax), __float_as_uint(pmax), false, false);
      pmax = fmaxf(__uint_as_float(rr[0]), __uint_as_float(rr[1])); }
    constexpr float C2 = 1.4426950408889634f * SCALE;
    if (__builtin_expect(__all((pmax - m_reg) * SCALE <= THR), 1)) { mn = m_reg; alpha = 1.f; }
    else { mn = fmaxf(m_reg, pmax); alpha = __builtin_amdgcn_exp2f((m_reg - mn) * C2); m_reg = mn; }
    const float mnL = -mn * C2;
#pragma unroll
    for (int r = 0; r < 16; ++r) p0[r] = fmaf(p0[r], C2, mnL);
#pragma unroll
    for (int r = 0; r < 16; ++r) p1[r] = fmaf(p1[r], C2, mnL);
#pragma unroll
    for (int r = 0; r < 16; ++r) p0[r] = __builtin_amdgcn_exp2f(p0[r]);
}
__device__ __forceinline__ void finishSM(f32x16& p0, f32x16& p1, float alpha, float& l_reg, bf16x8& pa0, bf16x8& pa1, bf16x8& pa2, bf16x8& pa3) {
#pragma unroll
    for (int r = 0; r < 16; ++r) p1[r] = __builtin_amdgcn_exp2f(p1[r]);
    float ps = 0;
#pragma unroll
    for (int r = 0; r < 16; ++r) ps += p0[r];
#pragma unroll
    for (int r = 0; r < 16; ++r) ps += p1[r];
    { auto rr = __builtin_amdgcn_permlane32_swap(__float_as_uint(ps), __float_as_uint(ps), false, false);
      ps = __uint_as_float(rr[0]) + __uint_as_float(rr[1]); }
    l_reg = l_reg * alpha + ps;
#define PK4(P, B_, OUT) do { unsigned a0 = cvt_pk_bf16(P[B_+0], P[B_+1]), a1 = cvt_pk_bf16(P[B_+2], P[B_+3]);                          \
        unsigned b0 = cvt_pk_bf16(P[B_+4], P[B_+5]), b1 = cvt_pk_bf16(P[B_+6], P[B_+7]);                                             \
        auto r0 = __builtin_amdgcn_permlane32_swap(a0, b0, false, false); auto r1 = __builtin_amdgcn_permlane32_swap(a1, b1, false, false); \
        u32x4 w = {r0[0], r1[0], r0[1], r1[1]}; OUT = *reinterpret_cast<bf16x8*>(&w); } while (0)
    PK4(p0, 0, pa0); PK4(p0, 8, pa1); PK4(p1, 0, pa2); PK4(p1, 8, pa3);
#undef PK4
}
template <int KB>
__device__ __forceinline__ void qkt(f32x16& p0, f32x16& p1, const char* K_lds, int r32, int hi, const bf16x8* qr, bool act) {
    if (!act) { const float NEG = -__builtin_inff();
#pragma unroll
        for (int r = 0; r < 16; ++r) { p0[r] = NEG; p1[r] = NEG; } return; }
    p0 = f32x16{}; p1 = f32x16{};
#pragma unroll
    for (int d0 = 0; d0 < 4; ++d0) { const char* a = K_lds + KB * SHM_K + KSWZ(r32, (d0 * 16 + hi * 8) * 2);
        bf16x8 b0 = *reinterpret_cast<const bf16x8*>(a);
        bf16x8 b1 = *reinterpret_cast<const bf16x8*>(a + 32 * 128);
        p0 = __builtin_amdgcn_mfma_f32_32x32x16_bf16(b0, qr[d0], p0, 0, 0, 0);
        p1 = __builtin_amdgcn_mfma_f32_32x32x16_bf16(b1, qr[d0], p1, 0, 0, 0); }
}
template <int VB>
__device__ __forceinline__ void pv_tile(f32x16* o, int vb0, bf16x8 pa0, bf16x8 pa1, bf16x8 pa2, bf16x8 pa3, bool act) {
    if (!act) return;
#define TRRD(dst, off) asm volatile("ds_read_b64_tr_b16 %0, %1 offset:%2" : "=&v"(dst) : "v"(vb0), "i"(off) : "memory")
#define PV_D0(d0) do { s16x4 l0, l1, l2, l3, h0, h1, h2, h3; constexpr int b_ = VB * SHM_V + (d0) * 512; \
        TRRD(l0, b_); TRRD(h0, b_ + 1024); TRRD(l1, b_ + 2048); TRRD(h1, b_ + 3072); TRRD(l2, b_ + 4096); TRRD(h2, b_ + 5120); TRRD(l3, b_ + 6144); TRRD(h3, b_ + 7168); \
        asm volatile("s_waitcnt lgkmcnt(0)" ::: "memory"); SBAR();   \
        o[d0] = __builtin_amdgcn_mfma_f32_32x32x16_bf16(pa0, (bf16x8){l0[0], l0[1], l0[2], l0[3], h0[0], h0[1], h0[2], h0[3]}, o[d0], 0, 0, 0);   \
        o[d0] = __builtin_amdgcn_mfma_f32_32x32x16_bf16(pa1, (bf16x8){l1[0], l1[1], l1[2], l1[3], h1[0], h1[1], h1[2], h1[3]}, o[d0], 0, 0, 0);   \
        o[d0] = __builtin_amdgcn_mfma_f32_32x32x16_bf16(pa2, (bf16x8){l2[0], l2[1], l2[2], l2[3], h2[0], h2[1], h2[2], h2[3]}, o[d0], 0, 0, 0);   \
        o[d0] = __builtin_amdgcn_mfma_f32_32x32x16_bf16(pa3, (bf16x8){l3[0], l3[1], l3[2], l3[3], h3[0], h3[1], h3[2], h3[3]}, o[d0], 0, 0, 0); } while (0)
    PV_D0(0); PV_D0(1);
#undef PV_D0
#undef TRRD
}
struct BlockRef { const bf16_t* Q; const bf16_t* K; const bf16_t* V; bf16_t* O; const u64* MW; int P0; };
struct Seam { bf16x8 qr[4]; bf16x8 st_v0, st_k0; u64 mw; };
#define VMW() asm volatile("s_waitcnt vmcnt(0)" ::: "memory")
#define VMWN(n) asm volatile("s_waitcnt vmcnt(%0)" :: "i"(n) : "memory")
#define TIDL() int tid_l = tid; asm volatile("" : "+v"(tid_l)); const int sr = tid_l >> 3, sc = (tid_l & 7) * 8; (void)sr; (void)sc
#define SLOAD_H(Kp, Vp, k0) do { TIDL(); const unsigned vo_ = (unsigned)((k0 + sr) * 512 + sc) * 2u; \
        S.st_v0 = load8((const bf16_t*)((const char*)(Vp) + vo_)); S.st_k0 = load8((const bf16_t*)((const char*)(Kp) + vo_)); } while (0)
#define SWRITE_HK(bf) do { TIDL(); *(bf16x8*)(K_lds + (bf) * SHM_K + KSWZ(sr, sc * 2)) = S.st_k0; } while (0)
#define SWRITE_HV(bf) do { TIDL(); *(bf16x8*)(V_lds + (bf) * SHM_V + v_st(sr, sc)) = S.st_v0; } while (0)
#define SWRITE_H(bf) do { SWRITE_HV(bf); SWRITE_HK(bf); } while (0)
#define MWLOAD(ref, tile) ((ref).MW[(size_t)(tile) * SEQ + wid * QBLK + r32])
__device__ __forceinline__ void dsa_prime(const BlockRef& cur, char* lds, Seam& S, int tid) {
    const int wid = __builtin_amdgcn_readfirstlane(tid >> 6), lane = tid & 63, r32 = lane & 31, hi = lane >> 5;
    char* K_lds = lds + 2 * SHM_V;
#pragma unroll
    for (int d0 = 0; d0 < 4; ++d0) S.qr[d0] = load8(cur.Q + (size_t)(wid * QBLK + r32) * 512 + d0 * 16 + hi * 8);
    S.mw = MWLOAD(cur, 0);
    SLOAD_H(cur.K, cur.V, 0); VMW(); SWRITE_HK(0);
    __syncthreads();
}
__device__ __forceinline__ void dsa_block(const BlockRef& cur, const BlockRef& nxt, char* lds, Seam& S, int tid) {
    const int wid = __builtin_amdgcn_readfirstlane(tid >> 6), lane = tid & 63, r32 = lane & 31, hi = lane >> 5;
    const int NT = (cur.P0 + QB - 1) / KVBLK + 1;
    const int qlo = cur.P0 + wid * QBLK, qm = qlo + r32 - 4 * hi;
    char* V_lds = lds; char* K_lds = lds + 2 * SHM_V;
    float* wsl = (float*)(lds + 2 * SHM_V + 2 * SHM_K) + wid * 64; float* li_l = wsl, * al_l = wsl + 32;
    const float* tbl0 = (const float*)(lds + LDS_TB) + (TB_PAD - 63);
    float m_reg = -1e30f, l_reg = 0; f32x16 o[2] = {};
    const int vb0 = (int)(uintptr_t)V_lds + v_rd_base(lane);
    const bf16_t* Kh = cur.K; const bf16_t* Vh = cur.V;
#define RESC(a) do { if (__any((a) < 1.f)) { if (hi == 0) al_l[r32] = (a); asm volatile("s_waitcnt lgkmcnt(0)" ::: "memory");              \
                     _Pragma("unroll") for (int d_ = 0; d_ < 2; ++d_) _Pragma("unroll") for (int r = 0; r < 16; ++r) o[d_][r] *= al_l[crow(r, hi)]; } } while (0)
#define KBASE(t) ((t) * KVBLK)
#define ACT(t) (KBASE(t) <= qlo + QBLK - 1)
#define MASKT(P0_, P1_, t, MWX) do { const int kb_ = KBASE(t); if (ACT(t)) mask_bias_tile(P0_, P1_, tbl0 + (qm - kb_), (unsigned)(MWX) >> (4 * hi), (unsigned)((MWX) >> 32) >> (4 * hi)); } while (0)
    constexpr int NQL = 5;
#define SEAM_K0() do { VMWN(NQL); SWRITE_HK(0); SBAR(); } while (0)
    f32x16 pA0, pA1, pB0, pB1; float mnA, mnB, alA, alB; bf16x8 pa0, pa1, pa2, pa3;
    u64 mwA = S.mw, mwB = 0;
    SWRITE_HV(0); SBAR();
    if (NT > 1) { SLOAD_H(Kh, Vh, KBASE(1)); mwB = MWLOAD(cur, 1); }
    SBAR(); qkt<0>(pA0, pA1, K_lds, r32, hi, S.qr, ACT(0));
    MASKT(pA0, pA1, 0, mwA); partialSM(pA0, pA1, m_reg, mnA, alA);
    if (NT > 1) { VMW(); SWRITE_H(1); }
    __syncthreads();
#define HALF_STEP(PX0, PX1, mnX, alX, PY0, PY1, alY, t, KB, VB, SB, MWX, MWY) do {                                                      \
        SBAR(); qkt<KB>(PX0, PX1, K_lds, r32, hi, S.qr, ACT(t));                                             \
        finishSM(PY0, PY1, alY, l_reg, pa0, pa1, pa2, pa3); SBAR();                                                           \
        if ((t) + 1 < NT) { SLOAD_H(Kh, Vh, KBASE((t) + 1)); MWY = MWLOAD(cur, (t) + 1); SBAR(); }                                               \
        pv_tile<VB>(o, vb0, pa0, pa1, pa2, pa3, ACT((t) - 1)); MASKT(PX0, PX1, (t), MWX); partialSM(PX0, PX1, m_reg, mnX, alX);                                        \
        __syncthreads();                                                                                                      \
        if ((t) + 1 < NT) { VMW(); SWRITE_H(SB); }                                                                          \
        RESC(alX); __syncthreads(); } while (0)
    for (int t = 1; t + 1 < NT; t += 2) {
        HALF_STEP(pB0, pB1, mnB, alB, pA0, pA1, alA, t, 1, 0, 0, mwB, mwA);
        HALF_STEP(pA0, pA1, mnA, alA, pB0, pB1, alB, t + 1, 0, 1, 1, mwA, mwB);
    }
    const bool even = (NT & 1) == 0;
    if (even) { SBAR(); qkt<1>(pB0, pB1, K_lds, r32, hi, S.qr, ACT(NT - 1)); SBAR(); }
    SLOAD_H(nxt.K, nxt.V, 0); SBAR();
#pragma unroll
    for (int d0 = 0; d0 < 4; ++d0) S.qr[d0] = load8(nxt.Q + (size_t)(wid * QBLK + r32) * 512 + d0 * 16 + hi * 8);
    S.mw = MWLOAD(nxt, 0);
    SBAR();
    finishSM(pA0, pA1, alA, l_reg, pa0, pa1, pa2, pa3); SBAR();
    pv_tile<0>(o, vb0, pa0, pa1, pa2, pa3, ACT(even ? NT - 2 : NT - 1));
    if (even) { MASKT(pB0, pB1, NT - 1, mwB); partialSM(pB0, pB1, m_reg, mnB, alB); __syncthreads(); RESC(alB);
        finishSM(pB0, pB1, alB, l_reg, pa0, pa1, pa2, pa3); SBAR(); pv_tile<1>(o, vb0, pa0, pa1, pa2, pa3, ACT(NT - 1)); }
    SBAR(); SEAM_K0();
    if (hi == 0) li_l[r32] = l_reg; asm volatile("s_waitcnt lgkmcnt(0)" ::: "memory");
    int r32e = r32, hie = hi; asm volatile("" : "+v"(r32e), "+v"(hie));
    float rli[16];
#pragma unroll
    for (int r = 0; r < 16; ++r) rli[r] = __builtin_amdgcn_rcpf(li_l[crow(r, hie)]);
    bf16_t* Ow = cur.O + (size_t)(wid * QBLK) * DM;
#pragma unroll
    for (int r = 0; r < 16; ++r) { const unsigned oo = (unsigned)(crow(r, hie) * DM + r32e) * 2u;
#pragma unroll
        for (int d0 = 0; d0 < 2; ++d0) { const float v = o[d0][r] * rli[r];
            const float vn = swz_xor<1>(v);
            if ((r32e & 1) == 0) *(unsigned*)((char*)Ow + oo + d0 * 64) = cvt_pk_bf16(v, vn); } }
    __syncthreads();
#undef RESC
#undef KBASE
#undef ACT
#undef MASKT
#undef SEAM_K0
#undef HALF_STEP
}
#undef VMW
#undef VMWN
#undef TIDL
#undef SLOAD_H
#undef SWRITE_HK
#undef SWRITE_HV
#undef SWRITE_H
#undef MWLOAD
#undef KSWZ
#undef SBAR
}

__device__ __forceinline__ swa::BlockRef dil_ref(int u, const bf16_t* H1p, bf16_t* OPp, float* LSEp) {
    const int x = u & 15, rest = u >> 4, g = rest % 3, bh = rest / 3, h = bh & 7, bl = bh >> 3;
    const int dsh = 2 * g, dil = 1 << dsh, r = x >> (4 - dsh), blk = x & ((16 >> dsh) - 1), P0 = blk * 256;
    const size_t row0 = (size_t)bl * SEQ + r, rowq = row0 + (size_t)dil * P0;
    swa::BlockRef R;
    R.K = H1p + row0 * IN1_N + g * 3072 + 1024 + h * 128; R.Q = H1p + rowq * IN1_N + g * 3072 + h * 128;
    R.O = OPp + ((size_t)g * CHUNK_T + rowq) * DM + h * 128; R.LSE = LSEp + ((size_t)g * CHUNK_T + rowq) * 8 + h;
    R.P0 = P0; R.bh = h; R.dsh = dsh;
    return R;
}

struct Args {
    const float* in[25]; float* out; unsigned char* ws; int ph_lo, ph_hi;
};
enum { I_X = 0, I_RELB, I_EWIN, I_CONVW, I_CONVB, I_CLNG, I_CLNB, I_EWOUT, I_ELN1G, I_ELN1B, I_FWG, I_FWU, I_FWD, I_ELN2G, I_ELN2B,
       I_OWIN, I_OWOUT, I_OLN1G, I_OLN1B, I_ROUTER, I_MWG, I_MWU, I_MWD, I_OLN2G, I_OLN2B };

__device__ __forceinline__ void transpose_item(const float* W, int ldw, int src_c0, int nvalid, int k0, bf16_t* WT, int K, int dst_row0, LAS float* scr, int lane) {
    (void)scr;
    const int kg = lane & 7, ng = lane >> 3;
    f32x4 v[8];
    const float* src = W + (size_t)(k0 + 8 * kg) * ldw + src_c0 + 4 * ng;
    const bool ok = 4 * ng < nvalid;
#pragma unroll
    for (int r = 0; r < 8; ++r) v[r] = ok ? *(const f32x4*)(src + (size_t)r * ldw) : (f32x4){0.f, 0.f, 0.f, 0.f};
#pragma unroll
    for (int c = 0; c < 4; ++c) { u32x4 o; o.x = cvt_pk_bf16(v[0][c], v[1][c]); o.y = cvt_pk_bf16(v[2][c], v[3][c]); o.z = cvt_pk_bf16(v[4][c], v[5][c]); o.w = cvt_pk_bf16(v[6][c], v[7][c]);
        *(u32x4*)(WT + (size_t)(dst_row0 + 4 * ng + c) * K + k0 + 8 * kg) = o; }
}
__device__ __forceinline__ void gu_item(const float* wg, const float* wu, int FF, int K, bf16_t* WT, int item, LAS float* scr, int lane) {
    const int nblk = 2 * FF / 32, kb = item / nblk, nb = item % nblk, tile = nb >> 3, sub = nb & 7;
    transpose_item(sub < 4 ? wg : wu, FF, tile * 128 + (sub & 3) * 32, 32, kb * 64, WT, K, nb * 32, scr, lane);
}
__device__ __forceinline__ void plain_item(const float* W, int K, int N, bf16_t* WT, int item, LAS float* scr, int lane) {
    const int nblk = N / 32, kb = item / nblk, nb = item % nblk;
    transpose_item(W, N, nb * 32, 32, kb * 64, WT, K, nb * 32, scr, lane);
}
__device__ __forceinline__ void in0_item(const float* W, bf16_t* WT, int item, LAS float* scr, int lane) {
    const int nblk = IN0_N / 32, kb = item / nblk, nb = item % nblk, tile = nb >> 3, sub = nb & 7;
    int src_c0, nvalid = 32;
    if (tile < 4) src_c0 = (sub < 4) ? tile * 128 + sub * 32 : 512 + tile * 128 + (sub - 4) * 32;
    else { src_c0 = nb * 32; nvalid = IN0_SRC - src_c0; nvalid = nvalid < 0 ? 0 : (nvalid > 32 ? 32 : nvalid); if (nvalid == 0) src_c0 = 0; }
    transpose_item(W, IN0_SRC, src_c0, nvalid, kb * 64, WT, DM, nb * 32, scr, lane);
}
__device__ __forceinline__ int rel_bucket(int n) {
    if (n < 16) return n;
    const float nf = (float)n;
    int large = 16 + (int)(logf(nf / 16.0f) / logf(128.0f) * 16.0f);
    return large < 31 ? large : 31;
}

__device__ __forceinline__ void ln_core(f32x4 (&v)[4], const float* g, const float* b, int lane) {
    float s = 0.f;
#pragma unroll
    for (int j = 0; j < 4; ++j) s += (v[j][0] + v[j][1]) + (v[j][2] + v[j][3]);
    const float mean = wave_sum(s) * (1.f / DM); float s2 = 0.f;
#pragma unroll
    for (int j = 0; j < 4; ++j) { v[j] = v[j] - mean; s2 += (v[j][0] * v[j][0] + v[j][1] * v[j][1]) + (v[j][2] * v[j][2] + v[j][3] * v[j][3]); }
    const float rstd = 1.f / sqrtf(wave_sum(s2) * (1.f / DM) + LN_EPS);
#pragma unroll
    for (int j = 0; j < 4; ++j) { const f32x4 gg = *(const f32x4*)(g + 4 * lane + 256 * j), bb = *(const f32x4*)(b + 4 * lane + 256 * j); v[j] = v[j] * rstd * gg + bb; }
}
__device__ __forceinline__ void store_row_bf16(bf16_t* orow, const f32x4 (&v)[4], int lane) {
#pragma unroll
    for (int j = 0; j < 4; ++j) { u32x2 w; w.x = cvt_pk_bf16(v[j][0], v[j][1]); w.y = cvt_pk_bf16(v[j][2], v[j][3]); *(u32x2*)(orow + 4 * lane + 256 * j) = w; }
}
__device__ __forceinline__ f32x4 ld_bf4(const bf16_t* p) { const u32x2 w = *(const u32x2*)p; return (f32x4){bf_lo(w.x), bf_hi(w.x), bf_lo(w.y), bf_hi(w.y)}; }

__device__ __forceinline__ int my_lane_asm() { int l; asm volatile("v_mbcnt_lo_u32_b32 %0, -1, 0\n\tv_mbcnt_hi_u32_b32 %0, -1, %0" : "=v"(l)); return l; }
__global__ void __launch_bounds__(NTHR, 2) fwd_kernel(Args args) {
    extern __shared__ __attribute__((aligned(16))) unsigned char lds_raw[];
    LAS unsigned char* lds = (LAS unsigned char*)lds_raw;
    const int G = gridDim.x, bid = blockIdx.x;
    const int NGW = G * NWAVES;
    volatile LAS unsigned* MISC = (volatile LAS unsigned*)(lds + LDS_MISC);
    const int wave_id = __builtin_amdgcn_readfirstlane((int)(threadIdx.x >> 6));
    {
        const int l0 = my_lane_asm();
        if (wave_id == 0 && l0 < 16) MISC[l0] = 0u;
        __syncthreads();
    }
#define MY_LANE() my_lane_asm()
#if ONE_LAUNCH
    (void)xcd_barrier_post((unsigned*)(args.ws + WS_CTL) + CW_BAR, MISC, wave_id == 0 && MY_LANE() == 0);
#define GRID_BAR() do { XcdBarrier _b; _b.bar = (unsigned*)(ws + WS_CTL) + CW_BAR; _b.x = xb_xcc_id(); _b.st = (volatile LAS unsigned*)(lds + LDS_MISC); xcd_barrier(_b, tid == 0); } while (0)
#else
#define GRID_BAR() do { } while (0)
#endif
    const int lo = args.ph_lo, hi = args.ph_hi;
#ifndef PH_MASK
#define PH_MASK 0xFFFFFFu
#endif
#define IN(k) ((((PH_MASK) >> (k)) & 1u) && lo <= (k) && (k) < hi)
#define BOTH(k) (IN(k) && IN((k) + 1))
#define PHASE_BEGIN int lane = MY_LANE(); asm volatile("" : "+v"(lane)); const int wave = wave_id; const int tid = wave * 64 + lane; const int gw = bid * NWAVES + wave; \
    size_t zoff_ = 0; asm volatile("" : "+s"(zoff_)); unsigned char* ws = args.ws + zoff_; float* outp = (float*)((unsigned char*)args.out + zoff_); unsigned* ctl = (unsigned*)(ws + WS_CTL); (void)lane; (void)wave; (void)gw; (void)ctl; (void)outp;
#define x_in (args.in[I_X])
#define WIN0 ((bf16_t*)(ws + WS_WIN0))
#define WOUT0 ((bf16_t*)(ws + WS_WOUT0))
#define WGU0 ((bf16_t*)(ws + WS_WGU0))
#define WD0 ((bf16_t*)(ws + WS_WD0))
#define WIN1 ((bf16_t*)(ws + WS_WIN1))
#define WOUT1 ((bf16_t*)(ws + WS_WOUT1))
#define MWGU ((bf16_t*)(ws + WS_MWGU))
#define MWD ((bf16_t*)(ws + WS_MWD))
#define BIAST ((float*)(ws + WS_BIAST))
#define XB ((bf16_t*)(ws + WS_XB))
#define Ub ((bf16_t*)(ws + WS_U))
#define Q0 ((bf16_t*)(ws + WS_Q0))
#define K0 ((bf16_t*)(ws + WS_Q0 + SEG0))
#define V0 ((bf16_t*)(ws + WS_Q0 + 2 * SEG0))
#define QI ((bf16_t*)(ws + WS_Q0 + 3 * SEG0))
#define KI ((bf16_t*)(ws + WS_KI))
#define WI ((float*)(ws + WS_WI))
#define MASK ((u64*)(ws + WS_MASK))
#define MIXIN ((bf16_t*)(ws + WS_MIXIN))
#define X1B ((bf16_t*)(ws + WS_X1B))
#define H0 ((bf16_t*)(ws + WS_H0))
#define X2B ((bf16_t*)(ws + WS_X2B))
#define H1 ((bf16_t*)(ws + WS_H1))
#define O1 ((bf16_t*)outp)
#define Y3 ((float*)(ws + WS_Y3))
#define X3B ((bf16_t*)(ws + WS_X3B))
#define YB ((bf16_t*)(ws + WS_YB))
#define MTOK ((int*)(ws + WS_MOE_TOK))
#define MGATE ((float*)(ws + WS_MOE_GATE))
#define GTAB ((const LAS int*)(lds + LDS_GTAB))

    if (IN(0)) { asm volatile("; PHASE_MARK 0"); PHASE_BEGIN
        LAS float* scr = (LAS float*)(lds + wave * 16384);
        constexpr int I_IN0 = 16 * (IN0_N / 32), I_OUT = 16 * 32, I_GU0 = 16 * (2 * FF0 / 32), I_D0 = (FF0 / 64) * 32, I_IN1 = 16 * (IN1_N / 32);
        constexpr int NIT = I_IN0 + I_OUT + I_GU0 + I_D0 + I_IN1 + I_OUT;
        for (int it = gw; it < NIT; it += NGW) {
            int r = it;
            if (r < I_IN0) { in0_item(args.in[I_EWIN], WIN0, r, scr, lane); continue; } r -= I_IN0;
            if (r < I_OUT) { plain_item(args.in[I_EWOUT], DM, DM, WOUT0, r, scr, lane); continue; } r -= I_OUT;
            if (r < I_GU0) { gu_item(args.in[I_FWG], args.in[I_FWU], FF0, DM, WGU0, r, scr, lane); continue; } r -= I_GU0;
            if (r < I_D0) { plain_item(args.in[I_FWD], FF0, DM, WD0, r, scr, lane); continue; } r -= I_D0;
            if (r < I_IN1) { plain_item(args.in[I_OWIN], DM, IN1_N, WIN1, r, scr, lane); continue; } r -= I_IN1;
            plain_item(args.in[I_OWOUT], DM, DM, WOUT1, r, scr, lane);
        }
        for (size_t i = (size_t)bid * NTHR + tid; i < (size_t)NTOK * DM / 8; i += (size_t)G * NTHR) {
            const f32x4 a = *(const f32x4*)(x_in + i * 8), b = *(const f32x4*)(x_in + i * 8 + 4);
            *(u32x4*)(XB + i * 8) = pg8::pack8(a, b);
        }
        for (int i = bid * NTHR + tid; i < 8 * 4096; i += G * NTHR) { const int h = i >> 12, d = i & 4095; BIAST[i] = args.in[I_RELB][rel_bucket(d) * 8 + h]; }
        if (BOTH(0)) GRID_BAR();
    }

    if (IN(1)) { asm volatile("; PHASE_MARK 1"); PHASE_BEGIN
        pg8::StaticOrder S; S.init(XB, NTOK, IN0_N, DM, G, bid);
        pg8::EpiIn0 E{Ub, Q0, KI, WI};
        pg8::gemm_phase<pg8::EpiIn0, pg8::StaticOrder, true, false>(tid, lds, WIN0, DM, S, E, GTAB);
        if (BOTH(1)) GRID_BAR();
    }

    if (IN(2)) { asm volatile("; PHASE_MARK 2"); PHASE_BEGIN
        {
            LAS bf16_t* ut = (LAS bf16_t*)lds;
            LAS float* yt = (LAS float*)(lds + 65536);
            const float* cw = args.in[I_CONVW];
            const int cp = tid & 255, th = tid >> 8;
            float w0[31], w1[31];
#pragma unroll
            for (int j = 0; j < 31; ++j) { const f32x2 wv = *(const f32x2*)(cw + j * 512 + 2 * cp); w0[j] = wv.x; w1[j] = wv.y; }
            const f32x2 cbv = *(const f32x2*)(args.in[I_CONVB] + 2 * cp);
            for (int tile = bid; tile < NTOK / 32; tile += G) {
                const int t0 = tile * 32, s0 = t0 & (SEQ - 1);
                for (int i = tid; i < 62 * 64; i += NTHR) { const int r = i >> 6, c8 = i & 63; const int sr = s0 - 30 + r;
                    u32x4 v = (u32x4){0u, 0u, 0u, 0u}; if (sr >= 0) v = *(const u32x4*)(Ub + (size_t)(t0 - 30 + r) * 512 + c8 * 8);
                    *(LAS u32x4*)(ut + r * 512 + c8 * 8) = v; }
                __syncthreads();
                {
                    float a0[16], a1[16];
#pragma unroll
                    for (int t = 0; t < 16; ++t) { a0[t] = cbv.x; a1[t] = cbv.y; }
#pragma unroll
                    for (int r = 0; r < 46; ++r) { const unsigned uv = *(const LAS unsigned*)(ut + (th * 16 + r) * 512 + 2 * cp); const float u0 = bf_lo(uv), u1 = bf_hi(uv);
#pragma unroll
                        for (int t = 0; t < 16; ++t) { const int j = r - t; if (j >= 0 && j < 31) { a0[t] += w0[j] * u0; a1[t] += w1[j] * u1; } } }
#pragma unroll
                    for (int t = 0; t < 16; ++t) *(LAS f32x2*)(yt + (th * 16 + t) * 512 + 2 * cp) = (f32x2){a0[t], a1[t]};
                }
                __syncthreads();
                const float* lg = args.in[I_CLNG]; const float* lb = args.in[I_CLNB];
#pragma unroll
                for (int tt = 0; tt < 4; ++tt) { const int t = wave * 4 + tt;
                    f32x4 a = *(LAS f32x4*)(yt + t * 512 + lane * 8), b = *(LAS f32x4*)(yt + t * 512 + lane * 8 + 4);
                    float s = (a[0] + a[1]) + (a[2] + a[3]) + (b[0] + b[1]) + (b[2] + b[3]); const float mean = wave_sum(s) * (1.f / 512.f);
                    a = a - mean; b = b - mean; float s2 = a[0] * a[0] + a[1] * a[1] + a[2] * a[2] + a[3] * a[3] + b[0] * b[0] + b[1] * b[1] + b[2] * b[2] + b[3] * b[3];
                    const float rstd = 1.f / sqrtf(wave_sum(s2) * (1.f / 512.f) + LN_EPS);
                    const f32x4 g0 = *(const f32x4*)(lg + lane * 8), g1 = *(const f32x4*)(lg + lane * 8 + 4), b0 = *(const f32x4*)(lb + lane * 8), b1 = *(const f32x4*)(lb + lane * 8 + 4);
                    a = a * rstd * g0 + b0; b = b * rstd * g1 + b1;
#pragma unroll
                    for (int j = 0; j < 4; ++j) { a[j] = a[j] * sigmoidf_(a[j]); b[j] = b[j] * sigmoidf_(b[j]); }
                    *(u32x4*)(MIXIN + (size_t)(t0 + t) * DM + lane * 8) = pg8::pack8(a, b); }
                __syncthreads();
            }
        }
        {
            constexpr int CAP = 512, HROW = 2052;
            LAS unsigned* hist = (LAS unsigned*)lds;
            LAS unsigned* clist = hist;
            LAS unsigned* mtile = (LAS unsigned*)(lds + 16 * HROW * 4);
            LAS unsigned* rinfo = mtile + 2048;
            LAS unsigned* ccnt = rinfo + 64;
            LAS unsigned* flag = rinfo + 80;
            LAS unsigned* rsel = rinfo + 96;
            LAS unsigned* whist = rinfo + 256 + wave * 256;
            const int vcu = (G % 8 == 0) ? (bid % 8) * (G / 8) + bid / 8 : bid;
            const int lane_p = lane;
            for (int it = 0; it < 8 && vcu < 256; ++it) {
                int lane = lane_p; asm volatile("" : "+v"(lane));
                const int tid = wave * 64 + lane, g4 = lane >> 4, r16 = lane & 15;
                const int b = it, qt = (it & 1) ? 255 - vcu : vcu;
                const int q0 = qt * 16, tok0 = b * SEQ + q0, nwords = (q0 + 15) / 64 + 1, q = q0 + r16;
                if (q0 < 256) {
                    for (int i = tid; i < 16 * nwords; i += NTHR) { const int r = i & 15, W = i >> 4; const int d = q0 + r - 64 * W;
                        const u64 word = d >= 63 ? ~0ull : (d < 0 ? 0ull : ((2ull << d) - 1ull));
                        MASK[((size_t)b * 64 + W) * SEQ + q0 + r] = word; }
                    continue;
                }
                for (int i = tid; i < 16 * 64 * 2; i += NTHR) mtile[i] = 0u;
                if (tid < 16) ccnt[tid] = 0u;
                unsigned prefix = 0u; int shift = 21, shift_prev = 32, level = 0; bool collect = false;
#define KLOAD(dst, st_) do { const int W_ = wave + 8 * ((st_) >> 1), hf_ = (st_) & 1; _Pragma("unroll") for (int u_ = 0; u_ < 2; ++u_) _Pragma("unroll") for (int c2_ = 0; c2_ < 2; ++c2_) \
                    dst[u_][c2_] = *(const bf16x8*)(KI + ((size_t)b * SEQ + 64 * W_ + 32 * hf_ + 16 * u_ + r16) * 64 + c2_ * 32 + g4 * 8); } while (0)
#define FIRST_PASS() do { \
                    bf16x8 Qf[8][2]; float wq[8]; \
                    _Pragma("unroll") for (int h = 0; h < 8; ++h) _Pragma("unroll") for (int c2 = 0; c2 < 2; ++c2) Qf[h][c2] = *(const bf16x8*)(QI + (size_t)(tok0 + r16) * 512 + h * 64 + c2 * 32 + g4 * 8); \
                    { const f32x4 w0 = *(const f32x4*)(WI + (size_t)(tok0 + r16) * 8), w1 = *(const f32x4*)(WI + (size_t)(tok0 + r16) * 8 + 4); \
                      wq[0] = w0[0]; wq[1] = w0[1]; wq[2] = w0[2]; wq[3] = w0[3]; wq[4] = w1[0]; wq[5] = w1[1]; wq[6] = w1[2]; wq[7] = w1[3]; } \
                    bf16x8 Kc[2][2], Kn[2][2]; \
                    if (nmine > 0) KLOAD(Kc, 0); \
                    for (int st = 0; st < 2 * nmine; ++st) { \
                        const int c = st >> 1, hf = st & 1, W = wave + 8 * c; \
                        if (st + 1 < 2 * nmine) KLOAD(Kn, st + 1); \
                        _Pragma("unroll") for (int tu = 0; tu < 2; ++tu) { \
                            float scv[4] = {0.f, 0.f, 0.f, 0.f}; \
                            _Pragma("unroll") for (int h = 0; h < 8; ++h) { \
                                f32x4 t = __builtin_amdgcn_mfma_f32_16x16x32_bf16(Kc[tu][0], Qf[h][0], (f32x4){0.f, 0.f, 0.f, 0.f}, 0, 0, 0); \
                                t = __builtin_amdgcn_mfma_f32_16x16x32_bf16(Kc[tu][1], Qf[h][1], t, 0, 0, 0); \
                                _Pragma("unroll") for (int i = 0; i < 4; ++i) { const int ti = __float_as_int(t[i]); scv[i] += wq[h] * __int_as_float(ti > 0 ? ti : 0); } \
                            } \
                            const int dq = q - (64 * W + 32 * hf + 16 * tu + 4 * g4);            \
                            u32x4 key; \
                            _Pragma("unroll") for (int i = 0; i < 4; ++i) { const unsigned uu = __float_as_uint(scv[i] + 0.0f); key[i] = (dq >= i) ? (uu ^ ((unsigned)((int)uu >> 31) | 0x80000000u)) : 0u; }     \
                            ksp[(c * 4 + hf * 2 + tu) * 64] = key; \
                            _Pragma("unroll") for (int i = 0; i < 4; ++i) { const unsigned a_ = key[i] ? ((key[i] >> 21) << 2) : (2050u << 2); \
                                asm volatile("ds_add_u32 %0, %1" :: "v"(hrow + a_), "v"(1u) : "memory"); } \
                        } \
                        _Pragma("unroll") for (int u = 0; u < 2; ++u) { Kc[u][0] = Kn[u][0]; Kc[u][1] = Kn[u][1]; } \
                    } } while (0)
#define LATER_PASS() do { \
                    for (int c = 0; c < nmine; ++c) { \
                        const int W = wave + 8 * c; \
                        u32x4 kk4[4]; \
                        _Pragma("unroll") for (int u = 0; u < 4; ++u) kk4[u] = ksp[(c * 4 + u) * 64]; \
                        unsigned braw0 = 0u, braw1 = 0u; \
                        _Pragma("unroll") for (int u = 0; u < 4; ++u) { \
                            if (!collect) { \
                                _Pragma("unroll") for (int i = 0; i < 4; ++i) { const unsigned key = kk4[u][i]; const bool m_ = key != 0u && (((key ^ prefix) & pmask) == 0u); const unsigned a_ = m_ ? (((key >> shift) & bmask) << 2) : (2050u << 2); \
                                    asm volatile("ds_add_u32 %0, %1" :: "v"(hrow + a_), "v"(1u) : "memory"); } \
                            } else { \
                                _Pragma("unroll") for (int i = 0; i < 4; ++i) { const unsigned key = kk4[u][i]; const bool valid = key != 0u; const unsigned kb_ = key >> shift, pb_ = prefix >> shift; \
                                    const unsigned bit_ = (valid && kb_ > pb_) ? (1u << (16 * (u & 1) + i)) : 0u; if (u < 2) braw0 |= bit_; else braw1 |= bit_; \
                                    if (valid && kb_ == pb_) { const unsigned pos = __hip_atomic_fetch_add((unsigned*)(ccnt + r16), 1u, __ATOMIC_RELAXED, __HIP_MEMORY_SCOPE_WORKGROUP); \
                                        if (pos < (unsigned)CAP) { clist[(r16 * CAP + pos) * 2] = key; clist[(r16 * CAP + pos) * 2 + 1] = (unsigned)(64 * W + 16 * u + 4 * g4 + i); } } } \
                            } \
                        } \
                        if (collect) { \
                            unsigned b0 = braw0 << (4 * g4), b1 = braw1 << (4 * g4); \
                            b0 |= (unsigned)__builtin_amdgcn_ds_swizzle((int)b0, (16 << 10) | 0x1f); b1 |= (unsigned)__builtin_amdgcn_ds_swizzle((int)b1, (16 << 10) | 0x1f); \
                            { auto r0 = __builtin_amdgcn_permlane32_swap(b0, b0, false, false); b0 = r0[0] | r0[1]; auto r1 = __builtin_amdgcn_permlane32_swap(b1, b1, false, false); b1 = r1[0] | r1[1]; } \
                            if (lane < 16) { mtile[(lane * 64 + W) * 2] = b0; mtile[(lane * 64 + W) * 2 + 1] = b1; } \
                        } \
                    } } while (0)
                const int nmine = (nwords > wave) ? ((nwords - wave + 7) >> 3) : 0;
                const int lane_q = lane;
                for (int pass = 0; pass < 4; ++pass) {
                    int lane = lane_q; asm volatile("" : "+v"(lane));
                    const int tid = wave * 64 + lane, g4 = lane >> 4, r16 = lane & 15, q = q0 + r16;
                    const unsigned hrow = (unsigned)(uintptr_t)(hist + r16 * HROW);
                    if (!collect) { for (int i = tid; i < 16 * HROW; i += NTHR) hist[i] = 0u; if (tid < 4) flag[tid] = 0u; }
                    const unsigned bmask = (level == 2) ? 1023u : 2047u, pmask = (level == 0) ? 0u : (level == 1) ? 0xFFE00000u : 0xFFFFFC00u;
                    __syncthreads();
                    u32x4* ksp = (u32x4*)(ws + WS_KS) + ((size_t)(vcu * 8 + wave) * 32) * 64 + lane;
                    if (pass == 0) FIRST_PASS(); else LATER_PASS();
                    __syncthreads();
                    if (collect) break;
                    {
                        const int row = tid >> 5, seg = tid & 31; const LAS unsigned* hr = hist + row * HROW + seg * 64;
                        unsigned tot = 0u;
#pragma unroll 8
                        for (int j = 0; j < 64; ++j) tot += hr[j];
                        unsigned inc = tot;
#pragma unroll
                        for (int o = 1; o < 32; o <<= 1) { const unsigned t = lane_get(inc, (lane & 32) | ((seg + o) & 31)); if (seg + o < 32) inc += t; }
                        const unsigned exc = inc - tot, kk = (level == 0) ? 256u : rinfo[row * 4 + 1], pfx = (level == 0) ? 0u : rinfo[row * 4 + 0];
                        if (exc < kk && inc >= kk) {
                            unsigned cum = exc, bin = 0u, kn = kk, cb = 0u; bool done = false;
#pragma unroll 1
                            for (int j = 63; j >= 0 && !done; --j) { const unsigned cj = hr[j];
                                if (cum + cj >= kk) { bin = seg * 64 + j; kn = kk - cum; cb = cj; done = true; } else cum += cj; }
                            rinfo[row * 4 + 0] = pfx | (bin << shift); rinfo[row * 4 + 1] = kn; rinfo[row * 4 + 2] = cb;
                            if (cb > (unsigned)CAP && level < 2) __hip_atomic_fetch_or((unsigned*)flag, 1u, __ATOMIC_RELAXED, __HIP_MEMORY_SCOPE_WORKGROUP);
                        }
                    }
                    __syncthreads();
                    prefix = rinfo[r16 * 4 + 0];
                    const unsigned more = flag[0];
                    __syncthreads();
                    if (more) { shift_prev = shift; ++level; shift = (level == 1) ? 10 : 0; } else collect = true;
                }
#undef FIRST_PASS
#undef LATER_PASS
#undef KLOAD
                for (int rr = 0; rr < 2; ++rr) {
                    int lane = lane_q; asm volatile("" : "+v"(lane));
                    const int row = wave * 2 + rr; unsigned cc = ccnt[row]; cc = cc > (unsigned)CAP ? (unsigned)CAP : cc; const int cn = (int)cc;
                    const LAS unsigned* cl = clist + row * CAP * 2;
                    unsigned pf = 0u; int kk = (int)rinfo[row * 4 + 1]; unsigned ties = 0u;
                    if (kk > cn) kk = cn;
                    if (kk > 0) {
                    for (int ps = 0; ps < 4; ++ps) {
                        const int sh = 24 - 8 * ps;
#pragma unroll
                        for (int j = 0; j < 4; ++j) whist[lane * 4 + j] = 0u;
                        WAVE_LDS_FENCE();
                        for (int i = lane; i < cn; i += 64) { const unsigned key = cl[i * 2];
                            const bool m = (ps == 0) || ((key >> (sh + 8)) == (pf >> (sh + 8)));
                            if (m) __hip_atomic_fetch_add((unsigned*)(whist + ((key >> sh) & 255u)), 1u, __ATOMIC_RELAXED, __HIP_MEMORY_SCOPE_WORKGROUP); }
                        WAVE_LDS_FENCE();
                        const unsigned c0 = whist[lane * 4 + 0], c1 = whist[lane * 4 + 1], c2 = whist[lane * 4 + 2], c3 = whist[lane * 4 + 3];
                        const unsigned sl = c0 + c1 + c2 + c3; unsigned inc = sl;
#pragma unroll
                        for (int o = 1; o < 64; o <<= 1) { const unsigned t = lane_get(inc, (lane + o) & 63); if (lane + o < 64) inc += t; }
                        const unsigned exc = inc - sl;
                        const bool found = (exc < (unsigned)kk) && (inc >= (unsigned)kk);
                        int bin = 0, kn = 0; unsigned cb = 0u;
                        { unsigned cum = exc;
                          if (cum + c3 >= (unsigned)kk) { bin = 3; kn = kk - (int)cum; cb = c3; } else { cum += c3;
                          if (cum + c2 >= (unsigned)kk) { bin = 2; kn = kk - (int)cum; cb = c2; } else { cum += c2;
                          if (cum + c1 >= (unsigned)kk) { bin = 1; kn = kk - (int)cum; cb = c1; } else { cum += c1; bin = 0; kn = kk - (int)cum; cb = c0; } } } }
                        const u64 fm = __ballot(found); const int src = fm ? (__ffsll((long long)fm) - 1) : 0;
                        bin = (int)lane_get((unsigned)(lane * 4 + bin), src); kk = (int)lane_get((unsigned)kn, src); ties = lane_get(cb, src);
                        pf |= ((unsigned)bin) << sh;
                        WAVE_LDS_FENCE();
                    }
                    unsigned cut = 0xFFFFFFFFu;
                    if (ties > (unsigned)kk) {
                        for (int i = lane; i < cn; i += 64) { if (cl[i * 2] == pf) { const unsigned myi = cl[i * 2 + 1]; int rank = 0;
                                for (int j = 0; j < cn; ++j) rank += (cl[j * 2] == pf && cl[j * 2 + 1] < myi) ? 1 : 0;
                                if (rank == kk - 1) rsel[row * 2 + 1] = myi; } }
                        WAVE_LDS_FENCE();
                        cut = rsel[row * 2 + 1];
                    }
                    for (int i = lane; i < cn; i += 64) { const unsigned key = cl[i * 2], kidx = cl[i * 2 + 1];
                        if (key > pf || (key == pf && kidx <= cut)) __hip_atomic_fetch_or((unsigned*)(mtile + (row * 64 + (kidx >> 6)) * 2 + ((kidx >> 5) & 1u)), 1u << (kidx & 31u), __ATOMIC_RELAXED, __HIP_MEMORY_SCOPE_WORKGROUP); }
                    }
                }
                __syncthreads();
                for (int i = tid; i < 16 * nwords; i += NTHR) { const int r = i & 15, W = i >> 4;
                    MASK[((size_t)b * 64 + W) * SEQ + q0 + r] = (u64)mtile[(r * 64 + W) * 2] | ((u64)mtile[(r * 64 + W) * 2 + 1] << 32); }
                __syncthreads();
            }
        }
        if (BOTH(2)) GRID_BAR();
    }

    if (IN(3)) { asm volatile("; PHASE_MARK 3"); PHASE_BEGIN
        const int vcu = (G % 8 == 0) ? (bid % 8) * (G / 8) + bid / 8 : bid;
        if (vcu < 256) {
            const int pp = vcu & 3, h = (vcu >> 2) & 7, b = vcu >> 5;
            { float* tb = (float*)(lds_raw + dsa::LDS_TB);
              for (int i = tid; i < dsa::TB_PAD + 4096; i += NTHR) tb[i] = (i >= dsa::TB_PAD) ? BIAST[h * 4096 + (i - dsa::TB_PAD)] * 8.0f : 0.f; }
            const bf16_t* Kp = K0 + (size_t)b * SEQ * 512 + h * 64; const bf16_t* Vp = V0 + (size_t)b * SEQ * 512 + h * 64;
#define DSA_REF(R, i_) do { const int qb_ = ((i_) == 0) ? pp : ((i_) == 1) ? 15 - pp : ((i_) == 2) ? pp + 4 : 11 - pp; const int P0_ = qb_ * 256; \
            R.Q = Q0 + ((size_t)b * SEQ + P0_) * 512 + h * 64; R.K = Kp; R.V = Vp; R.O = MIXIN + ((size_t)b * SEQ + P0_) * DM + 512 + h * 64; \
            R.MW = MASK + (size_t)b * 64 * SEQ + P0_; R.P0 = P0_; } while (0)
            dsa::Seam SS; dsa::BlockRef cur, nxt; DSA_REF(cur, 0);
            dsa::dsa_prime(cur, (char*)lds_raw, SS, tid);
            for (int i = 0; i < 4; ++i) {
                if (i < 3) { DSA_REF(nxt, i + 1); } else nxt = cur;
                dsa::dsa_block(cur, nxt, (char*)lds_raw, SS, tid);
                cur = nxt;
            }
#undef DSA_REF
        }
        if (BOTH(3)) GRID_BAR();
    }
    if (IN(4)) { asm volatile("; PHASE_MARK 4"); PHASE_BEGIN
        pg8::StaticOrder S; S.init(MIXIN, NTOK, DM, DM, G, bid);
        pg8::EpiRes E{(bf16_t*)outp, XB};
        pg8::gemm_phase<pg8::EpiRes, pg8::StaticOrder, true, false>(tid, lds, WOUT0, DM, S, E, GTAB);
        if (BOTH(4)) GRID_BAR();
    }
    if (IN(5)) { asm volatile("; PHASE_MARK 5"); PHASE_BEGIN
        for (int m = gw; m < NTOK; m += NGW) { f32x4 v[4];
#pragma unroll
            for (int j = 0; j < 4; ++j) v[j] = ld_bf4((const bf16_t*)outp + (size_t)m * DM + 4 * lane + 256 * j);
            ln_core(v, args.in[I_ELN1G], args.in[I_ELN1B], lane); store_row_bf16(X1B + (size_t)m * DM, v, lane); }
        if (BOTH(5)) GRID_BAR();
    }
    if (IN(6)) { asm volatile("; PHASE_MARK 6"); PHASE_BEGIN
        pg8::StaticOrder S; S.init(X1B, NTOK, 2 * FF0, DM, G, bid);
        pg8::EpiSwiglu<false> E{H0, FF0, (char*)outp, (char*)ws};
        pg8::gemm_phase<pg8::EpiSwiglu<false>, pg8::StaticOrder, true, false>(tid, lds, WGU0, DM, S, E, GTAB);
        if (BOTH(6)) GRID_BAR();
    }
    if (IN(7)) { asm volatile("; PHASE_MARK 7"); PHASE_BEGIN
        pg8::StaticOrder S; S.init(H0, NTOK, DM, FF0, G, bid);
        pg8::EpiRes E{(bf16_t*)outp, X1B};
        pg8::gemm_phase<pg8::EpiRes, pg8::StaticOrder, true, false>(tid, lds, WD0, FF0, S, E, GTAB);
        if (BOTH(7)) GRID_BAR();
    }
    if (IN(8)) { asm volatile("; PHASE_MARK 8"); PHASE_BEGIN
        for (int m = gw; m < NTOK; m += NGW) { f32x4 v[4];
#pragma unroll
            for (int j = 0; j < 4; ++j) v[j] = ld_bf4((const bf16_t*)outp + (size_t)m * DM + 4 * lane + 256 * j);
            ln_core(v, args.in[I_ELN2G], args.in[I_ELN2B], lane); store_row_bf16(X2B + (size_t)m * DM, v, lane); }
        if (BOTH(8)) GRID_BAR();
    }
#define MERGE_CHUNK(chm) do { \
        const bf16_t* OPp = (const bf16_t*)(ws + WS_OP); const float* LSEp = (const float*)(ws + WS_LSE); \
        for (int tl = gw; tl < CHUNK_T; tl += NGW) { const int hh = lane >> 3; \
            const float l0 = LSEp[(size_t)tl * 8 + hh], l1 = LSEp[((size_t)CHUNK_T + tl) * 8 + hh], l2 = LSEp[((size_t)2 * CHUNK_T + tl) * 8 + hh]; \
            const float mm = fmaxf(l0, fmaxf(l1, l2)); float w0 = __expf(l0 - mm), w1 = __expf(l1 - mm), w2 = __expf(l2 - mm); const float inv = 1.f / (w0 + w1 + w2); w0 *= inv; w1 *= inv; w2 *= inv; \
            const bf16_t* p0 = OPp + (size_t)tl * DM + lane * 16; const bf16_t* p1 = p0 + (size_t)CHUNK_T * DM; const bf16_t* p2 = p1 + (size_t)CHUNK_T * DM; \
            _Pragma("unroll") for (int q = 0; q < 2; ++q) { const u32x4 a = *(const u32x4*)(p0 + q * 8), b = *(const u32x4*)(p1 + q * 8), c = *(const u32x4*)(p2 + q * 8); u32x4 o; \
                o.x = cvt_pk_bf16(w0 * bf_lo(a.x) + w1 * bf_lo(b.x) + w2 * bf_lo(c.x), w0 * bf_hi(a.x) + w1 * bf_hi(b.x) + w2 * bf_hi(c.x)); \
                o.y = cvt_pk_bf16(w0 * bf_lo(a.y) + w1 * bf_lo(b.y) + w2 * bf_lo(c.y), w0 * bf_hi(a.y) + w1 * bf_hi(b.y) + w2 * bf_hi(c.y)); \
                o.z = cvt_pk_bf16(w0 * bf_lo(a.z) + w1 * bf_lo(b.z) + w2 * bf_lo(c.z), w0 * bf_hi(a.z) + w1 * bf_hi(b.z) + w2 * bf_hi(c.z)); \
                o.w = cvt_pk_bf16(w0 * bf_lo(a.w) + w1 * bf_lo(b.w) + w2 * bf_lo(c.w), w0 * bf_hi(a.w) + w1 * bf_hi(b.w) + w2 * bf_hi(c.w)); \
                *(u32x4*)(O1 + ((size_t)(chm) * CHUNK_T + tl) * DM + lane * 16 + q * 8) = o; } } } while (0)
#pragma unroll
    for (int ch = 0; ch < 2; ++ch) {
        if (IN(9 + 2 * ch)) { asm volatile("; PHASE_MARK 9"); PHASE_BEGIN
            if (ch == 1) { MERGE_CHUNK(0); }
            pg8::StaticOrder S; S.init(X2B + (size_t)ch * CHUNK_T * DM, CHUNK_T, IN1_N, DM, G, bid);
            pg8::EpiQkv1 E{H1, IN1_N, 1.0f};
            pg8::gemm_phase<pg8::EpiQkv1, pg8::StaticOrder, true, false>(tid, lds, WIN1, DM, S, E, GTAB);
            if (BOTH(9 + 2 * ch)) GRID_BAR();
        }
        if (IN(10 + 2 * ch)) { asm volatile("; PHASE_MARK 10"); PHASE_BEGIN
            constexpr int NU = CHUNK_B * 8 * 3 * 16;
            const int vcu = (G % 8 == 0) ? (bid % 8) * (G / 8) + bid / 8 : bid;
            bf16_t* OPp = (bf16_t*)(ws + WS_OP); float* LSEp = (float*)(ws + WS_LSE);
            int L0 = vcu;
            if (L0 < NU) {
                swa::Seam SS; swa::BlockRef cur = dil_ref(L0, H1, OPp, LSEp);
                swa::swa_prime(cur, BIAST, (char*)lds_raw, SS, tid);
                int slot = 0;
                for (;;) {
                    const int Ln = L0 + G; const bool last = Ln >= NU;
                    const swa::BlockRef nxt = last ? cur : dil_ref(Ln, H1, OPp, LSEp);
                    swa::swa_block(cur, nxt, BIAST, slot, (char*)lds_raw, SS, tid);
                    if (last) break;
                    cur = nxt; L0 = Ln; slot ^= 1;
                }
            }
            if (BOTH(10 + 2 * ch)) GRID_BAR();
        }
    }
    if (IN(13)) { asm volatile("; PHASE_MARK 13"); PHASE_BEGIN
        MERGE_CHUNK(1);
        if (BOTH(13)) GRID_BAR();
    }
    if (IN(14)) { asm volatile("; PHASE_MARK 14"); PHASE_BEGIN
        pg8::StaticOrder S; S.init(O1, NTOK, DM, DM, G, bid);
        pg8::EpiRes E{(bf16_t*)Y3, X2B};
        pg8::gemm_phase<pg8::EpiRes, pg8::StaticOrder, true, false>(tid, lds, WOUT1, DM, S, E, GTAB);
        if (BOTH(14)) GRID_BAR();
    }
    if (IN(15)) { asm volatile("; PHASE_MARK 15"); PHASE_BEGIN
        const float* rt = args.in[I_ROUTER];
        LAS unsigned* lcnt = (LAS unsigned*)lds;
        LAS unsigned* lbase = lcnt + 8;
        LAS int* lrow = (LAS int*)(lds + 256);
        LAS float* lgate = (LAS float*)(lds + 256 + 16384);
        if (tid < 8) lcnt[tid] = 0u;
        __syncthreads();
        int nloc = 0;
        for (int m = gw; m < NTOK; m += NGW, ++nloc) { f32x4 v[4];
#pragma unroll
            for (int j = 0; j < 4; ++j) v[j] = ld_bf4((const bf16_t*)Y3 + (size_t)m * DM + 4 * lane + 256 * j);
            ln_core(v, args.in[I_OLN1G], args.in[I_OLN1B], lane); store_row_bf16(X3B + (size_t)m * DM, v, lane);
            float lgt[8];
#pragma unroll
            for (int e = 0; e < 8; ++e) lgt[e] = 0.f;
#pragma unroll
            for (int j = 0; j < 4; ++j)
#pragma unroll
                for (int i = 0; i < 4; ++i) { const float* rr = rt + (size_t)(4 * lane + 256 * j + i) * 8; const f32x4 r0 = *(const f32x4*)rr, r1 = *(const f32x4*)(rr + 4); const float xv = v[j][i];
                    lgt[0] += xv * r0[0]; lgt[1] += xv * r0[1]; lgt[2] += xv * r0[2]; lgt[3] += xv * r0[3]; lgt[4] += xv * r1[0]; lgt[5] += xv * r1[1]; lgt[6] += xv * r1[2]; lgt[7] += xv * r1[3]; }
#pragma unroll
            for (int e = 0; e < 8; ++e) lgt[e] = wave_sum(lgt[e]);
            int e1 = 0; float v1 = lgt[0];
#pragma unroll
            for (int e = 1; e < 8; ++e) if (lgt[e] > v1) { v1 = lgt[e]; e1 = e; }
            int e2 = -1; float v2 = -INFINITY;
#pragma unroll
            for (int e = 0; e < 8; ++e) if (e != e1 && lgt[e] > v2) { v2 = lgt[e]; e2 = e; }
            const float g2 = 1.f / (1.f + __expf(v1 - v2)), g1 = 1.f - g2;
            if (lane == 0) { const int li = nloc * NWAVES + wave;
                const unsigned r1 = __hip_atomic_fetch_add((unsigned*)(lcnt + e1), 1u, __ATOMIC_RELAXED, __HIP_MEMORY_SCOPE_WORKGROUP), r2 = __hip_atomic_fetch_add((unsigned*)(lcnt + e2), 1u, __ATOMIC_RELAXED, __HIP_MEMORY_SCOPE_WORKGROUP);
                lrow[li * 4 + 0] = e1; lrow[li * 4 + 1] = (int)r1; lrow[li * 4 + 2] = e2; lrow[li * 4 + 3] = (int)r2; lgate[li * 2] = g1; lgate[li * 2 + 1] = g2; }
        }
        __syncthreads();
        if (tid < 8) lbase[tid] = atomicAdd(ctl + CW_MOECNT + tid, lcnt[tid]);
        __syncthreads();
        { const int nrows = (NTOK - bid * NWAVES + NGW - 1) / NGW;
          for (int li = tid; li < nrows * NWAVES; li += NTHR) { const int rnd = li / NWAVES, wv = li % NWAVES; const int m = (bid * NWAVES + wv) + rnd * NGW;
            if (m < NTOK) { const int e1 = lrow[li * 4 + 0], e2 = lrow[li * 4 + 2]; const unsigned p1 = lbase[e1] + (unsigned)lrow[li * 4 + 1], p2 = lbase[e2] + (unsigned)lrow[li * 4 + 3];
                if (p1 < (unsigned)NTOK) { MTOK[e1 * NTOK + p1] = m * 2; MGATE[e1 * NTOK + p1] = lgate[li * 2]; }
                if (p2 < (unsigned)NTOK) { MTOK[e2 * NTOK + p2] = m * 2 + 1; MGATE[e2 * NTOK + p2] = lgate[li * 2 + 1]; } } } }
        __syncthreads();
        {
            LAS float* scr = (LAS float*)(lds + wave * 16384);
            constexpr int I_GU = 16 * (2 * FFE / 32), I_D = (FFE / 64) * 32;
            for (int it = gw; it < NEXP * (I_GU + I_D); it += NGW) {
                const int e = it / (I_GU + I_D), r = it % (I_GU + I_D);
                if (r < I_GU) gu_item(args.in[I_MWG] + (size_t)e * DM * FFE, args.in[I_MWU] + (size_t)e * DM * FFE, FFE, DM, MWGU + (size_t)e * 2 * FFE * DM, r, scr, lane);
                else plain_item(args.in[I_MWD] + (size_t)e * FFE * DM, FFE, DM, MWD + (size_t)e * DM * FFE, r - I_GU, scr, lane);
            }
        }
        if (BOTH(15)) GRID_BAR();
    }
#pragma unroll
    for (int ch = 0; ch < 2; ++ch) {
        if (IN(16 + 2 * ch) || IN(17 + 2 * ch)) {
            LAS int* rt = (LAS int*)(lds + LDS_RT);
            int nM;
            { PHASE_BEGIN int ts[9]; int cn[8]; ts[0] = 0;
#pragma unroll
              for (int e = 0; e < 8; ++e) { int ce = __builtin_amdgcn_readfirstlane((int)ctl[CW_MOECNT + e]); ce = ce > NTOK ? NTOK : ce; cn[e] = ce; ts[e + 1] = ts[e] + (ce + 255) / 256; }
              const int t0 = ch * MOE_CH_TILES; int t1 = (ch == 0) ? MOE_CH_TILES : ts[8]; if (t1 > ts[8]) t1 = ts[8]; if (t1 > t0 + 136) t1 = t0 + 136; nM = __builtin_amdgcn_readfirstlane(t1 > t0 ? t1 - t0 : 0);
              if (tid < nM) { const int g = t0 + tid; int e = 0;
#pragma unroll
                  for (int k = 1; k < 8; ++k) e += (g >= ts[k]) ? 1 : 0;
                  int ce = cn[0], tse = ts[0];
#pragma unroll
                  for (int k = 1; k < 8; ++k) { ce = (e == k) ? cn[k] : ce; tse = (e == k) ? ts[k] : tse; }
                  const int j = g - tse; int nv = ce - j * 256; nv = nv > 256 ? 256 : nv;
                  rt[tid * 4 + 0] = e; rt[tid * 4 + 1] = e * NTOK + j * 256; rt[tid * 4 + 2] = nv; rt[tid * 4 + 3] = 0; } }
            __syncthreads();
            if (IN(16 + 2 * ch)) { asm volatile("; PHASE_MARK 16"); PHASE_BEGIN
                pg8::MoeOrder S{G, bid, nM, 2 * FFE / 256, rt, (const char*)X3B, (char*)outp, (char*)ws, true};
                LAS int* gtab = (LAS int*)(lds + LDS_GTAB);
                { pg8::Unit u; for (int i = 0; i < 16 && S.next(i, u); ++i) { if (tid < 256) { const int lb = rt[u.pm * 4 + 1], nv = rt[u.pm * 4 + 2]; const int r = tid < nv ? tid : 0; gtab[i * 256 + tid] = MTOK[lb + r] >> 1; } } }
                __syncthreads();
                pg8::EpiSwiglu<true> E{H0, FFE, (char*)outp, (char*)ws};
                pg8::gemm_phase<pg8::EpiSwiglu<true>, pg8::MoeOrder, true, true>(tid, lds, MWGU, DM, S, E, gtab);
                if (BOTH(16 + 2 * ch)) GRID_BAR();
            }
            if (IN(17 + 2 * ch)) { asm volatile("; PHASE_MARK 17"); PHASE_BEGIN
                pg8::MoeOrder S{G, bid, nM, DM / 256, rt, (const char*)X3B, (char*)outp, (char*)ws, false};
                pg8::EpiMoeDown E{YB, MTOK, MGATE, rt};
                pg8::gemm_phase<pg8::EpiMoeDown, pg8::MoeOrder, true, false>(tid, lds, MWD, FFE, S, E, GTAB);
                if (BOTH(17 + 2 * ch)) GRID_BAR();
            }
        }
    }
    if (IN(20)) { asm volatile("; PHASE_MARK 20"); PHASE_BEGIN
        for (int m = gw; m < NTOK; m += NGW) { f32x4 v[4];
#pragma unroll
            for (int j = 0; j < 4; ++j) { const size_t o = (size_t)m * DM + 4 * lane + 256 * j; v[j] = ld_bf4(X3B + o) * ALPHA + ld_bf4(YB + o) + ld_bf4(YB + (size_t)NTOK * DM + o); }
            ln_core(v, args.in[I_OLN2G], args.in[I_OLN2B], lane);
#pragma unroll
            for (int j = 0; j < 4; ++j) *(f32x4*)(outp + (size_t)m * DM + 4 * lane + 256 * j) = v[j]; }
    }
#undef IN
#undef BOTH
}

constexpr int NPHASES = 21;
extern "C" void kernel_launch(void* const* d_in, const int* in_sizes, int n_in, void* d_out, int out_size, void* d_ws, size_t ws_size, hipStream_t stream) {
    static int grid = 0;
    if (grid == 0) {
        if (n_in != 25 || out_size != NTOK * DM || ws_size < WS_END) { fprintf(stderr, "kernel_launch: unexpected shapes (n_in %d out %d ws %zu)\n", n_in, out_size, ws_size); grid = -1; return; }
        int dev = 0, cus = 0;
        if (hipGetDevice(&dev) != hipSuccess || hipDeviceGetAttribute(&cus, hipDeviceAttributeMultiprocessorCount, dev) != hipSuccess) { grid = -1; return; }
        if (hipFuncSetAttribute((const void*)fwd_kernel, hipFuncAttributeMaxDynamicSharedMemorySize, LDS_BYTES) != hipSuccess) { fprintf(stderr, "kernel_launch: hipFuncSetAttribute failed\n"); grid = -1; return; }
        int per_cu = 0;
        if (hipOccupancyMaxActiveBlocksPerMultiprocessor(&per_cu, (const void*)fwd_kernel, NTHR, LDS_BYTES) != hipSuccess || per_cu < 1) { fprintf(stderr, "kernel_launch: occupancy query says %d\n", per_cu); }
        (void)hipGetLastError();
        grid = cus;
    }
    if (grid < 0) return;
    (void)hipMemsetAsync((char*)d_ws + WS_CTL, 0, CTL_ZERO_BYTES, stream);
    Args a{};
    for (int i = 0; i < 25; ++i) a.in[i] = (const float*)d_in[i];
    a.out = (float*)d_out; a.ws = (unsigned char*)d_ws;
#if ONE_LAUNCH
    a.ph_lo = 0; a.ph_hi = NPHASES;
    hipLaunchKernelGGL(fwd_kernel, dim3(grid), dim3(NTHR), LDS_BYTES, stream, a);
#else
    for (int ph = 0; ph < NPHASES; ++ph) { a.ph_lo = ph; a.ph_hi = ph + 1; for (int rep = 0; rep < (((DUP_MASK) >> ph) & 1u ? 2 : 1); ++rep) hipLaunchKernelGGL(fwd_kernel, dim3(grid), dim3(NTHR), LDS_BYTES, stream, a); }
#endif
}
```

```cpp
#include <hip/hip_runtime.h>
#include <cstdio>
#include <cstdint>

#ifndef ONE_LAUNCH
#define ONE_LAUNCH 1
#endif
#ifndef DUP_MASK
#define DUP_MASK 0u
#endif

#define LAS __attribute__((address_space(3)))
typedef unsigned short bf16_t;
typedef short bf16x8 __attribute__((ext_vector_type(8)));
typedef float f32x4 __attribute__((ext_vector_type(4)));
typedef float f32x2 __attribute__((ext_vector_type(2)));
typedef unsigned u32x4 __attribute__((ext_vector_type(4)));
typedef unsigned u32x2 __attribute__((ext_vector_type(2)));
typedef unsigned long long u64;

constexpr int NB = 8, SEQ = 4096, DM = 1024, NTOK = NB * SEQ;
constexpr int IN0_SRC = 3144, IN0_N = 3328;
constexpr int FF0 = 2816, FFE = 3584, NEXP = 8;
constexpr int IN1_N = 9216;
constexpr int CHUNK_B = 4, CHUNK_T = CHUNK_B * SEQ;
constexpr int MOE_KS = 7, MOE_KSLICE = FFE / MOE_KS;
constexpr int MOE_CH_TILES = 128;
constexpr int HM_DOUT_TILES = 73;
constexpr float ALPHA = 1.4142135623730951f;
constexpr float LN_EPS = 1e-5f;
constexpr int NWAVES = 8, NTHR = 512;

constexpr size_t MiB = 1u << 20;
constexpr size_t WS_CTL = 0, CTL_ZERO_BYTES = 64 * 1024;
constexpr size_t WS_BIAST = 1 * MiB;
constexpr size_t WS_MOE_TOK = 2 * MiB;
constexpr size_t WS_MOE_GATE = 3 * MiB;
constexpr size_t WS_WIN0 = 4 * MiB;
constexpr size_t WS_WOUT0 = 11 * MiB;
constexpr size_t WS_WGU0 = 13 * MiB;
constexpr size_t WS_WD0 = 24 * MiB;
constexpr size_t WS_WIN1 = 30 * MiB;
constexpr size_t WS_WOUT1 = 48 * MiB;
constexpr size_t WS_XB = 50 * MiB;
constexpr size_t WS_U = 114 * MiB;
constexpr size_t WS_Q0 = 146 * MiB, SEG0 = 32 * MiB;
constexpr size_t WS_KI = 274 * MiB;
constexpr size_t WS_WI = 278 * MiB;
constexpr size_t WS_MASK = 280 * MiB;
constexpr size_t WS_MIXIN = 296 * MiB;
constexpr size_t WS_KS = 384 * MiB;
constexpr size_t WS_X1B = 50 * MiB;
constexpr size_t WS_H0 = 114 * MiB;
constexpr size_t WS_X2B = 448 * MiB;
constexpr size_t WS_H1 = 50 * MiB;
constexpr size_t WS_OP = 338 * MiB;
constexpr size_t WS_LSE = 434 * MiB;
constexpr size_t WS_Y3 = 216 * MiB;
constexpr size_t WS_X3B = 152 * MiB;
constexpr size_t WS_YB = 216 * MiB;
constexpr size_t WS_MWGU = 344 * MiB;
constexpr size_t WS_MWD = 456 * MiB;
constexpr size_t WS_SLAB = 116 * MiB;
constexpr size_t WS_YMAP = 146 * MiB;
constexpr size_t WS_HM = 4 * MiB;
constexpr size_t WS_END = 512 * MiB;
constexpr size_t HM_TILE_BYTES = (size_t)256 * FFE * 2;
constexpr int CW_MOECNT = 64;
constexpr int CW_BAR = 1024;

constexpr int LDS_GTAB = 131072;
constexpr int LDS_RT = 147456;
constexpr int LDS_MISC = 155648 + 2048;
constexpr int LDS_BYTES = 159744;

__device__ __forceinline__ unsigned cvt_pk_bf16(float lo, float hi) { unsigned r; asm volatile("v_cvt_pk_bf16_f32 %0, %1, %2" : "=v"(r) : "v"(lo), "v"(hi)); return r; }
__device__ __forceinline__ float bf_lo(unsigned w) { return __uint_as_float(w << 16); }
__device__ __forceinline__ float bf_hi(unsigned w) { return __uint_as_float(w & 0xffff0000u); }
__device__ __forceinline__ float bf2f(bf16_t b) { return __uint_as_float(((unsigned)b) << 16); }
template <int M> __device__ __forceinline__ float swz_xor(float v) {
    return __int_as_float(__builtin_amdgcn_ds_swizzle(__float_as_int(v), (M << 10) | 0x1f)); }
__device__ __forceinline__ float wave_sum(float v) {
    v += swz_xor<1>(v); v += swz_xor<2>(v); v += swz_xor<4>(v); v += swz_xor<8>(v); v += swz_xor<16>(v);
    auto rr = __builtin_amdgcn_permlane32_swap(__float_as_uint(v), __float_as_uint(v), false, false);
    return __uint_as_float(rr[0]) + __uint_as_float(rr[1]);
}
__device__ __forceinline__ float wave_max(float v) {
    v = fmaxf(v, swz_xor<1>(v)); v = fmaxf(v, swz_xor<2>(v)); v = fmaxf(v, swz_xor<4>(v)); v = fmaxf(v, swz_xor<8>(v)); v = fmaxf(v, swz_xor<16>(v));
    auto rr = __builtin_amdgcn_permlane32_swap(__float_as_uint(v), __float_as_uint(v), false, false);
    return fmaxf(__uint_as_float(rr[0]), __uint_as_float(rr[1]));
}
__device__ __forceinline__ unsigned lane_get(unsigned v, int src_lane) { return (unsigned)__builtin_amdgcn_ds_bpermute(src_lane << 2, (int)v); }
__device__ __forceinline__ float sigmoidf_(float x) { return __builtin_amdgcn_rcpf(1.0f + __expf(-x)); }
#define WAVE_LDS_FENCE() do { asm volatile("s_waitcnt lgkmcnt(0)" ::: "memory"); __builtin_amdgcn_wave_barrier(); } while (0)

#define XB_TMO      128
#define XB_XCNT(j)  (256  + 64 * (j))
#define XB_XSUB(j)  (1280 + 64 * (j))
#define XB_XGEN(j)  (2304 + 64 * (j))
#define XB_TOP      3328
#define XB_TOPGEN   3392
#define XCD_BAR_WORDS 3456
#define XB_SPIN_CAP (1u << 18)
__device__ __forceinline__ unsigned xb_ld(unsigned* p)              { return __hip_atomic_load(p, __ATOMIC_RELAXED, __HIP_MEMORY_SCOPE_AGENT); }
__device__ __forceinline__ unsigned xb_add(unsigned* p, unsigned v) { return __hip_atomic_fetch_add(p, v, __ATOMIC_RELAXED, __HIP_MEMORY_SCOPE_AGENT); }
__device__ __forceinline__ unsigned xb_xcc_id() { return (unsigned)__builtin_amdgcn_s_getreg((3 << 11) | 20) & 0xFu; }
#define XB_SPIN(cond, bar) do { unsigned _sp = 0; while (cond) { __builtin_amdgcn_s_sleep(1); \
    if ((++_sp & 255u) == 0u) { if (xb_ld(&(bar)[XB_TMO])) break; if (_sp > XB_SPIN_CAP) { atomicAdd(&(bar)[XB_TMO], 1u); break; } } } } while (0)
struct XcdBarrier { unsigned* bar; unsigned x; volatile LAS unsigned* st; };
__device__ __forceinline__ XcdBarrier xcd_barrier_post(unsigned* bar, volatile LAS unsigned* st, bool leader) {
    XcdBarrier b; b.bar = bar; b.x = xb_xcc_id(); b.st = st;
    if (leader) (void)xb_add(&bar[XB_XCNT(b.x)], 1u);
    return b;
}
__device__ __forceinline__ void xcd_barrier_complete(unsigned* bar, unsigned x, unsigned& nloc, unsigned& nx) {
    const unsigned G = gridDim.x * gridDim.y * gridDim.z;
    unsigned sum, cnt, mine, sp = 0u;
    for (;;) {
        sum = 0u; cnt = 0u; mine = 0u;
#pragma unroll
        for (unsigned j = 0; j < 16; ++j) { const unsigned c = xb_ld(&bar[XB_XCNT(j)]); sum += c; cnt += (c > 0u) ? 1u : 0u; mine = (j == x) ? c : mine; }
        if (sum == G) break;
        __builtin_amdgcn_s_sleep(1);
        if ((++sp & 255u) == 0u) { if (xb_ld(&bar[XB_TMO])) break; if (sp > XB_SPIN_CAP) { atomicAdd(&bar[XB_TMO], 1u); break; } }
    }
    nloc = mine > 0u ? mine : 1u; nx = cnt > 0u ? cnt : 1u;
}
__device__ __forceinline__ void xcd_barrier(const XcdBarrier& b, bool leader) {
    asm volatile("s_waitcnt vmcnt(0)" ::: "memory");
    __syncthreads();
    if (leader) {
        unsigned* bar = b.bar;
        __builtin_amdgcn_s_waitcnt(0);
        unsigned nloc = b.st[0], nx = b.st[1];
        if (nloc == 0u) { xcd_barrier_complete(bar, b.x, nloc, nx); b.st[0] = nloc; b.st[1] = nx; }
        const unsigned old = xb_add(&bar[XB_XSUB(b.x)], 1u);
        const unsigned gen = old / nloc;
        if (old + 1u == (gen + 1u) * nloc) {
            __builtin_amdgcn_fence(__ATOMIC_RELEASE, "agent");
            asm volatile("s_waitcnt vmcnt(0)" ::: "memory");
            const unsigned og = xb_add(&bar[XB_TOP], 1u);
            const unsigned tg = og / nx;
            if (og + 1u == (tg + 1u) * nx) xb_add(&bar[XB_TOPGEN], 1u);
            else XB_SPIN(xb_ld(&bar[XB_TOPGEN]) == tg, bar);
            __builtin_amdgcn_fence(__ATOMIC_ACQUIRE, "agent");
            xb_add(&bar[XB_XGEN(b.x)], 1u);
            asm volatile("s_waitcnt vmcnt(0)" ::: "memory");
        } else {
            XB_SPIN(xb_ld(&bar[XB_XGEN(b.x)]) == gen, bar);
            __builtin_amdgcn_fence(__ATOMIC_ACQUIRE, "agent");
            asm volatile("s_waitcnt vmcnt(0)" ::: "memory");
        }
    }
    __syncthreads();
}

namespace pg8 {
constexpr int BM = 256, BK = 64, HALF = 128, HTB = HALF * BK * 2, STAGE_BYTES = 8 * HTB, NXCD = 8, WGM = 8;
__host__ __device__ __forceinline__ int lds_byte(int r, int c) { const int st = (r >> 4) * 2 + (c >> 5), rr = r & 15, cc = c & 31, ob = rr * 64 + cc * 2; return st * 1024 + (ob ^ (((ob >> 9) & 1) << 5)); }
__host__ __device__ __forceinline__ void stage_rc(int b, int& R, int& C) { const int st = b / 1024, sb = b % 1024, swz = sb ^ (((sb >> 9) & 1) << 5); R = (st >> 1) * 16 + swz / 64; C = (st & 1) * 32 + (swz % 64) / 2; }
__host__ __device__ __forceinline__ int perm32(int rho) { const int n = rho >> 4, i = rho & 15; return 8 * (i >> 2) + 4 * n + (i & 3); }

struct Unit { int pm, pn; };

__device__ __forceinline__ void remap_unit(int wgid, int nM, int nN, int& pm, int& pn) {
    const int nwg = nM * nN;
    { const int q = nwg / NXCD, r = nwg % NXCD, xcd = wgid % NXCD, off = wgid / NXCD; wgid = (xcd < r ? xcd * (q + 1) : r * (q + 1) + (xcd - r) * q) + off; }
    const int nig = WGM * nN, gid = wgid / nig, fm = gid * WGM, gsz = (nM - fm) < WGM ? (nM - fm) : WGM;
    pm = fm + ((wgid % nig) % gsz); pn = (wgid % nig) / gsz;
}
struct StaticOrder {
    int nM, nN, nwg, G, c; const char* A; size_t tstepA;
    __device__ void init(const bf16_t* A_, int M, int N, int K, int G_, int c_) { nM = M / BM; nN = N / BM; nwg = nM * nN; G = G_; c = c_; A = (const char*)A_; tstepA = (size_t)BM * K * 2; }
    __device__ __forceinline__ bool next(int i, Unit& u) const {
        const long L = (long)i * G + c; if (L >= nwg) return false;
        remap_unit((int)L, nM, nN, u.pm, u.pn); return true;
    }
    __device__ __forceinline__ const char* a_ptr(const Unit& u) const { return A + (size_t)u.pm * tstepA; }
    __device__ __forceinline__ int b_tile(const Unit& u) const { return u.pn; }
    __device__ __forceinline__ size_t b_koff(const Unit&) const { return 0; }
};

#define PG8_LAS __attribute__((address_space(3)))
template <class Epi, class Sched, bool ALIGN_EPI, bool GATHER>
__device__ __forceinline__ void gemm_phase(const int tid, PG8_LAS unsigned char* lds, const bf16_t* Btp, const int K, const int ld, const Sched& S, const Epi& E, const PG8_LAS int* gtab) {
    const int wid = __builtin_amdgcn_readfirstlane(tid >> 6), lane = tid & 63, wr = wid >> 2, wc = wid & 3, fr = lane & 15, fq = lane >> 4;
    const int nt = K / BK;
    unsigned voffA[2], voffB[2];
#pragma unroll
    for (int i = 0; i < 2; ++i) { int R, C; stage_rc(tid * 16 + i * 8192, R, C); const int Rb = Epi::PERM ? ((R & ~31) + perm32(R & 31)) : R;
        voffA[i] = (unsigned)(R * ld + C) * 2u; voffB[i] = (unsigned)(Rb * ld + C) * 2u; }
    const size_t kstep = (size_t)(BK * 2);
    const size_t hstep = (size_t)HALF * ld * 2;
    const size_t tstep = 2 * hstep;
    const unsigned ldsw = (unsigned)wid * 1024u;
    const int aoff = lds_byte(wr * 64 + fr, fq * 8), boff = lds_byte(wc * 32 + fr, fq * 8);
#define PG8_SA(b, h) (((b) * 2 + (h)) * HTB)
#define PG8_SB(b, h) ((4 + (b) * 2 + (h)) * HTB)
#define PG8_STAGE(bufoff, gbase, voff) do { _Pragma("unroll") for (int _i = 0; _i < 2; ++_i) \
        __builtin_amdgcn_global_load_lds((const unsigned*)((const char*)(gbase) + (voff)[_i]), (PG8_LAS unsigned*)(lds + (bufoff) + ldsw + _i * 8192), 16, 0, 0); } while (0)
#define PG8_STAGE_AC(bufoff, kt, h) do { if constexpr (GATHER) { PG8_STAGE(bufoff, cA + (size_t)(kt) * kstep, gcur[h]); } else { PG8_STAGE(bufoff, cA + (size_t)(kt) * kstep + (h) * hstep, voffA); } } while (0)
#define PG8_STAGE_AN(bufoff, d, h) do { if constexpr (GATHER) { if (last) { unsigned _g[2]; _Pragma("unroll") for (int _i = 0; _i < 2; ++_i) { int _R, _C; stage_rc(tid * 16 + _i * 8192, _R, _C); _g[_i] = (unsigned)gtab[nslot * 256 + (h) * 128 + _R] * (unsigned)(ld * 2) + (unsigned)(_C * 2); } \
            PG8_STAGE(bufoff, nA + (size_t)(d) * kstep, _g); } else { PG8_STAGE(bufoff, cA + (size_t)(t + 2 + (d)) * kstep, gcur[h]); } } \
        else { PG8_STAGE(bufoff, a2 + (size_t)(d) * kstep + (h) * hstep, voffA); } } while (0)
#define PG8_LDA(dst, b, h) do { _Pragma("unroll") for (int m = 0; m < 4; ++m) _Pragma("unroll") for (int k = 0; k < 2; ++k) dst[m][k] = *(const PG8_LAS bf16x8*)(lds + PG8_SA(b, h) + aoff + m * 2048 + k * 1024); } while (0)
#define PG8_LDB(dst, b, h) do { _Pragma("unroll") for (int n = 0; n < 2; ++n) _Pragma("unroll") for (int k = 0; k < 2; ++k) dst[n][k] = *(const PG8_LAS bf16x8*)(lds + PG8_SB(b, h) + boff + n * 2048 + k * 1024); } while (0)
#define PG8_MMA(ai, bj, At, Bt) do { __builtin_amdgcn_s_setprio(1); _Pragma("unroll") for (int m = 0; m < 4; ++m) _Pragma("unroll") for (int n = 0; n < 2; ++n) _Pragma("unroll") for (int k = 0; k < 2; ++k) \
        acc[ai][bj][m][n] = __builtin_amdgcn_mfma_f32_16x16x32_bf16(Bt[n][k], At[m][k], acc[ai][bj][m][n], 0, 0, 0); __builtin_amdgcn_s_setprio(0); } while (0)
#define PG8_WAIT_V(n) asm volatile("s_waitcnt vmcnt(" #n ")" ::: "memory")
#define PG8_WAIT_L(n) asm volatile("s_waitcnt lgkmcnt(" #n ")" ::: "memory")
#define PG8_BAR __builtin_amdgcn_s_barrier()
#define PG8_SCHED __builtin_amdgcn_sched_barrier(0)
#define PG8_LOADG(dst, slot_) do { _Pragma("unroll") for (int _i = 0; _i < 2; ++_i) { int _R, _C; stage_rc(tid * 16 + _i * 8192, _R, _C); _Pragma("unroll") for (int _h = 0; _h < 2; ++_h) \
        dst[_h][_i] = (unsigned)gtab[(slot_) * 256 + _h * 128 + _R] * (unsigned)(ld * 2) + (unsigned)(_C * 2); } } while (0)
    Unit cur, nxt; int ui = 0;
    if (!S.next(0, cur)) return;
    f32x4 acc[2][2][4][2];
#pragma unroll
    for (int a = 0; a < 2; ++a)
#pragma unroll
        for (int b = 0; b < 2; ++b)
#pragma unroll
            for (int m = 0; m < 4; ++m)
#pragma unroll
                for (int n = 0; n < 2; ++n) acc[a][b][m][n] = (f32x4){0.f, 0.f, 0.f, 0.f};
    bf16x8 At[4][2], B0[2][2], B1[2][2];
    unsigned gcur[2][2] = {{0u, 0u}, {0u, 0u}};
    const char* cA = S.a_ptr(cur); const char* cB = (const char*)Btp + (size_t)S.b_tile(cur) * tstep + S.b_koff(cur);
    if constexpr (GATHER) { PG8_LOADG(gcur, 0); PG8_WAIT_L(0); }
    PG8_STAGE(PG8_SB(0, 0), cB, voffB); PG8_STAGE(PG8_SB(0, 1), cB + hstep, voffB); PG8_STAGE_AC(PG8_SA(0, 0), 0, 0); PG8_STAGE_AC(PG8_SA(0, 1), 0, 1);
    if (wr == 1) PG8_BAR;
    PG8_WAIT_V(2); PG8_BAR;
    PG8_STAGE(PG8_SB(1, 0), cB + kstep, voffB); PG8_STAGE_AC(PG8_SA(1, 0), 1, 0); PG8_STAGE(PG8_SB(1, 1), cB + hstep + kstep, voffB);
    PG8_WAIT_V(6); PG8_BAR;
    for (;;) {
        const bool has_next = S.next(ui + 1, nxt);
        const char* nA = has_next ? S.a_ptr(nxt) : cA; const char* nB = has_next ? (const char*)Btp + (size_t)S.b_tile(nxt) * tstep + S.b_koff(nxt) : cB;
        const int nslot = has_next ? ui + 1 : ui;
        for (int t = 0; t < nt; t += 2) {
            const bool last = (t == nt - 2);
            const char* a2 = last ? nA : cA + (size_t)(t + 2) * kstep; const char* b2 = last ? nB : cB + (size_t)(t + 2) * kstep;
            const char* b3 = b2 + kstep;
            (void)a2;
            PG8_LDB(B0, 0, 0); PG8_LDB(B1, 0, 1); PG8_SCHED; PG8_LDA(At, 0, 0); PG8_STAGE_AC(PG8_SA(1, 1), t + 1, 1);
            PG8_WAIT_V(8); PG8_WAIT_L(0); PG8_BAR; PG8_MMA(0, 0, At, B0); PG8_MMA(0, 1, At, B1); PG8_BAR; PG8_SCHED;
            PG8_LDA(At, 0, 1); PG8_STAGE(PG8_SB(0, 0), b2, voffB); PG8_STAGE(PG8_SB(0, 1), b2 + hstep, voffB); PG8_STAGE_AN(PG8_SA(0, 0), 0, 0);
            PG8_WAIT_V(8); PG8_WAIT_L(0); PG8_BAR; PG8_MMA(1, 0, At, B0); PG8_MMA(1, 1, At, B1); PG8_BAR; PG8_SCHED;
            PG8_LDB(B0, 1, 0); PG8_LDB(B1, 1, 1); PG8_SCHED; PG8_LDA(At, 1, 0); PG8_STAGE_AN(PG8_SA(0, 1), 0, 1);
            PG8_WAIT_V(8); PG8_WAIT_L(0); PG8_BAR; PG8_MMA(0, 0, At, B0); PG8_MMA(0, 1, At, B1); PG8_BAR; PG8_SCHED;
            PG8_LDA(At, 1, 1); PG8_STAGE(PG8_SB(1, 0), b3, voffB); PG8_STAGE(PG8_SB(1, 1), b3 + hstep, voffB); PG8_STAGE_AN(PG8_SA(1, 0), 1, 0);
            PG8_WAIT_V(8); PG8_WAIT_L(0); PG8_BAR; PG8_MMA(1, 0, At, B0); PG8_MMA(1, 1, At, B1); PG8_BAR; PG8_SCHED;
        }
        if constexpr (ALIGN_EPI) { if (wr == 0) PG8_BAR; }
        { int fr_e = fr, fq_e = fq; asm volatile("" : "+v"(fr_e), "+v"(fq_e)); E(acc, cur, wr, wc, fr_e, fq_e); }
        if (!has_next) break;
#pragma unroll
        for (int a = 0; a < 2; ++a)
#pragma unroll
            for (int b = 0; b < 2; ++b)
#pragma unroll
                for (int m = 0; m < 4; ++m)
#pragma unroll
                    for (int n = 0; n < 2; ++n) acc[a][b][m][n] = (f32x4){0.f, 0.f, 0.f, 0.f};
        cur = nxt; cA = nA; cB = nB; ++ui;
        if constexpr (GATHER) { PG8_LOADG(gcur, ui); }
        if constexpr (ALIGN_EPI) { if (wr == 1) PG8_BAR; }
    }
    PG8_WAIT_V(0);
    if constexpr (!ALIGN_EPI) { if (wr == 0) PG8_BAR; }
    PG8_BAR;
#undef PG8_SA
#undef PG8_SB
#undef PG8_STAGE
#undef PG8_STAGE_AC
#undef PG8_STAGE_AN
#undef PG8_LDA
#undef PG8_LDB
#undef PG8_MMA
#undef PG8_WAIT_V
#undef PG8_WAIT_L
#undef PG8_BAR
#undef PG8_SCHED
#undef PG8_LOADG
}

typedef f32x4 AccT[2][2][4][2];
__device__ __forceinline__ u32x4 pack8(const f32x4 v0, const f32x4 v1) { u32x4 w; w.x = cvt_pk_bf16(v0[0], v0[1]); w.y = cvt_pk_bf16(v0[2], v0[3]); w.z = cvt_pk_bf16(v1[0], v1[1]); w.w = cvt_pk_bf16(v1[2], v1[3]); return w; }

struct EpiIn0 {
    static constexpr bool PERM = true;
    bf16_t* U; bf16_t* Q; bf16_t* KI; float* WI;
    __device__ __forceinline__ void operator()(const AccT& acc, const Unit& u, int wr, int wc, int fr, int fq) const {
        const int row0 = u.pm * BM + wr * 64 + fr;
        if (u.pn < 4) {
            const int col0 = u.pn * 128 + wc * 32 + 8 * fq;
#pragma unroll
            for (int ai = 0; ai < 2; ++ai)
#pragma unroll
                for (int m = 0; m < 4; ++m) { f32x4 o0, o1;
#pragma unroll
                    for (int j = 0; j < 4; ++j) { o0[j] = acc[ai][0][m][0][j] * sigmoidf_(acc[ai][1][m][0][j]); o1[j] = acc[ai][0][m][1][j] * sigmoidf_(acc[ai][1][m][1][j]); }
                    *(u32x4*)(U + (size_t)(row0 + ai * HALF + m * 16) * 512 + col0) = pack8(o0, o1); }
        } else if (u.pn < 12) {
            const int t = (u.pn - 4) >> 1; bf16_t* base = Q + (size_t)t * (SEG0 / 2); const float sc = 1.0f;
            const int col0 = ((u.pn - 4) & 1) * 256 + wc * 32 + 8 * fq;
#pragma unroll
            for (int ai = 0; ai < 2; ++ai)
#pragma unroll
                for (int m = 0; m < 4; ++m)
#pragma unroll
                    for (int bj = 0; bj < 2; ++bj)
                        *(u32x4*)(base + (size_t)(row0 + ai * HALF + m * 16) * 512 + col0 + bj * HALF) = pack8(acc[ai][bj][m][0] * sc, acc[ai][bj][m][1] * sc);
        } else {
            if (wc < 2) {
#pragma unroll
                for (int ai = 0; ai < 2; ++ai)
#pragma unroll
                    for (int m = 0; m < 4; ++m) *(u32x4*)(KI + (size_t)(row0 + ai * HALF + m * 16) * 64 + wc * 32 + 8 * fq) = pack8(acc[ai][0][m][0], acc[ai][0][m][1]);
            } else if (wc == 2 && fq == 0) {
                const float sc = 0.04419417382415922f;
#pragma unroll
                for (int ai = 0; ai < 2; ++ai)
#pragma unroll
                    for (int m = 0; m < 4; ++m) { float* p = WI + (size_t)(row0 + ai * HALF + m * 16) * 8; *(f32x4*)p = acc[ai][0][m][0] * sc; *(f32x4*)(p + 4) = acc[ai][0][m][1] * sc; }
            }
        }
    }
};
struct EpiRes {
    static constexpr bool PERM = true;
    bf16_t* out; const bf16_t* resid;
    __device__ __forceinline__ void operator()(const AccT& acc, const Unit& u, int wr, int wc, int fr, int fq) const {
        const int row0 = u.pm * BM + wr * 64 + fr, col0 = u.pn * BM + wc * 32 + 8 * fq;
#pragma unroll
        for (int ai = 0; ai < 2; ++ai)
#pragma unroll
            for (int m = 0; m < 4; ++m) { const size_t off = (size_t)(row0 + ai * HALF + m * 16) * DM + col0;
#pragma unroll
                for (int bj = 0; bj < 2; ++bj) { const u32x4 w = *(const u32x4*)(resid + off + bj * HALF);
                    const f32x4 r0 = (f32x4){bf_lo(w.x), bf_hi(w.x), bf_lo(w.y), bf_hi(w.y)}, r1 = (f32x4){bf_lo(w.z), bf_hi(w.z), bf_lo(w.w), bf_hi(w.w)};
                    *(u32x4*)(out + off + bj * HALF) = pack8(r0 * ALPHA + acc[ai][bj][m][0], r1 * ALPHA + acc[ai][bj][m][1]); } }
    }
};
__device__ __forceinline__ char* hm_tile(char* dout, char* ws, int p) { return p < HM_DOUT_TILES ? dout + (size_t)p * HM_TILE_BYTES : ws + WS_HM + (size_t)(p - HM_DOUT_TILES) * HM_TILE_BYTES; }
template <bool TILE_LOCAL> struct EpiSwiglu {
    static constexpr bool PERM = true;
    bf16_t* H; int ldh; char* dout; char* ws;
    __device__ __forceinline__ void operator()(const AccT& acc, const Unit& u, int wr, int wc, int fr, int fq) const {
        bf16_t* base; if constexpr (TILE_LOCAL) base = (bf16_t*)hm_tile(dout, ws, u.pm); else base = H + (size_t)u.pm * BM * ldh;
        const int rl0 = wr * 64 + fr, col0 = u.pn * 128 + wc * 32 + 8 * fq;
#pragma unroll
        for (int ai = 0; ai < 2; ++ai)
#pragma unroll
            for (int m = 0; m < 4; ++m) { f32x4 o0, o1;
#pragma unroll
                for (int j = 0; j < 4; ++j) { const float g0 = acc[ai][0][m][0][j], g1 = acc[ai][0][m][1][j];
                    o0[j] = g0 * sigmoidf_(g0) * acc[ai][1][m][0][j]; o1[j] = g1 * sigmoidf_(g1) * acc[ai][1][m][1][j]; }
                *(u32x4*)(base + (size_t)(rl0 + ai * HALF + m * 16) * ldh + col0) = pack8(o0, o1); }
    }
};
struct EpiQkv1 {
    static constexpr bool PERM = true;
    bf16_t* O; int ldc; float qscale;
    __device__ __forceinline__ void operator()(const AccT& acc, const Unit& u, int wr, int wc, int fr, int fq) const {
        const int row0 = u.pm * BM + wr * 64 + fr, col0 = u.pn * BM + wc * 32 + 8 * fq; const float sc = ((u.pn % 12) < 4) ? qscale : 1.0f;
#pragma unroll
        for (int ai = 0; ai < 2; ++ai)
#pragma unroll
            for (int m = 0; m < 4; ++m)
#pragma unroll
                for (int bj = 0; bj < 2; ++bj)
                    *(u32x4*)(O + (size_t)(row0 + ai * HALF + m * 16) * ldc + col0 + bj * HALF) = pack8(acc[ai][bj][m][0] * sc, acc[ai][bj][m][1] * sc);
    }
};
struct EpiMoeDown {
    static constexpr bool PERM = true;
    bf16_t* YB; const int* tokk; const float* gate; const PG8_LAS int* rt;
    __device__ __forceinline__ void operator()(const AccT& acc, const Unit& u, int wr, int wc, int fr, int fq) const {
        const int lbase = rt[u.pm * 4 + 1], nvalid = rt[u.pm * 4 + 2];
        const int rl0 = wr * 64 + fr, col0 = u.pn * BM + wc * 32 + 8 * fq;
#pragma unroll
        for (int ai = 0; ai < 2; ++ai)
#pragma unroll
            for (int m = 0; m < 4; ++m) { const int rl = rl0 + ai * HALF + m * 16;
                if (rl < nvalid) { const int tk = tokk[lbase + rl]; const float g = gate[lbase + rl];
                    bf16_t* rowp = YB + ((size_t)(tk & 1) * NTOK + (size_t)(tk >> 1)) * DM + col0;
#pragma unroll
                    for (int bj = 0; bj < 2; ++bj) *(u32x4*)(rowp + bj * HALF) = pack8(acc[ai][bj][m][0] * g, acc[ai][bj][m][1] * g); } }
    }
};
struct MoeOrder {
    int G, c, nM, nN; const PG8_LAS int* rt; const char* xbase; char* dout; char* ws; bool up;
    __device__ __forceinline__ bool next(int i, Unit& u) const {
        const long L = (long)i * G + c; if (L >= (long)nM * nN) return false;
        remap_unit((int)L, nM, nN, u.pm, u.pn); return true;
    }
    __device__ __forceinline__ const char* a_ptr(const Unit& u) const { return up ? xbase : (const char*)hm_tile(dout, ws, u.pm); }
    __device__ __forceinline__ int b_tile(const Unit& u) const { return __builtin_amdgcn_readfirstlane(rt[u.pm * 4]) * nN + u.pn; }
    __device__ __forceinline__ size_t b_koff(const Unit&) const { return 0; }
};
struct LeftOrder {
    int G, c, nL; const PG8_LAS int* rt; char* dout; char* ws;
    __device__ __forceinline__ bool next(int i, Unit& u) const {
        const int L = i * G + c; if (L >= nL * 4 * MOE_KS) return false;
        const int ks = L % MOE_KS, r = L / MOE_KS; u.pm = MOE_CH_TILES + (r >> 2); u.pn = (r & 3) + 4 * ks; return true;
    }
    __device__ __forceinline__ const char* a_ptr(const Unit& u) const { return (const char*)hm_tile(dout, ws, u.pm) + (size_t)(u.pn >> 2) * MOE_KSLICE * 2; }
    __device__ __forceinline__ int b_tile(const Unit& u) const { return __builtin_amdgcn_readfirstlane(rt[u.pm * 4]) * 4 + (u.pn & 3); }
    __device__ __forceinline__ size_t b_koff(const Unit& u) const { return (size_t)(u.pn >> 2) * MOE_KSLICE * 2; }
};
struct EpiSlab {
    static constexpr bool PERM = true;
    bf16_t* slab;
    __device__ __forceinline__ void operator()(const AccT& acc, const Unit& u, int wr, int wc, int fr, int fq) const {
        const int ks = u.pn >> 2, pn = u.pn & 3, l = u.pm - MOE_CH_TILES;
        bf16_t* base = slab + ((size_t)(ks * 8 + l) * 256) * DM + pn * BM + wc * 32 + 8 * fq;
#pragma unroll
        for (int ai = 0; ai < 2; ++ai)
#pragma unroll
            for (int m = 0; m < 4; ++m) { bf16_t* rowp = base + (size_t)(wr * 64 + fr + ai * HALF + m * 16) * DM;
#pragma unroll
                for (int bj = 0; bj < 2; ++bj) *(u32x4*)(rowp + bj * HALF) = pack8(acc[ai][bj][m][0], acc[ai][bj][m][1]); }
    }
};
}


namespace swa {
constexpr int D = 128, NW = 8, QBLK = 32, KVBLK = 64, QB = NW * QBLK, WIN = 129;
constexpr int SHM_V = KVBLK * D * 2, SHM_K = KVBLK * D * 2;
constexpr int LDS_TB = 2 * SHM_V + 2 * SHM_K + NW * 64 * 4;
constexpr float SCALE = 0.08838834764831845f, THR = 8.f;
typedef float f32x16 __attribute__((ext_vector_type(16)));
typedef short s16x4 __attribute__((ext_vector_type(4)));
#define KSWZ(row, colB) ((row) * 256 + ((colB) ^ (((row) & 7) << 4)))
#define SBAR() __builtin_amdgcn_sched_barrier(0)
__device__ __forceinline__ int v_st(int k, int c) { const int kk = (k & ~0xC) | ((k & 4) << 1) | ((k & 8) >> 1); return ((kk >> 3) * 4 + (c >> 5)) * 512 + ((kk & 7) * 32 + (c & 31)) * 2; }
__device__ __forceinline__ int v_rd_base(int lane) { return ((lane & 3) << 3) | (((lane >> 2) & 3) << 6) | (((lane >> 4) & 1) << 5) | (((lane >> 5) & 1) << 8); }
constexpr int v_rd_off(int d0, int ks, int half) { return d0 * 512 + ks * 4096 + half * 2048; }
__device__ __forceinline__ int crow(int r, int hi) { return (r & 3) + 8 * (r >> 2) + 4 * hi; }
__device__ __forceinline__ bf16x8 load8(const bf16_t* p) { return *reinterpret_cast<const bf16x8*>(p); }
__device__ __forceinline__ void mask_bias_tile(f32x16& p0, f32x16& p1, int dq, const float* tb) {
    const float NEG = -__builtin_inff();
    float b0[16], b1[16];
#pragma unroll
    for (int r = 0; r < 16; ++r) { const int c = (r & 3) + 8 * (r >> 2); b0[r] = tb[59 - c]; b1[r] = tb[27 - c]; }
#pragma unroll
    for (int r = 0; r < 16; ++r) {
        const int c = (r & 3) + 8 * (r >> 2);
        const float a0 = p0[r] + b0[r], a1 = p1[r] + b1[r];
        p0[r] = ((unsigned)(dq - c) < (unsigned)WIN) ? a0 : NEG;
        p1[r] = ((unsigned)(dq - c - 32) < (unsigned)WIN) ? a1 : NEG;
    }
}
__device__ __forceinline__ void partialSM(f32x16& p0, f32x16& p1, float& m_reg, float& mn, float& alpha) {
    float pmax = p0[0];
#pragma unroll
    for (int r = 1; r < 16; ++r) pmax = fmaxf(pmax, p0[r]);
#pragma unroll
    for (int r = 0; r < 16; ++r) pmax = fmaxf(pmax, p1[r]);
    { auto rr = __builtin_amdgcn_permlane32_swap(__float_as_uint(pmax), __float_as_uint(pmax), false, false);
      pmax = fmaxf(__uint_as_float(rr[0]), __uint_as_float(rr[1])); }
    constexpr float C2 = 1.4426950408889634f * SCALE;
    if (__builtin_expect(__all((pmax - m_reg) * SCALE <= THR), 1)) { mn = m_reg; alpha = 1.f; }
    else { mn = fmaxf(m_reg, pmax); alpha = __builtin_amdgcn_exp2f((m_reg - mn) * C2); m_reg = mn; }
    const float mnL = -mn * C2;
#pragma unroll
    for (int r = 0; r < 16; ++r) p0[r] = fmaf(p0[r], C2, mnL);
#pragma unroll
    for (int r = 0; r < 16; ++r) p1[r] = fmaf(p1[r], C2, mnL);
#pragma unroll
    for (int r = 0; r < 16; ++r) p0[r] = __builtin_amdgcn_exp2f(p0[r]);
}
__device__ __forceinline__ void finishSM(f32x16& p0, f32x16& p1, float alpha, float& l_reg, bf16x8& pa0, bf16x8& pa1, bf16x8& pa2, bf16x8& pa3) {
#pragma unroll
    for (int r = 0; r < 16; ++r) p1[r] = __builtin_amdgcn_exp2f(p1[r]);
    float ps = 0;
#pragma unroll
    for (int r = 0; r < 16; ++r) ps += p0[r];
#pragma unroll
    for (int r = 0; r < 16; ++r) ps += p1[r];
    { auto rr = __builtin_amdgcn_permlane32_swap(__float_as_uint(ps), __float_as_uint(ps), false, false);
      ps = __uint_as_float(rr[0]) + __uint_as_float(rr[1]); }
    l_reg = l_reg * alpha + ps;
#define PK4(P, B_, OUT) do { unsigned a0 = cvt_pk_bf16(P[B_+0], P[B_+1]), a1 = cvt_pk_bf16(P[B_+2], P[B_+3]);                          \
        unsigned b0 = cvt_pk_bf16(P[B_+4], P[B_+5]), b1 = cvt_pk_bf16(P[B_+6], P[B_+7]);                                             \
        auto r0 = __builtin_amdgcn_permlane32_swap(a0, b0, false, false); auto r1 = __builtin_amdgcn_permlane32_swap(a1, b1, false, false); \
        u32x4 w = {r0[0], r1[0], r0[1], r1[1]}; OUT = *reinterpret_cast<bf16x8*>(&w); } while (0)
    PK4(p0, 0, pa0); PK4(p0, 8, pa1); PK4(p1, 0, pa2); PK4(p1, 8, pa3);
#undef PK4
}
template <int KB>
__device__ __forceinline__ void qkt(f32x16& p0, f32x16& p1, const char* K_lds, int r32, int hi, const bf16x8* qr, bool act) {
    if (!act) { const float NEG = -__builtin_inff();
#pragma unroll
        for (int r = 0; r < 16; ++r) { p0[r] = NEG; p1[r] = NEG; } return; }
    p0 = f32x16{}; p1 = f32x16{};
    const char* kb[4];
#pragma unroll
    for (int dd = 0; dd < 4; ++dd) kb[dd] = K_lds + KB * SHM_K + KSWZ(r32, (dd * 16 + hi * 8) * 2);
#pragma unroll
    for (int d0 = 0; d0 < 8; ++d0) { const char* a = kb[d0 & 3] + (d0 >> 2) * 128;
        bf16x8 b0 = *reinterpret_cast<const bf16x8*>(a);
        bf16x8 b1 = *reinterpret_cast<const bf16x8*>(a + 32 * 256);
        p0 = __builtin_amdgcn_mfma_f32_32x32x16_bf16(b0, qr[d0], p0, 0, 0, 0);
        p1 = __builtin_amdgcn_mfma_f32_32x32x16_bf16(b1, qr[d0], p1, 0, 0, 0); }
}
template <int VB>
__device__ __forceinline__ void pv_tile(f32x16* o, int vb0, bf16x8 pa0, bf16x8 pa1, bf16x8 pa2, bf16x8 pa3, bool act) {
    if (!act) return;
#define TRRD(dst, off) asm volatile("ds_read_b64_tr_b16 %0, %1 offset:%2" : "=&v"(dst) : "v"(vb0), "i"(off) : "memory")
#define PV_D0(d0) do { s16x4 l0, l1, l2, l3, h0, h1, h2, h3; constexpr int b_ = VB * SHM_V + v_rd_off(d0, 0, 0); \
        TRRD(l0, b_); TRRD(h0, b_ + 2048); TRRD(l1, b_ + 4096); TRRD(h1, b_ + 6144); TRRD(l2, b_ + 8192); TRRD(h2, b_ + 10240); TRRD(l3, b_ + 12288); TRRD(h3, b_ + 14336); \
        asm volatile("s_waitcnt lgkmcnt(0)" ::: "memory"); SBAR();   \
        o[d0] = __builtin_amdgcn_mfma_f32_32x32x16_bf16(pa0, (bf16x8){l0[0], l0[1], l0[2], l0[3], h0[0], h0[1], h0[2], h0[3]}, o[d0], 0, 0, 0);   \
        o[d0] = __builtin_amdgcn_mfma_f32_32x32x16_bf16(pa1, (bf16x8){l1[0], l1[1], l1[2], l1[3], h1[0], h1[1], h1[2], h1[3]}, o[d0], 0, 0, 0);   \
        o[d0] = __builtin_amdgcn_mfma_f32_32x32x16_bf16(pa2, (bf16x8){l2[0], l2[1], l2[2], l2[3], h2[0], h2[1], h2[2], h2[3]}, o[d0], 0, 0, 0);   \
        o[d0] = __builtin_amdgcn_mfma_f32_32x32x16_bf16(pa3, (bf16x8){l3[0], l3[1], l3[2], l3[3], h3[0], h3[1], h3[2], h3[3]}, o[d0], 0, 0, 0); } while (0)
    PV_D0(0); PV_D0(1); PV_D0(2); PV_D0(3);
#undef PV_D0
#undef TRRD
}
struct BlockRef { const bf16_t* Q; const bf16_t* K; bf16_t* O; float* LSE; int P0, bh, dsh;
    __device__ __forceinline__ int rs() const { return IN1_N << dsh; }
    __device__ __forceinline__ int os() const { return DM << dsh; }
    __device__ __forceinline__ int ls() const { return 8 << dsh; }
    __device__ __forceinline__ int skv() const { return SEQ >> dsh; }
    __device__ __forceinline__ const bf16_t* V() const { return K + 1024; } };
struct Seam { bf16x8 qr[8]; bf16x8 st_v0, st_v1, st_k0, st_k1; };
__device__ __forceinline__ int swa_jlo(int P0) { const int lowk = P0 - WIN + 1; return lowk > 0 ? lowk / KVBLK : 0; }
#define ROWP(p, k0, rs_, vo) ((const bf16_t*)((const char*)(p) + (size_t)(k0) * (size_t)(rs_) * 2 + (size_t)(vo)))
#define VMW() asm volatile("s_waitcnt vmcnt(0)" ::: "memory")
#define VMWN(n) asm volatile("s_waitcnt vmcnt(%0)" :: "i"(n) : "memory")
#define TIDL() int tid_l = tid; asm volatile("" : "+v"(tid_l)); const int sr = tid_l >> 4, sc = (tid_l & 15) * 8; (void)sr; (void)sc
#define SLOAD_H(Kp, Vp, k0, rs_) do { TIDL(); const unsigned vo0_ = (unsigned)(sr * (rs_) + sc) * 2u, vo1_ = vo0_ + (unsigned)(rs_) * 64u; \
                         S.st_v0 = load8(ROWP(Vp, k0, rs_, vo0_)); S.st_v1 = load8(ROWP(Vp, k0, rs_, vo1_));              \
                         S.st_k0 = load8(ROWP(Kp, k0, rs_, vo0_)); S.st_k1 = load8(ROWP(Kp, k0, rs_, vo1_)); } while (0)
#define SWRITE_HK(bf) do { TIDL(); const int kws = KSWZ(sr, sc * 2); *(bf16x8*)(K_lds + (bf) * SHM_K + kws) = S.st_k0; *(bf16x8*)(K_lds + (bf) * SHM_K + kws + 32 * 256) = S.st_k1; } while (0)
#define SWRITE_HV(bf) do { TIDL(); const int vst0 = v_st(sr, sc), vst1 = v_st(32 + sr, sc); *(bf16x8*)(V_lds + (bf) * SHM_V + vst0) = S.st_v0; *(bf16x8*)(V_lds + (bf) * SHM_V + vst1) = S.st_v1; } while (0)
#define SWRITE_H(bf) do { SWRITE_HV(bf); SWRITE_HK(bf); } while (0)
__device__ __forceinline__ void tb_load(const float* biast, int bh, int dsh, int tid, float& v0, float& v1) {
    const int d0 = tid - 384, d1 = tid + 512 - 384;
    v0 = (d0 >= 0 && d0 < WIN) ? biast[bh * 4096 + (d0 << dsh)] * (1.0f / SCALE) : 0.f;
    v1 = (d1 >= 0 && d1 < WIN) ? biast[bh * 4096 + (d1 << dsh)] * (1.0f / SCALE) : 0.f;
}
__device__ __forceinline__ void swa_prime(const BlockRef& cur, const float* biast, char* lds, Seam& S, int tid) {
    const int wid = __builtin_amdgcn_readfirstlane(tid >> 6), lane = tid & 63, r32 = lane & 31, hi = lane >> 5;
    char* K_lds = lds + 2 * SHM_V;
    const int kb0 = swa_jlo(cur.P0) * KVBLK;
    float t0, t1; tb_load(biast, cur.bh, cur.dsh, tid, t0, t1);
#pragma unroll
    for (int d0 = 0; d0 < 8; ++d0) S.qr[d0] = load8((const bf16_t*)((const char*)cur.Q + (size_t)((unsigned)((wid * QBLK + r32) * cur.rs() + hi * 8) * 2u)) + d0 * 16);
    SLOAD_H(cur.K, cur.V(), kb0, cur.rs()); VMW(); SWRITE_HK(0);
    float* tb = (float*)(lds + LDS_TB); tb[tid] = t0; tb[tid + 512] = t1;
    __syncthreads();
}
__device__ __forceinline__ void swa_block(const BlockRef& cur, const BlockRef& nxt, const float* biast, int slot, char* lds, Seam& S, int tid) {
    const int wid = __builtin_amdgcn_readfirstlane(tid >> 6), lane = tid & 63, r32 = lane & 31, hi = lane >> 5;
    const int j_lo = swa_jlo(cur.P0);
    int j_hi = (cur.P0 + QB - 1) / KVBLK + 1; if (j_hi > cur.skv() / KVBLK) j_hi = cur.skv() / KVBLK;
    const int NT = j_hi - j_lo;
    const int kbn = swa_jlo(nxt.P0) * KVBLK;
    const int qlo = cur.P0 + wid * QBLK, qm = qlo + r32 - 4 * hi;
    char* V_lds = lds; char* K_lds = lds + 2 * SHM_V;
    float* wsl = (float*)(lds + 2 * SHM_V + 2 * SHM_K) + wid * 64; float* li_l = wsl, * al_l = wsl + 32;
    const float* tbl0 = (const float*)(lds + LDS_TB + slot * 4096) + 325;
    float m_reg = -1e30f, l_reg = 0; f32x16 o[4] = {};
    const int vb0 = (int)(uintptr_t)V_lds + v_rd_base(lane);
    const bf16_t* Kh = cur.K; const bf16_t* Vh = cur.V(); const int rs = cur.rs();
#define RESC(a) do { if (__any((a) < 1.f)) { if (hi == 0) al_l[r32] = (a); asm volatile("s_waitcnt lgkmcnt(0)" ::: "memory");              \
                     _Pragma("unroll") for (int d_ = 0; d_ < 4; ++d_) _Pragma("unroll") for (int r = 0; r < 16; ++r) o[d_][r] *= al_l[crow(r, hi)]; } } while (0)
#define KBASE(t) ((j_lo + (t)) * KVBLK)
#define ACT(t) (KBASE(t) <= qlo + QBLK - 1 && KBASE(t) + KVBLK - 1 >= qlo - WIN + 1)
#define MASKT(P0_, P1_, t) do { const int kb_ = KBASE(t); if (ACT(t)) mask_bias_tile(P0_, P1_, qm - kb_, tbl0 + (qm - kb_)); } while (0)
    constexpr int NQL = 8;
#define SEAM_K0() do { VMWN(NQL); SWRITE_HK(0); SBAR(); } while (0)
    f32x16 pA0, pA1, pB0, pB1; float mnA, mnB, alA, alB; bf16x8 pa0, pa1, pa2, pa3;
    SWRITE_HV(0); SBAR();
    if (NT > 1) { SLOAD_H(Kh, Vh, KBASE(1), rs); }
    SBAR(); qkt<0>(pA0, pA1, K_lds, r32, hi, S.qr, ACT(0));
    MASKT(pA0, pA1, 0); partialSM(pA0, pA1, m_reg, mnA, alA);
    if (NT > 1) { VMW(); SWRITE_H(1); }
    __syncthreads();
#define HALF_STEP(PX0, PX1, mnX, alX, PY0, PY1, alY, t, KB, VB, SB) do {                                                      \
        SBAR(); qkt<KB>(PX0, PX1, K_lds, r32, hi, S.qr, ACT(t));                                             \
        finishSM(PY0, PY1, alY, l_reg, pa0, pa1, pa2, pa3); SBAR();                                                           \
        if ((t) + 1 < NT) { SLOAD_H(Kh, Vh, KBASE((t) + 1), rs); SBAR(); }                                               \
        pv_tile<VB>(o, vb0, pa0, pa1, pa2, pa3, ACT((t) - 1)); MASKT(PX0, PX1, (t)); partialSM(PX0, PX1, m_reg, mnX, alX);                                        \
        __syncthreads();                                                                                                      \
        if ((t) + 1 < NT) { VMW(); SWRITE_H(SB); }                                                                          \
        RESC(alX); __syncthreads(); } while (0)
    for (int t = 1; t + 1 < NT; t += 2) {
        HALF_STEP(pB0, pB1, mnB, alB, pA0, pA1, alA, t, 1, 0, 0);
        HALF_STEP(pA0, pA1, mnA, alA, pB0, pB1, alB, t + 1, 0, 1, 1);
    }
    const bool even = (NT & 1) == 0;
    if (even) { SBAR(); qkt<1>(pB0, pB1, K_lds, r32, hi, S.qr, ACT(NT - 1)); SBAR(); }
    SLOAD_H(nxt.K, nxt.V(), kbn, nxt.rs()); SBAR();
#pragma unroll
    for (int d0 = 0; d0 < 8; ++d0) S.qr[d0] = load8((const bf16_t*)((const char*)nxt.Q + (size_t)((unsigned)((wid * QBLK + r32) * nxt.rs() + hi * 8) * 2u)) + d0 * 16);
    SBAR();
    finishSM(pA0, pA1, alA, l_reg, pa0, pa1, pa2, pa3); SBAR();
    pv_tile<0>(o, vb0, pa0, pa1, pa2, pa3, ACT(even ? NT - 2 : NT - 1));
    if (even) { MASKT(pB0, pB1, NT - 1); partialSM(pB0, pB1, m_reg, mnB, alB); __syncthreads(); RESC(alB);
        finishSM(pB0, pB1, alB, l_reg, pa0, pa1, pa2, pa3); SBAR(); pv_tile<1>(o, vb0, pa0, pa1, pa2, pa3, ACT(NT - 1)); }
    SBAR(); SEAM_K0();
    float t0, t1; tb_load(biast, nxt.bh, nxt.dsh, tid, t0, t1);
    if (hi == 0) li_l[r32] = l_reg; asm volatile("s_waitcnt lgkmcnt(0)" ::: "memory");
    int r32e = r32, hie = hi; asm volatile("" : "+v"(r32e), "+v"(hie));
    if (hie == 0) cur.LSE[(size_t)(wid * QBLK + r32e) * cur.ls()] = m_reg * SCALE + __logf(l_reg);
    float rli[16];
#pragma unroll
    for (int r = 0; r < 16; ++r) rli[r] = __builtin_amdgcn_rcpf(li_l[crow(r, hie)]);
    const int os = cur.os();
    bf16_t* Ow = cur.O + (size_t)(wid * QBLK) * os;
#pragma unroll
    for (int r = 0; r < 16; ++r) { const unsigned oo = (unsigned)(crow(r, hie) * os + r32e) * 2u;
#pragma unroll
        for (int d0 = 0; d0 < 4; ++d0) { const float v = o[d0][r] * rli[r];
            const float vn = swz_xor<1>(v);
            if ((r32e & 1) == 0) *(unsigned*)((char*)Ow + oo + d0 * 64) = cvt_pk_bf16(v, vn); } }
    { float* tb = (float*)(lds + LDS_TB + (slot ^ 1) * 4096); tb[tid] = t0; tb[tid + 512] = t1; }
    __syncthreads();
#undef RESC
#undef KBASE
#undef ACT
#undef MASKT
#undef SEAM_K0
#undef HALF_STEP
}
#undef ROWP
#undef VMW
#undef VMWN
#undef SLOAD_H
#undef SWRITE_HK
#undef SWRITE_HV
#undef SWRITE_H
#undef TIDL
#undef KSWZ
#undef SBAR
}


namespace dsa {
constexpr int D = 64, NW = 8, QBLK = 32, KVBLK = 64, QB = NW * QBLK;
constexpr int SHM_V = KVBLK * D * 2, SHM_K = KVBLK * D * 2;
constexpr int LDS_TB = 2 * SHM_V + 2 * SHM_K + NW * 64 * 4;
constexpr int TB_PAD = 128;
constexpr float SCALE = 0.125f, THR = 8.f;
typedef float f32x16 __attribute__((ext_vector_type(16)));
typedef short s16x4 __attribute__((ext_vector_type(4)));
#define KSWZ(row, colB) ((row) * 128 + ((colB) ^ (((row) & 7) << 4)))
#define SBAR() __builtin_amdgcn_sched_barrier(0)
__device__ __forceinline__ int v_st(int k, int c) { const int kk = (k & ~0xC) | ((k & 4) << 1) | ((k & 8) >> 1); return ((kk >> 3) * 2 + (c >> 5)) * 512 + ((kk & 7) * 32 + (c & 31)) * 2; }
__device__ __forceinline__ int v_rd_base(int lane) { return ((lane & 3) << 3) | (((lane >> 2) & 3) << 6) | (((lane >> 4) & 1) << 5) | (((lane >> 5) & 1) << 8); }
__device__ __forceinline__ int crow(int r, int hi) { return (r & 3) + 8 * (r >> 2) + 4 * hi; }
__device__ __forceinline__ bf16x8 load8(const bf16_t* p) { return *reinterpret_cast<const bf16x8*>(p); }
__device__ __forceinline__ void mask_bias_tile(f32x16& p0, f32x16& p1, const float* tb, unsigned lo4, unsigned hi4) {
    const float NEG = -__builtin_inff();
    float b0[16], b1[16];
#pragma unroll
    for (int r = 0; r < 16; ++r) { const int c = (r & 3) + 8 * (r >> 2); b0[r] = tb[63 - c]; b1[r] = tb[31 - c]; }
#pragma unroll
    for (int r = 0; r < 16; ++r) {
        const int c = (r & 3) + 8 * (r >> 2);
        const float a0 = p0[r] + b0[r], a1 = p1[r] + b1[r];
        p0[r] = ((lo4 >> c) & 1u) ? a0 : NEG;
        p1[r] = ((hi4 >> c) & 1u) ? a1 : NEG;
    }
}
__device__ __forceinline__ void partialSM(f32x16& p0, f32x16& p1, float& m_reg, float& mn, float& alpha) {
    float pmax = p0[0];
#pragma unroll
    for (int r = 1; r < 16; ++r) pmax = fmaxf(pmax, p0[r]);
#pragma unroll
    for (int r = 0; r < 16; ++r) pmax = fmaxf(pmax, p1[r]);
    { auto rr = __builtin_amdgcn_permlane32_swap(__float_as_uint(pmax), __float_as_uint(pmax), false, false);
      pmax = fmaxf(__uint_as_float(rr[0]), __uint_as_float(rr[1])); }
    constexpr float C2 = 1.4426950408889634f * SCALE;
    if (__builtin_expect(__all((pmax - m_reg) * SCALE <= THR), 1)) { mn = m_reg; alpha = 1.f; }
    else { mn = fmaxf(m_reg, pmax); alpha = __builtin_amdgcn_exp2f((m_reg - mn) * C2); m_reg = mn; }
    const float mnL = -mn * C2;
#pragma unroll
    for (int r = 0; r < 16; ++r) p0[r] = fmaf(p0[r], C2, mnL);
#pragma unroll
    for (int r = 0; r < 16; ++r) p1[r] = fmaf(p1[r], C2, mnL);
#pragma unroll
    for (int r = 0; r < 16; ++r) p0[r] = __builtin_amdgcn_exp2f(p0[r]);
}
__device__ __forceinline__ void finishSM(f32x16& p0, f32x16& p1, float alpha, float& l_reg, bf16x8& pa0, bf16x8& pa1, bf16x8& pa2, bf16x8& pa3) {
#pragma unroll
    for (int r = 0; r < 16; ++r) p1[r] = __builtin_amdgcn_exp2f(p1[r]);
    float ps = 0;
#pragma unroll
    for (int r = 0; r < 16; ++r) ps += p0[r];
#pragma unroll
    for (int r = 0; r < 16; ++r) ps += p1[r];
    { auto rr = __builtin_amdgcn_permlane32_swap(__float_as_uint(ps), __float_as_uint(ps), false, false);
      ps = __uint_as_float(rr[0]) + __uint_as_float(rr[1]); }
    l_reg = l_reg * alpha + ps;
#define PK4(P, B_, OUT) do { unsigned a0 = cvt_pk_bf16(P[B_+0], P[B_+1]), a1 = cvt_pk_bf16(P[B_+2], P[B_+3]);                          \
        unsigned b0 = cvt_pk_bf16(P[B_+4], P[B_+5]), b1 = cvt_pk_bf16(P[B_+6], P[B_+7]);                                             \
        auto r0 = __builtin_amdgcn_permlane32_swap(a0, b0, false, false); auto r1 = __builtin_amdgcn_permlane32_swap(a1, b1, false, false); \
        u32x4 w = {r0[0], r1[0], r0[1], r1[1]}; OUT = *reinterpret_cast<bf16x8*>(&w); } while (0)
    PK4(p0, 0, pa0); PK4(p0, 8, pa1); PK4(p1, 0, pa2); PK4(p1, 8, pa3);
#undef PK4
}
template <int KB>
__device__ __forceinline__ void qkt(f32x16& p0, f32x16& p1, const char* K_lds, int r32, int hi, const bf16x8* qr, bool act) {
    if (!act) { const float NEG = -__builtin_inff();
#pragma unroll
        for (int r = 0; r < 16; ++r) { p0[r] = NEG; p1[r] = NEG; } return; }
    p0 = f32x16{}; p1 = f32x16{};
#pragma unroll
    for (int d0 = 0; d0 < 4; ++d0) { const char* a = K_lds + KB * SHM_K + KSWZ(r32, (d0 * 16 + hi * 8) * 2);
        bf16x8 b0 = *reinterpret_cast<const bf16x8*>(a);
        bf16x8 b1 = *reinterpret_cast<const bf16x8*>(a + 32 * 128);
        p0 = __builtin_amdgcn_mfma_f32_32x32x16_bf16(b0, qr[d0], p0, 0, 0, 0);
        p1 = __builtin_amdgcn_mfma_f32_32x32x16_bf16(b1, qr[d0], p1, 0, 0, 0); }
}
template <int VB>
__device__ __forceinline__ void pv_tile(f32x16* o, int vb0, bf16x8 pa0, bf16x8 pa1, bf16x8 pa2, bf16x8 pa3, bool act) {
    if (!act) return;
#define TRRD(dst, off) asm volatile("ds_read_b64_tr_b16 %0, %1 offset:%2" : "=&v"(dst) : "v"(vb0), "i"(off) : "memory")
#define PV_D0(d0) do { s16x4 l0, l1, l2, l3, h0, h1, h2, h3; constexpr int b_ = VB * SHM_V + (d0) * 512; \
        TRRD(l0, b_); TRRD(h0, b_ + 1024); TRRD(l1, b_ + 2048); TRRD(h1, b_ + 3072); TRRD(l2, b_ + 4096); TRRD(h2, b_ + 5120); TRRD(l3, b_ + 6144); TRRD(h3, b_ + 7168); \
        asm volatile("s_waitcnt lgkmcnt(0)" ::: "memory"); SBAR();   \
        o[d0] = __builtin_amdgcn_mfma_f32_32x32x16_bf16(pa0, (bf16x8){l0[0], l0[1], l0[2], l0[3], h0[0], h0[1], h0[2], h0[3]}, o[d0], 0, 0, 0);   \
        o[d0] = __builtin_amdgcn_mfma_f32_32x32x16_bf16(pa1, (bf16x8){l1[0], l1[1], l1[2], l1[3], h1[0], h1[1], h1[2], h1[3]}, o[d0], 0, 0, 0);   \
        o[d0] = __builtin_amdgcn_mfma_f32_32x32x16_bf16(pa2, (bf16x8){l2[0], l2[1], l2[2], l2[3], h2[0], h2[1], h2[2], h2[3]}, o[d0], 0, 0, 0);   \
        o[d0] = __builtin_amdgcn_mfma_f32_32x32x16_bf16(pa3, (bf16x8){l3[0], l3[1], l3[2], l3[3], h3[0], h3[1], h3[2], h3[3]}, o[d0], 0, 0, 0); } while (0)
    PV_D0(0); PV_D0(1);
#undef PV_D0
#undef TRRD
}
struct BlockRef { const bf16_t* Q; const bf16_t* K; const bf16_t* V; bf16_t* O; const u64* MW; int P0; };
struct Seam { bf16x8 qr[4]; bf16x8 st_v0, st_k0; u64 mw; };
#define VMW() asm volatile("s_waitcnt vmcnt(0)" ::: "memory")
#define VMWN(n) asm volatile("s_waitcnt vmcnt(%0)" :: "i"(n) : "memory")
#define TIDL() int tid_l = tid; asm volatile("" : "+v"(tid_l)); const int sr = tid_l >> 3, sc = (tid_l & 7) * 8; (void)sr; (void)sc
#define SLOAD_H(Kp, Vp, k0) do { TIDL(); const unsigned vo_ = (unsigned)((k0 + sr) * 512 + sc) * 2u; \
        S.st_v0 = load8((const bf16_t*)((const char*)(Vp) + vo_)); S.st_k0 = load8((const bf16_t*)((const char*)(Kp) + vo_)); } while (0)
#define SWRITE_HK(bf) do { TIDL(); *(bf16x8*)(K_lds + (bf) * SHM_K + KSWZ(sr, sc * 2)) = S.st_k0; } while (0)
#define SWRITE_HV(bf) do { TIDL(); *(bf16x8*)(V_lds + (bf) * SHM_V + v_st(sr, sc)) = S.st_v0; } while (0)
#define SWRITE_H(bf) do { SWRITE_HV(bf); SWRITE_HK(bf); } while (0)
#define MWLOAD(ref, tile) ((ref).MW[(size_t)(tile) * SEQ + wid * QBLK + r32])
__device__ __forceinline__ void dsa_prime(const BlockRef& cur, char* lds, Seam& S, int tid) {
    const int wid = __builtin_amdgcn_readfirstlane(tid >> 6), lane = tid & 63, r32 = lane & 31, hi = lane >> 5;
    char* K_lds = lds + 2 * SHM_V;
#pragma unroll
    for (int d0 = 0; d0 < 4; ++d0) S.qr[d0] = load8(cur.Q + (size_t)(wid * QBLK + r32) * 512 + d0 * 16 + hi * 8);
    S.mw = MWLOAD(cur, 0);
    SLOAD_H(cur.K, cur.V, 0); VMW(); SWRITE_HK(0);
    __syncthreads();
}
__device__ __forceinline__ void dsa_block(const BlockRef& cur, const BlockRef& nxt, char* lds, Seam& S, int tid) {
    const int wid = __builtin_amdgcn_readfirstlane(tid >> 6), lane = tid & 63, r32 = lane & 31, hi = lane >> 5;
    const int NT = (cur.P0 + QB - 1) / KVBLK + 1;
    const int qlo = cur.P0 + wid * QBLK, qm = qlo + r32 - 4 * hi;
    char* V_lds = lds; char* K_lds = lds + 2 * SHM_V;
    float* wsl = (float*)(lds + 2 * SHM_V + 2 * SHM_K) + wid * 64; float* li_l = wsl, * al_l = wsl + 32;
    const float* tbl0 = (const float*)(lds + LDS_TB) + (TB_PAD - 63);
    float m_reg = -1e30f, l_reg = 0; f32x16 o[2] = {};
    const int vb0 = (int)(uintptr_t)V_lds + v_rd_base(lane);
    const bf16_t* Kh = cur.K; const bf16_t* Vh = cur.V;
#define RESC(a) do { if (__any((a) < 1.f)) { if (hi == 0) al_l[r32] = (a); asm volatile("s_waitcnt lgkmcnt(0)" ::: "memory");              \
                     _Pragma("unroll") for (int d_ = 0; d_ < 2; ++d_) _Pragma("unroll") for (int r = 0; r < 16; ++r) o[d_][r] *= al_l[crow(r, hi)]; } } while (0)
#define KBASE(t) ((t) * KVBLK)
#define ACT(t) (KBASE(t) <= qlo + QBLK - 1)
#define MASKT(P0_, P1_, t, MWX) do { const int kb_ = KBASE(t); if (ACT(t)) mask_bias_tile(P0_, P1_, tbl0 + (qm - kb_), (unsigned)(MWX) >> (4 * hi), (unsigned)((MWX) >> 32) >> (4 * hi)); } while (0)
    constexpr int NQL = 5;
#define SEAM_K0() do { VMWN(NQL); SWRITE_HK(0); SBAR(); } while (0)
    f32x16 pA0, pA1, pB0, pB1; float mnA, mnB, alA, alB; bf16x8 pa0, pa1, pa2, pa3;
    u64 mwA = S.mw, mwB = 0;
    SWRITE_HV(0); SBAR();
    if (NT > 1) { SLOAD_H(Kh, Vh, KBASE(1)); mwB = MWLOAD(cur, 1); }
    SBAR(); qkt<0>(pA0, pA1, K_lds, r32, hi, S.qr, ACT(0));
    MASKT(pA0, pA1, 0, mwA); partialSM(pA0, pA1, m_reg, mnA, alA);
    if (NT > 1) { VMW(); SWRITE_H(1); }
    __syncthreads();
#define HALF_STEP(PX0, PX1, mnX, alX, PY0, PY1, alY, t, KB, VB, SB, MWX, MWY) do {                                                      \
        SBAR(); qkt<KB>(PX0, PX1, K_lds, r32, hi, S.qr, ACT(t));                                             \
        finishSM(PY0, PY1, alY, l_reg, pa0, pa1, pa2, pa3); SBAR();                                                           \
        if ((t) + 1 < NT) { SLOAD_H(Kh, Vh, KBASE((t) + 1)); MWY = MWLOAD(cur, (t) + 1); SBAR(); }                                               \
        pv_tile<VB>(o, vb0, pa0, pa1, pa2, pa3, ACT((t) - 1)); MASKT(PX0, PX1, (t), MWX); partialSM(PX0, PX1, m_reg, mnX, alX);                                        \
        __syncthreads();                                                                                                      \
        if ((t) + 1 < NT) { VMW(); SWRITE_H(SB); }                                                                          \
        RESC(alX); __syncthreads(); } while (0)
    for (int t = 1; t + 1 < NT; t += 2) {
        HALF_STEP(pB0, pB1, mnB, alB, pA0, pA1, alA, t, 1, 0, 0, mwB, mwA);
        HALF_STEP(pA0, pA1, mnA, alA, pB0, pB1, alB, t + 1, 0, 1, 1, mwA, mwB);
    }
    const bool even = (NT & 1) == 0;
    if (even) { SBAR(); qkt<1>(pB0, pB1, K_lds, r32, hi, S.qr, ACT(NT - 1)); SBAR(); }
    SLOAD_H(nxt.K, nxt.V, 0); SBAR();
#pragma unroll
    for (int d0 = 0; d0 < 4; ++d0) S.qr[d0] = load8(nxt.Q + (size_t)(wid * QBLK + r32) * 512 + d0 * 16 + hi * 8);
    S.mw = MWLOAD(nxt, 0);
    SBAR();
    finishSM(pA0, pA1, alA, l_reg, pa0, pa1, pa2, pa3); SBAR();
    pv_tile<0>(o, vb0, pa0, pa1, pa2, pa3, ACT(even ? NT - 2 : NT - 1));
    if (even) { MASKT(pB0, pB1, NT - 1, mwB); partialSM(pB0, pB1, m_reg, mnB, alB); __syncthreads(); RESC(alB);
        finishSM(pB0, pB1, alB, l_reg, pa0, pa1, pa2, pa3); SBAR(); pv_tile<1>(o, vb0, pa0, pa1, pa2, pa3, ACT(NT - 1)); }
    SBAR(); SEAM_K0();
    if (hi == 0) li_l[r32] = l_reg; asm volatile("s_waitcnt lgkmcnt(0)" ::: "memory");
    int r32e = r32, hie = hi; asm volatile("" : "+v"(r32e), "+v"(hie));
    float rli[16];
#pragma unroll
    for (int r = 0; r < 16; ++r) rli[r] = __builtin_amdgcn_rcpf(li_l[crow(r, hie)]);
    bf16_t* Ow = cur.O + (size_t)(wid * QBLK) * DM;
#pragma unroll
    for (int r = 0; r < 16; ++r) { const unsigned oo = (unsigned)(crow(r, hie) * DM + r32e) * 2u;
#pragma unroll
        for (int d0 = 0; d0 < 2; ++d0) { const float v = o[d0][r] * rli[r];
            const float vn = swz_xor<1>(v);
            if ((r32e & 1) == 0) *(unsigned*)((char*)Ow + oo + d0 * 64) = cvt_pk_bf16(v, vn); } }
    __syncthreads();
#undef RESC
#undef KBASE
#undef ACT
#undef MASKT
#undef SEAM_K0
#undef HALF_STEP
}
#undef VMW
#undef VMWN
#undef TIDL
#undef SLOAD_H
#undef SWRITE_HK
#undef SWRITE_HV
#undef SWRITE_H
#undef MWLOAD
#undef KSWZ
#undef SBAR
}

__device__ __forceinline__ swa::BlockRef dil_ref(int u, const bf16_t* H1p, bf16_t* OPp, float* LSEp) {
    const int x = u & 15, rest = u >> 4, g = rest % 3, bh = rest / 3, h = bh & 7, bl = bh >> 3;
    const int dsh = 2 * g, dil = 1 << dsh, r = x >> (4 - dsh), blk = x & ((16 >> dsh) - 1), P0 = blk * 256;
    const size_t row0 = (size_t)bl * SEQ + r, rowq = row0 + (size_t)dil * P0;
    swa::BlockRef R;
    R.K = H1p + row0 * IN1_N + g * 3072 + 1024 + h * 128; R.Q = H1p + rowq * IN1_N + g * 3072 + h * 128;
    R.O = OPp + ((size_t)g * CHUNK_T + rowq) * DM + h * 128; R.LSE = LSEp + ((size_t)g * CHUNK_T + rowq) * 8 + h;
    R.P0 = P0; R.bh = h; R.dsh = dsh;
    return R;
}

struct Args {
    const float* in[25]; float* out; unsigned char* ws; int ph_lo, ph_hi;
};
enum { I_X = 0, I_RELB, I_EWIN, I_CONVW, I_CONVB, I_CLNG, I_CLNB, I_EWOUT, I_ELN1G, I_ELN1B, I_FWG, I_FWU, I_FWD, I_ELN2G, I_ELN2B,
       I_OWIN, I_OWOUT, I_OLN1G, I_OLN1B, I_ROUTER, I_MWG, I_MWU, I_MWD, I_OLN2G, I_OLN2B };

__device__ __forceinline__ void transpose_item(const float* W, int ldw, int src_c0, int nvalid, int k0, bf16_t* WT, int K, int dst_row0, LAS float* scr, int lane) {
    (void)scr;
    const int kg = lane & 7, ng = lane >> 3;
    f32x4 v[8];
    const float* src = W + (size_t)(k0 + 8 * kg) * ldw + src_c0 + 4 * ng;
    const bool ok = 4 * ng < nvalid;
#pragma unroll
    for (int r = 0; r < 8; ++r) v[r] = ok ? *(const f32x4*)(src + (size_t)r * ldw) : (f32x4){0.f, 0.f, 0.f, 0.f};
#pragma unroll
    for (int c = 0; c < 4; ++c) { u32x4 o; o.x = cvt_pk_bf16(v[0][c], v[1][c]); o.y = cvt_pk_bf16(v[2][c], v[3][c]); o.z = cvt_pk_bf16(v[4][c], v[5][c]); o.w = cvt_pk_bf16(v[6][c], v[7][c]);
        *(u32x4*)(WT + (size_t)(dst_row0 + 4 * ng + c) * K + k0 + 8 * kg) = o; }
}
__device__ __forceinline__ void gu_item(const float* wg, const float* wu, int FF, int K, bf16_t* WT, int item, LAS float* scr, int lane) {
    const int nblk = 2 * FF / 32, kb = item / nblk, nb = item % nblk, tile = nb >> 3, sub = nb & 7;
    transpose_item(sub < 4 ? wg : wu, FF, tile * 128 + (sub & 3) * 32, 32, kb * 64, WT, K, nb * 32, scr, lane);
}
__device__ __forceinline__ void plain_item(const float* W, int K, int N, bf16_t* WT, int item, LAS float* scr, int lane) {
    const int nblk = N / 32, kb = item / nblk, nb = item % nblk;
    transpose_item(W, N, nb * 32, 32, kb * 64, WT, K, nb * 32, scr, lane);
}
__device__ __forceinline__ void in0_item(const float* W, bf16_t* WT, int item, LAS float* scr, int lane) {
    const int nblk = IN0_N / 32, kb = item / nblk, nb = item % nblk, tile = nb >> 3, sub = nb & 7;
    int src_c0, nvalid = 32;
    if (tile < 4) src_c0 = (sub < 4) ? tile * 128 + sub * 32 : 512 + tile * 128 + (sub - 4) * 32;
    else { src_c0 = nb * 32; nvalid = IN0_SRC - src_c0; nvalid = nvalid < 0 ? 0 : (nvalid > 32 ? 32 : nvalid); if (nvalid == 0) src_c0 = 0; }
    transpose_item(W, IN0_SRC, src_c0, nvalid, kb * 64, WT, DM, nb * 32, scr, lane);
}
__device__ __forceinline__ int rel_bucket(int n) {
    if (n < 16) return n;
    const float nf = (float)n;
    int large = 16 + (int)(logf(nf / 16.0f) / logf(128.0f) * 16.0f);
    return large < 31 ? large : 31;
}

__device__ __forceinline__ void ln_core(f32x4 (&v)[4], const float* g, const float* b, int lane) {
    float s = 0.f;
#pragma unroll
    for (int j = 0; j < 4; ++j) s += (v[j][0] + v[j][1]) + (v[j][2] + v[j][3]);
    const float mean = wave_sum(s) * (1.f / DM); float s2 = 0.f;
#pragma unroll
    for (int j = 0; j < 4; ++j) { v[j] = v[j] - mean; s2 += (v[j][0] * v[j][0] + v[j][1] * v[j][1]) + (v[j][2] * v[j][2] + v[j][3] * v[j][3]); }
    const float rstd = 1.f / sqrtf(wave_sum(s2) * (1.f / DM) + LN_EPS);
#pragma unroll
    for (int j = 0; j < 4; ++j) { const f32x4 gg = *(const f32x4*)(g + 4 * lane + 256 * j), bb = *(const f32x4*)(b + 4 * lane + 256 * j); v[j] = v[j] * rstd * gg + bb; }
}
__device__ __forceinline__ void store_row_bf16(bf16_t* orow, const f32x4 (&v)[4], int lane) {
#pragma unroll
    for (int j = 0; j < 4; ++j) { u32x2 w; w.x = cvt_pk_bf16(v[j][0], v[j][1]); w.y = cvt_pk_bf16(v[j][2], v[j][3]); *(u32x2*)(orow + 4 * lane + 256 * j) = w; }
}
__device__ __forceinline__ f32x4 ld_bf4(const bf16_t* p) { const u32x2 w = *(const u32x2*)p; return (f32x4){bf_lo(w.x), bf_hi(w.x), bf_lo(w.y), bf_hi(w.y)}; }

__device__ __forceinline__ int my_lane_asm() { int l; asm volatile("v_mbcnt_lo_u32_b32 %0, -1, 0\n\tv_mbcnt_hi_u32_b32 %0, -1, %0" : "=v"(l)); return l; }
__global__ void __launch_bounds__(NTHR, 2) fwd_kernel(Args args) {
    extern __shared__ __attribute__((aligned(16))) unsigned char lds_raw[];
    LAS unsigned char* lds = (LAS unsigned char*)lds_raw;
    const int G = gridDim.x, bid = blockIdx.x;
    const int NGW = G * NWAVES;
    volatile LAS unsigned* MISC = (volatile LAS unsigned*)(lds + LDS_MISC);
    const int wave_id = __builtin_amdgcn_readfirstlane((int)(threadIdx.x >> 6));
    {
        const int l0 = my_lane_asm();
        if (wave_id == 0 && l0 < 16) MISC[l0] = 0u;
        __syncthreads();
    }
#define MY_LANE() my_lane_asm()
#if ONE_LAUNCH
    (void)xcd_barrier_post((unsigned*)(args.ws + WS_CTL) + CW_BAR, MISC, wave_id == 0 && MY_LANE() == 0);
#define GRID_BAR() do { XcdBarrier _b; _b.bar = (unsigned*)(ws + WS_CTL) + CW_BAR; _b.x = xb_xcc_id(); _b.st = (volatile LAS unsigned*)(lds + LDS_MISC); xcd_barrier(_b, tid == 0); } while (0)
#else
#define GRID_BAR() do { } while (0)
#endif
    const int lo = args.ph_lo, hi = args.ph_hi;
#ifndef PH_MASK
#define PH_MASK 0xFFFFFFu
#endif
#define IN(k) ((((PH_MASK) >> (k)) & 1u) && lo <= (k) && (k) < hi)
#define BOTH(k) (IN(k) && IN((k) + 1))
#define PHASE_BEGIN int lane = MY_LANE(); asm volatile("" : "+v"(lane)); const int wave = wave_id; const int tid = wave * 64 + lane; const int gw = bid * NWAVES + wave; \
    size_t zoff_ = 0; asm volatile("" : "+s"(zoff_)); unsigned char* ws = args.ws + zoff_; float* outp = (float*)((unsigned char*)args.out + zoff_); unsigned* ctl = (unsigned*)(ws + WS_CTL); (void)lane; (void)wave; (void)gw; (void)ctl; (void)outp;
#define x_in (args.in[I_X])
#define WIN0 ((bf16_t*)(ws + WS_WIN0))
#define WOUT0 ((bf16_t*)(ws + WS_WOUT0))
#define WGU0 ((bf16_t*)(ws + WS_WGU0))
#define WD0 ((bf16_t*)(ws + WS_WD0))
#define WIN1 ((bf16_t*)(ws + WS_WIN1))
#define WOUT1 ((bf16_t*)(ws + WS_WOUT1))
#define MWGU ((bf16_t*)(ws + WS_MWGU))
#define MWD ((bf16_t*)(ws + WS_MWD))
#define BIAST ((float*)(ws + WS_BIAST))
#define XB ((bf16_t*)(ws + WS_XB))
#define Ub ((bf16_t*)(ws + WS_U))
#define Q0 ((bf16_t*)(ws + WS_Q0))
#define K0 ((bf16_t*)(ws + WS_Q0 + SEG0))
#define V0 ((bf16_t*)(ws + WS_Q0 + 2 * SEG0))
#define QI ((bf16_t*)(ws + WS_Q0 + 3 * SEG0))
#define KI ((bf16_t*)(ws + WS_KI))
#define WI ((float*)(ws + WS_WI))
#define MASK ((u64*)(ws + WS_MASK))
#define MIXIN ((bf16_t*)(ws + WS_MIXIN))
#define X1B ((bf16_t*)(ws + WS_X1B))
#define H0 ((bf16_t*)(ws + WS_H0))
#define X2B ((bf16_t*)(ws + WS_X2B))
#define H1 ((bf16_t*)(ws + WS_H1))
#define O1 ((bf16_t*)outp)
#define Y3 ((float*)(ws + WS_Y3))
#define X3B ((bf16_t*)(ws + WS_X3B))
#define YB ((bf16_t*)(ws + WS_YB))
#define MTOK ((int*)(ws + WS_MOE_TOK))
#define MGATE ((float*)(ws + WS_MOE_GATE))
#define GTAB ((const LAS int*)(lds + LDS_GTAB))

    if (IN(0)) { asm volatile("; PHASE_MARK 0"); PHASE_BEGIN
        LAS float* scr = (LAS float*)(lds + wave * 16384);
        constexpr int I_IN0 = 16 * (IN0_N / 32), I_OUT = 16 * 32, I_GU0 = 16 * (2 * FF0 / 32), I_D0 = (FF0 / 64) * 32, I_IN1 = 16 * (IN1_N / 32);
        constexpr int NIT = I_IN0 + I_OUT + I_GU0 + I_D0 + I_IN1 + I_OUT;
        for (int it = gw; it < NIT; it += NGW) {
            int r = it;
            if (r < I_IN0) { in0_item(args.in[I_EWIN], WIN0, r, scr, lane); continue; } r -= I_IN0;
            if (r < I_OUT) { plain_item(args.in[I_EWOUT], DM, DM, WOUT0, r, scr, lane); continue; } r -= I_OUT;
            if (r < I_GU0) { gu_item(args.in[I_FWG], args.in[I_FWU], FF0, DM, WGU0, r, scr, lane); continue; } r -= I_GU0;
            if (r < I_D0) { plain_item(args.in[I_FWD], FF0, DM, WD0, r, scr, lane); continue; } r -= I_D0;
            if (r < I_IN1) { plain_item(args.in[I_OWIN], DM, IN1_N, WIN1, r, scr, lane); continue; } r -= I_IN1;
            plain_item(args.in[I_OWOUT], DM, DM, WOUT1, r, scr, lane);
        }
        for (size_t i = (size_t)bid * NTHR + tid; i < (size_t)NTOK * DM / 8; i += (size_t)G * NTHR) {
            const f32x4 a = *(const f32x4*)(x_in + i * 8), b = *(const f32x4*)(x_in + i * 8 + 4);
            *(u32x4*)(XB + i * 8) = pg8::pack8(a, b);
        }
        for (int i = bid * NTHR + tid; i < 8 * 4096; i += G * NTHR) { const int h = i >> 12, d = i & 4095; BIAST[i] = args.in[I_RELB][rel_bucket(d) * 8 + h]; }
        if (BOTH(0)) GRID_BAR();
    }

    if (IN(1)) { asm volatile("; PHASE_MARK 1"); PHASE_BEGIN
        pg8::StaticOrder S; S.init(XB, NTOK, IN0_N, DM, G, bid);
        pg8::EpiIn0 E{Ub, Q0, KI, WI};
        pg8::gemm_phase<pg8::EpiIn0, pg8::StaticOrder, true, false>(tid, lds, WIN0, DM, DM, S, E, GTAB);
        if (BOTH(1)) GRID_BAR();
    }

    if (IN(2)) { asm volatile("; PHASE_MARK 2"); PHASE_BEGIN
        {
            LAS bf16_t* ut = (LAS bf16_t*)lds;
            LAS float* yt = (LAS float*)(lds + 65536);
            const float* cw = args.in[I_CONVW];
            const int cp = tid & 255, th = tid >> 8;
            float w0[31], w1[31];
#pragma unroll
            for (int j = 0; j < 31; ++j) { const f32x2 wv = *(const f32x2*)(cw + j * 512 + 2 * cp); w0[j] = wv.x; w1[j] = wv.y; }
            const f32x2 cbv = *(const f32x2*)(args.in[I_CONVB] + 2 * cp);
            for (int tile = bid; tile < NTOK / 32; tile += G) {
                const int t0 = tile * 32, s0 = t0 & (SEQ - 1);
                for (int i = tid; i < 62 * 64; i += NTHR) { const int r = i >> 6, c8 = i & 63; const int sr = s0 - 30 + r;
                    u32x4 v = (u32x4){0u, 0u, 0u, 0u}; if (sr >= 0) v = *(const u32x4*)(Ub + (size_t)(t0 - 30 + r) * 512 + c8 * 8);
                    *(LAS u32x4*)(ut + r * 512 + c8 * 8) = v; }
                __syncthreads();
                {
                    float a0[16], a1[16];
#pragma unroll
                    for (int t = 0; t < 16; ++t) { a0[t] = cbv.x; a1[t] = cbv.y; }
#pragma unroll
                    for (int r = 0; r < 46; ++r) { const unsigned uv = *(const LAS unsigned*)(ut + (th * 16 + r) * 512 + 2 * cp); const float u0 = bf_lo(uv), u1 = bf_hi(uv);
#pragma unroll
                        for (int t = 0; t < 16; ++t) { const int j = r - t; if (j >= 0 && j < 31) { a0[t] += w0[j] * u0; a1[t] += w1[j] * u1; } } }
#pragma unroll
                    for (int t = 0; t < 16; ++t) *(LAS f32x2*)(yt + (th * 16 + t) * 512 + 2 * cp) = (f32x2){a0[t], a1[t]};
                }
                __syncthreads();
                const float* lg = args.in[I_CLNG]; const float* lb = args.in[I_CLNB];
#pragma unroll
                for (int tt = 0; tt < 4; ++tt) { const int t = wave * 4 + tt;
                    f32x4 a = *(LAS f32x4*)(yt + t * 512 + lane * 8), b = *(LAS f32x4*)(yt + t * 512 + lane * 8 + 4);
                    float s = (a[0] + a[1]) + (a[2] + a[3]) + (b[0] + b[1]) + (b[2] + b[3]); const float mean = wave_sum(s) * (1.f / 512.f);
                    a = a - mean; b = b - mean; float s2 = a[0] * a[0] + a[1] * a[1] + a[2] * a[2] + a[3] * a[3] + b[0] * b[0] + b[1] * b[1] + b[2] * b[2] + b[3] * b[3];
                    const float rstd = 1.f / sqrtf(wave_sum(s2) * (1.f / 512.f) + LN_EPS);
                    const f32x4 g0 = *(const f32x4*)(lg + lane * 8), g1 = *(const f32x4*)(lg + lane * 8 + 4), b0 = *(const f32x4*)(lb + lane * 8), b1 = *(const f32x4*)(lb + lane * 8 + 4);
                    a = a * rstd * g0 + b0; b = b * rstd * g1 + b1;
#pragma unroll
                    for (int j = 0; j < 4; ++j) { a[j] = a[j] * sigmoidf_(a[j]); b[j] = b[j] * sigmoidf_(b[j]); }
                    *(u32x4*)(MIXIN + (size_t)(t0 + t) * DM + lane * 8) = pg8::pack8(a, b); }
                __syncthreads();
            }
        }
        {
            constexpr int CAP = 512, HROW = 2052;
            LAS unsigned* hist = (LAS unsigned*)lds;
            LAS unsigned* clist = hist;
            LAS unsigned* mtile = (LAS unsigned*)(lds + 16 * HROW * 4);
            LAS unsigned* rinfo = mtile + 2048;
            LAS unsigned* ccnt = rinfo + 64;
            LAS unsigned* flag = rinfo + 80;
            LAS unsigned* rsel = rinfo + 96;
            LAS unsigned* whist = rinfo + 256 + wave * 256;
            const int vcu = (G % 8 == 0) ? (bid % 8) * (G / 8) + bid / 8 : bid;
            const int lane_p = lane;
            for (int it = 0; it < 8 && vcu < 256; ++it) {
                int lane = lane_p; asm volatile("" : "+v"(lane));
                const int tid = wave * 64 + lane, g4 = lane >> 4, r16 = lane & 15;
                const int b = it, qt = (it & 1) ? 255 - vcu : vcu;
                const int q0 = qt * 16, tok0 = b * SEQ + q0, nwords = (q0 + 15) / 64 + 1, q = q0 + r16;
                if (q0 < 256) {
                    for (int i = tid; i < 16 * nwords; i += NTHR) { const int r = i & 15, W = i >> 4; const int d = q0 + r - 64 * W;
                        const u64 word = d >= 63 ? ~0ull : (d < 0 ? 0ull : ((2ull << d) - 1ull));
                        MASK[((size_t)b * 64 + W) * SEQ + q0 + r] = word; }
                    continue;
                }
                for (int i = tid; i < 16 * 64 * 2; i += NTHR) mtile[i] = 0u;
                if (tid < 16) ccnt[tid] = 0u;
                unsigned prefix = 0u; int shift = 21, shift_prev = 32, level = 0; bool collect = false;
#define KLOAD(dst, st_) do { const int W_ = wave + 8 * ((st_) >> 1), hf_ = (st_) & 1; _Pragma("unroll") for (int u_ = 0; u_ < 2; ++u_) _Pragma("unroll") for (int c2_ = 0; c2_ < 2; ++c2_) \
                    dst[u_][c2_] = *(const bf16x8*)(KI + ((size_t)b * SEQ + 64 * W_ + 32 * hf_ + 16 * u_ + r16) * 64 + c2_ * 32 + g4 * 8); } while (0)
#define FIRST_PASS() do { \
                    bf16x8 Qf[8][2]; float wq[8]; \
                    _Pragma("unroll") for (int h = 0; h < 8; ++h) _Pragma("unroll") for (int c2 = 0; c2 < 2; ++c2) Qf[h][c2] = *(const bf16x8*)(QI + (size_t)(tok0 + r16) * 512 + h * 64 + c2 * 32 + g4 * 8); \
                    { const f32x4 w0 = *(const f32x4*)(WI + (size_t)(tok0 + r16) * 8), w1 = *(const f32x4*)(WI + (size_t)(tok0 + r16) * 8 + 4); \
                      wq[0] = w0[0]; wq[1] = w0[1]; wq[2] = w0[2]; wq[3] = w0[3]; wq[4] = w1[0]; wq[5] = w1[1]; wq[6] = w1[2]; wq[7] = w1[3]; } \
                    bf16x8 Kc[2][2], Kn[2][2]; \
                    if (nmine > 0) KLOAD(Kc, 0); \
                    for (int st = 0; st < 2 * nmine; ++st) { \
                        const int c = st >> 1, hf = st & 1, W = wave + 8 * c; \
                        if (st + 1 < 2 * nmine) KLOAD(Kn, st + 1); \
                        _Pragma("unroll") for (int tu = 0; tu < 2; ++tu) { \
                            float scv[4] = {0.f, 0.f, 0.f, 0.f}; \
                            _Pragma("unroll") for (int h = 0; h < 8; ++h) { \
                                f32x4 t = __builtin_amdgcn_mfma_f32_16x16x32_bf16(Kc[tu][0], Qf[h][0], (f32x4){0.f, 0.f, 0.f, 0.f}, 0, 0, 0); \
                                t = __builtin_amdgcn_mfma_f32_16x16x32_bf16(Kc[tu][1], Qf[h][1], t, 0, 0, 0); \
                                _Pragma("unroll") for (int i = 0; i < 4; ++i) { const int ti = __float_as_int(t[i]); scv[i] += wq[h] * __int_as_float(ti > 0 ? ti : 0); } \
                            } \
                            const int dq = q - (64 * W + 32 * hf + 16 * tu + 4 * g4);            \
                            u32x4 key; \
                            _Pragma("unroll") for (int i = 0; i < 4; ++i) { const unsigned uu = __float_as_uint(scv[i] + 0.0f); key[i] = (dq >= i) ? (uu ^ ((unsigned)((int)uu >> 31) | 0x80000000u)) : 0u; }     \
                            ksp[(c * 4 + hf * 2 + tu) * 64] = key; \
                            _Pragma("unroll") for (int i = 0; i < 4; ++i) { const unsigned a_ = key[i] ? ((key[i] >> 21) << 2) : (2050u << 2); \
                                asm volatile("ds_add_u32 %0, %1" :: "v"(hrow + a_), "v"(1u) : "memory"); } \
                        } \
                        _Pragma("unroll") for (int u = 0; u < 2; ++u) { Kc[u][0] = Kn[u][0]; Kc[u][1] = Kn[u][1]; } \
                    } } while (0)
#define LATER_PASS() do { \
                    for (int c = 0; c < nmine; ++c) { \
                        const int W = wave + 8 * c; \
                        u32x4 kk4[4]; \
                        _Pragma("unroll") for (int u = 0; u < 4; ++u) kk4[u] = ksp[(c * 4 + u) * 64]; \
                        unsigned braw0 = 0u, braw1 = 0u; \
                        _Pragma("unroll") for (int u = 0; u < 4; ++u) { \
                            if (!collect) { \
                                _Pragma("unroll") for (int i = 0; i < 4; ++i) { const unsigned key = kk4[u][i]; const bool m_ = key != 0u && (((key ^ prefix) & pmask) == 0u); const unsigned a_ = m_ ? (((key >> shift) & bmask) << 2) : (2050u << 2); \
                                    asm volatile("ds_add_u32 %0, %1" :: "v"(hrow + a_), "v"(1u) : "memory"); } \
                            } else { \
                                _Pragma("unroll") for (int i = 0; i < 4; ++i) { const unsigned key = kk4[u][i]; const bool valid = key != 0u; const unsigned kb_ = key >> shift, pb_ = prefix >> shift; \
                                    const unsigned bit_ = (valid && kb_ > pb_) ? (1u << (16 * (u & 1) + i)) : 0u; if (u < 2) braw0 |= bit_; else braw1 |= bit_; \
                                    if (valid && kb_ == pb_) { const unsigned pos = __hip_atomic_fetch_add((unsigned*)(ccnt + r16), 1u, __ATOMIC_RELAXED, __HIP_MEMORY_SCOPE_WORKGROUP); \
                                        if (pos < (unsigned)CAP) { clist[(r16 * CAP + pos) * 2] = key; clist[(r16 * CAP + pos) * 2 + 1] = (unsigned)(64 * W + 16 * u + 4 * g4 + i); } } } \
                            } \
                        } \
                        if (collect) { \
                            unsigned b0 = braw0 << (4 * g4), b1 = braw1 << (4 * g4); \
                            b0 |= (unsigned)__builtin_amdgcn_ds_swizzle((int)b0, (16 << 10) | 0x1f); b1 |= (unsigned)__builtin_amdgcn_ds_swizzle((int)b1, (16 << 10) | 0x1f); \
                            { auto r0 = __builtin_amdgcn_permlane32_swap(b0, b0, false, false); b0 = r0[0] | r0[1]; auto r1 = __builtin_amdgcn_permlane32_swap(b1, b1, false, false); b1 = r1[0] | r1[1]; } \
                            if (lane < 16) { mtile[(lane * 64 + W) * 2] = b0; mtile[(lane * 64 + W) * 2 + 1] = b1; } \
                        } \
                    } } while (0)
                const int nmine = (nwords > wave) ? ((nwords - wave + 7) >> 3) : 0;
                const int lane_q = lane;
                for (int pass = 0; pass < 4; ++pass) {
                    int lane = lane_q; asm volatile("" : "+v"(lane));
                    const int tid = wave * 64 + lane, g4 = lane >> 4, r16 = lane & 15, q = q0 + r16;
                    const unsigned hrow = (unsigned)(uintptr_t)(hist + r16 * HROW);
                    if (!collect) { for (int i = tid; i < 16 * HROW; i += NTHR) hist[i] = 0u; if (tid < 4) flag[tid] = 0u; }
                    const unsigned bmask = (level == 2) ? 1023u : 2047u, pmask = (level == 0) ? 0u : (level == 1) ? 0xFFE00000u : 0xFFFFFC00u;
                    __syncthreads();
                    u32x4* ksp = (u32x4*)(ws + WS_KS) + ((size_t)(vcu * 8 + wave) * 32) * 64 + lane;
                    if (pass == 0) FIRST_PASS(); else LATER_PASS();
                    __syncthreads();
                    if (collect) break;
                    {
                        const int row = tid >> 5, seg = tid & 31; const LAS unsigned* hr = hist + row * HROW + seg * 64;
                        unsigned tot = 0u;
#pragma unroll 8
                        for (int j = 0; j < 64; ++j) tot += hr[j];
                        unsigned inc = tot;
#pragma unroll
                        for (int o = 1; o < 32; o <<= 1) { const unsigned t = lane_get(inc, (lane & 32) | ((seg + o) & 31)); if (seg + o < 32) inc += t; }
                        const unsigned exc = inc - tot, kk = (level == 0) ? 256u : rinfo[row * 4 + 1], pfx = (level == 0) ? 0u : rinfo[row * 4 + 0];
                        if (exc < kk && inc >= kk) {
                            unsigned cum = exc, bin = 0u, kn = kk, cb = 0u; bool done = false;
#pragma unroll 1
                            for (int j = 63; j >= 0 && !done; --j) { const unsigned cj = hr[j];
                                if (cum + cj >= kk) { bin = seg * 64 + j; kn = kk - cum; cb = cj; done = true; } else cum += cj; }
                            rinfo[row * 4 + 0] = pfx | (bin << shift); rinfo[row * 4 + 1] = kn; rinfo[row * 4 + 2] = cb;
                            if (cb > (unsigned)CAP && level < 2) __hip_atomic_fetch_or((unsigned*)flag, 1u, __ATOMIC_RELAXED, __HIP_MEMORY_SCOPE_WORKGROUP);
                        }
                    }
                    __syncthreads();
                    prefix = rinfo[r16 * 4 + 0];
                    const unsigned more = flag[0];
                    __syncthreads();
                    if (more) { shift_prev = shift; ++level; shift = (level == 1) ? 10 : 0; } else collect = true;
                }
#undef FIRST_PASS
#undef LATER_PASS
#undef KLOAD
                for (int rr = 0; rr < 2; ++rr) {
                    int lane = lane_q; asm volatile("" : "+v"(lane));
                    const int row = wave * 2 + rr; unsigned cc = ccnt[row]; cc = cc > (unsigned)CAP ? (unsigned)CAP : cc; const int cn = (int)cc;
                    const LAS unsigned* cl = clist + row * CAP * 2;
                    unsigned pf = 0u; int kk = (int)rinfo[row * 4 + 1]; unsigned ties = 0u;
                    if (kk > cn) kk = cn;
                    if (kk > 0) {
                    for (int ps = 0; ps < 4; ++ps) {
                        const int sh = 24 - 8 * ps;
#pragma unroll
                        for (int j = 0; j < 4; ++j) whist[lane * 4 + j] = 0u;
                        WAVE_LDS_FENCE();
                        for (int i = lane; i < cn; i += 64) { const unsigned key = cl[i * 2];
                            const bool m = (ps == 0) || ((key >> (sh + 8)) == (pf >> (sh + 8)));
                            if (m) __hip_atomic_fetch_add((unsigned*)(whist + ((key >> sh) & 255u)), 1u, __ATOMIC_RELAXED, __HIP_MEMORY_SCOPE_WORKGROUP); }
                        WAVE_LDS_FENCE();
                        const unsigned c0 = whist[lane * 4 + 0], c1 = whist[lane * 4 + 1], c2 = whist[lane * 4 + 2], c3 = whist[lane * 4 + 3];
                        const unsigned sl = c0 + c1 + c2 + c3; unsigned inc = sl;
#pragma unroll
                        for (int o = 1; o < 64; o <<= 1) { const unsigned t = lane_get(inc, (lane + o) & 63); if (lane + o < 64) inc += t; }
                        const unsigned exc = inc - sl;
                        const bool found = (exc < (unsigned)kk) && (inc >= (unsigned)kk);
                        int bin = 0, kn = 0; unsigned cb = 0u;
                        { unsigned cum = exc;
                          if (cum + c3 >= (unsigned)kk) { bin = 3; kn = kk - (int)cum; cb = c3; } else { cum += c3;
                          if (cum + c2 >= (unsigned)kk) { bin = 2; kn = kk - (int)cum; cb = c2; } else { cum += c2;
                          if (cum + c1 >= (unsigned)kk) { bin = 1; kn = kk - (int)cum; cb = c1; } else { cum += c1; bin = 0; kn = kk - (int)cum; cb = c0; } } } }
                        const u64 fm = __ballot(found); const int src = fm ? (__ffsll((long long)fm) - 1) : 0;
                        bin = (int)lane_get((unsigned)(lane * 4 + bin), src); kk = (int)lane_get((unsigned)kn, src); ties = lane_get(cb, src);
                        pf |= ((unsigned)bin) << sh;
                        WAVE_LDS_FENCE();
                    }
                    unsigned cut = 0xFFFFFFFFu;
                    if (ties > (unsigned)kk) {
                        for (int i = lane; i < cn; i += 64) { if (cl[i * 2] == pf) { const unsigned myi = cl[i * 2 + 1]; int rank = 0;
                                for (int j = 0; j < cn; ++j) rank += (cl[j * 2] == pf && cl[j * 2 + 1] < myi) ? 1 : 0;
                                if (rank == kk - 1) rsel[row * 2 + 1] = myi; } }
                        WAVE_LDS_FENCE();
                        cut = rsel[row * 2 + 1];
                    }
                    for (int i = lane; i < cn; i += 64) { const unsigned key = cl[i * 2], kidx = cl[i * 2 + 1];
                        if (key > pf || (key == pf && kidx <= cut)) __hip_atomic_fetch_or((unsigned*)(mtile + (row * 64 + (kidx >> 6)) * 2 + ((kidx >> 5) & 1u)), 1u << (kidx & 31u), __ATOMIC_RELAXED, __HIP_MEMORY_SCOPE_WORKGROUP); }
                    }
                }
                __syncthreads();
                for (int i = tid; i < 16 * nwords; i += NTHR) { const int r = i & 15, W = i >> 4;
                    MASK[((size_t)b * 64 + W) * SEQ + q0 + r] = (u64)mtile[(r * 64 + W) * 2] | ((u64)mtile[(r * 64 + W) * 2 + 1] << 32); }
                __syncthreads();
            }
        }
        if (BOTH(2)) GRID_BAR();
    }

    if (IN(3)) { asm volatile("; PHASE_MARK 3"); PHASE_BEGIN
        const int vcu = (G % 8 == 0) ? (bid % 8) * (G / 8) + bid / 8 : bid;
        if (vcu < 256) {
            const int pp = vcu & 3, h = (vcu >> 2) & 7, b = vcu >> 5;
            { float* tb = (float*)(lds_raw + dsa::LDS_TB);
              for (int i = tid; i < dsa::TB_PAD + 4096; i += NTHR) tb[i] = (i >= dsa::TB_PAD) ? BIAST[h * 4096 + (i - dsa::TB_PAD)] * 8.0f : 0.f; }
            const bf16_t* Kp = K0 + (size_t)b * SEQ * 512 + h * 64; const bf16_t* Vp = V0 + (size_t)b * SEQ * 512 + h * 64;
#define DSA_REF(R, i_) do { const int qb_ = ((i_) == 0) ? pp : ((i_) == 1) ? 15 - pp : ((i_) == 2) ? pp + 4 : 11 - pp; const int P0_ = qb_ * 256; \
            R.Q = Q0 + ((size_t)b * SEQ + P0_) * 512 + h * 64; R.K = Kp; R.V = Vp; R.O = MIXIN + ((size_t)b * SEQ + P0_) * DM + 512 + h * 64; \
            R.MW = MASK + (size_t)b * 64 * SEQ + P0_; R.P0 = P0_; } while (0)
            dsa::Seam SS; dsa::BlockRef cur, nxt; DSA_REF(cur, 0);
            dsa::dsa_prime(cur, (char*)lds_raw, SS, tid);
            for (int i = 0; i < 4; ++i) {
                if (i < 3) { DSA_REF(nxt, i + 1); } else nxt = cur;
                dsa::dsa_block(cur, nxt, (char*)lds_raw, SS, tid);
                cur = nxt;
            }
#undef DSA_REF
        }
        if (BOTH(3)) GRID_BAR();
    }
    if (IN(4)) { asm volatile("; PHASE_MARK 4"); PHASE_BEGIN
        pg8::StaticOrder S; S.init(MIXIN, NTOK, DM, DM, G, bid);
        pg8::EpiRes E{(bf16_t*)outp, XB};
        pg8::gemm_phase<pg8::EpiRes, pg8::StaticOrder, true, false>(tid, lds, WOUT0, DM, DM, S, E, GTAB);
        if (BOTH(4)) GRID_BAR();
    }
    if (IN(5)) { asm volatile("; PHASE_MARK 5"); PHASE_BEGIN
        for (int m = gw; m < NTOK; m += NGW) { f32x4 v[4];
#pragma unroll
            for (int j = 0; j < 4; ++j) v[j] = ld_bf4((const bf16_t*)outp + (size_t)m * DM + 4 * lane + 256 * j);
            ln_core(v, args.in[I_ELN1G], args.in[I_ELN1B], lane); store_row_bf16(X1B + (size_t)m * DM, v, lane); }
        if (BOTH(5)) GRID_BAR();
    }
    if (IN(6)) { asm volatile("; PHASE_MARK 6"); PHASE_BEGIN
        pg8::StaticOrder S; S.init(X1B, NTOK, 2 * FF0, DM, G, bid);
        pg8::EpiSwiglu<false> E{H0, FF0, (char*)outp, (char*)ws};
        pg8::gemm_phase<pg8::EpiSwiglu<false>, pg8::StaticOrder, true, false>(tid, lds, WGU0, DM, DM, S, E, GTAB);
        if (BOTH(6)) GRID_BAR();
    }
    if (IN(7)) { asm volatile("; PHASE_MARK 7"); PHASE_BEGIN
        pg8::StaticOrder S; S.init(H0, NTOK, DM, FF0, G, bid);
        pg8::EpiRes E{(bf16_t*)outp, X1B};
        pg8::gemm_phase<pg8::EpiRes, pg8::StaticOrder, true, false>(tid, lds, WD0, FF0, FF0, S, E, GTAB);
        if (BOTH(7)) GRID_BAR();
    }
    if (IN(8)) { asm volatile("; PHASE_MARK 8"); PHASE_BEGIN
        for (int m = gw; m < NTOK; m += NGW) { f32x4 v[4];
#pragma unroll
            for (int j = 0; j < 4; ++j) v[j] = ld_bf4((const bf16_t*)outp + (size_t)m * DM + 4 * lane + 256 * j);
            ln_core(v, args.in[I_ELN2G], args.in[I_ELN2B], lane); store_row_bf16(X2B + (size_t)m * DM, v, lane); }
        if (BOTH(8)) GRID_BAR();
    }
#define MERGE_CHUNK(chm) do { \
        const bf16_t* OPp = (const bf16_t*)(ws + WS_OP); const float* LSEp = (const float*)(ws + WS_LSE); \
        for (int tl = gw; tl < CHUNK_T; tl += NGW) { const int hh = lane >> 3; \
            const float l0 = LSEp[(size_t)tl * 8 + hh], l1 = LSEp[((size_t)CHUNK_T + tl) * 8 + hh], l2 = LSEp[((size_t)2 * CHUNK_T + tl) * 8 + hh]; \
            const float mm = fmaxf(l0, fmaxf(l1, l2)); float w0 = __expf(l0 - mm), w1 = __expf(l1 - mm), w2 = __expf(l2 - mm); const float inv = 1.f / (w0 + w1 + w2); w0 *= inv; w1 *= inv; w2 *= inv; \
            const bf16_t* p0 = OPp + (size_t)tl * DM + lane * 16; const bf16_t* p1 = p0 + (size_t)CHUNK_T * DM; const bf16_t* p2 = p1 + (size_t)CHUNK_T * DM; \
            _Pragma("unroll") for (int q = 0; q < 2; ++q) { const u32x4 a = *(const u32x4*)(p0 + q * 8), b = *(const u32x4*)(p1 + q * 8), c = *(const u32x4*)(p2 + q * 8); u32x4 o; \
                o.x = cvt_pk_bf16(w0 * bf_lo(a.x) + w1 * bf_lo(b.x) + w2 * bf_lo(c.x), w0 * bf_hi(a.x) + w1 * bf_hi(b.x) + w2 * bf_hi(c.x)); \
                o.y = cvt_pk_bf16(w0 * bf_lo(a.y) + w1 * bf_lo(b.y) + w2 * bf_lo(c.y), w0 * bf_hi(a.y) + w1 * bf_hi(b.y) + w2 * bf_hi(c.y)); \
                o.z = cvt_pk_bf16(w0 * bf_lo(a.z) + w1 * bf_lo(b.z) + w2 * bf_lo(c.z), w0 * bf_hi(a.z) + w1 * bf_hi(b.z) + w2 * bf_hi(c.z)); \
                o.w = cvt_pk_bf16(w0 * bf_lo(a.w) + w1 * bf_lo(b.w) + w2 * bf_lo(c.w), w0 * bf_hi(a.w) + w1 * bf_hi(b.w) + w2 * bf_hi(c.w)); \
                *(u32x4*)(O1 + ((size_t)(chm) * CHUNK_T + tl) * DM + lane * 16 + q * 8) = o; } } } while (0)
#pragma unroll
    for (int ch = 0; ch < 2; ++ch) {
        if (IN(9 + 2 * ch)) { asm volatile("; PHASE_MARK 9"); PHASE_BEGIN
            if (ch == 1) { MERGE_CHUNK(0); }
            pg8::StaticOrder S; S.init(X2B + (size_t)ch * CHUNK_T * DM, CHUNK_T, IN1_N, DM, G, bid);
            pg8::EpiQkv1 E{H1, IN1_N, 1.0f};
            pg8::gemm_phase<pg8::EpiQkv1, pg8::StaticOrder, true, false>(tid, lds, WIN1, DM, DM, S, E, GTAB);
            if (BOTH(9 + 2 * ch)) GRID_BAR();
        }
        if (IN(10 + 2 * ch)) { asm volatile("; PHASE_MARK 10"); PHASE_BEGIN
            constexpr int NU = CHUNK_B * 8 * 3 * 16;
            const int vcu = (G % 8 == 0) ? (bid % 8) * (G / 8) + bid / 8 : bid;
            bf16_t* OPp = (bf16_t*)(ws + WS_OP); float* LSEp = (float*)(ws + WS_LSE);
            int L0 = vcu;
            if (L0 < NU) {
                swa::Seam SS; swa::BlockRef cur = dil_ref(L0, H1, OPp, LSEp);
                swa::swa_prime(cur, BIAST, (char*)lds_raw, SS, tid);
                int slot = 0;
                for (;;) {
                    const int Ln = L0 + G; const bool last = Ln >= NU;
                    const swa::BlockRef nxt = last ? cur : dil_ref(Ln, H1, OPp, LSEp);
                    swa::swa_block(cur, nxt, BIAST, slot, (char*)lds_raw, SS, tid);
                    if (last) break;
                    cur = nxt; L0 = Ln; slot ^= 1;
                }
            }
            if (BOTH(10 + 2 * ch)) GRID_BAR();
        }
    }
    if (IN(13)) { asm volatile("; PHASE_MARK 13"); PHASE_BEGIN
        MERGE_CHUNK(1);
        if (BOTH(13)) GRID_BAR();
    }
    if (IN(14)) { asm volatile("; PHASE_MARK 14"); PHASE_BEGIN
        pg8::StaticOrder S; S.init(O1, NTOK, DM, DM, G, bid);
        pg8::EpiRes E{(bf16_t*)Y3, X2B};
        pg8::gemm_phase<pg8::EpiRes, pg8::StaticOrder, true, false>(tid, lds, WOUT1, DM, DM, S, E, GTAB);
        if (BOTH(14)) GRID_BAR();
    }
    if (IN(15)) { asm volatile("; PHASE_MARK 15"); PHASE_BEGIN
        const float* rt = args.in[I_ROUTER];
        LAS unsigned* lcnt = (LAS unsigned*)lds;
        LAS unsigned* lbase = lcnt + 8;
        LAS int* lrow = (LAS int*)(lds + 256);
        LAS float* lgate = (LAS float*)(lds + 256 + 16384);
        if (tid < 8) lcnt[tid] = 0u;
        { int* ym = (int*)(ws + WS_YMAP); for (int i = bid * NTHR + tid; i < 2 * NTOK; i += G * NTHR) ym[i] = -1; }
        __syncthreads();
        int nloc = 0;
        for (int m = gw; m < NTOK; m += NGW, ++nloc) { f32x4 v[4];
#pragma unroll
            for (int j = 0; j < 4; ++j) v[j] = ld_bf4((const bf16_t*)Y3 + (size_t)m * DM + 4 * lane + 256 * j);
            ln_core(v, args.in[I_OLN1G], args.in[I_OLN1B], lane); store_row_bf16(X3B + (size_t)m * DM, v, lane);
            float lgt[8];
#pragma unroll
            for (int e = 0; e < 8; ++e) lgt[e] = 0.f;
#pragma unroll
            for (int j = 0; j < 4; ++j)
#pragma unroll
                for (int i = 0; i < 4; ++i) { const float* rr = rt + (size_t)(4 * lane + 256 * j + i) * 8; const f32x4 r0 = *(const f32x4*)rr, r1 = *(const f32x4*)(rr + 4); const float xv = v[j][i];
                    lgt[0] += xv * r0[0]; lgt[1] += xv * r0[1]; lgt[2] += xv * r0[2]; lgt[3] += xv * r0[3]; lgt[4] += xv * r1[0]; lgt[5] += xv * r1[1]; lgt[6] += xv * r1[2]; lgt[7] += xv * r1[3]; }
#pragma unroll
            for (int e = 0; e < 8; ++e) lgt[e] = wave_sum(lgt[e]);
            int e1 = 0; float v1 = lgt[0];
#pragma unroll
            for (int e = 1; e < 8; ++e) if (lgt[e] > v1) { v1 = lgt[e]; e1 = e; }
            int e2 = -1; float v2 = -INFINITY;
#pragma unroll
            for (int e = 0; e < 8; ++e) if (e != e1 && lgt[e] > v2) { v2 = lgt[e]; e2 = e; }
            const float g2 = 1.f / (1.f + __expf(v1 - v2)), g1 = 1.f - g2;
            if (lane == 0) { const int li = nloc * NWAVES + wave;
                const unsigned r1 = __hip_atomic_fetch_add((unsigned*)(lcnt + e1), 1u, __ATOMIC_RELAXED, __HIP_MEMORY_SCOPE_WORKGROUP), r2 = __hip_atomic_fetch_add((unsigned*)(lcnt + e2), 1u, __ATOMIC_RELAXED, __HIP_MEMORY_SCOPE_WORKGROUP);
                lrow[li * 4 + 0] = e1; lrow[li * 4 + 1] = (int)r1; lrow[li * 4 + 2] = e2; lrow[li * 4 + 3] = (int)r2; lgate[li * 2] = g1; lgate[li * 2 + 1] = g2; }
        }
        __syncthreads();
        if (tid < 8) lbase[tid] = atomicAdd(ctl + CW_MOECNT + tid, lcnt[tid]);
        __syncthreads();
        { const int nrows = (NTOK - bid * NWAVES + NGW - 1) / NGW;
          for (int li = tid; li < nrows * NWAVES; li += NTHR) { const int rnd = li / NWAVES, wv = li % NWAVES; const int m = (bid * NWAVES + wv) + rnd * NGW;
            if (m < NTOK) { const int e1 = lrow[li * 4 + 0], e2 = lrow[li * 4 + 2]; const unsigned p1 = lbase[e1] + (unsigned)lrow[li * 4 + 1], p2 = lbase[e2] + (unsigned)lrow[li * 4 + 3];
                if (p1 < (unsigned)NTOK) { MTOK[e1 * NTOK + p1] = m * 2; MGATE[e1 * NTOK + p1] = lgate[li * 2]; }
                if (p2 < (unsigned)NTOK) { MTOK[e2 * NTOK + p2] = m * 2 + 1; MGATE[e2 * NTOK + p2] = lgate[li * 2 + 1]; } } } }
        __syncthreads();
        {
            LAS float* scr = (LAS float*)(lds + wave * 16384);
            constexpr int I_GU = 16 * (2 * FFE / 32), I_D = (FFE / 64) * 32;
            for (int it = gw; it < NEXP * (I_GU + I_D); it += NGW) {
                const int e = it / (I_GU + I_D), r = it % (I_GU + I_D);
                if (r < I_GU) gu_item(args.in[I_MWG] + (size_t)e * DM * FFE, args.in[I_MWU] + (size_t)e * DM * FFE, FFE, DM, MWGU + (size_t)e * 2 * FFE * DM, r, scr, lane);
                else plain_item(args.in[I_MWD] + (size_t)e * FFE * DM, FFE, DM, MWD + (size_t)e * DM * FFE, r - I_GU, scr, lane);
            }
        }
        if (BOTH(15)) GRID_BAR();
    }
#pragma unroll
    for (int ch = 0; ch < 2; ++ch) {
        if (IN(16 + 2 * ch) || IN(17 + 2 * ch)) {
            LAS int* rt = (LAS int*)(lds + LDS_RT);
            int nM;
            { PHASE_BEGIN int ts[9]; int cn[8]; ts[0] = 0;
#pragma unroll
              for (int e = 0; e < 8; ++e) { int ce = __builtin_amdgcn_readfirstlane((int)ctl[CW_MOECNT + e]); ce = ce > NTOK ? NTOK : ce; cn[e] = ce; ts[e + 1] = ts[e] + (ce + 255) / 256; }
              const int t0 = ch * MOE_CH_TILES; int t1 = (ch == 0) ? MOE_CH_TILES : ts[8]; if (t1 > ts[8]) t1 = ts[8]; if (t1 > t0 + 136) t1 = t0 + 136; nM = __builtin_amdgcn_readfirstlane(t1 > t0 ? t1 - t0 : 0);
              if (tid < nM) { const int g = t0 + tid; int e = 0;
#pragma unroll
                  for (int k = 1; k < 8; ++k) e += (g >= ts[k]) ? 1 : 0;
                  int ce = cn[0], tse = ts[0];
#pragma unroll
                  for (int k = 1; k < 8; ++k) { ce = (e == k) ? cn[k] : ce; tse = (e == k) ? ts[k] : tse; }
                  const int j = g - tse; int nv = ce - j * 256; nv = nv > 256 ? 256 : nv;
                  rt[tid * 4 + 0] = e; rt[tid * 4 + 1] = e * NTOK + j * 256; rt[tid * 4 + 2] = nv; rt[tid * 4 + 3] = 0; } }
            __syncthreads();
            if (IN(16 + 2 * ch)) { asm volatile("; PHASE_MARK 16"); PHASE_BEGIN
                pg8::MoeOrder S{G, bid, nM, 2 * FFE / 256, rt, (const char*)X3B, (char*)outp, (char*)ws, true};
                LAS int* gtab = (LAS int*)(lds + LDS_GTAB);
                { pg8::Unit u; for (int i = 0; i < 16 && S.next(i, u); ++i) { if (tid < 256) { const int lb = rt[u.pm * 4 + 1], nv = rt[u.pm * 4 + 2]; const int r = tid < nv ? tid : 0; gtab[i * 256 + tid] = MTOK[lb + r] >> 1; } } }
                __syncthreads();
                pg8::EpiSwiglu<true> E{H0, FFE, (char*)outp, (char*)ws};
                pg8::gemm_phase<pg8::EpiSwiglu<true>, pg8::MoeOrder, true, true>(tid, lds, MWGU, DM, DM, S, E, gtab);
                if (BOTH(16 + 2 * ch)) GRID_BAR();
            }
            if (IN(17 + 2 * ch)) { asm volatile("; PHASE_MARK 17"); PHASE_BEGIN
                const int nReg = nM < MOE_CH_TILES ? nM : MOE_CH_TILES, nL = nM - nReg;
                {
                    pg8::MoeOrder S{G, bid, nReg, DM / 256, rt, (const char*)X3B, (char*)outp, (char*)ws, false};
                    pg8::EpiMoeDown E{YB, MTOK, MGATE, rt};
                    pg8::gemm_phase<pg8::EpiMoeDown, pg8::MoeOrder, true, false>(tid, lds, MWD, FFE, FFE, S, E, GTAB);
                }
                if (nL > 0) {
                    if (bid < nL && tid < 256) { const int lb = rt[(MOE_CH_TILES + bid) * 4 + 1], nv = rt[(MOE_CH_TILES + bid) * 4 + 2];
                        if (tid < nv) { const int tk = MTOK[lb + tid]; int* ym = (int*)(ws + WS_YMAP); float* yg = (float*)(ws + WS_YMAP) + 2 * NTOK;
                            ym[(tk & 1) * NTOK + (tk >> 1)] = bid * 256 + tid; yg[(tk & 1) * NTOK + (tk >> 1)] = MGATE[lb + tid]; } }
                    pg8::LeftOrder S{G, bid, nL, rt, (char*)outp, (char*)ws};
                    pg8::EpiSlab E{(bf16_t*)(ws + WS_SLAB)};
                    pg8::gemm_phase<pg8::EpiSlab, pg8::LeftOrder, true, false>(tid, lds, MWD, MOE_KSLICE, FFE, S, E, GTAB);
                }
                if (BOTH(17 + 2 * ch)) GRID_BAR();
            }
        }
    }
    if (IN(20)) { asm volatile("; PHASE_MARK 20"); PHASE_BEGIN
        for (int m = gw; m < NTOK; m += NGW) { f32x4 v[4];
#pragma unroll
            for (int j = 0; j < 4; ++j) { const size_t o = (size_t)m * DM + 4 * lane + 256 * j; v[j] = ld_bf4(X3B + o) * ALPHA; }
            const int* ym = (const int*)(ws + WS_YMAP); const float* yg = (const float*)(ws + WS_YMAP) + 2 * NTOK;
#pragma unroll
            for (int k = 0; k < 2; ++k) { const int sr = __builtin_amdgcn_readfirstlane(ym[k * NTOK + m]);
                if (sr < 0) {
#pragma unroll
                    for (int j = 0; j < 4; ++j) v[j] += ld_bf4(YB + (size_t)k * NTOK * DM + (size_t)m * DM + 4 * lane + 256 * j);
                } else {
                    const float g = yg[k * NTOK + m]; const bf16_t* sl = (const bf16_t*)(ws + WS_SLAB) + (size_t)sr * DM;
                    for (int ks = 0; ks < MOE_KS; ++ks)
#pragma unroll
                        for (int j = 0; j < 4; ++j) v[j] += ld_bf4(sl + (size_t)ks * 8 * 256 * DM + 4 * lane + 256 * j) * g;
                } }
            ln_core(v, args.in[I_OLN2G], args.in[I_OLN2B], lane);
#pragma unroll
            for (int j = 0; j < 4; ++j) *(f32x4*)(outp + (size_t)m * DM + 4 * lane + 256 * j) = v[j]; }
    }
#undef IN
#undef BOTH
}

constexpr int NPHASES = 21;
extern "C" void kernel_launch(void* const* d_in, const int* in_sizes, int n_in, void* d_out, int out_size, void* d_ws, size_t ws_size, hipStream_t stream) {
    static int grid = 0;
    if (grid == 0) {
        if (n_in != 25 || out_size != NTOK * DM || ws_size < WS_END) { fprintf(stderr, "kernel_launch: unexpected shapes (n_in %d out %d ws %zu)\n", n_in, out_size, ws_size); grid = -1; return; }
        int dev = 0, cus = 0;
        if (hipGetDevice(&dev) != hipSuccess || hipDeviceGetAttribute(&cus, hipDeviceAttributeMultiprocessorCount, dev) != hipSuccess) { grid = -1; return; }
        if (hipFuncSetAttribute((const void*)fwd_kernel, hipFuncAttributeMaxDynamicSharedMemorySize, LDS_BYTES) != hipSuccess) { fprintf(stderr, "kernel_launch: hipFuncSetAttribute failed\n"); grid = -1; return; }
        int per_cu = 0;
        if (hipOccupancyMaxActiveBlocksPerMultiprocessor(&per_cu, (const void*)fwd_kernel, NTHR, LDS_BYTES) != hipSuccess || per_cu < 1) { fprintf(stderr, "kernel_launch: occupancy query says %d\n", per_cu); }
        (void)hipGetLastError();
        grid = cus;
    }
    if (grid < 0) return;
    (void)hipMemsetAsync((char*)d_ws + WS_CTL, 0, CTL_ZERO_BYTES, stream);
    Args a{};
    for (int i = 0; i < 25; ++i) a.in[i] = (const float*)d_in[i];
    a.out = (float*)d_out; a.ws = (unsigned char*)d_ws;
#if ONE_LAUNCH
    a.ph_lo = 0; a.ph_hi = NPHASES;
    hipLaunchKernelGGL(fwd_kernel, dim3(grid), dim3(NTHR), LDS_BYTES, stream, a);
#else
    for (int ph = 0; ph < NPHASES; ++ph) { a.ph_lo = ph; a.ph_hi = ph + 1; for (int rep = 0; rep < (((DUP_MASK) >> ph) & 1u ? 2 : 1); ++rep) hipLaunchKernelGGL(fwd_kernel, dim3(grid), dim3(NTHR), LDS_BYTES, stream, a); }
#endif
}
```
